# Optimizing an MI355X kernel written in HIP

```python
import jax, jax.numpy as jnp
from jax import lax
import numpy as np

D_MODEL = 1024
BATCH = 2
SEQ = 8192
DEPTH = 1
DEC_BATCH = 128
DEC_SEQ = 8
PAST_LEN = 2048
PAGE_SIZE = 128

D_MIX = D_MODEL
HG_HEADS = 8
HG_DK = 64
HG_DV = 64
HG_QK = HG_HEADS * HG_DK
HG_WIDTH = HG_HEADS * HG_DV
HG_CHUNK = 64
SB_HEADS = 8
SB_DH = 64
SB_WIDTH = SB_HEADS * SB_DH
SB_QBLOCK = 128
SB_SCALE = SB_DH ** -0.5
SB_BIAS_INIT = -7.0
N_MEM = 256
CA_HEADS = 4
CA_DH = D_MODEL // CA_HEADS
D_FF = 2816
CONV_W = 3
RMS_EPS = 1e-6
D_IN = 2 * HG_QK + 2 * HG_WIDTH + 3 * SB_WIDTH

kernel_name = "hymba_hgrn2_stickbreaking_convffn_step"


def rmsnorm(x, g):
    xf = x.astype(jnp.float32)
    y = xf * lax.rsqrt(jnp.mean(xf * xf, axis=-1, keepdims=True) + RMS_EPS)
    return (y * g.astype(jnp.float32)).astype(x.dtype)


def hgrn2_recurrence(q, logf, k, v, s0, chunk):
    n, t, h, dk = q.shape
    dv = v.shape[-1]
    nc = t // chunk

    def to_chunks(a):
        return a.reshape(n, nc, chunk, h, a.shape[-1]).transpose(1, 0, 2, 3, 4)

    causal = jnp.tril(jnp.ones((chunk, chunk), dtype=bool))[None, :, :, None, None]

    def step(s, inp):
        qc, lfc, kc, vc = inp
        b = jnp.cumsum(lfc, axis=1)
        o_inter = jnp.einsum('nthk,nhkv->nthv', qc * jnp.exp(b), s)
        diff = jnp.where(causal, b[:, :, None] - b[:, None, :], 0.0)
        decay = jnp.where(causal, jnp.exp(diff), 0.0)
        att = jnp.einsum('nthk,ntshk,nshk->nhts', qc, decay, kc)
        o_intra = jnp.einsum('nhts,nshv->nthv', att, vc)
        b_last = b[:, -1]
        s_new = jnp.exp(b_last)[..., None] * s + jnp.einsum(
            'nshk,nshv->nhkv', kc * jnp.exp(b_last[:, None] - b), vc)
        return s_new, o_inter + o_intra

    s_t, o = lax.scan(step, s0, (to_chunks(q), to_chunks(logf), to_chunks(k), to_chunks(v)))
    return o.transpose(1, 0, 2, 3, 4).reshape(n, t, h, dv), s_t


def sb_attend(q, k, v, bias, q_pos, k_pos):
    z = jnp.einsum('nqhd,nkhd->nhqk', q.astype(jnp.float32), k.astype(jnp.float32)) * SB_SCALE
    z = z + bias.astype(jnp.float32)[None, :, None, None]
    strict = (k_pos[None, :] < q_pos[:, None])[None, None]
    c = jnp.where(strict, jax.nn.log_sigmoid(-z), 0.0)
    later = lax.cumsum(c, axis=3, reverse=True) - c
    a = jnp.where(strict, jnp.exp(jax.nn.log_sigmoid(z) + later), 0.0)
    return jnp.einsum('nhqk,nkhd->nqhd', a, v.astype(jnp.float32))


def stick_breaking(q, k, v, bias, q_offset):
    n, t, h, d = q.shape
    qb = min(SB_QBLOCK, t)
    nb = t // qb
    k_pos = jnp.arange(k.shape[1])

    def one_block(i):
        q_blk = lax.dynamic_slice_in_dim(q, i * qb, qb, axis=1)
        q_pos = q_offset + i * qb + jnp.arange(qb)
        return sb_attend(q_blk, k, v, bias, q_pos, k_pos)

    o = lax.map(one_block, jnp.arange(nb))
    return o.transpose(1, 0, 2, 3, 4).reshape(n, t, h, d)


def token_mix(h, p, lb, s0, past_k, past_v, chunk):
    n, t, _ = h.shape
    f32 = jnp.float32
    proj = h @ p['w_in']
    sizes = [HG_QK, HG_QK, HG_WIDTH, HG_WIDTH, SB_WIDTH, SB_WIDTH, SB_WIDTH]
    cuts = [int(c) for c in np.cumsum(sizes)[:-1]]
    hq, hf, hi, hgate, sq, sk, sv = jnp.split(proj, cuts, axis=-1)
    q = hq.reshape(n, t, HG_HEADS, HG_DK).astype(f32)
    f = lb + (1.0 - lb) * jax.nn.sigmoid(hf.reshape(n, t, HG_HEADS, HG_DK).astype(f32))
    vin = hi.reshape(n, t, HG_HEADS, HG_DV).astype(f32)
    o_hg, s_t = hgrn2_recurrence(q, jnp.log(f), 1.0 - f, vin, s0.astype(f32), chunk)
    o_hg = o_hg * lax.rsqrt(jnp.mean(o_hg * o_hg, axis=-1, keepdims=True) + RMS_EPS)
    o_hg = o_hg.reshape(n, t, HG_WIDTH) * p['hg_norm'].astype(f32) * jax.nn.silu(hgate.astype(f32))
    qs = sq.reshape(n, t, SB_HEADS, SB_DH)
    ks = sk.reshape(n, t, SB_HEADS, SB_DH)
    vs = sv.reshape(n, t, SB_HEADS, SB_DH)
    if past_k is None:
        keys, vals, offset = ks, vs, 0
    else:
        keys = jnp.concatenate([past_k.astype(ks.dtype), ks], axis=1)
        vals = jnp.concatenate([past_v.astype(vs.dtype), vs], axis=1)
        offset = past_k.shape[1]
    o_sb = stick_breaking(qs, keys, vals, p['sb_bias'], offset).reshape(n, t, SB_WIDTH)
    mixed = jnp.concatenate([o_hg, o_sb], axis=-1).astype(h.dtype) @ p['w_o']
    return mixed, s_t, ks, vs


def cross_attend(h, mk, mv, p):
    n, t, _ = h.shape
    q = (h @ p['w_cq']).reshape(n, t, CA_HEADS, CA_DH)
    s = jnp.einsum('nthd,nmhd->nhtm', q.astype(jnp.float32), mk.astype(jnp.float32)) * (CA_DH ** -0.5)
    pr = jax.nn.softmax(s, axis=-1)
    o = jnp.einsum('nhtm,nmhd->nthd', pr, mv.astype(jnp.float32))
    return o.reshape(n, t, CA_HEADS * CA_DH).astype(h.dtype) @ p['w_co']


def conv_ffn(h, p, buf):
    t = h.shape[1]
    u = h @ p['w_up']
    ext = jnp.concatenate([buf.astype(u.dtype), u], axis=1)
    c = p['conv_b'] + sum(p['conv_w'][j] * ext[:, j:j + t] for j in range(CONV_W))
    gate, val = jnp.split(c, 2, axis=-1)
    y = (jax.nn.gelu(gate, approximate=True) * val) @ p['w_down']
    return y, ext[:, t:]


def layer_forward(x, p, lb, s0, past_k, past_v, buf, mk, mv, chunk):
    mixed, s_t, k_new, v_new = token_mix(rmsnorm(x, p['g_mix_pre']), p, lb, s0, past_k, past_v, chunk)
    x = x + rmsnorm(mixed, p['g_mix_post'])
    x = x + rmsnorm(cross_attend(rmsnorm(x, p['g_ca_pre']), mk, mv, p), p['g_ca_post'])
    y, buf_new = conv_ffn(rmsnorm(x, p['g_ffn_pre']), p, buf)
    x = x + rmsnorm(y, p['g_ffn_post'])
    return x, s_t, k_new, v_new, buf_new


def memory_kv(mem, g, w_ck, w_cv):
    n = mem.shape[0]
    mn = rmsnorm(mem, g)
    mk = (mn @ w_ck).reshape(n, N_MEM, CA_HEADS, CA_DH)
    mv = (mn @ w_cv).reshape(n, N_MEM, CA_HEADS, CA_DH)
    return mk, mv


def setup_inputs(seed: int = 0) -> dict:
    key = jax.random.key(seed)
    ks = jax.random.split(key, 32)
    f32 = jnp.float32

    def nrm(k, shape, scale):
        return jax.random.normal(k, shape, f32) * scale

    def gain(k, shape):
        return 1.0 + 0.1 * jax.random.normal(k, shape, f32)

    n_pages = PAST_LEN // PAGE_SIZE
    n_pool = (DEC_BATCH * n_pages * 5) // 4
    perm = jax.random.permutation(ks[0], n_pool)
    page_table = perm[:DEC_BATCH * n_pages].reshape(DEC_BATCH, n_pages).astype(jnp.int32)
    return {
        'x_prompt': nrm(ks[1], (BATCH, SEQ, D_MODEL), 1.0),
        'x_sample': nrm(ks[2], (DEC_BATCH, DEC_SEQ, D_MODEL), 1.0),
        'cache_sb_k': nrm(ks[3], (DEPTH, n_pool, PAGE_SIZE, SB_HEADS, SB_DH), 1.0),
        'cache_sb_v': nrm(ks[4], (DEPTH, n_pool, PAGE_SIZE, SB_HEADS, SB_DH), 1.0),
        'state_hgrn': nrm(ks[5], (DEPTH, DEC_BATCH, HG_HEADS, HG_DK, HG_DV), 0.5),
        'state_ffn_conv': nrm(ks[6], (DEPTH, DEC_BATCH, CONV_W - 1, 2 * D_FF), 1.0),
        'cache_mem_k': nrm(ks[7], (DEPTH, DEC_BATCH, N_MEM, CA_HEADS, CA_DH), 1.0),
        'cache_mem_v': nrm(ks[8], (DEPTH, DEC_BATCH, N_MEM, CA_HEADS, CA_DH), 1.0),
        'page_table': page_table,
        'mem_prompt': nrm(ks[9], (BATCH, N_MEM, D_MODEL), 1.0),
        'w_in': nrm(ks[10], (DEPTH, D_MODEL, D_IN), D_MODEL ** -0.5),
        'hg_norm': gain(ks[11], (DEPTH, HG_WIDTH)),
        'hg_lb': nrm(ks[12], (DEPTH + 1, HG_QK), 0.5),
        'sb_bias': SB_BIAS_INIT + nrm(ks[29], (DEPTH, SB_HEADS), 0.5),
        'w_o': nrm(ks[13], (DEPTH, D_MIX, D_MODEL), D_MIX ** -0.5),
        'g_mix_pre': gain(ks[14], (DEPTH, D_MODEL)),
        'g_mix_post': gain(ks[15], (DEPTH, D_MODEL)),
        'g_ca_pre': gain(ks[16], (DEPTH, D_MODEL)),
        'g_ca_post': gain(ks[17], (DEPTH, D_MODEL)),
        'g_mem': gain(ks[18], (DEPTH, D_MODEL)),
        'w_cq': nrm(ks[19], (DEPTH, D_MODEL, D_MODEL), D_MODEL ** -0.5),
        'w_ck': nrm(ks[20], (DEPTH, D_MODEL, D_MODEL), D_MODEL ** -0.5),
        'w_cv': nrm(ks[21], (DEPTH, D_MODEL, D_MODEL), D_MODEL ** -0.5),
        'w_co': nrm(ks[22], (DEPTH, D_MODEL, D_MODEL), D_MODEL ** -0.5),
        'g_ffn_pre': gain(ks[23], (DEPTH, D_MODEL)),
        'g_ffn_post': gain(ks[24], (DEPTH, D_MODEL)),
        'w_up': nrm(ks[25], (DEPTH, D_MODEL, 2 * D_FF), D_MODEL ** -0.5),
        'conv_w': nrm(ks[26], (DEPTH, CONV_W, 2 * D_FF), CONV_W ** -0.5),
        'conv_b': nrm(ks[27], (DEPTH, 2 * D_FF), 0.01),
        'w_down': nrm(ks[28], (DEPTH, D_FF, D_MODEL), D_FF ** -0.5),
    }


def reference(x_prompt, x_sample, cache_sb_k, cache_sb_v, state_hgrn, state_ffn_conv,
              cache_mem_k, cache_mem_v, page_table, mem_prompt,
              w_in, hg_norm, hg_lb, sb_bias, w_o, g_mix_pre, g_mix_post, g_ca_pre, g_ca_post, g_mem,
              w_cq, w_ck, w_cv, w_co, g_ffn_pre, g_ffn_post, w_up, conv_w, conv_b, w_down):
    n_prompt, seq_len, _ = x_prompt.shape
    n_dec, dec_len, _ = x_sample.shape
    n_pages = page_table.shape[1]
    past_len = n_pages * PAGE_SIZE
    lower_bounds = jnp.cumsum(jax.nn.softmax(hg_lb.astype(jnp.float32), axis=0), axis=0)

    yp, ys = x_prompt, x_sample
    kp_l, vp_l, sp_l, bp_l, mkp_l, mvp_l = [], [], [], [], [], []
    ks_l, vs_l, ss_l, bs_l = [], [], [], []
    for l in range(DEPTH):
        p = {'w_in': w_in[l], 'hg_norm': hg_norm[l], 'sb_bias': sb_bias[l], 'w_o': w_o[l],
             'g_mix_pre': g_mix_pre[l], 'g_mix_post': g_mix_post[l],
             'g_ca_pre': g_ca_pre[l], 'g_ca_post': g_ca_post[l],
             'w_cq': w_cq[l], 'w_co': w_co[l],
             'g_ffn_pre': g_ffn_pre[l], 'g_ffn_post': g_ffn_post[l],
             'w_up': w_up[l], 'conv_w': conv_w[l], 'conv_b': conv_b[l], 'w_down': w_down[l]}
        lb = lower_bounds[l].reshape(HG_HEADS, HG_DK)

        mk_p, mv_p = memory_kv(mem_prompt, g_mem[l], w_ck[l], w_cv[l])
        s0_p = jnp.zeros((n_prompt, HG_HEADS, HG_DK, HG_DV), jnp.float32)
        buf_p = jnp.zeros((n_prompt, CONV_W - 1, 2 * D_FF), x_prompt.dtype)
        yp, s_p, k_p, v_p, nb_p = layer_forward(yp, p, lb, s0_p, None, None, buf_p,
                                                mk_p, mv_p, min(HG_CHUNK, seq_len))

        past_k = cache_sb_k[l][page_table].reshape(n_dec, past_len, SB_HEADS, SB_DH)
        past_v = cache_sb_v[l][page_table].reshape(n_dec, past_len, SB_HEADS, SB_DH)
        ys, s_s, k_s, v_s, nb_s = layer_forward(ys, p, lb, state_hgrn[l], past_k, past_v,
                                                state_ffn_conv[l], cache_mem_k[l], cache_mem_v[l],
                                                dec_len)

        kp_l.append(k_p); vp_l.append(v_p); sp_l.append(s_p); bp_l.append(nb_p)
        mkp_l.append(mk_p); mvp_l.append(mv_p)
        ks_l.append(k_s); vs_l.append(v_s); ss_l.append(s_s); bs_l.append(nb_s)

    return (yp, ys,
            jnp.stack(kp_l), jnp.stack(vp_l), jnp.stack(sp_l), jnp.stack(bp_l),
            jnp.stack(mkp_l), jnp.stack(mvp_l),
            jnp.stack(ks_l), jnp.stack(vs_l), jnp.stack(ss_l), jnp.stack(bs_l))
```

```cpp
#include <hip/hip_runtime.h>
#include <cstdio>
#include <cstdint>
namespace pg8 {
#define PG8_LAS __attribute__((address_space(3)))
typedef unsigned short bf16_t;
typedef short bf16x8 __attribute__((ext_vector_type(8)));
typedef float f32x4 __attribute__((ext_vector_type(4)));
typedef unsigned u32x4 __attribute__((ext_vector_type(4)));
constexpr int BM = 256, BK = 64, HALF = 128, HTB = HALF * BK * 2  , STAGE_BYTES = 8 * HTB, NXCD = 8, WGM = 8;

__host__ __device__ __forceinline__ int lds_byte(int r, int c) { const int st = (r >> 4) * 2 + (c >> 5), rr = r & 15, cc = c & 31, ob = rr * 64 + cc * 2; return st * 1024 + (ob ^ (((ob >> 9) & 1) << 5)); }
__host__ __device__ __forceinline__ void stage_rc(int b, int& R, int& C) { const int st = b / 1024, sb = b % 1024, swz = sb ^ (((sb >> 9) & 1) << 5); R = (st >> 1) * 16 + swz / 64; C = (st & 1) * 32 + (swz % 64) / 2; }
__host__ __device__ __forceinline__ int perm32(int rho) { const int n = rho >> 4, i = rho & 15; return 8 * (i >> 2) + 4 * n + (i & 3); }

struct Unit { int pm, pn; };
struct Gemm { const bf16_t* A; const bf16_t* Bt; int M, N, K; };

struct StaticOrder {
    int nM, nN, nwg, G, c;
    __host__ __device__ void init(int M, int N, int G_, int c_) { nM = M / BM; nN = N / BM; nwg = nM * nN; G = G_; c = c_; }
    __host__ __device__ bool next(int i, Unit& u) const {
        const long L = (long)i * G + c; if (L >= nwg) return false;
        int wgid = (int)L; { const int q = nwg / NXCD, r = nwg % NXCD, xcd = wgid % NXCD, off = wgid / NXCD; wgid = (xcd < r ? xcd * (q + 1) : r * (q + 1) + (xcd - r) * q) + off; }
        const int nig = WGM * nN, gid = wgid / nig, fm = gid * WGM, gsz = (nM - fm) < WGM ? (nM - fm) : WGM;
        u.pm = fm + ((wgid % nig) % gsz); u.pn = (wgid % nig) / gsz; return true;
    }
    __device__ __forceinline__ void a_ready(const Unit&) const {}
    __device__ __forceinline__ void done(const Unit&) const {}
};

__device__ __forceinline__ unsigned cvt_pk_bf16(float lo, float hi) { unsigned r; asm volatile("v_cvt_pk_bf16_f32 %0, %1, %2" : "=v"(r) : "v"(lo), "v"(hi)); return r; }
typedef float f32x2 __attribute__((ext_vector_type(2)));
typedef __bf16 bf16x2_t __attribute__((ext_vector_type(2)));
__device__ __forceinline__ unsigned pk_bf16(float lo, float hi) { f32x2 v = {lo, hi}; bf16x2_t b = __builtin_convertvector(v, bf16x2_t); return __builtin_bit_cast(unsigned, b); }
__device__ __forceinline__ u32x4 pk8(f32x4 a, f32x4 b) { u32x4 w; w.x = pk_bf16(a[0], a[1]); w.y = pk_bf16(a[2], a[3]); w.z = pk_bf16(b[0], b[1]); w.w = pk_bf16(b[2], b[3]); return w; }

struct EpiStore {
    static constexpr bool PERM = true, AFTER_DRAIN = false;
    bf16_t* O; int ldc; float scale; float* cap_p; float* cap_s;
    __device__ __forceinline__ void operator()(const f32x4 (&acc)[2][2][4][2], const Unit& u, int wr, int wc, int fr, int fq) const {
        const int row0 = u.pm * BM + wr * 64 + fr, col0 = u.pn * BM + wc * 32 + 8 * fq;
#pragma unroll
        for (int ai = 0; ai < 2; ++ai)
#pragma unroll
            for (int m = 0; m < 4; ++m) {
                const int row = row0 + ai * HALF + m * 16;
                float* cap = nullptr;
                if (cap_p) {
                    if (row < 16384) { const int t = row & 8191; if (t >= 8190) cap = cap_p + (size_t)((row >> 13) * 2 + (t - 8190)) * 5632; }
                    else { const int r2 = row - 16384, t = r2 & 7; if (t >= 6) cap = cap_s + (size_t)((r2 >> 3) * 2 + (t - 6)) * 5632; }
                }
#pragma unroll
                for (int bj = 0; bj < 2; ++bj) {
                    const int col = col0 + bj * HALF;
                    const f32x4 v0 = acc[ai][bj][m][0] * scale, v1 = acc[ai][bj][m][1] * scale;
                    *(u32x4*)(O + (size_t)row * ldc + col) = pk8(v0, v1);
                    if (cap) { *(f32x4*)(cap + col) = v0; *(f32x4*)(cap + col + 4) = v1; }
                }
            }
    }
};

struct EpiInProj {
    static constexpr bool PERM = true, AFTER_DRAIN = false;
    bf16_t *QH, *VH, *GH, *SQ, *SK, *SV; float* LF; const float* LB; float* kp; float* vp; float* ks; float* vs; float sqscale;
    __device__ __forceinline__ void operator()(const f32x4 (&acc)[2][2][4][2], const Unit& u, int wr, int wc, int fr, int fq) const {
        const int seg = u.pn >> 1;
        const int row0 = u.pm * BM + wr * 64 + fr, col0 = (u.pn & 1) * BM + wc * 32 + 8 * fq;
        if (seg == 1) {
#pragma unroll
            for (int bj = 0; bj < 2; ++bj) {
                const int col = col0 + bj * HALF;
                const f32x4 l0 = *(const f32x4*)(LB + col), l1 = *(const f32x4*)(LB + col + 4);
#pragma unroll
                for (int ai = 0; ai < 2; ++ai)
#pragma unroll
                    for (int m = 0; m < 4; ++m) {
                        const int row = row0 + ai * HALF + m * 16;
                        f32x4 o0, o1;
#pragma unroll
                        for (int e = 0; e < 4; ++e) {
                            const float s0 = 1.f / (1.f + __expf(-acc[ai][bj][m][0][e])), s1 = 1.f / (1.f + __expf(-acc[ai][bj][m][1][e]));
                            o0[e] = __logf(l0[e] + (1.f - l0[e]) * s0); o1[e] = __logf(l1[e] + (1.f - l1[e]) * s1);
                        }
                        *(f32x4*)(LF + (size_t)row * 512 + col) = o0; *(f32x4*)(LF + (size_t)row * 512 + col + 4) = o1;
                    }
            }
            return;
        }
        bf16_t* dst = seg == 0 ? QH : seg == 2 ? VH : seg == 3 ? GH : seg == 4 ? SQ : seg == 5 ? SK : SV;
        const float sc = seg == 4 ? sqscale : 1.f;
        float* fp = seg == 5 ? kp : seg == 6 ? vp : nullptr;
        float* fs = seg == 5 ? ks : vs;
#pragma unroll
        for (int ai = 0; ai < 2; ++ai)
#pragma unroll
            for (int m = 0; m < 4; ++m) {
                const int row = row0 + ai * HALF + m * 16;
#pragma unroll
                for (int bj = 0; bj < 2; ++bj) {
                    const int col = col0 + bj * HALF;
                    const f32x4 v0 = acc[ai][bj][m][0], v1 = acc[ai][bj][m][1];
                    *(u32x4*)(dst + (size_t)row * 512 + col) = pk8(v0 * sc, v1 * sc);
                    if (fp) { float* f = row < 16384 ? fp + (size_t)row * 512 + col : fs + (size_t)(row - 16384) * 512 + col; *(f32x4*)f = v0; *(f32x4*)(f + 4) = v1; }
                }
            }
    }
};

struct EpiMemKV {
    static constexpr bool PERM = true, AFTER_DRAIN = false;
    bf16_t *MK, *MV; float *ok, *ov;
    __device__ __forceinline__ void operator()(const f32x4 (&acc)[2][2][4][2], const Unit& u, int wr, int wc, int fr, int fq) const {
        const int seg = u.pn >> 2;
        const int row0 = u.pm * BM + wr * 64 + fr, col0 = (u.pn & 3) * BM + wc * 32 + 8 * fq;
        bf16_t* dst = seg == 0 ? MK : MV; float* fo = seg == 0 ? ok : ov;
#pragma unroll
        for (int ai = 0; ai < 2; ++ai)
#pragma unroll
            for (int m = 0; m < 4; ++m) {
                const int row = row0 + ai * HALF + m * 16;
#pragma unroll
                for (int bj = 0; bj < 2; ++bj) {
                    const int col = col0 + bj * HALF;
                    const f32x4 v0 = acc[ai][bj][m][0], v1 = acc[ai][bj][m][1];
                    *(u32x4*)(dst + (size_t)row * 1024 + col) = pk8(v0, v1);
                    *(f32x4*)(fo + (size_t)row * 1024 + col) = v0; *(f32x4*)(fo + (size_t)row * 1024 + col + 4) = v1;
                }
            }
    }
};

template <class Epi, class Sched, bool ALIGN_EPI = false, bool SP2 = false>
__device__ __forceinline__ void gemm_phase(PG8_LAS unsigned char* lds, const Gemm g, const Sched& S, const Epi& E) {
    const int tid = threadIdx.x, wid = __builtin_amdgcn_readfirstlane(tid >> 6), lane = tid & 63, wr = wid >> 2, wc = wid & 3, fr = lane & 15, fq = lane >> 4;
    const int K = g.K, nt = K / BK;
    unsigned voffA[2], voffB[2];
#pragma unroll
    for (int i = 0; i < 2; ++i) { int R, C; stage_rc(tid * 16 + i * 8192, R, C); const int Rb = Epi::PERM ? ((R & ~31) + perm32(R & 31)) : R;
        voffA[i] = (unsigned)(R * K + C) * 2u; voffB[i] = (unsigned)(Rb * K + C) * 2u; }
    const size_t kstep = (size_t)(BK * 2);
    const size_t hstep = (size_t)HALF * K * 2;
    const size_t tstep = 2 * hstep;
    const unsigned ldsw = (unsigned)wid * 1024u;
    const int aoff = lds_byte(wr * 64 + fr, fq * 8), boff = lds_byte(wc * 32 + fr, fq * 8);
#define PG8_SA(b, h) (((b) * 2 + (h)) * HTB)
#define PG8_SB(b, h) ((4 + (b) * 2 + (h)) * HTB)
#define PG8_STAGE(bufoff, gbase, voff) do { _Pragma("unroll") for (int _i = 0; _i < 2; ++_i) \
        __builtin_amdgcn_global_load_lds((const unsigned*)((const char*)(gbase) + (voff)[_i]), (PG8_LAS unsigned*)(lds + (bufoff) + ldsw + _i * 8192), 16, 0, 0); } while (0)
#define PG8_LDA(dst, b, h) do { _Pragma("unroll") for (int m = 0; m < 4; ++m) _Pragma("unroll") for (int k = 0; k < 2; ++k) dst[m][k] = *(const PG8_LAS bf16x8*)(lds + PG8_SA(b, h) + aoff + m * 2048 + k * 1024); } while (0)
#define PG8_LDB(dst, b, h) do { _Pragma("unroll") for (int n = 0; n < 2; ++n) _Pragma("unroll") for (int k = 0; k < 2; ++k) dst[n][k] = *(const PG8_LAS bf16x8*)(lds + PG8_SB(b, h) + boff + n * 2048 + k * 1024); } while (0)
#define PG8_MMA(ai, bj, At, Bt) do { __builtin_amdgcn_s_setprio(1); _Pragma("unroll") for (int m = 0; m < 4; ++m) _Pragma("unroll") for (int n = 0; n < 2; ++n) _Pragma("unroll") for (int k = 0; k < 2; ++k) \
        acc[ai][bj][m][n] = __builtin_amdgcn_mfma_f32_16x16x32_bf16(Bt[n][k], At[m][k], acc[ai][bj][m][n], 0, 0, 0); __builtin_amdgcn_s_setprio(0); } while (0)
#define PG8_WAIT_V(n) asm volatile("s_waitcnt vmcnt(" #n ")" ::: "memory")
#define PG8_WAIT_L(n) asm volatile("s_waitcnt lgkmcnt(" #n ")" ::: "memory")
#define PG8_BAR __builtin_amdgcn_s_barrier()
#define PG8_SCHED __builtin_amdgcn_sched_barrier(0)
    Unit cur, nxt; int ui = 0;
    if (!S.next(0, cur)) return;
    f32x4 acc[2][2][4][2];
#pragma unroll
    for (int a = 0; a < 2; ++a)
#pragma unroll
        for (int b = 0; b < 2; ++b)
#pragma unroll
            for (int m = 0; m < 4; ++m)
#pragma unroll
                for (int n = 0; n < 2; ++n) acc[a][b][m][n] = (f32x4){0.f, 0.f, 0.f, 0.f};
    bf16x8 At[4][2], B0[2][2], B1[2][2];
    const char* cA = (const char*)g.A + (size_t)cur.pm * tstep; const char* cB = (const char*)g.Bt + (size_t)cur.pn * tstep;
    S.a_ready(cur);
    if constexpr (SP2) {
        PG8_STAGE(PG8_SB(0, 0), cB, voffB); PG8_STAGE(PG8_SB(0, 1), cB + hstep, voffB); PG8_STAGE(PG8_SA(0, 0), cA, voffA); PG8_STAGE(PG8_SA(0, 1), cA + hstep, voffA);
        if (wr == 1) PG8_BAR;
        PG8_WAIT_V(2); PG8_BAR;
        PG8_STAGE(PG8_SB(1, 0), cB + kstep, voffB); PG8_STAGE(PG8_SA(1, 0), cA + kstep, voffA); PG8_STAGE(PG8_SB(1, 1), cB + hstep + kstep, voffB);
        PG8_WAIT_V(6); PG8_BAR;
    } else {
        PG8_STAGE(PG8_SB(0, 0), cB, voffB); PG8_STAGE(PG8_SA(0, 0), cA, voffA); PG8_STAGE(PG8_SB(0, 1), cB + hstep, voffB); PG8_STAGE(PG8_SA(0, 1), cA + hstep, voffA);
        if (wr == 1) PG8_BAR;
        PG8_WAIT_V(4); PG8_BAR;
        PG8_STAGE(PG8_SB(1, 0), cB + kstep, voffB); PG8_STAGE(PG8_SA(1, 0), cA + kstep, voffA); PG8_STAGE(PG8_SB(1, 1), cB + hstep + kstep, voffB);
        PG8_WAIT_V(6); PG8_BAR;
    }
    for (;;) {
        const bool has_next = S.next(ui + 1, nxt);
        const char* nA = has_next ? (const char*)g.A + (size_t)nxt.pm * tstep : cA; const char* nB = has_next ? (const char*)g.Bt + (size_t)nxt.pn * tstep : cB;
        for (int t = 0; t < nt; t += 2) {
            const bool last = (t == nt - 2);
            const char* a1 = cA + (size_t)(t + 1) * kstep;
            const char* a2 = last ? nA : cA + (size_t)(t + 2) * kstep; const char* b2 = last ? nB : cB + (size_t)(t + 2) * kstep;
            const char* a3 = a2 + kstep; const char* b3 = b2 + kstep;
            if (last && has_next) S.a_ready(nxt);
            if constexpr (SP2) {
            PG8_LDB(B0, 0, 0); PG8_LDB(B1, 0, 1); PG8_SCHED; PG8_LDA(At, 0, 0); PG8_STAGE(PG8_SA(1, 1), a1 + hstep, voffA);
            PG8_WAIT_V(8); PG8_WAIT_L(0); PG8_BAR; PG8_MMA(0, 0, At, B0); PG8_MMA(0, 1, At, B1); PG8_BAR; PG8_SCHED;
            PG8_LDA(At, 0, 1); PG8_STAGE(PG8_SB(0, 0), b2, voffB); PG8_STAGE(PG8_SB(0, 1), b2 + hstep, voffB); PG8_STAGE(PG8_SA(0, 0), a2, voffA);
            PG8_WAIT_V(8); PG8_WAIT_L(0); PG8_BAR; PG8_MMA(1, 0, At, B0); PG8_MMA(1, 1, At, B1); PG8_BAR; PG8_SCHED;
            PG8_LDB(B0, 1, 0); PG8_LDB(B1, 1, 1); PG8_SCHED; PG8_LDA(At, 1, 0); PG8_STAGE(PG8_SA(0, 1), a2 + hstep, voffA);
            PG8_WAIT_V(8); PG8_WAIT_L(0); PG8_BAR; PG8_MMA(0, 0, At, B0); PG8_MMA(0, 1, At, B1); PG8_BAR; PG8_SCHED;
            PG8_LDA(At, 1, 1); PG8_STAGE(PG8_SB(1, 0), b3, voffB); PG8_STAGE(PG8_SB(1, 1), b3 + hstep, voffB); PG8_STAGE(PG8_SA(1, 0), a3, voffA);
            PG8_WAIT_V(8); PG8_WAIT_L(0); PG8_BAR; PG8_MMA(1, 0, At, B0); PG8_MMA(1, 1, At, B1); PG8_BAR; PG8_SCHED;
            } else {
            PG8_LDB(B0, 0, 0); PG8_SCHED; PG8_LDA(At, 0, 0); PG8_STAGE(PG8_SA(1, 1), a1 + hstep, voffA);
            PG8_WAIT_L(8); PG8_BAR; PG8_WAIT_L(0); PG8_MMA(0, 0, At, B0); PG8_BAR; PG8_SCHED;
            PG8_LDB(B1, 0, 1); PG8_STAGE(PG8_SB(0, 0), b2, voffB);
            PG8_BAR; PG8_WAIT_L(0); PG8_MMA(0, 1, At, B1); PG8_BAR;
            PG8_LDA(At, 0, 1); PG8_STAGE(PG8_SA(0, 0), a2, voffA);
            PG8_BAR; PG8_WAIT_L(0); PG8_MMA(1, 0, At, B0); PG8_BAR; PG8_SCHED;
            PG8_STAGE(PG8_SB(0, 1), b2 + hstep, voffB);
            PG8_WAIT_V(6); PG8_BAR; PG8_MMA(1, 1, At, B1); PG8_BAR;
            PG8_LDB(B0, 1, 0); PG8_SCHED; PG8_LDA(At, 1, 0); PG8_STAGE(PG8_SA(0, 1), a2 + hstep, voffA);
            PG8_WAIT_L(8); PG8_BAR; PG8_WAIT_L(0); PG8_MMA(0, 0, At, B0); PG8_BAR; PG8_SCHED;
            PG8_LDB(B1, 1, 1); PG8_STAGE(PG8_SB(1, 0), b3, voffB);
            PG8_BAR; PG8_WAIT_L(0); PG8_MMA(0, 1, At, B1); PG8_BAR;
            PG8_LDA(At, 1, 1); PG8_STAGE(PG8_SA(1, 0), a3, voffA);
            PG8_BAR; PG8_WAIT_L(0); PG8_MMA(1, 0, At, B0); PG8_BAR; PG8_SCHED;
            PG8_STAGE(PG8_SB(1, 1), b3 + hstep, voffB);
            PG8_WAIT_V(6); PG8_BAR; PG8_MMA(1, 1, At, B1); PG8_BAR;
            }
        }
        if constexpr (ALIGN_EPI) { if (wr == 0) PG8_BAR; }
        if constexpr (!Epi::AFTER_DRAIN) { E(acc, cur, wr, wc, fr, fq); S.done(cur); }
        if (!has_next) break;
#pragma unroll
        for (int a = 0; a < 2; ++a)
#pragma unroll
            for (int b = 0; b < 2; ++b)
#pragma unroll
                for (int m = 0; m < 4; ++m)
#pragma unroll
                    for (int n = 0; n < 2; ++n) acc[a][b][m][n] = (f32x4){0.f, 0.f, 0.f, 0.f};
        cur = nxt; cA = nA; cB = nB; ++ui;
        if constexpr (ALIGN_EPI) { if (wr == 1) PG8_BAR; }
    }
    PG8_WAIT_V(0);
    if constexpr (!ALIGN_EPI) { if (wr == 0) PG8_BAR; }
    PG8_BAR;
    if constexpr (Epi::AFTER_DRAIN) { E.fused(acc, cur, wr, wc, fr, fq, lds, wid, lane); S.done(cur); }
#undef PG8_SA
#undef PG8_SB
#undef PG8_STAGE
#undef PG8_LDA
#undef PG8_LDB
#undef PG8_MMA
#undef PG8_WAIT_V
#undef PG8_WAIT_L
#undef PG8_BAR
#undef PG8_SCHED
}
}
#define GAS __attribute__((address_space(1)))
#define LAS __attribute__((address_space(3)))
#define LDS_WAIT() asm volatile("s_waitcnt lgkmcnt(0)" ::: "memory")
#define VM_WAIT() asm volatile("s_waitcnt vmcnt(0)" ::: "memory")
#define XB_TMO      128
#define XB_XCNT(j)  (256  + 64 * (j))
#define XB_XSUB(j)  (1280 + 64 * (j))
#define XB_XGEN(j)  (2304 + 64 * (j))
#define XB_TOP      3328
#define XB_TOPGEN   3392
#define XCD_BAR_WORDS 3456
#define XB_SPIN_CAP (1u << 23)

__device__ __forceinline__ unsigned xb_ld(unsigned* p)              { return __hip_atomic_load(p, __ATOMIC_RELAXED, __HIP_MEMORY_SCOPE_AGENT); }
__device__ __forceinline__ unsigned xb_add(unsigned* p, unsigned v) { return __hip_atomic_fetch_add(p, v, __ATOMIC_RELAXED, __HIP_MEMORY_SCOPE_AGENT); }
__device__ __forceinline__ unsigned xb_xcc_id() { return (unsigned)__builtin_amdgcn_s_getreg((3 << 11) | 20) & 0xFu; }
#define XB_SPIN(cond, bar) do { unsigned _sp = 0; while (cond) { __builtin_amdgcn_s_sleep(1); \
    if ((++_sp & 255u) == 0u) { if (xb_ld(&(bar)[XB_TMO])) break; if (_sp > XB_SPIN_CAP) { atomicAdd(&(bar)[XB_TMO], 1u); break; } } } } while (0)

struct XcdBarrier {
    unsigned* bar; unsigned x;
    volatile LAS unsigned* st;
};

__device__ __forceinline__ XcdBarrier xcd_barrier_post(unsigned* bar, volatile LAS unsigned* st) {
    XcdBarrier b; b.bar = bar; b.x = xb_xcc_id(); b.st = st;
    if (threadIdx.x == 0) (void)xb_add(&bar[XB_XCNT(b.x)], 1u);
    return b;
}
__device__ __forceinline__ void xcd_barrier_complete(unsigned* bar, unsigned x, unsigned& nloc, unsigned& nx) {
    const unsigned G = gridDim.x * gridDim.y * gridDim.z;
    unsigned sum, cnt, mine, sp = 0u;
    for (;;) {
        sum = 0u; cnt = 0u; mine = 0u;
#pragma unroll
        for (unsigned j = 0; j < 16; ++j) { const unsigned c = xb_ld(&bar[XB_XCNT(j)]); sum += c; cnt += (c > 0u) ? 1u : 0u; mine = (j == x) ? c : mine; }
        if (sum == G) break;
        __builtin_amdgcn_s_sleep(1);
        if ((++sp & 255u) == 0u) { if (xb_ld(&bar[XB_TMO])) break; if (sp > XB_SPIN_CAP) { atomicAdd(&bar[XB_TMO], 1u); break; } }
    }
    nloc = mine > 0u ? mine : 1u; nx = cnt > 0u ? cnt : 1u;
}

__device__ __forceinline__ void xcd_barrier(const XcdBarrier& b) {
    asm volatile("s_waitcnt vmcnt(0)" ::: "memory");
    __syncthreads();
    if (threadIdx.x == 0) {
        unsigned* bar = b.bar;
        __builtin_amdgcn_s_waitcnt(0);
        unsigned nloc = b.st[0], nx = b.st[1];
        if (nloc == 0u) { xcd_barrier_complete(bar, b.x, nloc, nx); b.st[0] = nloc; b.st[1] = nx; }
        const unsigned old = xb_add(&bar[XB_XSUB(b.x)], 1u);
        const unsigned gen = old / nloc;
        if (old + 1u == (gen + 1u) * nloc) {
            __builtin_amdgcn_fence(__ATOMIC_RELEASE, "agent");
            asm volatile("s_waitcnt vmcnt(0)" ::: "memory");
            const unsigned og = xb_add(&bar[XB_TOP], 1u);
            const unsigned tg = og / nx;
            if (og + 1u == (tg + 1u) * nx) xb_add(&bar[XB_TOPGEN], 1u);
            else XB_SPIN(xb_ld(&bar[XB_TOPGEN]) == tg, bar);
            __builtin_amdgcn_fence(__ATOMIC_ACQUIRE, "agent");
            xb_add(&bar[XB_XGEN(b.x)], 1u);
            asm volatile("s_waitcnt vmcnt(0)" ::: "memory");
        } else {
            XB_SPIN(xb_ld(&bar[XB_XGEN(b.x)]) == gen, bar);
            __builtin_amdgcn_fence(__ATOMIC_ACQUIRE, "agent");
            asm volatile("s_waitcnt vmcnt(0)" ::: "memory");
        }
    }
    __syncthreads();
}
constexpr int NWAVES = 8, NTHREADS = 512;
constexpr int DM = 1024, SEQ = 8192, NBATCH = 2, MP = NBATCH * SEQ, NDEC = 128, TDEC = 8, MS = NDEC * TDEC, MT = MP + MS;
constexpr int DIN = 3584, HW = 512, NH = 8, HD = 64;
constexpr int NMEM = 256, CAH = 4, CAD = 256, DFF = 2816, DFF2 = 5632;
constexpr int PAST = 2048, PAGE = 128, NPAGES = 16;
constexpr float RMS_EPS = 1e-6f, LOG2E = 1.4426950408889634f;
constexpr float SQ_SCALE = 0.125f * LOG2E;
constexpr float CQ_SCALE = 0.0625f * LOG2E;
enum { I_XP = 0, I_XS, I_CK, I_CV, I_SH, I_SC, I_MK, I_MV, I_PT, I_MEM, I_WIN, I_HGN, I_HLB, I_SBB, I_WO, I_GMIXPRE, I_GMIXPOST, I_GCAPRE, I_GCAPOST, I_GMEM,
       I_WCQ, I_WCK, I_WCV, I_WCO, I_GFFNPRE, I_GFFNPOST, I_WUP, I_CONVW, I_CONVB, I_WDN, N_IN };
constexpr size_t O_YP = 0, O_YS = 16777216, O_KP = 17825792, O_VP = 26214400, O_HP = 34603008, O_CP = 34668544, O_MKP = 34691072, O_MVP = 35215360,
                 O_KS = 35739648, O_VS = 36263936, O_HS = 36788224, O_CS = 40982528, O_END = 42424320;
constexpr size_t MiB = 1u << 20;
constexpr size_t WS_CTL = 0, CTL_ZERO_BYTES = 1 * MiB;
constexpr size_t WS_WIN = 2 * MiB, WS_WO = 9 * MiB, WS_WCQ = 11 * MiB, WS_WCO = 13 * MiB, WS_WCKV = 15 * MiB, WS_WUP = 19 * MiB, WS_WDN = 30 * MiB;
constexpr size_t WS_LB = 36 * MiB, WS_MN = 37 * MiB, WS_MK = 38 * MiB, WS_MV = 39 * MiB;
constexpr size_t WS_H = 40 * MiB, WS_QH = 74 * MiB, WS_LF = 91 * MiB, WS_VH = 125 * MiB, WS_GH = 142 * MiB, WS_SQ = 159 * MiB, WS_SK = 176 * MiB, WS_SV = 193 * MiB;
constexpr size_t WS_OMIX = 210 * MiB, WS_BR = 244 * MiB, WS_X1 = 278 * MiB, WS_X2 = 346 * MiB, WS_QCA = 414 * MiB, WS_U = 448 * MiB, WS_G = 635 * MiB, WS_END = 730 * MiB;
constexpr int CW_BAR = 4096;
constexpr int RING_OFF = 0, RING_BYTES = 131072, LDSCTL_OFF = RING_BYTES, MISC_OFF = LDSCTL_OFF + 320, LDS_BYTES = 147456;

typedef unsigned short bf16;
typedef unsigned v4u __attribute__((ext_vector_type(4)));
typedef unsigned v2u __attribute__((ext_vector_type(2)));
typedef float f32x4 __attribute__((ext_vector_type(4)));
using pg8::pk_bf16;
__device__ __forceinline__ float bf2f(unsigned short b) { return __uint_as_float((unsigned)b << 16); }
__device__ __forceinline__ float bflo(unsigned w) { return __uint_as_float(w << 16); }
__device__ __forceinline__ float bfhi(unsigned w) { return __uint_as_float(w & 0xffff0000u); }
__device__ __forceinline__ unsigned short f2bf(float f) { return (unsigned short)(pk_bf16(f, 0.f) & 0xffffu); }
__device__ __forceinline__ float wave_sum(float v) {
#pragma unroll
    for (int o = 1; o < 64; o <<= 1) v += __shfl_xor(v, o);
    return v;
}
__device__ __forceinline__ float rdlane(float v, int l) { return __uint_as_float((unsigned)__builtin_amdgcn_readlane((int)__float_as_uint(v), l)); }

struct Args { const void* in[N_IN]; float* out; unsigned char* ws; int ph_lo, ph_hi; };
struct Ctx { const void* const* in; float* out; unsigned char* ws; LAS unsigned char* lds; int tid, lane, wave, gw, ngw; };

__device__ __forceinline__ void p0_transpose_item(const float* W, int K, int N, bf16* WT, int row_off, LAS float* scr, int item, int lane) {
    const int nblk = N / 32, kb = item / nblk, nb = item % nblk, k0 = 64 * kb, n0 = 32 * nb;
#pragma unroll 8
    for (int i = 0; i < 32; ++i) { const int kk = 2 * i + (lane >> 5); scr[kk * 33 + (lane & 31)] = W[(size_t)(k0 + kk) * N + n0 + (lane & 31)]; }
    LDS_WAIT(); asm volatile("" ::: "memory");
    const int c = lane & 7;
#pragma unroll
    for (int j = 0; j < 4; ++j) { const int n = (lane >> 3) + 8 * j; const LAS float* s = scr + (8 * c) * 33 + n;
        v4u o; o.x = pk_bf16(s[0 * 33], s[1 * 33]); o.y = pk_bf16(s[2 * 33], s[3 * 33]); o.z = pk_bf16(s[4 * 33], s[5 * 33]); o.w = pk_bf16(s[6 * 33], s[7 * 33]);
        *(v4u*)(WT + (size_t)(row_off + n0 + n) * K + k0 + 8 * c) = o; }
    LDS_WAIT(); asm volatile("" ::: "memory");
}
__device__ __forceinline__ void rms_row_to_bf16(const float* xrow, const float* g, bf16* orow, int lane) {
    const f32x4* xr = (const f32x4*)xrow + lane; const f32x4* gr = (const f32x4*)g + lane;
    f32x4 v[4]; float s = 0.f;
#pragma unroll
    for (int j = 0; j < 4; ++j) { v[j] = xr[64 * j]; s += (v[j].x * v[j].x + v[j].y * v[j].y) + (v[j].z * v[j].z + v[j].w * v[j].w); }
    const float r = rsqrtf(wave_sum(s) * (1.f / DM) + RMS_EPS);
    v2u* o8 = (v2u*)orow + lane;
#pragma unroll
    for (int j = 0; j < 4; ++j) { const f32x4 gg = gr[64 * j]; v2u w; w.x = pk_bf16(v[j].x * r * gg.x, v[j].y * r * gg.y); w.y = pk_bf16(v[j].z * r * gg.z, v[j].w * r * gg.w); o8[64 * j] = w; }
}
__device__ __forceinline__ void p0_prologue(const Ctx& C) {
    LAS float* scr = (LAS float*)(C.lds + RING_OFF + C.wave * 16384);
    const float* w_in = (const float*)C.in[I_WIN]; const float* w_o = (const float*)C.in[I_WO]; const float* w_cq = (const float*)C.in[I_WCQ]; const float* w_ck = (const float*)C.in[I_WCK];
    const float* w_cv = (const float*)C.in[I_WCV]; const float* w_co = (const float*)C.in[I_WCO]; const float* w_up = (const float*)C.in[I_WUP]; const float* w_dn = (const float*)C.in[I_WDN];
    bf16* Win = (bf16*)(C.ws + WS_WIN); bf16* Wo = (bf16*)(C.ws + WS_WO); bf16* Wcq = (bf16*)(C.ws + WS_WCQ); bf16* Wco = (bf16*)(C.ws + WS_WCO); bf16* Wckv = (bf16*)(C.ws + WS_WCKV);
    bf16* Wup = (bf16*)(C.ws + WS_WUP); bf16* Wdn = (bf16*)(C.ws + WS_WDN);
    constexpr int I_IN = (DM / 64) * (DIN / 32), I_SQ = (DM / 64) * (DM / 32), I_UP = (DM / 64) * (DFF2 / 32), I_DN = (DFF / 64) * (DM / 32);
    constexpr int NITEMS = I_IN + 5 * I_SQ + I_UP + I_DN;
    for (int it = C.gw; it < NITEMS; it += C.ngw) {
        int r = it;
        if (r < I_IN) { p0_transpose_item(w_in, DM, DIN, Win, 0, scr, r, C.lane); continue; } r -= I_IN;
        if (r < I_SQ) { p0_transpose_item(w_o, DM, DM, Wo, 0, scr, r, C.lane); continue; } r -= I_SQ;
        if (r < I_SQ) { p0_transpose_item(w_cq, DM, DM, Wcq, 0, scr, r, C.lane); continue; } r -= I_SQ;
        if (r < I_SQ) { p0_transpose_item(w_co, DM, DM, Wco, 0, scr, r, C.lane); continue; } r -= I_SQ;
        if (r < I_SQ) { p0_transpose_item(w_ck, DM, DM, Wckv, 0, scr, r, C.lane); continue; } r -= I_SQ;
        if (r < I_SQ) { p0_transpose_item(w_cv, DM, DM, Wckv, DM, scr, r, C.lane); continue; } r -= I_SQ;
        if (r < I_UP) { p0_transpose_item(w_up, DM, DFF2, Wup, 0, scr, r, C.lane); continue; } r -= I_UP;
        p0_transpose_item(w_dn, DFF, DM, Wdn, 0, scr, r, C.lane);
    }
    const float* xp = (const float*)C.in[I_XP]; const float* xs = (const float*)C.in[I_XS]; const float* mem = (const float*)C.in[I_MEM];
    bf16* H = (bf16*)(C.ws + WS_H); bf16* MN = (bf16*)(C.ws + WS_MN);
    const float* g_pre = (const float*)C.in[I_GMIXPRE]; const float* g_mem = (const float*)C.in[I_GMEM];
    for (int m = C.gw; m < MT + NBATCH * NMEM; m += C.ngw) {
        if (m < MP) rms_row_to_bf16(xp + (size_t)m * DM, g_pre, H + (size_t)m * DM, C.lane);
        else if (m < MT) rms_row_to_bf16(xs + (size_t)(m - MP) * DM, g_pre, H + (size_t)m * DM, C.lane);
        else rms_row_to_bf16(mem + (size_t)(m - MT) * DM, g_mem, MN + (size_t)(m - MT) * DM, C.lane);
    }
    if (C.gw == 0) {
        const float* lbp = (const float*)C.in[I_HLB]; float* LB = (float*)(C.ws + WS_LB);
        for (int k = C.lane; k < HW; k += 64) { const float a = lbp[k], b = lbp[HW + k]; LB[k] = 1.f / (1.f + __expf(b - a)); }
    }
}
__device__ __forceinline__ void hgrn_chain(const Ctx& C, int rowbase, int T, int h, const float* S0, float* Sout) {
    const float* LF = (const float*)(C.ws + WS_LF); const bf16* QH = (const bf16*)(C.ws + WS_QH); const bf16* VH = (const bf16*)(C.ws + WS_VH); const bf16* GH = (const bf16*)(C.ws + WS_GH);
    bf16* OMIX = (bf16*)(C.ws + WS_OMIX); const float* hgn = (const float*)C.in[I_HGN];
    const int lane = C.lane; const float gn = hgn[h * HD + lane];
    float S[64];
#pragma unroll
    for (int k = 0; k < 64; ++k) S[k] = S0 ? S0[k * 64 + lane] : 0.f;
    for (int t = 0; t < T; ++t) {
        const size_t off = (size_t)(rowbase + t) * HW + h * HD + lane;
        const float fk = __expf(LF[off]), kk = 1.f - fk, qk = bf2f(QH[off]), vd = bf2f(VH[off]), g = bf2f(GH[off]);
        float o = 0.f;
#pragma unroll
        for (int k = 0; k < 64; ++k) { const float f_ = rdlane(fk, k), k_ = rdlane(kk, k), q_ = rdlane(qk, k); S[k] = f_ * S[k] + k_ * vd; o += S[k] * q_; }
        const float r = rsqrtf(wave_sum(o * o) * (1.f / HD) + RMS_EPS);
        OMIX[(size_t)(rowbase + t) * DM + h * HD + lane] = f2bf(o * r * gn * (g / (1.f + __expf(-g))));
    }
#pragma unroll
    for (int k = 0; k < 64; ++k) Sout[k * 64 + lane] = S[k];
}
template <bool SAMPLE>
__device__ __forceinline__ void sb_query(const Ctx& C, int row, int h, int nkeys, int seq  ) {
    const bf16* SQ = (const bf16*)(C.ws + WS_SQ); const bf16* SK = (const bf16*)(C.ws + WS_SK); const bf16* SV = (const bf16*)(C.ws + WS_SV);
    const float* ck = (const float*)C.in[I_CK]; const float* cv = (const float*)C.in[I_CV]; const int* pt = (const int*)C.in[I_PT];
    bf16* OMIX = (bf16*)(C.ws + WS_OMIX);
    const int lane = C.lane; const float bias2 = ((const float*)C.in[I_SBB])[h] * LOG2E;
    float q[64];
    { const v4u* qp = (const v4u*)(SQ + (size_t)row * HW + h * HD);
#pragma unroll
      for (int c = 0; c < 8; ++c) { const v4u w = qp[c]; q[8 * c] = bflo(w.x); q[8 * c + 1] = bfhi(w.x); q[8 * c + 2] = bflo(w.y); q[8 * c + 3] = bfhi(w.y); q[8 * c + 4] = bflo(w.z); q[8 * c + 5] = bfhi(w.z); q[8 * c + 6] = bflo(w.w); q[8 * c + 7] = bfhi(w.w); } }
    float Cc = 1.f, o = 0.f;
    for (int base = nkeys > 0 ? ((nkeys - 1) & ~63) : -1; base >= 0; base -= 64) {
        const int j = base + lane; const bool valid = j < nkeys; const int jc = valid ? j : nkeys - 1;
        float z = 0.f;
        if (SAMPLE && jc < PAST) {
            const float* kr = ck + (((size_t)pt[seq * NPAGES + (jc >> 7)] * PAGE + (jc & 127)) * NH + h) * HD;
#pragma unroll
            for (int c = 0; c < 16; ++c) { const f32x4 w = ((const f32x4*)kr)[c]; z += q[4 * c] * w.x + q[4 * c + 1] * w.y + q[4 * c + 2] * w.z + q[4 * c + 3] * w.w; }
        } else {
            const size_t krow = SAMPLE ? (size_t)(MP + seq * TDEC + (jc - PAST)) : (size_t)seq * SEQ + jc;
            const v4u* kr = (const v4u*)(SK + krow * HW + h * HD);
#pragma unroll
            for (int c = 0; c < 8; ++c) { const v4u w = kr[c]; z += q[8 * c] * bflo(w.x) + q[8 * c + 1] * bfhi(w.x) + q[8 * c + 2] * bflo(w.y) + q[8 * c + 3] * bfhi(w.y) + q[8 * c + 4] * bflo(w.z) + q[8 * c + 5] * bfhi(w.z) + q[8 * c + 6] * bflo(w.w) + q[8 * c + 7] * bfhi(w.w); }
        }
        const float u = valid ? exp2f(z + bias2) : 0.f;
        float incl = 1.f / (1.f + u);
#pragma unroll
        for (int off = 1; off < 64; off <<= 1) { const float y = __shfl_down(incl, off); if (lane + off < 64) incl *= y; }
        const float a = u * incl * Cc;
        Cc *= __shfl(incl, 0);
        const int nk = nkeys - base < 64 ? nkeys - base : 64;
        for (int jj = 0; jj < nk; ++jj) {
            const float aj = __shfl(a, jj); const int jk = base + jj; float vv;
            if (SAMPLE && jk < PAST) vv = cv[(((size_t)pt[seq * NPAGES + (jk >> 7)] * PAGE + (jk & 127)) * NH + h) * HD + lane];
            else { const size_t vrow = SAMPLE ? (size_t)(MP + seq * TDEC + (jk - PAST)) : (size_t)seq * SEQ + jk; vv = bf2f(SV[vrow * HW + h * HD + lane]); }
            o += aj * vv;
        }
    }
    OMIX[(size_t)row * DM + HW + h * HD + lane] = f2bf(o);
}
__device__ __forceinline__ void p2_naive(const Ctx& C) {
    const int NLONG = NBATCH * NH;
    if (C.gw < NLONG) { const int b = C.gw / NH, h = C.gw % NH; hgrn_chain(C, b * SEQ, SEQ, h, nullptr, C.out + O_HP + (size_t)(b * NH + h) * 4096); return; }
    const int w = C.gw - NLONG, nw = C.ngw - NLONG;
    for (int i = w; i < NDEC * NH; i += nw) { const int n = i / NH, h = i % NH; hgrn_chain(C, MP + n * TDEC, TDEC, h, (const float*)C.in[I_SH] + (size_t)i * 4096, C.out + O_HS + (size_t)i * 4096); }
    for (int i = w; i < MP * NH; i += nw) { const int bh = i & 15, t = SEQ - 1 - (i >> 4), b = bh >> 3, h = bh & 7; sb_query<false>(C, b * SEQ + t, h, t, b); }
    for (int i = w; i < MS * NH; i += nw) { const int h = i & 7, r = i >> 3, n = r >> 3, t = r & 7; sb_query<true>(C, MP + r, h, PAST + t, n); }
}

__device__ __forceinline__ void thin_row(const float* xin, const bf16* br, const float* gpost, float* xout, const float* gpre, bf16* hrow, int lane) {
    const f32x4* xr = (const f32x4*)xin + lane; const v2u* bp = (const v2u*)br + lane; const f32x4* gp = (const f32x4*)gpost + lane;
    f32x4 b[4]; float s = 0.f;
#pragma unroll
    for (int j = 0; j < 4; ++j) { const v2u w = bp[64 * j]; b[j] = (f32x4){bflo(w.x), bfhi(w.x), bflo(w.y), bfhi(w.y)}; s += (b[j].x * b[j].x + b[j].y * b[j].y) + (b[j].z * b[j].z + b[j].w * b[j].w); }
    const float r = rsqrtf(wave_sum(s) * (1.f / DM) + RMS_EPS);
    float s2 = 0.f;
#pragma unroll
    for (int j = 0; j < 4; ++j) { b[j] = xr[64 * j] + b[j] * r * gp[64 * j]; s2 += (b[j].x * b[j].x + b[j].y * b[j].y) + (b[j].z * b[j].z + b[j].w * b[j].w); }
    f32x4* xo = (f32x4*)xout + lane;
#pragma unroll
    for (int j = 0; j < 4; ++j) xo[64 * j] = b[j];
    if (hrow) {
        const float r2 = rsqrtf(wave_sum(s2) * (1.f / DM) + RMS_EPS); const f32x4* g2 = (const f32x4*)gpre + lane; v2u* o8 = (v2u*)hrow + lane;
#pragma unroll
        for (int j = 0; j < 4; ++j) { const f32x4 gg = g2[64 * j]; v2u w; w.x = pk_bf16(b[j].x * r2 * gg.x, b[j].y * r2 * gg.y); w.y = pk_bf16(b[j].z * r2 * gg.z, b[j].w * r2 * gg.w); o8[64 * j] = w; }
    }
}
template <int WHICH>
__device__ __forceinline__ void p_thin(const Ctx& C) {
    const bf16* BR = (const bf16*)(C.ws + WS_BR); bf16* H = (bf16*)(C.ws + WS_H);
    float* X1 = (float*)(C.ws + WS_X1); float* X2 = (float*)(C.ws + WS_X2);
    const float* gpost = (const float*)C.in[WHICH == 0 ? I_GMIXPOST : WHICH == 1 ? I_GCAPOST : I_GFFNPOST];
    const float* gpre = (const float*)C.in[WHICH == 0 ? I_GCAPRE : I_GFFNPRE];
    for (int m = C.gw; m < MT; m += C.ngw) {
        const float* xin; float* xout;
        if (WHICH == 0) { xin = m < MP ? (const float*)C.in[I_XP] + (size_t)m * DM : (const float*)C.in[I_XS] + (size_t)(m - MP) * DM; xout = X1 + (size_t)m * DM; }
        else if (WHICH == 1) { xin = X1 + (size_t)m * DM; xout = X2 + (size_t)m * DM; }
        else { xin = X2 + (size_t)m * DM; xout = m < MP ? C.out + O_YP + (size_t)m * DM : C.out + O_YS + (size_t)(m - MP) * DM; }
        thin_row(xin, BR + (size_t)m * DM, gpost, xout, gpre, WHICH == 2 ? nullptr : H + (size_t)m * DM, C.lane);
    }
}

__device__ __forceinline__ void p6_naive(const Ctx& C) {
    const bf16* QCA = (const bf16*)(C.ws + WS_QCA); const bf16* MK = (const bf16*)(C.ws + WS_MK); const bf16* MV = (const bf16*)(C.ws + WS_MV);
    const float* cmk = (const float*)C.in[I_MK]; const float* cmv = (const float*)C.in[I_MV]; bf16* OCA = (bf16*)(C.ws + WS_OMIX);
    const int lane = C.lane;
    for (int it = C.gw; it < MT * CAH; it += C.ngw) {
        const int row = it >> 2, h = it & 3;
        const v2u qw = *((const v2u*)(QCA + (size_t)row * DM + h * CAD) + lane);
        const float q0 = bflo(qw.x), q1 = bfhi(qw.x), q2 = bflo(qw.y), q3 = bfhi(qw.y);
        float mx = -1e30f, l = 0.f, o0 = 0.f, o1 = 0.f, o2 = 0.f, o3 = 0.f;
        for (int m = 0; m < NMEM; ++m) {
            float k0, k1, k2, k3, v0, v1, v2, v3;
            if (row < MP) { const size_t off = ((size_t)((row >> 13) * NMEM + m)) * DM + h * CAD; const v2u kw = *((const v2u*)(MK + off) + lane), vw = *((const v2u*)(MV + off) + lane);
                k0 = bflo(kw.x); k1 = bfhi(kw.x); k2 = bflo(kw.y); k3 = bfhi(kw.y); v0 = bflo(vw.x); v1 = bfhi(vw.x); v2 = bflo(vw.y); v3 = bfhi(vw.y); }
            else { const size_t off = ((size_t)(((row - MP) >> 3) * NMEM + m)) * DM + h * CAD; const f32x4 kw = *((const f32x4*)(cmk + off) + lane), vw = *((const f32x4*)(cmv + off) + lane);
                k0 = kw.x; k1 = kw.y; k2 = kw.z; k3 = kw.w; v0 = vw.x; v1 = vw.y; v2 = vw.z; v3 = vw.w; }
            const float s = wave_sum(q0 * k0 + q1 * k1 + q2 * k2 + q3 * k3);
            const float mn = fmaxf(mx, s), sc = exp2f(mx - mn), p = exp2f(s - mn);
            l = l * sc + p; o0 = o0 * sc + p * v0; o1 = o1 * sc + p * v1; o2 = o2 * sc + p * v2; o3 = o3 * sc + p * v3; mx = mn;
        }
        const float il = 1.f / l; v2u w; w.x = pk_bf16(o0 * il, o1 * il); w.y = pk_bf16(o2 * il, o3 * il);
        *((v2u*)(OCA + (size_t)row * DM + h * CAD) + lane) = w;
    }
}

__device__ __forceinline__ float gelu_tanh(float x) { return x / (1.f + __expf(-1.5957691216057308f * (x + 0.044715f * x * x * x))); }
__device__ __forceinline__ void ld8(const bf16* p, float (&v)[8]) { const v4u w = *(const v4u*)p; v[0] = bflo(w.x); v[1] = bfhi(w.x); v[2] = bflo(w.y); v[3] = bfhi(w.y); v[4] = bflo(w.z); v[5] = bfhi(w.z); v[6] = bflo(w.w); v[7] = bfhi(w.w); }
__device__ __forceinline__ void ld8f(const float* p, float (&v)[8]) { const f32x4 a = *(const f32x4*)p, b = *(const f32x4*)(p + 4); v[0] = a.x; v[1] = a.y; v[2] = a.z; v[3] = a.w; v[4] = b.x; v[5] = b.y; v[6] = b.z; v[7] = b.w; }
__device__ __forceinline__ void p10_convgate(const Ctx& C) {
    const bf16* U = (const bf16*)(C.ws + WS_U); bf16* G = (bf16*)(C.ws + WS_G);
    const float* cw = (const float*)C.in[I_CONVW]; const float* cb = (const float*)C.in[I_CONVB]; const float* sc = (const float*)C.in[I_SC];
    constexpr int NCH = DFF / 8;
    const int gt = C.gw * 64 + C.lane, ngt = C.ngw * 64;
    for (int it = gt; it < MT * NCH; it += ngt) {
        const int row = it / NCH, c = (it % NCH) * 8;
        const int t = row < MP ? (row & (SEQ - 1)) : ((row - MP) & 7);
        float res[2][8];
#pragma unroll
        for (int half = 0; half < 2; ++half) {
            const int col = c + half * DFF;
            float u0[8], u1[8], u2[8], w0[8], w1[8], w2[8], bb[8];
            ld8(U + (size_t)row * DFF2 + col, u2);
            if (t >= 1) ld8(U + (size_t)(row - 1) * DFF2 + col, u1);
            else if (row < MP) {
#pragma unroll
                for (int e = 0; e < 8; ++e) u1[e] = 0.f;
            } else ld8f(sc + ((size_t)((row - MP) >> 3) * 2 + 1) * DFF2 + col, u1);
            if (t >= 2) ld8(U + (size_t)(row - 2) * DFF2 + col, u0);
            else if (row < MP) {
#pragma unroll
                for (int e = 0; e < 8; ++e) u0[e] = 0.f;
            } else ld8f(sc + ((size_t)((row - MP) >> 3) * 2 + t) * DFF2 + col, u0);
            ld8f(cw + col, w0); ld8f(cw + DFF2 + col, w1); ld8f(cw + 2 * DFF2 + col, w2); ld8f(cb + col, bb);
#pragma unroll
            for (int e = 0; e < 8; ++e) res[half][e] = bb[e] + w0[e] * u0[e] + w1[e] * u1[e] + w2[e] * u2[e];
        }
        v4u o;
        o.x = pk_bf16(gelu_tanh(res[0][0]) * res[1][0], gelu_tanh(res[0][1]) * res[1][1]); o.y = pk_bf16(gelu_tanh(res[0][2]) * res[1][2], gelu_tanh(res[0][3]) * res[1][3]);
        o.z = pk_bf16(gelu_tanh(res[0][4]) * res[1][4], gelu_tanh(res[0][5]) * res[1][5]); o.w = pk_bf16(gelu_tanh(res[0][6]) * res[1][6], gelu_tanh(res[0][7]) * res[1][7]);
        *(v4u*)(G + (size_t)row * DFF + c) = o;
    }
}
constexpr int NPH = 13;
#ifndef MK_ONE_LAUNCH
#define MK_ONE_LAUNCH 1
#endif
__global__ void __launch_bounds__(NTHREADS, 2) fwd(Args args) {
    extern __shared__ __attribute__((aligned(16))) unsigned char lds_raw[];
    Ctx C;
    C.in = args.in; C.out = args.out; C.ws = args.ws; C.lds = (LAS unsigned char*)lds_raw;
    C.tid = threadIdx.x; C.lane = C.tid & 63; C.wave = __builtin_amdgcn_readfirstlane(C.tid >> 6);
    C.gw = blockIdx.x * NWAVES + C.wave; C.ngw = gridDim.x * NWAVES;
    const int G = gridDim.x, bid = blockIdx.x;
    volatile LAS unsigned* MISC = (volatile LAS unsigned*)(C.lds + MISC_OFF);
    for (int u = C.tid; u < (LDS_BYTES - LDSCTL_OFF) / 4; u += NTHREADS) ((LAS unsigned*)(C.lds + LDSCTL_OFF))[u] = 0u;
    __syncthreads();
    const int lo = args.ph_lo, hi = args.ph_hi;
    XcdBarrier bar; bar.bar = (unsigned*)(C.ws + WS_CTL) + CW_BAR; bar.x = 0; bar.st = nullptr;
    if (hi - lo > 1) bar = xcd_barrier_post((unsigned*)(C.ws + WS_CTL) + CW_BAR, MISC + 8);
#define IN(k) (lo <= (k) && (k) < hi)
#define SEAM(k) do { if (IN(k) && IN((k) + 1)) xcd_barrier(bar); } while (0)
    bf16* H = (bf16*)(C.ws + WS_H);
    if (IN(0)) { p0_prologue(C); } SEAM(0);
    if (IN(1)) {
        { pg8::Gemm g{H, (const bf16*)(C.ws + WS_WIN), MT, DIN, DM}; pg8::StaticOrder S; S.init(MT, DIN, G, bid);
          pg8::EpiInProj E{(bf16*)(C.ws + WS_QH), (bf16*)(C.ws + WS_VH), (bf16*)(C.ws + WS_GH), (bf16*)(C.ws + WS_SQ), (bf16*)(C.ws + WS_SK), (bf16*)(C.ws + WS_SV), (float*)(C.ws + WS_LF),
                           (const float*)(C.ws + WS_LB), C.out + O_KP, C.out + O_VP, C.out + O_KS, C.out + O_VS, SQ_SCALE};
          pg8::gemm_phase<pg8::EpiInProj, pg8::StaticOrder, true, true>(C.lds + RING_OFF, g, S, E); }
        { pg8::Gemm g{(const bf16*)(C.ws + WS_MN), (const bf16*)(C.ws + WS_WCKV), NBATCH * NMEM, 2 * DM, DM}; pg8::StaticOrder S; S.init(NBATCH * NMEM, 2 * DM, G, (bid + G - 184 % G) % G);
          pg8::EpiMemKV E{(bf16*)(C.ws + WS_MK), (bf16*)(C.ws + WS_MV), C.out + O_MKP, C.out + O_MVP};
          pg8::gemm_phase<pg8::EpiMemKV, pg8::StaticOrder, true, true>(C.lds + RING_OFF, g, S, E); }
    } SEAM(1);
    if (IN(2)) { p2_naive(C); } SEAM(2);
    if (IN(3)) { pg8::Gemm g{(const bf16*)(C.ws + WS_OMIX), (const bf16*)(C.ws + WS_WO), MT, DM, DM}; pg8::StaticOrder S; S.init(MT, DM, G, bid);
        pg8::EpiStore E{(bf16*)(C.ws + WS_BR), DM, 1.f, nullptr, nullptr};
        pg8::gemm_phase<pg8::EpiStore, pg8::StaticOrder, true, true>(C.lds + RING_OFF, g, S, E); } SEAM(3);
    if (IN(4)) { p_thin<0>(C); } SEAM(4);
    if (IN(5)) { pg8::Gemm g{H, (const bf16*)(C.ws + WS_WCQ), MT, DM, DM}; pg8::StaticOrder S; S.init(MT, DM, G, bid);
        pg8::EpiStore E{(bf16*)(C.ws + WS_QCA), DM, CQ_SCALE, nullptr, nullptr};
        pg8::gemm_phase<pg8::EpiStore, pg8::StaticOrder, true, true>(C.lds + RING_OFF, g, S, E); } SEAM(5);
    if (IN(6)) { p6_naive(C); } SEAM(6);
    if (IN(7)) { pg8::Gemm g{(const bf16*)(C.ws + WS_OMIX), (const bf16*)(C.ws + WS_WCO), MT, DM, DM}; pg8::StaticOrder S; S.init(MT, DM, G, bid);
        pg8::EpiStore E{(bf16*)(C.ws + WS_BR), DM, 1.f, nullptr, nullptr};
        pg8::gemm_phase<pg8::EpiStore, pg8::StaticOrder, true, true>(C.lds + RING_OFF, g, S, E); } SEAM(7);
    if (IN(8)) { p_thin<1>(C); } SEAM(8);
    if (IN(9)) { pg8::Gemm g{H, (const bf16*)(C.ws + WS_WUP), MT, DFF2, DM}; pg8::StaticOrder S; S.init(MT, DFF2, G, bid);
        pg8::EpiStore E{(bf16*)(C.ws + WS_U), DFF2, 1.f, C.out + O_CP, C.out + O_CS};
        pg8::gemm_phase<pg8::EpiStore, pg8::StaticOrder, true, true>(C.lds + RING_OFF, g, S, E); } SEAM(9);
    if (IN(10)) { p10_convgate(C); } SEAM(10);
    if (IN(11)) { pg8::Gemm g{(const bf16*)(C.ws + WS_G), (const bf16*)(C.ws + WS_WDN), MT, DM, DFF}; pg8::StaticOrder S; S.init(MT, DM, G, bid);
        pg8::EpiStore E{(bf16*)(C.ws + WS_BR), DM, 1.f, nullptr, nullptr};
        pg8::gemm_phase<pg8::EpiStore, pg8::StaticOrder, true, true>(C.lds + RING_OFF, g, S, E); } SEAM(11);
    if (IN(12)) { p_thin<2>(C); }
#undef IN
#undef SEAM
}

extern "C" void kernel_launch(void* const* d_in, const int* in_sizes, int n_in, void* d_out, int out_size, void* d_ws, size_t ws_size, hipStream_t stream) {
    static int grid = 0;
    if (grid == 0) {
        if (n_in != N_IN || (size_t)out_size != O_END || ws_size < WS_END) { fprintf(stderr, "kernel_launch: unexpected problem: n_in %d out %d ws %zu\n", n_in, out_size, ws_size); grid = -1; return; }
        int dev = 0, cus = 0, per_cu = 0;
        if (hipGetDevice(&dev) != hipSuccess || hipDeviceGetAttribute(&cus, hipDeviceAttributeMultiprocessorCount, dev) != hipSuccess) { grid = -1; return; }
        if (hipFuncSetAttribute((const void*)fwd, hipFuncAttributeMaxDynamicSharedMemorySize, LDS_BYTES) != hipSuccess) { fprintf(stderr, "kernel_launch: hipFuncSetAttribute failed\n"); grid = -1; return; }
        if (hipOccupancyMaxActiveBlocksPerMultiprocessor(&per_cu, (const void*)fwd, NTHREADS, LDS_BYTES) != hipSuccess || per_cu < 1) fprintf(stderr, "kernel_launch: occupancy query says %d\n", per_cu);
        (void)hipGetLastError();
        grid = cus;
    }
    if (grid < 0) return;
    (void)hipMemsetAsync((char*)d_ws + WS_CTL, 0, CTL_ZERO_BYTES, stream);
    Args a{};
    for (int i = 0; i < N_IN; ++i) a.in[i] = d_in[i];
    a.out = (float*)d_out; a.ws = (unsigned char*)d_ws;
#if MK_ONE_LAUNCH
    a.ph_lo = 0; a.ph_hi = NPH;
    hipLaunchKernelGGL(fwd, dim3(grid), dim3(NTHREADS), LDS_BYTES, stream, a);
#else
    for (int p = 0; p < NPH; ++p) { a.ph_lo = p; a.ph_hi = p + 1; hipLaunchKernelGGL(fwd, dim3(grid), dim3(NTHREADS), LDS_BYTES, stream, a); }
#endif
}
```

```cpp
#include <hip/hip_runtime.h>
#include <cstdio>
#include <cstdint>
namespace pg8 {
#define PG8_LAS __attribute__((address_space(3)))
typedef unsigned short bf16_t;
typedef short bf16x8 __attribute__((ext_vector_type(8)));
typedef float f32x4 __attribute__((ext_vector_type(4)));
typedef unsigned u32x4 __attribute__((ext_vector_type(4)));
constexpr int BM = 256, BK = 64, HALF = 128, HTB = HALF * BK * 2  , STAGE_BYTES = 8 * HTB, NXCD = 8, WGM = 8;

__host__ __device__ __forceinline__ int lds_byte(int r, int c) { const int st = (r >> 4) * 2 + (c >> 5), rr = r & 15, cc = c & 31, ob = rr * 64 + cc * 2; return st * 1024 + (ob ^ (((ob >> 9) & 1) << 5)); }
__host__ __device__ __forceinline__ void stage_rc(int b, int& R, int& C) { const int st = b / 1024, sb = b % 1024, swz = sb ^ (((sb >> 9) & 1) << 5); R = (st >> 1) * 16 + swz / 64; C = (st & 1) * 32 + (swz % 64) / 2; }
__host__ __device__ __forceinline__ int perm32(int rho) { const int n = rho >> 4, i = rho & 15; return 8 * (i >> 2) + 4 * n + (i & 3); }

struct Unit { int pm, pn; };
struct Gemm { const bf16_t* A; const bf16_t* Bt; int M, N, K; };

struct StaticOrder {
    int nM, nN, nwg, G, c;
    __host__ __device__ void init(int M, int N, int G_, int c_) { nM = M / BM; nN = N / BM; nwg = nM * nN; G = G_; c = c_; }
    __host__ __device__ bool next(int i, Unit& u) const {
        const long L = (long)i * G + c; if (L >= nwg) return false;
        int wgid = (int)L; { const int q = nwg / NXCD, r = nwg % NXCD, xcd = wgid % NXCD, off = wgid / NXCD; wgid = (xcd < r ? xcd * (q + 1) : r * (q + 1) + (xcd - r) * q) + off; }
        const int nig = WGM * nN, gid = wgid / nig, fm = gid * WGM, gsz = (nM - fm) < WGM ? (nM - fm) : WGM;
        u.pm = fm + ((wgid % nig) % gsz); u.pn = (wgid % nig) / gsz; return true;
    }
    __device__ __forceinline__ void a_ready(const Unit&) const {}
    __device__ __forceinline__ void done(const Unit&) const {}
};

__device__ __forceinline__ unsigned cvt_pk_bf16(float lo, float hi) { unsigned r; asm volatile("v_cvt_pk_bf16_f32 %0, %1, %2" : "=v"(r) : "v"(lo), "v"(hi)); return r; }
typedef float f32x2 __attribute__((ext_vector_type(2)));
typedef __bf16 bf16x2_t __attribute__((ext_vector_type(2)));
__device__ __forceinline__ unsigned pk_bf16(float lo, float hi) { f32x2 v = {lo, hi}; bf16x2_t b = __builtin_convertvector(v, bf16x2_t); return __builtin_bit_cast(unsigned, b); }
__device__ __forceinline__ u32x4 pk8(f32x4 a, f32x4 b) { u32x4 w; w.x = pk_bf16(a[0], a[1]); w.y = pk_bf16(a[2], a[3]); w.z = pk_bf16(b[0], b[1]); w.w = pk_bf16(b[2], b[3]); return w; }

struct EpiStore {
    static constexpr bool PERM = true, AFTER_DRAIN = false;
    bf16_t* O; int ldc; float scale; float* cap_p; float* cap_s;
    __device__ __forceinline__ void operator()(const f32x4 (&acc)[2][2][4][2], const Unit& u, int wr, int wc, int fr, int fq) const {
        const int row0 = u.pm * BM + wr * 64 + fr, col0 = u.pn * BM + wc * 32 + 8 * fq;
#pragma unroll
        for (int ai = 0; ai < 2; ++ai)
#pragma unroll
            for (int m = 0; m < 4; ++m) {
                const int row = row0 + ai * HALF + m * 16;
                float* cap = nullptr;
                if (cap_p) {
                    if (row < 16384) { const int t = row & 8191; if (t >= 8190) cap = cap_p + (size_t)((row >> 13) * 2 + (t - 8190)) * 5632; }
                    else { const int r2 = row - 16384, t = r2 & 7; if (t >= 6) cap = cap_s + (size_t)((r2 >> 3) * 2 + (t - 6)) * 5632; }
                }
#pragma unroll
                for (int bj = 0; bj < 2; ++bj) {
                    const int col = col0 + bj * HALF;
                    const f32x4 v0 = acc[ai][bj][m][0] * scale, v1 = acc[ai][bj][m][1] * scale;
                    *(u32x4*)(O + (size_t)row * ldc + col) = pk8(v0, v1);
                    if (cap) { *(f32x4*)(cap + col) = v0; *(f32x4*)(cap + col + 4) = v1; }
                }
            }
    }
};

struct EpiInProj {
    static constexpr bool PERM = true, AFTER_DRAIN = false;
    bf16_t *QH, *VH, *GH, *SQ, *SK, *SV; float* LF; const float* LB; float* kp; float* vp; float* ks; float* vs; float sqscale;
    __device__ __forceinline__ void operator()(const f32x4 (&acc)[2][2][4][2], const Unit& u, int wr, int wc, int fr, int fq) const {
        const int seg = u.pn >> 1;
        const int row0 = u.pm * BM + wr * 64 + fr, col0 = (u.pn & 1) * BM + wc * 32 + 8 * fq;
        if (seg == 1) {
#pragma unroll
            for (int bj = 0; bj < 2; ++bj) {
                const int col = col0 + bj * HALF;
                const f32x4 l0 = *(const f32x4*)(LB + col), l1 = *(const f32x4*)(LB + col + 4);
#pragma unroll
                for (int ai = 0; ai < 2; ++ai)
#pragma unroll
                    for (int m = 0; m < 4; ++m) {
                        const int row = row0 + ai * HALF + m * 16;
                        f32x4 o0, o1;
#pragma unroll
                        for (int e = 0; e < 4; ++e) {
                            const float s0 = 1.f / (1.f + __expf(-acc[ai][bj][m][0][e])), s1 = 1.f / (1.f + __expf(-acc[ai][bj][m][1][e]));
                            o0[e] = __logf(l0[e] + (1.f - l0[e]) * s0); o1[e] = __logf(l1[e] + (1.f - l1[e]) * s1);
                        }
                        *(f32x4*)(LF + (size_t)row * 512 + col) = o0; *(f32x4*)(LF + (size_t)row * 512 + col + 4) = o1;
                    }
            }
            return;
        }
        bf16_t* dst = seg == 0 ? QH : seg == 2 ? VH : seg == 3 ? GH : seg == 4 ? SQ : seg == 5 ? SK : SV;
        const float sc = seg == 4 ? sqscale : 1.f;
        float* fp = seg == 5 ? kp : seg == 6 ? vp : nullptr;
        float* fs = seg == 5 ? ks : vs;
#pragma unroll
        for (int ai = 0; ai < 2; ++ai)
#pragma unroll
            for (int m = 0; m < 4; ++m) {
                const int row = row0 + ai * HALF + m * 16;
#pragma unroll
                for (int bj = 0; bj < 2; ++bj) {
                    const int col = col0 + bj * HALF;
                    const f32x4 v0 = acc[ai][bj][m][0], v1 = acc[ai][bj][m][1];
                    *(u32x4*)(dst + (size_t)row * 512 + col) = pk8(v0 * sc, v1 * sc);
                    if (fp) { float* f = row < 16384 ? fp + (size_t)row * 512 + col : fs + (size_t)(row - 16384) * 512 + col; *(f32x4*)f = v0; *(f32x4*)(f + 4) = v1; }
                }
            }
    }
};

struct EpiMemKV {
    static constexpr bool PERM = true, AFTER_DRAIN = false;
    bf16_t *MK, *MV; float *ok, *ov;
    __device__ __forceinline__ void operator()(const f32x4 (&acc)[2][2][4][2], const Unit& u, int wr, int wc, int fr, int fq) const {
        const int seg = u.pn >> 2;
        const int row0 = u.pm * BM + wr * 64 + fr, col0 = (u.pn & 3) * BM + wc * 32 + 8 * fq;
        bf16_t* dst = seg == 0 ? MK : MV; float* fo = seg == 0 ? ok : ov;
#pragma unroll
        for (int ai = 0; ai < 2; ++ai)
#pragma unroll
            for (int m = 0; m < 4; ++m) {
                const int row = row0 + ai * HALF + m * 16;
#pragma unroll
                for (int bj = 0; bj < 2; ++bj) {
                    const int col = col0 + bj * HALF;
                    const f32x4 v0 = acc[ai][bj][m][0], v1 = acc[ai][bj][m][1];
                    *(u32x4*)(dst + (size_t)row * 1024 + col) = pk8(v0, v1);
                    *(f32x4*)(fo + (size_t)row * 1024 + col) = v0; *(f32x4*)(fo + (size_t)row * 1024 + col + 4) = v1;
                }
            }
    }
};

template <class Epi, class Sched, bool ALIGN_EPI = false, bool SP2 = false>
__device__ __forceinline__ void gemm_phase(PG8_LAS unsigned char* lds, const Gemm g, const Sched& S, const Epi& E) {
    const int tid = threadIdx.x, wid = __builtin_amdgcn_readfirstlane(tid >> 6), lane = tid & 63, wr = wid >> 2, wc = wid & 3, fr = lane & 15, fq = lane >> 4;
    const int K = g.K, nt = K / BK;
    unsigned voffA[2], voffB[2];
#pragma unroll
    for (int i = 0; i < 2; ++i) { int R, C; stage_rc(tid * 16 + i * 8192, R, C); const int Rb = Epi::PERM ? ((R & ~31) + perm32(R & 31)) : R;
        voffA[i] = (unsigned)(R * K + C) * 2u; voffB[i] = (unsigned)(Rb * K + C) * 2u; }
    const size_t kstep = (size_t)(BK * 2);
    const size_t hstep = (size_t)HALF * K * 2;
    const size_t tstep = 2 * hstep;
    const unsigned ldsw = (unsigned)wid * 1024u;
    const int aoff = lds_byte(wr * 64 + fr, fq * 8), boff = lds_byte(wc * 32 + fr, fq * 8);
#define PG8_SA(b, h) (((b) * 2 + (h)) * HTB)
#define PG8_SB(b, h) ((4 + (b) * 2 + (h)) * HTB)
#define PG8_STAGE(bufoff, gbase, voff) do { _Pragma("unroll") for (int _i = 0; _i < 2; ++_i) \
        __builtin_amdgcn_global_load_lds((const unsigned*)((const char*)(gbase) + (voff)[_i]), (PG8_LAS unsigned*)(lds + (bufoff) + ldsw + _i * 8192), 16, 0, 0); } while (0)
#define PG8_LDA(dst, b, h) do { _Pragma("unroll") for (int m = 0; m < 4; ++m) _Pragma("unroll") for (int k = 0; k < 2; ++k) dst[m][k] = *(const PG8_LAS bf16x8*)(lds + PG8_SA(b, h) + aoff + m * 2048 + k * 1024); } while (0)
#define PG8_LDB(dst, b, h) do { _Pragma("unroll") for (int n = 0; n < 2; ++n) _Pragma("unroll") for (int k = 0; k < 2; ++k) dst[n][k] = *(const PG8_LAS bf16x8*)(lds + PG8_SB(b, h) + boff + n * 2048 + k * 1024); } while (0)
#define PG8_MMA(ai, bj, At, Bt) do { __builtin_amdgcn_s_setprio(1); _Pragma("unroll") for (int m = 0; m < 4; ++m) _Pragma("unroll") for (int n = 0; n < 2; ++n) _Pragma("unroll") for (int k = 0; k < 2; ++k) \
        acc[ai][bj][m][n] = __builtin_amdgcn_mfma_f32_16x16x32_bf16(Bt[n][k], At[m][k], acc[ai][bj][m][n], 0, 0, 0); __builtin_amdgcn_s_setprio(0); } while (0)
#define PG8_WAIT_V(n) asm volatile("s_waitcnt vmcnt(" #n ")" ::: "memory")
#define PG8_WAIT_L(n) asm volatile("s_waitcnt lgkmcnt(" #n ")" ::: "memory")
#define PG8_BAR __builtin_amdgcn_s_barrier()
#define PG8_SCHED __builtin_amdgcn_sched_barrier(0)
    Unit cur, nxt; int ui = 0;
    if (!S.next(0, cur)) return;
    f32x4 acc[2][2][4][2];
#pragma unroll
    for (int a = 0; a < 2; ++a)
#pragma unroll
        for (int b = 0; b < 2; ++b)
#pragma unroll
            for (int m = 0; m < 4; ++m)
#pragma unroll
                for (int n = 0; n < 2; ++n) acc[a][b][m][n] = (f32x4){0.f, 0.f, 0.f, 0.f};
    bf16x8 At[4][2], B0[2][2], B1[2][2];
    const char* cA = (const char*)g.A + (size_t)cur.pm * tstep; const char* cB = (const char*)g.Bt + (size_t)cur.pn * tstep;
    S.a_ready(cur);
    if constexpr (SP2) {
        PG8_STAGE(PG8_SB(0, 0), cB, voffB); PG8_STAGE(PG8_SB(0, 1), cB + hstep, voffB); PG8_STAGE(PG8_SA(0, 0), cA, voffA); PG8_STAGE(PG8_SA(0, 1), cA + hstep, voffA);
        if (wr == 1) PG8_BAR;
        PG8_WAIT_V(2); PG8_BAR;
        PG8_STAGE(PG8_SB(1, 0), cB + kstep, voffB); PG8_STAGE(PG8_SA(1, 0), cA + kstep, voffA); PG8_STAGE(PG8_SB(1, 1), cB + hstep + kstep, voffB);
        PG8_WAIT_V(6); PG8_BAR;
    } else {
        PG8_STAGE(PG8_SB(0, 0), cB, voffB); PG8_STAGE(PG8_SA(0, 0), cA, voffA); PG8_STAGE(PG8_SB(0, 1), cB + hstep, voffB); PG8_STAGE(PG8_SA(0, 1), cA + hstep, voffA);
        if (wr == 1) PG8_BAR;
        PG8_WAIT_V(4); PG8_BAR;
        PG8_STAGE(PG8_SB(1, 0), cB + kstep, voffB); PG8_STAGE(PG8_SA(1, 0), cA + kstep, voffA); PG8_STAGE(PG8_SB(1, 1), cB + hstep + kstep, voffB);
        PG8_WAIT_V(6); PG8_BAR;
    }
    for (;;) {
        const bool has_next = S.next(ui + 1, nxt);
        const char* nA = has_next ? (const char*)g.A + (size_t)nxt.pm * tstep : cA; const char* nB = has_next ? (const char*)g.Bt + (size_t)nxt.pn * tstep : cB;
        for (int t = 0; t < nt; t += 2) {
            const bool last = (t == nt - 2);
            const char* a1 = cA + (size_t)(t + 1) * kstep;
            const char* a2 = last ? nA : cA + (size_t)(t + 2) * kstep; const char* b2 = last ? nB : cB + (size_t)(t + 2) * kstep;
            const char* a3 = a2 + kstep; const char* b3 = b2 + kstep;
            if (last && has_next) S.a_ready(nxt);
            if constexpr (SP2) {
            PG8_LDB(B0, 0, 0); PG8_LDB(B1, 0, 1); PG8_SCHED; PG8_LDA(At, 0, 0); PG8_STAGE(PG8_SA(1, 1), a1 + hstep, voffA);
            PG8_WAIT_V(8); PG8_WAIT_L(0); PG8_BAR; PG8_MMA(0, 0, At, B0); PG8_MMA(0, 1, At, B1); PG8_BAR; PG8_SCHED;
            PG8_LDA(At, 0, 1); PG8_STAGE(PG8_SB(0, 0), b2, voffB); PG8_STAGE(PG8_SB(0, 1), b2 + hstep, voffB); PG8_STAGE(PG8_SA(0, 0), a2, voffA);
            PG8_WAIT_V(8); PG8_WAIT_L(0); PG8_BAR; PG8_MMA(1, 0, At, B0); PG8_MMA(1, 1, At, B1); PG8_BAR; PG8_SCHED;
            PG8_LDB(B0, 1, 0); PG8_LDB(B1, 1, 1); PG8_SCHED; PG8_LDA(At, 1, 0); PG8_STAGE(PG8_SA(0, 1), a2 + hstep, voffA);
            PG8_WAIT_V(8); PG8_WAIT_L(0); PG8_BAR; PG8_MMA(0, 0, At, B0); PG8_MMA(0, 1, At, B1); PG8_BAR; PG8_SCHED;
            PG8_LDA(At, 1, 1); PG8_STAGE(PG8_SB(1, 0), b3, voffB); PG8_STAGE(PG8_SB(1, 1), b3 + hstep, voffB); PG8_STAGE(PG8_SA(1, 0), a3, voffA);
            PG8_WAIT_V(8); PG8_WAIT_L(0); PG8_BAR; PG8_MMA(1, 0, At, B0); PG8_MMA(1, 1, At, B1); PG8_BAR; PG8_SCHED;
            } else {
            PG8_LDB(B0, 0, 0); PG8_SCHED; PG8_LDA(At, 0, 0); PG8_STAGE(PG8_SA(1, 1), a1 + hstep, voffA);
            PG8_WAIT_L(8); PG8_BAR; PG8_WAIT_L(0); PG8_MMA(0, 0, At, B0); PG8_BAR; PG8_SCHED;
            PG8_LDB(B1, 0, 1); PG8_STAGE(PG8_SB(0, 0), b2, voffB);
            PG8_BAR; PG8_WAIT_L(0); PG8_MMA(0, 1, At, B1); PG8_BAR;
            PG8_LDA(At, 0, 1); PG8_STAGE(PG8_SA(0, 0), a2, voffA);
            PG8_BAR; PG8_WAIT_L(0); PG8_MMA(1, 0, At, B0); PG8_BAR; PG8_SCHED;
            PG8_STAGE(PG8_SB(0, 1), b2 + hstep, voffB);
            PG8_WAIT_V(6); PG8_BAR; PG8_MMA(1, 1, At, B1); PG8_BAR;
            PG8_LDB(B0, 1, 0); PG8_SCHED; PG8_LDA(At, 1, 0); PG8_STAGE(PG8_SA(0, 1), a2 + hstep, voffA);
            PG8_WAIT_L(8); PG8_BAR; PG8_WAIT_L(0); PG8_MMA(0, 0, At, B0); PG8_BAR; PG8_SCHED;
            PG8_LDB(B1, 1, 1); PG8_STAGE(PG8_SB(1, 0), b3, voffB);
            PG8_BAR; PG8_WAIT_L(0); PG8_MMA(0, 1, At, B1); PG8_BAR;
            PG8_LDA(At, 1, 1); PG8_STAGE(PG8_SA(1, 0), a3, voffA);
            PG8_BAR; PG8_WAIT_L(0); PG8_MMA(1, 0, At, B0); PG8_BAR; PG8_SCHED;
            PG8_STAGE(PG8_SB(1, 1), b3 + hstep, voffB);
            PG8_WAIT_V(6); PG8_BAR; PG8_MMA(1, 1, At, B1); PG8_BAR;
            }
        }
        if constexpr (ALIGN_EPI) { if (wr == 0) PG8_BAR; }
        if constexpr (!Epi::AFTER_DRAIN) { E(acc, cur, wr, wc, fr, fq); S.done(cur); }
        if (!has_next) break;
#pragma unroll
        for (int a = 0; a < 2; ++a)
#pragma unroll
            for (int b = 0; b < 2; ++b)
#pragma unroll
                for (int m = 0; m < 4; ++m)
#pragma unroll
                    for (int n = 0; n < 2; ++n) acc[a][b][m][n] = (f32x4){0.f, 0.f, 0.f, 0.f};
        cur = nxt; cA = nA; cB = nB; ++ui;
        if constexpr (ALIGN_EPI) { if (wr == 1) PG8_BAR; }
    }
    PG8_WAIT_V(0);
    if constexpr (!ALIGN_EPI) { if (wr == 0) PG8_BAR; }
    PG8_BAR;
    if constexpr (Epi::AFTER_DRAIN) { E.fused(acc, cur, wr, wc, fr, fq, lds, wid, lane); S.done(cur); }
#undef PG8_SA
#undef PG8_SB
#undef PG8_STAGE
#undef PG8_LDA
#undef PG8_LDB
#undef PG8_MMA
#undef PG8_WAIT_V
#undef PG8_WAIT_L
#undef PG8_BAR
#undef PG8_SCHED
}
}
#define GAS __attribute__((address_space(1)))
#define LAS __attribute__((address_space(3)))
#define LDS_WAIT() asm volatile("s_waitcnt lgkmcnt(0)" ::: "memory")
#define VM_WAIT() asm volatile("s_waitcnt vmcnt(0)" ::: "memory")
#define XB_TMO      128
#define XB_XCNT(j)  (256  + 64 * (j))
#define XB_XSUB(j)  (1280 + 64 * (j))
#define XB_XGEN(j)  (2304 + 64 * (j))
#define XB_TOP      3328
#define XB_TOPGEN   3392
#define XCD_BAR_WORDS 3456
#define XB_SPIN_CAP (1u << 23)

__device__ __forceinline__ unsigned xb_ld(unsigned* p)              { return __hip_atomic_load(p, __ATOMIC_RELAXED, __HIP_MEMORY_SCOPE_AGENT); }
__device__ __forceinline__ unsigned xb_add(unsigned* p, unsigned v) { return __hip_atomic_fetch_add(p, v, __ATOMIC_RELAXED, __HIP_MEMORY_SCOPE_AGENT); }
__device__ __forceinline__ unsigned xb_xcc_id() { return (unsigned)__builtin_amdgcn_s_getreg((3 << 11) | 20) & 0xFu; }
#define XB_SPIN(cond, bar) do { unsigned _sp = 0; while (cond) { __builtin_amdgcn_s_sleep(1); \
    if ((++_sp & 255u) == 0u) { if (xb_ld(&(bar)[XB_TMO])) break; if (_sp > XB_SPIN_CAP) { atomicAdd(&(bar)[XB_TMO], 1u); break; } } } } while (0)

struct XcdBarrier {
    unsigned* bar; unsigned x;
    volatile LAS unsigned* st;
};

__device__ __forceinline__ XcdBarrier xcd_barrier_post(unsigned* bar, volatile LAS unsigned* st) {
    XcdBarrier b; b.bar = bar; b.x = xb_xcc_id(); b.st = st;
    if (threadIdx.x == 0) (void)xb_add(&bar[XB_XCNT(b.x)], 1u);
    return b;
}
__device__ __forceinline__ void xcd_barrier_complete(unsigned* bar, unsigned x, unsigned& nloc, unsigned& nx) {
    const unsigned G = gridDim.x * gridDim.y * gridDim.z;
    unsigned sum, cnt, mine, sp = 0u;
    for (;;) {
        sum = 0u; cnt = 0u; mine = 0u;
#pragma unroll
        for (unsigned j = 0; j < 16; ++j) { const unsigned c = xb_ld(&bar[XB_XCNT(j)]); sum += c; cnt += (c > 0u) ? 1u : 0u; mine = (j == x) ? c : mine; }
        if (sum == G) break;
        __builtin_amdgcn_s_sleep(1);
        if ((++sp & 255u) == 0u) { if (xb_ld(&bar[XB_TMO])) break; if (sp > XB_SPIN_CAP) { atomicAdd(&bar[XB_TMO], 1u); break; } }
    }
    nloc = mine > 0u ? mine : 1u; nx = cnt > 0u ? cnt : 1u;
}

__device__ __forceinline__ void xcd_barrier(const XcdBarrier& b) {
    asm volatile("s_waitcnt vmcnt(0)" ::: "memory");
    __syncthreads();
    if (threadIdx.x == 0) {
        unsigned* bar = b.bar;
        __builtin_amdgcn_s_waitcnt(0);
        unsigned nloc = b.st[0], nx = b.st[1];
        if (nloc == 0u) { xcd_barrier_complete(bar, b.x, nloc, nx); b.st[0] = nloc; b.st[1] = nx; }
        const unsigned old = xb_add(&bar[XB_XSUB(b.x)], 1u);
        const unsigned gen = old / nloc;
        if (old + 1u == (gen + 1u) * nloc) {
            __builtin_amdgcn_fence(__ATOMIC_RELEASE, "agent");
            asm volatile("s_waitcnt vmcnt(0)" ::: "memory");
            const unsigned og = xb_add(&bar[XB_TOP], 1u);
            const unsigned tg = og / nx;
            if (og + 1u == (tg + 1u) * nx) xb_add(&bar[XB_TOPGEN], 1u);
            else XB_SPIN(xb_ld(&bar[XB_TOPGEN]) == tg, bar);
            __builtin_amdgcn_fence(__ATOMIC_ACQUIRE, "agent");
            xb_add(&bar[XB_XGEN(b.x)], 1u);
            asm volatile("s_waitcnt vmcnt(0)" ::: "memory");
        } else {
            XB_SPIN(xb_ld(&bar[XB_XGEN(b.x)]) == gen, bar);
            __builtin_amdgcn_fence(__ATOMIC_ACQUIRE, "agent");
            asm volatile("s_waitcnt vmcnt(0)" ::: "memory");
        }
    }
    __syncthreads();
}
constexpr int NWAVES = 8, NTHREADS = 512;
constexpr int DM = 1024, SEQ = 8192, NBATCH = 2, MP = NBATCH * SEQ, NDEC = 128, TDEC = 8, MS = NDEC * TDEC, MT = MP + MS;
constexpr int DIN = 3584, HW = 512, NH = 8, HD = 64;
constexpr int NMEM = 256, CAH = 4, CAD = 256, DFF = 2816, DFF2 = 5632;
constexpr int PAST = 2048, PAGE = 128, NPAGES = 16;
constexpr float RMS_EPS = 1e-6f, LOG2E = 1.4426950408889634f;
constexpr float SQ_SCALE = 0.125f * LOG2E;
constexpr float CQ_SCALE = 0.0625f * LOG2E;
enum { I_XP = 0, I_XS, I_CK, I_CV, I_SH, I_SC, I_MK, I_MV, I_PT, I_MEM, I_WIN, I_HGN, I_HLB, I_SBB, I_WO, I_GMIXPRE, I_GMIXPOST, I_GCAPRE, I_GCAPOST, I_GMEM,
       I_WCQ, I_WCK, I_WCV, I_WCO, I_GFFNPRE, I_GFFNPOST, I_WUP, I_CONVW, I_CONVB, I_WDN, N_IN };
constexpr size_t O_YP = 0, O_YS = 16777216, O_KP = 17825792, O_VP = 26214400, O_HP = 34603008, O_CP = 34668544, O_MKP = 34691072, O_MVP = 35215360,
                 O_KS = 35739648, O_VS = 36263936, O_HS = 36788224, O_CS = 40982528, O_END = 42424320;
constexpr size_t MiB = 1u << 20;
constexpr size_t WS_CTL = 0, CTL_ZERO_BYTES = 1 * MiB;
constexpr size_t WS_WIN = 2 * MiB, WS_WO = 9 * MiB, WS_WCQ = 11 * MiB, WS_WCO = 13 * MiB, WS_WCKV = 15 * MiB, WS_WUP = 19 * MiB, WS_WDN = 30 * MiB;
constexpr size_t WS_LB = 36 * MiB, WS_MN = 37 * MiB, WS_MK = 38 * MiB, WS_MV = 39 * MiB;
constexpr size_t WS_H = 40 * MiB, WS_QH = 74 * MiB, WS_LF = 91 * MiB, WS_VH = 125 * MiB, WS_GH = 142 * MiB, WS_SQ = 159 * MiB, WS_SK = 176 * MiB, WS_SV = 193 * MiB;
constexpr size_t WS_OMIX = 210 * MiB, WS_BR = 244 * MiB, WS_X1 = 278 * MiB, WS_X2 = 346 * MiB, WS_QCA = 414 * MiB, WS_U = 448 * MiB, WS_G = 635 * MiB, WS_UCT = 730 * MiB, WS_DC = 762 * MiB, WS_SCT = 763 * MiB, WS_END = 780 * MiB;
constexpr int CW_BAR = 4096;
constexpr int RING_OFF = 0, RING_BYTES = 162816, LDSCTL_OFF = RING_BYTES, MISC_OFF = LDSCTL_OFF + 320, LDS_BYTES = 163840;

typedef unsigned short bf16;
typedef unsigned v4u __attribute__((ext_vector_type(4)));
typedef unsigned v2u __attribute__((ext_vector_type(2)));
typedef float f32x4 __attribute__((ext_vector_type(4)));
using pg8::pk_bf16;
__device__ __forceinline__ float bf2f(unsigned short b) { return __uint_as_float((unsigned)b << 16); }
__device__ __forceinline__ float bflo(unsigned w) { return __uint_as_float(w << 16); }
__device__ __forceinline__ float bfhi(unsigned w) { return __uint_as_float(w & 0xffff0000u); }
__device__ __forceinline__ unsigned short f2bf(float f) { return (unsigned short)(pk_bf16(f, 0.f) & 0xffffu); }
__device__ __forceinline__ float wave_sum(float v) {
#pragma unroll
    for (int o = 1; o < 64; o <<= 1) v += __shfl_xor(v, o);
    return v;
}
__device__ __forceinline__ float rdlane(float v, int l) { return __uint_as_float((unsigned)__builtin_amdgcn_readlane((int)__float_as_uint(v), l)); }

struct Args { const void* in[N_IN]; float* out; unsigned char* ws; int ph_lo, ph_hi; };
struct Ctx { const void* const* in; float* out; unsigned char* ws; LAS unsigned char* lds; int tid, lane, wave, gw, ngw; };

__device__ __forceinline__ void p0_transpose_item(const float* W, int K, int N, bf16* WT, int row_off, LAS float* scr, int item, int lane) {
    const int nblk = N / 32, kb = item / nblk, nb = item % nblk, k0 = 64 * kb, n0 = 32 * nb;
#pragma unroll 8
    for (int i = 0; i < 32; ++i) { const int kk = 2 * i + (lane >> 5); scr[kk * 33 + (lane & 31)] = W[(size_t)(k0 + kk) * N + n0 + (lane & 31)]; }
    LDS_WAIT(); asm volatile("" ::: "memory");
    const int c = lane & 7;
#pragma unroll
    for (int j = 0; j < 4; ++j) { const int n = (lane >> 3) + 8 * j; const LAS float* s = scr + (8 * c) * 33 + n;
        v4u o; o.x = pk_bf16(s[0 * 33], s[1 * 33]); o.y = pk_bf16(s[2 * 33], s[3 * 33]); o.z = pk_bf16(s[4 * 33], s[5 * 33]); o.w = pk_bf16(s[6 * 33], s[7 * 33]);
        *(v4u*)(WT + (size_t)(row_off + n0 + n) * K + k0 + 8 * c) = o; }
    LDS_WAIT(); asm volatile("" ::: "memory");
}
__device__ __forceinline__ void rms_row_to_bf16(const float* xrow, const float* g, bf16* orow, int lane) {
    const f32x4* xr = (const f32x4*)xrow + lane; const f32x4* gr = (const f32x4*)g + lane;
    f32x4 v[4]; float s = 0.f;
#pragma unroll
    for (int j = 0; j < 4; ++j) { v[j] = xr[64 * j]; s += (v[j].x * v[j].x + v[j].y * v[j].y) + (v[j].z * v[j].z + v[j].w * v[j].w); }
    const float r = rsqrtf(wave_sum(s) * (1.f / DM) + RMS_EPS);
    v2u* o8 = (v2u*)orow + lane;
#pragma unroll
    for (int j = 0; j < 4; ++j) { const f32x4 gg = gr[64 * j]; v2u w; w.x = pk_bf16(v[j].x * r * gg.x, v[j].y * r * gg.y); w.y = pk_bf16(v[j].z * r * gg.z, v[j].w * r * gg.w); o8[64 * j] = w; }
}
__device__ __forceinline__ void p0_prologue(const Ctx& C) {
    LAS float* scr = (LAS float*)(C.lds + RING_OFF + C.wave * 16384);
    const float* w_in = (const float*)C.in[I_WIN]; const float* w_o = (const float*)C.in[I_WO]; const float* w_cq = (const float*)C.in[I_WCQ]; const float* w_ck = (const float*)C.in[I_WCK];
    const float* w_cv = (const float*)C.in[I_WCV]; const float* w_co = (const float*)C.in[I_WCO]; const float* w_up = (const float*)C.in[I_WUP]; const float* w_dn = (const float*)C.in[I_WDN];
    bf16* Win = (bf16*)(C.ws + WS_WIN); bf16* Wo = (bf16*)(C.ws + WS_WO); bf16* Wcq = (bf16*)(C.ws + WS_WCQ); bf16* Wco = (bf16*)(C.ws + WS_WCO); bf16* Wckv = (bf16*)(C.ws + WS_WCKV);
    bf16* Wup = (bf16*)(C.ws + WS_WUP); bf16* Wdn = (bf16*)(C.ws + WS_WDN);
    constexpr int I_IN = (DM / 64) * (DIN / 32), I_SQ = (DM / 64) * (DM / 32), I_UP = (DM / 64) * (DFF2 / 32), I_DN = (DFF / 64) * (DM / 32);
    constexpr int NITEMS = I_IN + 5 * I_SQ + I_UP + I_DN;
    for (int it = C.gw; it < NITEMS; it += C.ngw) {
        int r = it;
        if (r < I_IN) { p0_transpose_item(w_in, DM, DIN, Win, 0, scr, r, C.lane); continue; } r -= I_IN;
        if (r < I_SQ) { p0_transpose_item(w_o, DM, DM, Wo, 0, scr, r, C.lane); continue; } r -= I_SQ;
        if (r < I_SQ) { p0_transpose_item(w_cq, DM, DM, Wcq, 0, scr, r, C.lane); continue; } r -= I_SQ;
        if (r < I_SQ) { p0_transpose_item(w_co, DM, DM, Wco, 0, scr, r, C.lane); continue; } r -= I_SQ;
        if (r < I_SQ) { p0_transpose_item(w_ck, DM, DM, Wckv, 0, scr, r, C.lane); continue; } r -= I_SQ;
        if (r < I_SQ) { p0_transpose_item(w_cv, DM, DM, Wckv, DM, scr, r, C.lane); continue; } r -= I_SQ;
        if (r < I_UP) { p0_transpose_item(w_up, DM, DFF2, Wup, 0, scr, r, C.lane); continue; } r -= I_UP;
        p0_transpose_item(w_dn, DFF, DM, Wdn, 0, scr, r, C.lane);
    }
    const float* xp = (const float*)C.in[I_XP]; const float* xs = (const float*)C.in[I_XS]; const float* mem = (const float*)C.in[I_MEM];
    bf16* H = (bf16*)(C.ws + WS_H); bf16* MN = (bf16*)(C.ws + WS_MN);
    const float* g_pre = (const float*)C.in[I_GMIXPRE]; const float* g_mem = (const float*)C.in[I_GMEM];
    for (int m = C.gw; m < MT + NBATCH * NMEM; m += C.ngw) {
        if (m < MP) rms_row_to_bf16(xp + (size_t)m * DM, g_pre, H + (size_t)m * DM, C.lane);
        else if (m < MT) rms_row_to_bf16(xs + (size_t)(m - MP) * DM, g_pre, H + (size_t)m * DM, C.lane);
        else rms_row_to_bf16(mem + (size_t)(m - MT) * DM, g_mem, MN + (size_t)(m - MT) * DM, C.lane);
    }
    if (C.gw == 0) {
        const float* lbp = (const float*)C.in[I_HLB]; float* LB = (float*)(C.ws + WS_LB);
        for (int k = C.lane; k < HW; k += 64) { const float a = lbp[k], b = lbp[HW + k]; LB[k] = 1.f / (1.f + __expf(b - a)); }
    }
}
typedef short bf16x8s __attribute__((ext_vector_type(8)));
typedef short s16x4 __attribute__((ext_vector_type(4)));
typedef short v4i16_t __attribute__((ext_vector_type(4)));
constexpr int HRS = 72;
__device__ __forceinline__ s16x4 tr4(const LAS bf16* p) { return __builtin_bit_cast(s16x4, __builtin_amdgcn_ds_read_tr16_b64_v4i16((LAS v4i16_t*)p)); }
__device__ __forceinline__ bf16x8s cat8(s16x4 lo, s16x4 hi) { return (bf16x8s){lo[0], lo[1], lo[2], lo[3], hi[0], hi[1], hi[2], hi[3]}; }
__device__ __forceinline__ f32x4 mfma16(bf16x8s a, bf16x8s b, f32x4 c) { return __builtin_amdgcn_mfma_f32_16x16x32_bf16(a, b, c, 0, 0, 0); }
__device__ __forceinline__ void hg_stage_v(const bf16* VH, int r0, int h, LAS bf16* Vt, int lane) {
#pragma unroll
    for (int it = 0; it < 8; ++it) { const int row = it * 8 + (lane >> 3), ch = lane & 7; const v4u w = *(const v4u*)(VH + (size_t)(r0 + row) * HW + h * HD + ch * 8); *(LAS v4u*)(Vt + row * HRS + ch * 8) = w; }
}
__device__ __forceinline__ void hgrn_h1(const Ctx& C, int cid) {
    const float* LF = (const float*)(C.ws + WS_LF); const bf16* VH = (const bf16*)(C.ws + WS_VH);
    float* UCT = (float*)(C.ws + WS_UCT); float* DC = (float*)(C.ws + WS_DC);
    const int lane = C.lane, i = lane & 15, g = lane >> 4;
    const int chain = cid >> 7, ci = cid & 127, b = chain >> 3, h = chain & 7, r0 = b * SEQ + ci * 64;
    LAS bf16* Vt = (LAS bf16*)(C.lds + RING_OFF + C.wave * 18432); LAS bf16* Kt = Vt + 64 * HRS;
    hg_stage_v(VH, r0, h, Vt, lane);
    const float* lfp = LF + (size_t)r0 * HW + h * HD + lane;
    float bl = 0.f;
#pragma unroll 16
    for (int t = 0; t < 64; ++t) bl += lfp[(size_t)t * HW];
    { float run = 0.f;
#pragma unroll 16
      for (int s = 0; s < 64; ++s) { const float lf = lfp[(size_t)s * HW]; run += lf; Kt[s * HRS + lane] = f2bf((1.f - __expf(lf)) * __expf(bl - run)); } }
    DC[(size_t)cid * 64 + lane] = __expf(bl);
    LDS_WAIT();
#pragma unroll
    for (int kb = 0; kb < 4; ++kb) {
        bf16x8s af[2];
#pragma unroll
        for (int ks = 0; ks < 2; ++ks) af[ks] = cat8(tr4(Kt + (32 * ks + 8 * g + (i >> 2)) * HRS + 16 * kb + (i & 3) * 4), tr4(Kt + (32 * ks + 8 * g + 4 + (i >> 2)) * HRS + 16 * kb + (i & 3) * 4));
#pragma unroll
        for (int db = 0; db < 4; ++db) {
            f32x4 acc = {0.f, 0.f, 0.f, 0.f};
#pragma unroll
            for (int ks = 0; ks < 2; ++ks) { const bf16x8s bfr = cat8(tr4(Vt + (32 * ks + 8 * g + (i >> 2)) * HRS + 16 * db + (i & 3) * 4), tr4(Vt + (32 * ks + 8 * g + 4 + (i >> 2)) * HRS + 16 * db + (i & 3) * 4));
                acc = mfma16(af[ks], bfr, acc); }
            *(f32x4*)(UCT + ((size_t)cid * 64 + 16 * db + i) * 64 + 16 * kb + 4 * g) = acc;
        }
    }
    LDS_WAIT();
}
__device__ __forceinline__ void hgrn_h2(const Ctx& C) {
    const float* UCT = (const float*)(C.ws + WS_UCT); const float* DC = (const float*)(C.ws + WS_DC); bf16* SCT = (bf16*)(C.ws + WS_SCT);
    const int lane = C.lane;
    for (int w = C.gw; w < NBATCH * NH * 64; w += C.ngw) {
        const int chain = w >> 6, d = w & 63; float S = 0.f;
        for (int c0 = 0; c0 < 128; c0 += 16) {
            float u[16], dc[16];
#pragma unroll
            for (int j = 0; j < 16; ++j) { const size_t cid = (size_t)chain * 128 + c0 + j; u[j] = UCT[(cid * 64 + d) * 64 + lane]; dc[j] = DC[cid * 64 + lane]; }
#pragma unroll
            for (int j = 0; j < 16; ++j) { const size_t cid = (size_t)chain * 128 + c0 + j; SCT[(cid * 64 + d) * 64 + lane] = f2bf(S); S = dc[j] * S + u[j]; }
        }
        C.out[O_HP + (size_t)chain * 4096 + lane * 64 + d] = S;
    }
}
__device__ __forceinline__ void hgrn_h3(const Ctx& C, int cid) {
    const float* LF = (const float*)(C.ws + WS_LF); const bf16* QH = (const bf16*)(C.ws + WS_QH); const bf16* VH = (const bf16*)(C.ws + WS_VH); const bf16* GH = (const bf16*)(C.ws + WS_GH);
    const bf16* SCT = (const bf16*)(C.ws + WS_SCT); bf16* OMIX = (bf16*)(C.ws + WS_OMIX); const float* hgn = (const float*)C.in[I_HGN];
    const int lane = C.lane, i = lane & 15, g = lane >> 4;
    const int chain = cid >> 7, ci = cid & 127, b = chain >> 3, h = chain & 7, r0 = b * SEQ + ci * 64;
    LAS bf16* Vt = (LAS bf16*)(C.lds + RING_OFF + C.wave * 18432); LAS bf16* Kb = Vt + 64 * HRS; LAS bf16* Qh = Kb + 16 * HRS; LAS bf16* Qt = Qh + 16 * HRS;
    hg_stage_v(VH, r0, h, Vt, lane);
    const float* lfp = LF + (size_t)r0 * HW + h * HD + lane; const bf16* qp = QH + (size_t)r0 * HW + h * HD + lane;
    float eb[4];
    bf16x8s sfr[4][2];
#pragma unroll
    for (int db = 0; db < 4; ++db)
#pragma unroll
        for (int ks = 0; ks < 2; ++ks) sfr[db][ks] = *(const bf16x8s*)(SCT + ((size_t)cid * 64 + 16 * db + i) * 64 + 32 * ks + 8 * g);
#pragma unroll
    for (int is = 0; is < 4; ++is) {
        const float ri = is ? eb[is - 1] : 0.f, er = __expf(ri);
        { float run = 0.f;
#pragma unroll
          for (int tt = 0; tt < 16; ++tt) { const int t = 16 * is + tt; run += lfp[(size_t)t * HW]; const float qt = bf2f(qp[(size_t)t * HW]) * __expf(run);
              Qt[tt * HRS + lane] = f2bf(qt); Qh[tt * HRS + lane] = f2bf(qt * er); }
          eb[is] = ri + run; }
        LDS_WAIT();
        bf16x8s qhf[2], qtf[2];
#pragma unroll
        for (int ks = 0; ks < 2; ++ks) { qhf[ks] = *(const LAS bf16x8s*)(Qh + i * HRS + 32 * ks + 8 * g); qtf[ks] = *(const LAS bf16x8s*)(Qt + i * HRS + 32 * ks + 8 * g); }
        f32x4 o[4];
#pragma unroll
        for (int db = 0; db < 4; ++db) { o[db] = (f32x4){0.f, 0.f, 0.f, 0.f};
#pragma unroll
            for (int ks = 0; ks < 2; ++ks) o[db] = mfma16(sfr[db][ks], qhf[ks], o[db]); }
#pragma unroll
        for (int jp = 0; jp <= is / 2; ++jp) {
            f32x4 x[2];
#pragma unroll
            for (int jj = 0; jj < 2; ++jj) {
                const int j = 2 * jp + jj; x[jj] = (f32x4){0.f, 0.f, 0.f, 0.f};
                if (j <= is) {
                    { float run = (j ? eb[j - 1] : 0.f) - ri;
#pragma unroll
                      for (int ss = 0; ss < 16; ++ss) { const int s = 16 * j + ss; const float lf = lfp[(size_t)s * HW]; run += lf; Kb[ss * HRS + lane] = f2bf((1.f - __expf(lf)) * __expf(-run)); } }
                    LDS_WAIT();
#pragma unroll
                    for (int ks = 0; ks < 2; ++ks) { const bf16x8s kf = *(const LAS bf16x8s*)(Kb + i * HRS + 32 * ks + 8 * g); x[jj] = mfma16(kf, qtf[ks], x[jj]); }
                    if (j == is) {
#pragma unroll
                        for (int e = 0; e < 4; ++e) if (4 * g + e > i) x[jj][e] = 0.f;
                    }
                    LDS_WAIT();
                }
            }
            bf16x8s pb; { const unsigned w0 = pk_bf16(x[0][0], x[0][1]), w1 = pk_bf16(x[0][2], x[0][3]), w2 = pk_bf16(x[1][0], x[1][1]), w3 = pk_bf16(x[1][2], x[1][3]); const v4u ww = {w0, w1, w2, w3}; pb = __builtin_bit_cast(bf16x8s, ww); }
            const int j0 = 2 * jp, j1 = (2 * jp + 1 <= is) ? 2 * jp + 1 : 2 * jp;
#pragma unroll
            for (int db = 0; db < 4; ++db) { const bf16x8s vf = cat8(tr4(Vt + (16 * j0 + 4 * g + (i >> 2)) * HRS + 16 * db + (i & 3) * 4), tr4(Vt + (16 * j1 + 4 * g + (i >> 2)) * HRS + 16 * db + (i & 3) * 4));
                o[db] = mfma16(vf, pb, o[db]); }
        }
        float ss = 0.f;
#pragma unroll
        for (int db = 0; db < 4; ++db) ss += (o[db][0] * o[db][0] + o[db][1] * o[db][1]) + (o[db][2] * o[db][2] + o[db][3] * o[db][3]);
        ss += __shfl_xor(ss, 16); ss += __shfl_xor(ss, 32);
        const float r = rsqrtf(ss * (1.f / HD) + RMS_EPS); const size_t row = (size_t)(r0 + 16 * is + i);
#pragma unroll
        for (int db = 0; db < 4; ++db) { const int d0 = h * HD + 16 * db + 4 * g; const v2u gw = *(const v2u*)(GH + row * HW + d0); const f32x4 gn = *(const f32x4*)(hgn + d0);
            const float g0 = bflo(gw.x), g1 = bfhi(gw.x), g2 = bflo(gw.y), g3 = bfhi(gw.y);
            v2u w; w.x = pk_bf16(o[db][0] * r * gn.x * (g0 / (1.f + __expf(-g0))), o[db][1] * r * gn.y * (g1 / (1.f + __expf(-g1))));
            w.y = pk_bf16(o[db][2] * r * gn.z * (g2 / (1.f + __expf(-g2))), o[db][3] * r * gn.w * (g3 / (1.f + __expf(-g3))));
            *(v2u*)(OMIX + row * DM + d0) = w; }
    }
    LDS_WAIT();
}
__device__ __forceinline__ void hgrn_chain(const Ctx& C, int rowbase, int T, int h, const float* S0, float* Sout) {
    const float* LF = (const float*)(C.ws + WS_LF); const bf16* QH = (const bf16*)(C.ws + WS_QH); const bf16* VH = (const bf16*)(C.ws + WS_VH); const bf16* GH = (const bf16*)(C.ws + WS_GH);
    bf16* OMIX = (bf16*)(C.ws + WS_OMIX); const float* hgn = (const float*)C.in[I_HGN];
    const int lane = C.lane; const float gn = hgn[h * HD + lane];
    float S[64];
#pragma unroll
    for (int k = 0; k < 64; ++k) S[k] = S0 ? S0[k * 64 + lane] : 0.f;
    for (int t = 0; t < T; ++t) {
        const size_t off = (size_t)(rowbase + t) * HW + h * HD + lane;
        const float fk = __expf(LF[off]), kk = 1.f - fk, qk = bf2f(QH[off]), vd = bf2f(VH[off]), g = bf2f(GH[off]);
        float o = 0.f;
#pragma unroll
        for (int k = 0; k < 64; ++k) { const float f_ = rdlane(fk, k), k_ = rdlane(kk, k), q_ = rdlane(qk, k); S[k] = f_ * S[k] + k_ * vd; o += S[k] * q_; }
        const float r = rsqrtf(wave_sum(o * o) * (1.f / HD) + RMS_EPS);
        OMIX[(size_t)(rowbase + t) * DM + h * HD + lane] = f2bf(o * r * gn * (g / (1.f + __expf(-g))));
    }
#pragma unroll
    for (int k = 0; k < 64; ++k) Sout[k * 64 + lane] = S[k];
}
template <bool SAMPLE>
__device__ __forceinline__ void sb_query(const Ctx& C, int row, int h, int nkeys, int seq  ) {
    const bf16* SQ = (const bf16*)(C.ws + WS_SQ); const bf16* SK = (const bf16*)(C.ws + WS_SK); const bf16* SV = (const bf16*)(C.ws + WS_SV);
    const float* ck = (const float*)C.in[I_CK]; const float* cv = (const float*)C.in[I_CV]; const int* pt = (const int*)C.in[I_PT];
    bf16* OMIX = (bf16*)(C.ws + WS_OMIX);
    const int lane = C.lane; const float bias2 = ((const float*)C.in[I_SBB])[h] * LOG2E;
    float q[64];
    { const v4u* qp = (const v4u*)(SQ + (size_t)row * HW + h * HD);
#pragma unroll
      for (int c = 0; c < 8; ++c) { const v4u w = qp[c]; q[8 * c] = bflo(w.x); q[8 * c + 1] = bfhi(w.x); q[8 * c + 2] = bflo(w.y); q[8 * c + 3] = bfhi(w.y); q[8 * c + 4] = bflo(w.z); q[8 * c + 5] = bfhi(w.z); q[8 * c + 6] = bflo(w.w); q[8 * c + 7] = bfhi(w.w); } }
    float Cc = 1.f, o = 0.f;
    for (int base = nkeys > 0 ? ((nkeys - 1) & ~63) : -1; base >= 0; base -= 64) {
        const int j = base + lane; const bool valid = j < nkeys; const int jc = valid ? j : nkeys - 1;
        float z = 0.f;
        if (SAMPLE && jc < PAST) {
            const float* kr = ck + (((size_t)pt[seq * NPAGES + (jc >> 7)] * PAGE + (jc & 127)) * NH + h) * HD;
#pragma unroll
            for (int c = 0; c < 16; ++c) { const f32x4 w = ((const f32x4*)kr)[c]; z += q[4 * c] * w.x + q[4 * c + 1] * w.y + q[4 * c + 2] * w.z + q[4 * c + 3] * w.w; }
        } else {
            const size_t krow = SAMPLE ? (size_t)(MP + seq * TDEC + (jc - PAST)) : (size_t)seq * SEQ + jc;
            const v4u* kr = (const v4u*)(SK + krow * HW + h * HD);
#pragma unroll
            for (int c = 0; c < 8; ++c) { const v4u w = kr[c]; z += q[8 * c] * bflo(w.x) + q[8 * c + 1] * bfhi(w.x) + q[8 * c + 2] * bflo(w.y) + q[8 * c + 3] * bfhi(w.y) + q[8 * c + 4] * bflo(w.z) + q[8 * c + 5] * bfhi(w.z) + q[8 * c + 6] * bflo(w.w) + q[8 * c + 7] * bfhi(w.w); }
        }
        const float u = valid ? exp2f(z + bias2) : 0.f;
        float incl = 1.f / (1.f + u);
#pragma unroll
        for (int off = 1; off < 64; off <<= 1) { const float y = __shfl_down(incl, off); if (lane + off < 64) incl *= y; }
        const float a = u * incl * Cc;
        Cc *= __shfl(incl, 0);
        const int nk = nkeys - base < 64 ? nkeys - base : 64;
        for (int jj = 0; jj < nk; ++jj) {
            const float aj = __shfl(a, jj); const int jk = base + jj; float vv;
            if (SAMPLE && jk < PAST) vv = cv[(((size_t)pt[seq * NPAGES + (jk >> 7)] * PAGE + (jk & 127)) * NH + h) * HD + lane];
            else { const size_t vrow = SAMPLE ? (size_t)(MP + seq * TDEC + (jk - PAST)) : (size_t)seq * SEQ + jk; vv = bf2f(SV[vrow * HW + h * HD + lane]); }
            o += aj * vv;
        }
    }
    OMIX[(size_t)row * DM + HW + h * HD + lane] = f2bf(o);
}
__device__ __forceinline__ void p2_mix1(const Ctx& C) {
    for (int cid = C.gw; cid < NBATCH * NH * (SEQ / 64); cid += C.ngw) hgrn_h1(C, cid);
    const int w = C.gw, nw = C.ngw;
    for (int i = w; i < NDEC * NH; i += nw) { const int n = i / NH, h = i % NH; hgrn_chain(C, MP + n * TDEC, TDEC, h, (const float*)C.in[I_SH] + (size_t)i * 4096, C.out + O_HS + (size_t)i * 4096); }
    for (int i = w; i < MP * NH; i += nw) { const int bh = i & 15, t = SEQ - 1 - (i >> 4), b = bh >> 3, h = bh & 7; sb_query<false>(C, b * SEQ + t, h, t, b); }
    for (int i = w; i < MS * NH; i += nw) { const int h = i & 7, r = i >> 3, n = r >> 3, t = r & 7; sb_query<true>(C, MP + r, h, PAST + t, n); }
}
__device__ __forceinline__ void p4_mix3(const Ctx& C) {
    for (int cid = C.gw; cid < NBATCH * NH * (SEQ / 64); cid += C.ngw) hgrn_h3(C, cid);
}

__device__ __forceinline__ void thin_row(const float* xin, const bf16* br, const float* gpost, float* xout, const float* gpre, bf16* hrow, int lane) {
    const f32x4* xr = (const f32x4*)xin + lane; const v2u* bp = (const v2u*)br + lane; const f32x4* gp = (const f32x4*)gpost + lane;
    f32x4 b[4]; float s = 0.f;
#pragma unroll
    for (int j = 0; j < 4; ++j) { const v2u w = bp[64 * j]; b[j] = (f32x4){bflo(w.x), bfhi(w.x), bflo(w.y), bfhi(w.y)}; s += (b[j].x * b[j].x + b[j].y * b[j].y) + (b[j].z * b[j].z + b[j].w * b[j].w); }
    const float r = rsqrtf(wave_sum(s) * (1.f / DM) + RMS_EPS);
    float s2 = 0.f;
#pragma unroll
    for (int j = 0; j < 4; ++j) { b[j] = xr[64 * j] + b[j] * r * gp[64 * j]; s2 += (b[j].x * b[j].x + b[j].y * b[j].y) + (b[j].z * b[j].z + b[j].w * b[j].w); }
    f32x4* xo = (f32x4*)xout + lane;
#pragma unroll
    for (int j = 0; j < 4; ++j) xo[64 * j] = b[j];
    if (hrow) {
        const float r2 = rsqrtf(wave_sum(s2) * (1.f / DM) + RMS_EPS); const f32x4* g2 = (const f32x4*)gpre + lane; v2u* o8 = (v2u*)hrow + lane;
#pragma unroll
        for (int j = 0; j < 4; ++j) { const f32x4 gg = g2[64 * j]; v2u w; w.x = pk_bf16(b[j].x * r2 * gg.x, b[j].y * r2 * gg.y); w.y = pk_bf16(b[j].z * r2 * gg.z, b[j].w * r2 * gg.w); o8[64 * j] = w; }
    }
}
template <int WHICH>
__device__ __forceinline__ void p_thin(const Ctx& C) {
    const bf16* BR = (const bf16*)(C.ws + WS_BR); bf16* H = (bf16*)(C.ws + WS_H);
    float* X1 = (float*)(C.ws + WS_X1); float* X2 = (float*)(C.ws + WS_X2);
    const float* gpost = (const float*)C.in[WHICH == 0 ? I_GMIXPOST : WHICH == 1 ? I_GCAPOST : I_GFFNPOST];
    const float* gpre = (const float*)C.in[WHICH == 0 ? I_GCAPRE : I_GFFNPRE];
    for (int m = C.gw; m < MT; m += C.ngw) {
        const float* xin; float* xout;
        if (WHICH == 0) { xin = m < MP ? (const float*)C.in[I_XP] + (size_t)m * DM : (const float*)C.in[I_XS] + (size_t)(m - MP) * DM; xout = X1 + (size_t)m * DM; }
        else if (WHICH == 1) { xin = X1 + (size_t)m * DM; xout = X2 + (size_t)m * DM; }
        else { xin = X2 + (size_t)m * DM; xout = m < MP ? C.out + O_YP + (size_t)m * DM : C.out + O_YS + (size_t)(m - MP) * DM; }
        thin_row(xin, BR + (size_t)m * DM, gpost, xout, gpre, WHICH == 2 ? nullptr : H + (size_t)m * DM, C.lane);
    }
}

__device__ __forceinline__ void p6_naive(const Ctx& C) {
    const bf16* QCA = (const bf16*)(C.ws + WS_QCA); const bf16* MK = (const bf16*)(C.ws + WS_MK); const bf16* MV = (const bf16*)(C.ws + WS_MV);
    const float* cmk = (const float*)C.in[I_MK]; const float* cmv = (const float*)C.in[I_MV]; bf16* OCA = (bf16*)(C.ws + WS_OMIX);
    const int lane = C.lane;
    for (int it = C.gw; it < MT * CAH; it += C.ngw) {
        const int row = it >> 2, h = it & 3;
        const v2u qw = *((const v2u*)(QCA + (size_t)row * DM + h * CAD) + lane);
        const float q0 = bflo(qw.x), q1 = bfhi(qw.x), q2 = bflo(qw.y), q3 = bfhi(qw.y);
        float mx = -1e30f, l = 0.f, o0 = 0.f, o1 = 0.f, o2 = 0.f, o3 = 0.f;
        for (int m = 0; m < NMEM; ++m) {
            float k0, k1, k2, k3, v0, v1, v2, v3;
            if (row < MP) { const size_t off = ((size_t)((row >> 13) * NMEM + m)) * DM + h * CAD; const v2u kw = *((const v2u*)(MK + off) + lane), vw = *((const v2u*)(MV + off) + lane);
                k0 = bflo(kw.x); k1 = bfhi(kw.x); k2 = bflo(kw.y); k3 = bfhi(kw.y); v0 = bflo(vw.x); v1 = bfhi(vw.x); v2 = bflo(vw.y); v3 = bfhi(vw.y); }
            else { const size_t off = ((size_t)(((row - MP) >> 3) * NMEM + m)) * DM + h * CAD; const f32x4 kw = *((const f32x4*)(cmk + off) + lane), vw = *((const f32x4*)(cmv + off) + lane);
                k0 = kw.x; k1 = kw.y; k2 = kw.z; k3 = kw.w; v0 = vw.x; v1 = vw.y; v2 = vw.z; v3 = vw.w; }
            const float s = wave_sum(q0 * k0 + q1 * k1 + q2 * k2 + q3 * k3);
            const float mn = fmaxf(mx, s), sc = exp2f(mx - mn), p = exp2f(s - mn);
            l = l * sc + p; o0 = o0 * sc + p * v0; o1 = o1 * sc + p * v1; o2 = o2 * sc + p * v2; o3 = o3 * sc + p * v3; mx = mn;
        }
        const float il = 1.f / l; v2u w; w.x = pk_bf16(o0 * il, o1 * il); w.y = pk_bf16(o2 * il, o3 * il);
        *((v2u*)(OCA + (size_t)row * DM + h * CAD) + lane) = w;
    }
}

__device__ __forceinline__ float gelu_tanh(float x) { return x / (1.f + __expf(-1.5957691216057308f * (x + 0.044715f * x * x * x))); }
__device__ __forceinline__ void ld8(const bf16* p, float (&v)[8]) { const v4u w = *(const v4u*)p; v[0] = bflo(w.x); v[1] = bfhi(w.x); v[2] = bflo(w.y); v[3] = bfhi(w.y); v[4] = bflo(w.z); v[5] = bfhi(w.z); v[6] = bflo(w.w); v[7] = bfhi(w.w); }
__device__ __forceinline__ void ld8f(const float* p, float (&v)[8]) { const f32x4 a = *(const f32x4*)p, b = *(const f32x4*)(p + 4); v[0] = a.x; v[1] = a.y; v[2] = a.z; v[3] = a.w; v[4] = b.x; v[5] = b.y; v[6] = b.z; v[7] = b.w; }
__device__ __forceinline__ void p10_convgate(const Ctx& C) {
    const bf16* U = (const bf16*)(C.ws + WS_U); bf16* G = (bf16*)(C.ws + WS_G);
    const float* cw = (const float*)C.in[I_CONVW]; const float* cb = (const float*)C.in[I_CONVB]; const float* sc = (const float*)C.in[I_SC];
    constexpr int NCH = DFF / 8;
    const int gt = C.gw * 64 + C.lane, ngt = C.ngw * 64;
    for (int it = gt; it < MT * NCH; it += ngt) {
        const int row = it / NCH, c = (it % NCH) * 8;
        const int t = row < MP ? (row & (SEQ - 1)) : ((row - MP) & 7);
        float res[2][8];
#pragma unroll
        for (int half = 0; half < 2; ++half) {
            const int col = c + half * DFF;
            float u0[8], u1[8], u2[8], w0[8], w1[8], w2[8], bb[8];
            ld8(U + (size_t)row * DFF2 + col, u2);
            if (t >= 1) ld8(U + (size_t)(row - 1) * DFF2 + col, u1);
            else if (row < MP) {
#pragma unroll
                for (int e = 0; e < 8; ++e) u1[e] = 0.f;
            } else ld8f(sc + ((size_t)((row - MP) >> 3) * 2 + 1) * DFF2 + col, u1);
            if (t >= 2) ld8(U + (size_t)(row - 2) * DFF2 + col, u0);
            else if (row < MP) {
#pragma unroll
                for (int e = 0; e < 8; ++e) u0[e] = 0.f;
            } else ld8f(sc + ((size_t)((row - MP) >> 3) * 2 + t) * DFF2 + col, u0);
            ld8f(cw + col, w0); ld8f(cw + DFF2 + col, w1); ld8f(cw + 2 * DFF2 + col, w2); ld8f(cb + col, bb);
#pragma unroll
            for (int e = 0; e < 8; ++e) res[half][e] = bb[e] + w0[e] * u0[e] + w1[e] * u1[e] + w2[e] * u2[e];
        }
        v4u o;
        o.x = pk_bf16(gelu_tanh(res[0][0]) * res[1][0], gelu_tanh(res[0][1]) * res[1][1]); o.y = pk_bf16(gelu_tanh(res[0][2]) * res[1][2], gelu_tanh(res[0][3]) * res[1][3]);
        o.z = pk_bf16(gelu_tanh(res[0][4]) * res[1][4], gelu_tanh(res[0][5]) * res[1][5]); o.w = pk_bf16(gelu_tanh(res[0][6]) * res[1][6], gelu_tanh(res[0][7]) * res[1][7]);
        *(v4u*)(G + (size_t)row * DFF + c) = o;
    }
}
enum { PH_PRO = 0, PH_INPROJ, PH_MIX1, PH_SCAN, PH_MIX3, PH_OPROJ, PH_THIN0, PH_CQ, PH_CA, PH_CO, PH_THIN1, PH_UP, PH_CONV, PH_DOWN, PH_THIN2, NPH };
#ifndef MK_ONE_LAUNCH
#define MK_ONE_LAUNCH 1
#endif
__global__ void __launch_bounds__(NTHREADS, 2) fwd(Args args) {
    extern __shared__ __attribute__((aligned(16))) unsigned char lds_raw[];
    Ctx C;
    C.in = args.in; C.out = args.out; C.ws = args.ws; C.lds = (LAS unsigned char*)lds_raw;
    C.tid = threadIdx.x; C.lane = C.tid & 63; C.wave = __builtin_amdgcn_readfirstlane(C.tid >> 6);
    C.gw = blockIdx.x * NWAVES + C.wave; C.ngw = gridDim.x * NWAVES;
    const int G = gridDim.x, bid = blockIdx.x;
    volatile LAS unsigned* MISC = (volatile LAS unsigned*)(C.lds + MISC_OFF);
    for (int u = C.tid; u < (LDS_BYTES - LDSCTL_OFF) / 4; u += NTHREADS) ((LAS unsigned*)(C.lds + LDSCTL_OFF))[u] = 0u;
    __syncthreads();
    const int lo = args.ph_lo, hi = args.ph_hi;
    XcdBarrier bar; bar.bar = (unsigned*)(C.ws + WS_CTL) + CW_BAR; bar.x = 0; bar.st = nullptr;
    if (hi - lo > 1) bar = xcd_barrier_post((unsigned*)(C.ws + WS_CTL) + CW_BAR, MISC + 8);
#define IN(k) (lo <= (k) && (k) < hi)
#define SEAM(k) do { if (IN(k) && IN((k) + 1)) xcd_barrier(bar); } while (0)
    bf16* H = (bf16*)(C.ws + WS_H);
    if (IN(PH_PRO)) { p0_prologue(C); } SEAM(PH_PRO);
    if (IN(PH_INPROJ)) {
        { pg8::Gemm g{H, (const bf16*)(C.ws + WS_WIN), MT, DIN, DM}; pg8::StaticOrder S; S.init(MT, DIN, G, bid);
          pg8::EpiInProj E{(bf16*)(C.ws + WS_QH), (bf16*)(C.ws + WS_VH), (bf16*)(C.ws + WS_GH), (bf16*)(C.ws + WS_SQ), (bf16*)(C.ws + WS_SK), (bf16*)(C.ws + WS_SV), (float*)(C.ws + WS_LF),
                           (const float*)(C.ws + WS_LB), C.out + O_KP, C.out + O_VP, C.out + O_KS, C.out + O_VS, SQ_SCALE};
          pg8::gemm_phase<pg8::EpiInProj, pg8::StaticOrder, true, true>(C.lds + RING_OFF, g, S, E); }
        { pg8::Gemm g{(const bf16*)(C.ws + WS_MN), (const bf16*)(C.ws + WS_WCKV), NBATCH * NMEM, 2 * DM, DM}; pg8::StaticOrder S; S.init(NBATCH * NMEM, 2 * DM, G, (bid + G - 184 % G) % G);
          pg8::EpiMemKV E{(bf16*)(C.ws + WS_MK), (bf16*)(C.ws + WS_MV), C.out + O_MKP, C.out + O_MVP};
          pg8::gemm_phase<pg8::EpiMemKV, pg8::StaticOrder, true, true>(C.lds + RING_OFF, g, S, E); }
    } SEAM(PH_INPROJ);
    if (IN(PH_MIX1)) { p2_mix1(C); } SEAM(PH_MIX1);
    if (IN(PH_SCAN)) { hgrn_h2(C); } SEAM(PH_SCAN);
    if (IN(PH_MIX3)) { p4_mix3(C); } SEAM(PH_MIX3);
    if (IN(PH_OPROJ)) { pg8::Gemm g{(const bf16*)(C.ws + WS_OMIX), (const bf16*)(C.ws + WS_WO), MT, DM, DM}; pg8::StaticOrder S; S.init(MT, DM, G, bid);
        pg8::EpiStore E{(bf16*)(C.ws + WS_BR), DM, 1.f, nullptr, nullptr};
        pg8::gemm_phase<pg8::EpiStore, pg8::StaticOrder, true, true>(C.lds + RING_OFF, g, S, E); } SEAM(PH_OPROJ);
    if (IN(PH_THIN0)) { p_thin<0>(C); } SEAM(PH_THIN0);
    if (IN(PH_CQ)) { pg8::Gemm g{H, (const bf16*)(C.ws + WS_WCQ), MT, DM, DM}; pg8::StaticOrder S; S.init(MT, DM, G, bid);
        pg8::EpiStore E{(bf16*)(C.ws + WS_QCA), DM, CQ_SCALE, nullptr, nullptr};
        pg8::gemm_phase<pg8::EpiStore, pg8::StaticOrder, true, true>(C.lds + RING_OFF, g, S, E); } SEAM(PH_CQ);
    if (IN(PH_CA)) { p6_naive(C); } SEAM(PH_CA);
    if (IN(PH_CO)) { pg8::Gemm g{(const bf16*)(C.ws + WS_OMIX), (const bf16*)(C.ws + WS_WCO), MT, DM, DM}; pg8::StaticOrder S; S.init(MT, DM, G, bid);
        pg8::EpiStore E{(bf16*)(C.ws + WS_BR), DM, 1.f, nullptr, nullptr};
        pg8::gemm_phase<pg8::EpiStore, pg8::StaticOrder, true, true>(C.lds + RING_OFF, g, S, E); } SEAM(PH_CO);
    if (IN(PH_THIN1)) { p_thin<1>(C); } SEAM(PH_THIN1);
    if (IN(PH_UP)) { pg8::Gemm g{H, (const bf16*)(C.ws + WS_WUP), MT, DFF2, DM}; pg8::StaticOrder S; S.init(MT, DFF2, G, bid);
        pg8::EpiStore E{(bf16*)(C.ws + WS_U), DFF2, 1.f, C.out + O_CP, C.out + O_CS};
        pg8::gemm_phase<pg8::EpiStore, pg8::StaticOrder, true, true>(C.lds + RING_OFF, g, S, E); } SEAM(PH_UP);
    if (IN(PH_CONV)) { p10_convgate(C); } SEAM(PH_CONV);
    if (IN(PH_DOWN)) { pg8::Gemm g{(const bf16*)(C.ws + WS_G), (const bf16*)(C.ws + WS_WDN), MT, DM, DFF}; pg8::StaticOrder S; S.init(MT, DM, G, bid);
        pg8::EpiStore E{(bf16*)(C.ws + WS_BR), DM, 1.f, nullptr, nullptr};
        pg8::gemm_phase<pg8::EpiStore, pg8::StaticOrder, true, true>(C.lds + RING_OFF, g, S, E); } SEAM(PH_DOWN);
    if (IN(PH_THIN2)) { p_thin<2>(C); }
#undef IN
#undef SEAM
}

extern "C" void kernel_launch(void* const* d_in, const int* in_sizes, int n_in, void* d_out, int out_size, void* d_ws, size_t ws_size, hipStream_t stream) {
    static int grid = 0;
    if (grid == 0) {
        if (n_in != N_IN || (size_t)out_size != O_END || ws_size < WS_END) { fprintf(stderr, "kernel_launch: unexpected problem: n_in %d out %d ws %zu\n", n_in, out_size, ws_size); grid = -1; return; }
        int dev = 0, cus = 0, per_cu = 0;
        if (hipGetDevice(&dev) != hipSuccess || hipDeviceGetAttribute(&cus, hipDeviceAttributeMultiprocessorCount, dev) != hipSuccess) { grid = -1; return; }
        if (hipFuncSetAttribute((const void*)fwd, hipFuncAttributeMaxDynamicSharedMemorySize, LDS_BYTES) != hipSuccess) { fprintf(stderr, "kernel_launch: hipFuncSetAttribute failed\n"); grid = -1; return; }
        if (hipOccupancyMaxActiveBlocksPerMultiprocessor(&per_cu, (const void*)fwd, NTHREADS, LDS_BYTES) != hipSuccess || per_cu < 1) fprintf(stderr, "kernel_launch: occupancy query says %d\n", per_cu);
        (void)hipGetLastError();
        grid = cus;
    }
    if (grid < 0) return;
    (void)hipMemsetAsync((char*)d_ws + WS_CTL, 0, CTL_ZERO_BYTES, stream);
    Args a{};
    for (int i = 0; i < N_IN; ++i) a.in[i] = d_in[i];
    a.out = (float*)d_out; a.ws = (unsigned char*)d_ws;
#if MK_ONE_LAUNCH
    a.ph_lo = 0; a.ph_hi = NPH;
    hipLaunchKernelGGL(fwd, dim3(grid), dim3(NTHREADS), LDS_BYTES, stream, a);
#else
    for (int p = 0; p < NPH; ++p) { a.ph_lo = p; a.ph_hi = p + 1; hipLaunchKernelGGL(fwd, dim3(grid), dim3(NTHREADS), LDS_BYTES, stream, a); }
#endif
}
```

```cpp
#include <hip/hip_runtime.h>
#include <cstdio>
#include <cstdint>
namespace pg8 {
#define PG8_LAS __attribute__((address_space(3)))
typedef unsigned short bf16_t;
typedef short bf16x8 __attribute__((ext_vector_type(8)));
typedef float f32x4 __attribute__((ext_vector_type(4)));
typedef unsigned u32x4 __attribute__((ext_vector_type(4)));
constexpr int BM = 256, BK = 64, HALF = 128, HTB = HALF * BK * 2  , STAGE_BYTES = 8 * HTB, NXCD = 8, WGM = 8;

__host__ __device__ __forceinline__ int lds_byte(int r, int c) { const int st = (r >> 4) * 2 + (c >> 5), rr = r & 15, cc = c & 31, ob = rr * 64 + cc * 2; return st * 1024 + (ob ^ (((ob >> 9) & 1) << 5)); }
__host__ __device__ __forceinline__ void stage_rc(int b, int& R, int& C) { const int st = b / 1024, sb = b % 1024, swz = sb ^ (((sb >> 9) & 1) << 5); R = (st >> 1) * 16 + swz / 64; C = (st & 1) * 32 + (swz % 64) / 2; }
__host__ __device__ __forceinline__ int perm32(int rho) { const int n = rho >> 4, i = rho & 15; return 8 * (i >> 2) + 4 * n + (i & 3); }

struct Unit { int pm, pn; };
struct Gemm { const bf16_t* A; const bf16_t* Bt; int M, N, K; };

struct StaticOrder {
    int nM, nN, nwg, G, c;
    __host__ __device__ void init(int M, int N, int G_, int c_) { nM = M / BM; nN = N / BM; nwg = nM * nN; G = G_; c = c_; }
    __host__ __device__ bool next(int i, Unit& u) const {
        const long L = (long)i * G + c; if (L >= nwg) return false;
        int wgid = (int)L; { const int q = nwg / NXCD, r = nwg % NXCD, xcd = wgid % NXCD, off = wgid / NXCD; wgid = (xcd < r ? xcd * (q + 1) : r * (q + 1) + (xcd - r) * q) + off; }
        const int nig = WGM * nN, gid = wgid / nig, fm = gid * WGM, gsz = (nM - fm) < WGM ? (nM - fm) : WGM;
        u.pm = fm + ((wgid % nig) % gsz); u.pn = (wgid % nig) / gsz; return true;
    }
    __device__ __forceinline__ void a_ready(const Unit&) const {}
    __device__ __forceinline__ void done(const Unit&) const {}
};

__device__ __forceinline__ unsigned cvt_pk_bf16(float lo, float hi) { unsigned r; asm volatile("v_cvt_pk_bf16_f32 %0, %1, %2" : "=v"(r) : "v"(lo), "v"(hi)); return r; }
typedef float f32x2 __attribute__((ext_vector_type(2)));
typedef __bf16 bf16x2_t __attribute__((ext_vector_type(2)));
__device__ __forceinline__ unsigned pk_bf16(float lo, float hi) { f32x2 v = {lo, hi}; bf16x2_t b = __builtin_convertvector(v, bf16x2_t); return __builtin_bit_cast(unsigned, b); }
__device__ __forceinline__ u32x4 pk8(f32x4 a, f32x4 b) { u32x4 w; w.x = pk_bf16(a[0], a[1]); w.y = pk_bf16(a[2], a[3]); w.z = pk_bf16(b[0], b[1]); w.w = pk_bf16(b[2], b[3]); return w; }

struct EpiStore {
    static constexpr bool PERM = true, AFTER_DRAIN = false;
    bf16_t* O; int ldc; float scale; float* cap_p; float* cap_s;
    __device__ __forceinline__ void operator()(const f32x4 (&acc)[2][2][4][2], const Unit& u, int wr, int wc, int fr, int fq) const {
        const int row0 = u.pm * BM + wr * 64 + fr, col0 = u.pn * BM + wc * 32 + 8 * fq;
#pragma unroll
        for (int ai = 0; ai < 2; ++ai)
#pragma unroll
            for (int m = 0; m < 4; ++m) {
                const int row = row0 + ai * HALF + m * 16;
                float* cap = nullptr;
                if (cap_p) {
                    if (row < 16384) { const int t = row & 8191; if (t >= 8190) cap = cap_p + (size_t)((row >> 13) * 2 + (t - 8190)) * 5632; }
                    else { const int r2 = row - 16384, t = r2 & 7; if (t >= 6) cap = cap_s + (size_t)((r2 >> 3) * 2 + (t - 6)) * 5632; }
                }
#pragma unroll
                for (int bj = 0; bj < 2; ++bj) {
                    const int col = col0 + bj * HALF;
                    const f32x4 v0 = acc[ai][bj][m][0] * scale, v1 = acc[ai][bj][m][1] * scale;
                    *(u32x4*)(O + (size_t)row * ldc + col) = pk8(v0, v1);
                    if (cap) { *(f32x4*)(cap + col) = v0; *(f32x4*)(cap + col + 4) = v1; }
                }
            }
    }
};

struct EpiInProj {
    static constexpr bool PERM = true, AFTER_DRAIN = false;
    bf16_t *QH, *VH, *GH, *SQ, *SK, *SV; float* LF; const float* LB; float* kp; float* vp; float* ks; float* vs; float sqscale;
    __device__ __forceinline__ void operator()(const f32x4 (&acc)[2][2][4][2], const Unit& u, int wr, int wc, int fr, int fq) const {
        const int seg = u.pn >> 1;
        const int row0 = u.pm * BM + wr * 64 + fr, col0 = (u.pn & 1) * BM + wc * 32 + 8 * fq;
        if (seg == 1) {
#pragma unroll
            for (int bj = 0; bj < 2; ++bj) {
                const int col = col0 + bj * HALF;
                const f32x4 l0 = *(const f32x4*)(LB + col), l1 = *(const f32x4*)(LB + col + 4);
#pragma unroll
                for (int ai = 0; ai < 2; ++ai)
#pragma unroll
                    for (int m = 0; m < 4; ++m) {
                        const int row = row0 + ai * HALF + m * 16;
                        f32x4 o0, o1;
#pragma unroll
                        for (int e = 0; e < 4; ++e) {
                            const float s0 = 1.f / (1.f + __expf(-acc[ai][bj][m][0][e])), s1 = 1.f / (1.f + __expf(-acc[ai][bj][m][1][e]));
                            o0[e] = __logf(l0[e] + (1.f - l0[e]) * s0); o1[e] = __logf(l1[e] + (1.f - l1[e]) * s1);
                        }
                        *(f32x4*)(LF + (size_t)row * 512 + col) = o0; *(f32x4*)(LF + (size_t)row * 512 + col + 4) = o1;
                    }
            }
            return;
        }
        bf16_t* dst = seg == 0 ? QH : seg == 2 ? VH : seg == 3 ? GH : seg == 4 ? SQ : seg == 5 ? SK : SV;
        const float sc = seg == 4 ? sqscale : 1.f;
        float* fp = seg == 5 ? kp : seg == 6 ? vp : nullptr;
        float* fs = seg == 5 ? ks : vs;
#pragma unroll
        for (int ai = 0; ai < 2; ++ai)
#pragma unroll
            for (int m = 0; m < 4; ++m) {
                const int row = row0 + ai * HALF + m * 16;
#pragma unroll
                for (int bj = 0; bj < 2; ++bj) {
                    const int col = col0 + bj * HALF;
                    const f32x4 v0 = acc[ai][bj][m][0], v1 = acc[ai][bj][m][1];
                    *(u32x4*)(dst + (size_t)row * 512 + col) = pk8(v0 * sc, v1 * sc);
                    if (fp) { float* f = row < 16384 ? fp + (size_t)row * 512 + col : fs + (size_t)(row - 16384) * 512 + col; *(f32x4*)f = v0; *(f32x4*)(f + 4) = v1; }
                }
            }
    }
};

struct EpiMemKV {
    static constexpr bool PERM = true, AFTER_DRAIN = false;
    bf16_t *MK, *MV; float *ok, *ov;
    __device__ __forceinline__ void operator()(const f32x4 (&acc)[2][2][4][2], const Unit& u, int wr, int wc, int fr, int fq) const {
        const int seg = u.pn >> 2;
        const int row0 = u.pm * BM + wr * 64 + fr, col0 = (u.pn & 3) * BM + wc * 32 + 8 * fq;
        bf16_t* dst = seg == 0 ? MK : MV; float* fo = seg == 0 ? ok : ov;
#pragma unroll
        for (int ai = 0; ai < 2; ++ai)
#pragma unroll
            for (int m = 0; m < 4; ++m) {
                const int row = row0 + ai * HALF + m * 16;
#pragma unroll
                for (int bj = 0; bj < 2; ++bj) {
                    const int col = col0 + bj * HALF;
                    const f32x4 v0 = acc[ai][bj][m][0], v1 = acc[ai][bj][m][1];
                    *(u32x4*)(dst + (size_t)row * 1024 + col) = pk8(v0, v1);
                    *(f32x4*)(fo + (size_t)row * 1024 + col) = v0; *(f32x4*)(fo + (size_t)row * 1024 + col + 4) = v1;
                }
            }
    }
};

template <class Epi, class Sched, bool ALIGN_EPI = false, bool SP2 = false>
__device__ __forceinline__ void gemm_phase(PG8_LAS unsigned char* lds, const Gemm g, const Sched& S, const Epi& E) {
    const int tid = threadIdx.x, wid = __builtin_amdgcn_readfirstlane(tid >> 6), lane = tid & 63, wr = wid >> 2, wc = wid & 3, fr = lane & 15, fq = lane >> 4;
    const int K = g.K, nt = K / BK;
    unsigned voffA[2], voffB[2];
#pragma unroll
    for (int i = 0; i < 2; ++i) { int R, C; stage_rc(tid * 16 + i * 8192, R, C); const int Rb = Epi::PERM ? ((R & ~31) + perm32(R & 31)) : R;
        voffA[i] = (unsigned)(R * K + C) * 2u; voffB[i] = (unsigned)(Rb * K + C) * 2u; }
    const size_t kstep = (size_t)(BK * 2);
    const size_t hstep = (size_t)HALF * K * 2;
    const size_t tstep = 2 * hstep;
    const unsigned ldsw = (unsigned)wid * 1024u;
    const int aoff = lds_byte(wr * 64 + fr, fq * 8), boff = lds_byte(wc * 32 + fr, fq * 8);
#define PG8_SA(b, h) (((b) * 2 + (h)) * HTB)
#define PG8_SB(b, h) ((4 + (b) * 2 + (h)) * HTB)
#define PG8_STAGE(bufoff, gbase, voff) do { _Pragma("unroll") for (int _i = 0; _i < 2; ++_i) \
        __builtin_amdgcn_global_load_lds((const unsigned*)((const char*)(gbase) + (voff)[_i]), (PG8_LAS unsigned*)(lds + (bufoff) + ldsw + _i * 8192), 16, 0, 0); } while (0)
#define PG8_LDA(dst, b, h) do { _Pragma("unroll") for (int m = 0; m < 4; ++m) _Pragma("unroll") for (int k = 0; k < 2; ++k) dst[m][k] = *(const PG8_LAS bf16x8*)(lds + PG8_SA(b, h) + aoff + m * 2048 + k * 1024); } while (0)
#define PG8_LDB(dst, b, h) do { _Pragma("unroll") for (int n = 0; n < 2; ++n) _Pragma("unroll") for (int k = 0; k < 2; ++k) dst[n][k] = *(const PG8_LAS bf16x8*)(lds + PG8_SB(b, h) + boff + n * 2048 + k * 1024); } while (0)
#define PG8_MMA(ai, bj, At, Bt) do { __builtin_amdgcn_s_setprio(1); _Pragma("unroll") for (int m = 0; m < 4; ++m) _Pragma("unroll") for (int n = 0; n < 2; ++n) _Pragma("unroll") for (int k = 0; k < 2; ++k) \
        acc[ai][bj][m][n] = __builtin_amdgcn_mfma_f32_16x16x32_bf16(Bt[n][k], At[m][k], acc[ai][bj][m][n], 0, 0, 0); __builtin_amdgcn_s_setprio(0); } while (0)
#define PG8_WAIT_V(n) asm volatile("s_waitcnt vmcnt(" #n ")" ::: "memory")
#define PG8_WAIT_L(n) asm volatile("s_waitcnt lgkmcnt(" #n ")" ::: "memory")
#define PG8_BAR __builtin_amdgcn_s_barrier()
#define PG8_SCHED __builtin_amdgcn_sched_barrier(0)
    Unit cur, nxt; int ui = 0;
    if (!S.next(0, cur)) return;
    f32x4 acc[2][2][4][2];
#pragma unroll
    for (int a = 0; a < 2; ++a)
#pragma unroll
        for (int b = 0; b < 2; ++b)
#pragma unroll
            for (int m = 0; m < 4; ++m)
#pragma unroll
                for (int n = 0; n < 2; ++n) acc[a][b][m][n] = (f32x4){0.f, 0.f, 0.f, 0.f};
    bf16x8 At[4][2], B0[2][2], B1[2][2];
    const char* cA = (const char*)g.A + (size_t)cur.pm * tstep; const char* cB = (const char*)g.Bt + (size_t)cur.pn * tstep;
    S.a_ready(cur);
    if constexpr (SP2) {
        PG8_STAGE(PG8_SB(0, 0), cB, voffB); PG8_STAGE(PG8_SB(0, 1), cB + hstep, voffB); PG8_STAGE(PG8_SA(0, 0), cA, voffA); PG8_STAGE(PG8_SA(0, 1), cA + hstep, voffA);
        if (wr == 1) PG8_BAR;
        PG8_WAIT_V(2); PG8_BAR;
        PG8_STAGE(PG8_SB(1, 0), cB + kstep, voffB); PG8_STAGE(PG8_SA(1, 0), cA + kstep, voffA); PG8_STAGE(PG8_SB(1, 1), cB + hstep + kstep, voffB);
        PG8_WAIT_V(6); PG8_BAR;
    } else {
        PG8_STAGE(PG8_SB(0, 0), cB, voffB); PG8_STAGE(PG8_SA(0, 0), cA, voffA); PG8_STAGE(PG8_SB(0, 1), cB + hstep, voffB); PG8_STAGE(PG8_SA(0, 1), cA + hstep, voffA);
        if (wr == 1) PG8_BAR;
        PG8_WAIT_V(4); PG8_BAR;
        PG8_STAGE(PG8_SB(1, 0), cB + kstep, voffB); PG8_STAGE(PG8_SA(1, 0), cA + kstep, voffA); PG8_STAGE(PG8_SB(1, 1), cB + hstep + kstep, voffB);
        PG8_WAIT_V(6); PG8_BAR;
    }
    for (;;) {
        const bool has_next = S.next(ui + 1, nxt);
        const char* nA = has_next ? (const char*)g.A + (size_t)nxt.pm * tstep : cA; const char* nB = has_next ? (const char*)g.Bt + (size_t)nxt.pn * tstep : cB;
        for (int t = 0; t < nt; t += 2) {
            const bool last = (t == nt - 2);
            const char* a1 = cA + (size_t)(t + 1) * kstep;
            const char* a2 = last ? nA : cA + (size_t)(t + 2) * kstep; const char* b2 = last ? nB : cB + (size_t)(t + 2) * kstep;
            const char* a3 = a2 + kstep; const char* b3 = b2 + kstep;
            if (last && has_next) S.a_ready(nxt);
            if constexpr (SP2) {
            PG8_LDB(B0, 0, 0); PG8_LDB(B1, 0, 1); PG8_SCHED; PG8_LDA(At, 0, 0); PG8_STAGE(PG8_SA(1, 1), a1 + hstep, voffA);
            PG8_WAIT_V(8); PG8_WAIT_L(0); PG8_BAR; PG8_MMA(0, 0, At, B0); PG8_MMA(0, 1, At, B1); PG8_BAR; PG8_SCHED;
            PG8_LDA(At, 0, 1); PG8_STAGE(PG8_SB(0, 0), b2, voffB); PG8_STAGE(PG8_SB(0, 1), b2 + hstep, voffB); PG8_STAGE(PG8_SA(0, 0), a2, voffA);
            PG8_WAIT_V(8); PG8_WAIT_L(0); PG8_BAR; PG8_MMA(1, 0, At, B0); PG8_MMA(1, 1, At, B1); PG8_BAR; PG8_SCHED;
            PG8_LDB(B0, 1, 0); PG8_LDB(B1, 1, 1); PG8_SCHED; PG8_LDA(At, 1, 0); PG8_STAGE(PG8_SA(0, 1), a2 + hstep, voffA);
            PG8_WAIT_V(8); PG8_WAIT_L(0); PG8_BAR; PG8_MMA(0, 0, At, B0); PG8_MMA(0, 1, At, B1); PG8_BAR; PG8_SCHED;
            PG8_LDA(At, 1, 1); PG8_STAGE(PG8_SB(1, 0), b3, voffB); PG8_STAGE(PG8_SB(1, 1), b3 + hstep, voffB); PG8_STAGE(PG8_SA(1, 0), a3, voffA);
            PG8_WAIT_V(8); PG8_WAIT_L(0); PG8_BAR; PG8_MMA(1, 0, At, B0); PG8_MMA(1, 1, At, B1); PG8_BAR; PG8_SCHED;
            } else {
            PG8_LDB(B0, 0, 0); PG8_SCHED; PG8_LDA(At, 0, 0); PG8_STAGE(PG8_SA(1, 1), a1 + hstep, voffA);
            PG8_WAIT_L(8); PG8_BAR; PG8_WAIT_L(0); PG8_MMA(0, 0, At, B0); PG8_BAR; PG8_SCHED;
            PG8_LDB(B1, 0, 1); PG8_STAGE(PG8_SB(0, 0), b2, voffB);
            PG8_BAR; PG8_WAIT_L(0); PG8_MMA(0, 1, At, B1); PG8_BAR;
            PG8_LDA(At, 0, 1); PG8_STAGE(PG8_SA(0, 0), a2, voffA);
            PG8_BAR; PG8_WAIT_L(0); PG8_MMA(1, 0, At, B0); PG8_BAR; PG8_SCHED;
            PG8_STAGE(PG8_SB(0, 1), b2 + hstep, voffB);
            PG8_WAIT_V(6); PG8_BAR; PG8_MMA(1, 1, At, B1); PG8_BAR;
            PG8_LDB(B0, 1, 0); PG8_SCHED; PG8_LDA(At, 1, 0); PG8_STAGE(PG8_SA(0, 1), a2 + hstep, voffA);
            PG8_WAIT_L(8); PG8_BAR; PG8_WAIT_L(0); PG8_MMA(0, 0, At, B0); PG8_BAR; PG8_SCHED;
            PG8_LDB(B1, 1, 1); PG8_STAGE(PG8_SB(1, 0), b3, voffB);
            PG8_BAR; PG8_WAIT_L(0); PG8_MMA(0, 1, At, B1); PG8_BAR;
            PG8_LDA(At, 1, 1); PG8_STAGE(PG8_SA(1, 0), a3, voffA);
            PG8_BAR; PG8_WAIT_L(0); PG8_MMA(1, 0, At, B0); PG8_BAR; PG8_SCHED;
            PG8_STAGE(PG8_SB(1, 1), b3 + hstep, voffB);
            PG8_WAIT_V(6); PG8_BAR; PG8_MMA(1, 1, At, B1); PG8_BAR;
            }
        }
        if constexpr (ALIGN_EPI) { if (wr == 0) PG8_BAR; }
        if constexpr (!Epi::AFTER_DRAIN) { E(acc, cur, wr, wc, fr, fq); S.done(cur); }
        if (!has_next) break;
#pragma unroll
        for (int a = 0; a < 2; ++a)
#pragma unroll
            for (int b = 0; b < 2; ++b)
#pragma unroll
                for (int m = 0; m < 4; ++m)
#pragma unroll
                    for (int n = 0; n < 2; ++n) acc[a][b][m][n] = (f32x4){0.f, 0.f, 0.f, 0.f};
        cur = nxt; cA = nA; cB = nB; ++ui;
        if constexpr (ALIGN_EPI) { if (wr == 1) PG8_BAR; }
    }
    PG8_WAIT_V(0);
    if constexpr (!ALIGN_EPI) { if (wr == 0) PG8_BAR; }
    PG8_BAR;
    if constexpr (Epi::AFTER_DRAIN) { E.fused(acc, cur, wr, wc, fr, fq, lds, wid, lane); S.done(cur); }
#undef PG8_SA
#undef PG8_SB
#undef PG8_STAGE
#undef PG8_LDA
#undef PG8_LDB
#undef PG8_MMA
#undef PG8_WAIT_V
#undef PG8_WAIT_L
#undef PG8_BAR
#undef PG8_SCHED
}
}
#define GAS __attribute__((address_space(1)))
#define LAS __attribute__((address_space(3)))
#define LDS_WAIT() asm volatile("s_waitcnt lgkmcnt(0)" ::: "memory")
#define VM_WAIT() asm volatile("s_waitcnt vmcnt(0)" ::: "memory")
#define XB_TMO      128
#define XB_XCNT(j)  (256  + 64 * (j))
#define XB_XSUB(j)  (1280 + 64 * (j))
#define XB_XGEN(j)  (2304 + 64 * (j))
#define XB_TOP      3328
#define XB_TOPGEN   3392
#define XCD_BAR_WORDS 3456
#define XB_SPIN_CAP (1u << 23)

__device__ __forceinline__ unsigned xb_ld(unsigned* p)              { return __hip_atomic_load(p, __ATOMIC_RELAXED, __HIP_MEMORY_SCOPE_AGENT); }
__device__ __forceinline__ unsigned xb_add(unsigned* p, unsigned v) { return __hip_atomic_fetch_add(p, v, __ATOMIC_RELAXED, __HIP_MEMORY_SCOPE_AGENT); }
__device__ __forceinline__ unsigned xb_xcc_id() { return (unsigned)__builtin_amdgcn_s_getreg((3 << 11) | 20) & 0xFu; }
#define XB_SPIN(cond, bar) do { unsigned _sp = 0; while (cond) { __builtin_amdgcn_s_sleep(1); \
    if ((++_sp & 255u) == 0u) { if (xb_ld(&(bar)[XB_TMO])) break; if (_sp > XB_SPIN_CAP) { atomicAdd(&(bar)[XB_TMO], 1u); break; } } } } while (0)

struct XcdBarrier {
    unsigned* bar; unsigned x;
    volatile LAS unsigned* st;
};

__device__ __forceinline__ XcdBarrier xcd_barrier_post(unsigned* bar, volatile LAS unsigned* st) {
    XcdBarrier b; b.bar = bar; b.x = xb_xcc_id(); b.st = st;
    if (threadIdx.x == 0) (void)xb_add(&bar[XB_XCNT(b.x)], 1u);
    return b;
}
__device__ __forceinline__ void xcd_barrier_complete(unsigned* bar, unsigned x, unsigned& nloc, unsigned& nx) {
    const unsigned G = gridDim.x * gridDim.y * gridDim.z;
    unsigned sum, cnt, mine, sp = 0u;
    for (;;) {
        sum = 0u; cnt = 0u; mine = 0u;
#pragma unroll
        for (unsigned j = 0; j < 16; ++j) { const unsigned c = xb_ld(&bar[XB_XCNT(j)]); sum += c; cnt += (c > 0u) ? 1u : 0u; mine = (j == x) ? c : mine; }
        if (sum == G) break;
        __builtin_amdgcn_s_sleep(1);
        if ((++sp & 255u) == 0u) { if (xb_ld(&bar[XB_TMO])) break; if (sp > XB_SPIN_CAP) { atomicAdd(&bar[XB_TMO], 1u); break; } }
    }
    nloc = mine > 0u ? mine : 1u; nx = cnt > 0u ? cnt : 1u;
}

__device__ __forceinline__ void xcd_barrier(const XcdBarrier& b) {
    asm volatile("s_waitcnt vmcnt(0)" ::: "memory");
    __syncthreads();
    if (threadIdx.x == 0) {
        unsigned* bar = b.bar;
        __builtin_amdgcn_s_waitcnt(0);
        unsigned nloc = b.st[0], nx = b.st[1];
        if (nloc == 0u) { xcd_barrier_complete(bar, b.x, nloc, nx); b.st[0] = nloc; b.st[1] = nx; }
        const unsigned old = xb_add(&bar[XB_XSUB(b.x)], 1u);
        const unsigned gen = old / nloc;
        if (old + 1u == (gen + 1u) * nloc) {
            __builtin_amdgcn_fence(__ATOMIC_RELEASE, "agent");
            asm volatile("s_waitcnt vmcnt(0)" ::: "memory");
            const unsigned og = xb_add(&bar[XB_TOP], 1u);
            const unsigned tg = og / nx;
            if (og + 1u == (tg + 1u) * nx) xb_add(&bar[XB_TOPGEN], 1u);
            else XB_SPIN(xb_ld(&bar[XB_TOPGEN]) == tg, bar);
            __builtin_amdgcn_fence(__ATOMIC_ACQUIRE, "agent");
            xb_add(&bar[XB_XGEN(b.x)], 1u);
            asm volatile("s_waitcnt vmcnt(0)" ::: "memory");
        } else {
            XB_SPIN(xb_ld(&bar[XB_XGEN(b.x)]) == gen, bar);
            __builtin_amdgcn_fence(__ATOMIC_ACQUIRE, "agent");
            asm volatile("s_waitcnt vmcnt(0)" ::: "memory");
        }
    }
    __syncthreads();
}
constexpr int NWAVES = 8, NTHREADS = 512;
constexpr int DM = 1024, SEQ = 8192, NBATCH = 2, MP = NBATCH * SEQ, NDEC = 128, TDEC = 8, MS = NDEC * TDEC, MT = MP + MS;
constexpr int DIN = 3584, HW = 512, NH = 8, HD = 64;
constexpr int NMEM = 256, CAH = 4, CAD = 256, DFF = 2816, DFF2 = 5632;
constexpr int PAST = 2048, PAGE = 128, NPAGES = 16;
constexpr float RMS_EPS = 1e-6f, LOG2E = 1.4426950408889634f;
constexpr float SQ_SCALE = 0.125f * LOG2E;
constexpr float CQ_SCALE = 0.0625f * LOG2E;
enum { I_XP = 0, I_XS, I_CK, I_CV, I_SH, I_SC, I_MK, I_MV, I_PT, I_MEM, I_WIN, I_HGN, I_HLB, I_SBB, I_WO, I_GMIXPRE, I_GMIXPOST, I_GCAPRE, I_GCAPOST, I_GMEM,
       I_WCQ, I_WCK, I_WCV, I_WCO, I_GFFNPRE, I_GFFNPOST, I_WUP, I_CONVW, I_CONVB, I_WDN, N_IN };
constexpr size_t O_YP = 0, O_YS = 16777216, O_KP = 17825792, O_VP = 26214400, O_HP = 34603008, O_CP = 34668544, O_MKP = 34691072, O_MVP = 35215360,
                 O_KS = 35739648, O_VS = 36263936, O_HS = 36788224, O_CS = 40982528, O_END = 42424320;
constexpr size_t MiB = 1u << 20;
constexpr size_t WS_CTL = 0, CTL_ZERO_BYTES = 1 * MiB;
constexpr size_t WS_WIN = 2 * MiB, WS_WO = 9 * MiB, WS_WCQ = 11 * MiB, WS_WCO = 13 * MiB, WS_WCKV = 15 * MiB, WS_WUP = 19 * MiB, WS_WDN = 30 * MiB;
constexpr size_t WS_LB = 36 * MiB, WS_MN = 37 * MiB, WS_MK = 38 * MiB, WS_MV = 39 * MiB;
constexpr size_t WS_H = 40 * MiB, WS_QH = 74 * MiB, WS_LF = 91 * MiB, WS_VH = 125 * MiB, WS_GH = 142 * MiB, WS_SQ = 159 * MiB, WS_SK = 176 * MiB, WS_SV = 193 * MiB;
constexpr size_t WS_OMIX = 210 * MiB, WS_BR = 244 * MiB, WS_X1 = 278 * MiB, WS_X2 = 346 * MiB, WS_QCA = 414 * MiB, WS_U = 448 * MiB, WS_G = 635 * MiB, WS_UCT = 730 * MiB, WS_DC = 762 * MiB, WS_SCT = 763 * MiB, WS_END = 780 * MiB;
constexpr int CW_BAR = 4096;
constexpr int RING_OFF = 0, RING_BYTES = 162816, LDSCTL_OFF = RING_BYTES, MISC_OFF = LDSCTL_OFF + 320, LDS_BYTES = 163840;

typedef unsigned short bf16;
typedef unsigned v4u __attribute__((ext_vector_type(4)));
typedef unsigned v2u __attribute__((ext_vector_type(2)));
typedef float f32x4 __attribute__((ext_vector_type(4)));
using pg8::pk_bf16;
__device__ __forceinline__ float bf2f(unsigned short b) { return __uint_as_float((unsigned)b << 16); }
__device__ __forceinline__ float bflo(unsigned w) { return __uint_as_float(w << 16); }
__device__ __forceinline__ float bfhi(unsigned w) { return __uint_as_float(w & 0xffff0000u); }
__device__ __forceinline__ unsigned short f2bf(float f) { return (unsigned short)(pk_bf16(f, 0.f) & 0xffffu); }
__device__ __forceinline__ float wave_sum(float v) {
#pragma unroll
    for (int o = 1; o < 64; o <<= 1) v += __shfl_xor(v, o);
    return v;
}
__device__ __forceinline__ float rdlane(float v, int l) { return __uint_as_float((unsigned)__builtin_amdgcn_readlane((int)__float_as_uint(v), l)); }

struct Args { const void* in[N_IN]; float* out; unsigned char* ws; int ph_lo, ph_hi; };
struct Ctx { const void* const* in; float* out; unsigned char* ws; LAS unsigned char* lds; int tid, lane, wave, gw, ngw; };

__device__ __forceinline__ void p0_transpose_item(const float* W, int K, int N, bf16* WT, int row_off, LAS float* scr, int item, int lane) {
    const int nblk = N / 32, kb = item / nblk, nb = item % nblk, k0 = 64 * kb, n0 = 32 * nb;
#pragma unroll 8
    for (int i = 0; i < 32; ++i) { const int kk = 2 * i + (lane >> 5); scr[kk * 33 + (lane & 31)] = W[(size_t)(k0 + kk) * N + n0 + (lane & 31)]; }
    LDS_WAIT(); asm volatile("" ::: "memory");
    const int c = lane & 7;
#pragma unroll
    for (int j = 0; j < 4; ++j) { const int n = (lane >> 3) + 8 * j; const LAS float* s = scr + (8 * c) * 33 + n;
        v4u o; o.x = pk_bf16(s[0 * 33], s[1 * 33]); o.y = pk_bf16(s[2 * 33], s[3 * 33]); o.z = pk_bf16(s[4 * 33], s[5 * 33]); o.w = pk_bf16(s[6 * 33], s[7 * 33]);
        *(v4u*)(WT + (size_t)(row_off + n0 + n) * K + k0 + 8 * c) = o; }
    LDS_WAIT(); asm volatile("" ::: "memory");
}
__device__ __forceinline__ void rms_row_to_bf16(const float* xrow, const float* g, bf16* orow, int lane) {
    const f32x4* xr = (const f32x4*)xrow + lane; const f32x4* gr = (const f32x4*)g + lane;
    f32x4 v[4]; float s = 0.f;
#pragma unroll
    for (int j = 0; j < 4; ++j) { v[j] = xr[64 * j]; s += (v[j].x * v[j].x + v[j].y * v[j].y) + (v[j].z * v[j].z + v[j].w * v[j].w); }
    const float r = rsqrtf(wave_sum(s) * (1.f / DM) + RMS_EPS);
    v2u* o8 = (v2u*)orow + lane;
#pragma unroll
    for (int j = 0; j < 4; ++j) { const f32x4 gg = gr[64 * j]; v2u w; w.x = pk_bf16(v[j].x * r * gg.x, v[j].y * r * gg.y); w.y = pk_bf16(v[j].z * r * gg.z, v[j].w * r * gg.w); o8[64 * j] = w; }
}
__device__ __forceinline__ void p0_prologue(const Ctx& C) {
    LAS float* scr = (LAS float*)(C.lds + RING_OFF + C.wave * 16384);
    const float* w_in = (const float*)C.in[I_WIN]; const float* w_o = (const float*)C.in[I_WO]; const float* w_cq = (const float*)C.in[I_WCQ]; const float* w_ck = (const float*)C.in[I_WCK];
    const float* w_cv = (const float*)C.in[I_WCV]; const float* w_co = (const float*)C.in[I_WCO]; const float* w_up = (const float*)C.in[I_WUP]; const float* w_dn = (const float*)C.in[I_WDN];
    bf16* Win = (bf16*)(C.ws + WS_WIN); bf16* Wo = (bf16*)(C.ws + WS_WO); bf16* Wcq = (bf16*)(C.ws + WS_WCQ); bf16* Wco = (bf16*)(C.ws + WS_WCO); bf16* Wckv = (bf16*)(C.ws + WS_WCKV);
    bf16* Wup = (bf16*)(C.ws + WS_WUP); bf16* Wdn = (bf16*)(C.ws + WS_WDN);
    constexpr int I_IN = (DM / 64) * (DIN / 32), I_SQ = (DM / 64) * (DM / 32), I_UP = (DM / 64) * (DFF2 / 32), I_DN = (DFF / 64) * (DM / 32);
    constexpr int NITEMS = I_IN + 5 * I_SQ + I_UP + I_DN;
    for (int it = C.gw; it < NITEMS; it += C.ngw) {
        int r = it;
        if (r < I_IN) { p0_transpose_item(w_in, DM, DIN, Win, 0, scr, r, C.lane); continue; } r -= I_IN;
        if (r < I_SQ) { p0_transpose_item(w_o, DM, DM, Wo, 0, scr, r, C.lane); continue; } r -= I_SQ;
        if (r < I_SQ) { p0_transpose_item(w_cq, DM, DM, Wcq, 0, scr, r, C.lane); continue; } r -= I_SQ;
        if (r < I_SQ) { p0_transpose_item(w_co, DM, DM, Wco, 0, scr, r, C.lane); continue; } r -= I_SQ;
        if (r < I_SQ) { p0_transpose_item(w_ck, DM, DM, Wckv, 0, scr, r, C.lane); continue; } r -= I_SQ;
        if (r < I_SQ) { p0_transpose_item(w_cv, DM, DM, Wckv, DM, scr, r, C.lane); continue; } r -= I_SQ;
        if (r < I_UP) { p0_transpose_item(w_up, DM, DFF2, Wup, 0, scr, r, C.lane); continue; } r -= I_UP;
        p0_transpose_item(w_dn, DFF, DM, Wdn, 0, scr, r, C.lane);
    }
    const float* xp = (const float*)C.in[I_XP]; const float* xs = (const float*)C.in[I_XS]; const float* mem = (const float*)C.in[I_MEM];
    bf16* H = (bf16*)(C.ws + WS_H); bf16* MN = (bf16*)(C.ws + WS_MN);
    const float* g_pre = (const float*)C.in[I_GMIXPRE]; const float* g_mem = (const float*)C.in[I_GMEM];
    for (int m = C.gw; m < MT + NBATCH * NMEM; m += C.ngw) {
        if (m < MP) rms_row_to_bf16(xp + (size_t)m * DM, g_pre, H + (size_t)m * DM, C.lane);
        else if (m < MT) rms_row_to_bf16(xs + (size_t)(m - MP) * DM, g_pre, H + (size_t)m * DM, C.lane);
        else rms_row_to_bf16(mem + (size_t)(m - MT) * DM, g_mem, MN + (size_t)(m - MT) * DM, C.lane);
    }
    if (C.gw == 0) {
        const float* lbp = (const float*)C.in[I_HLB]; float* LB = (float*)(C.ws + WS_LB);
        for (int k = C.lane; k < HW; k += 64) { const float a = lbp[k], b = lbp[HW + k]; LB[k] = 1.f / (1.f + __expf(b - a)); }
    }
}
typedef short bf16x8s __attribute__((ext_vector_type(8)));
typedef short s16x4 __attribute__((ext_vector_type(4)));
typedef short v4i16_t __attribute__((ext_vector_type(4)));
constexpr int HRS = 72;
__device__ __forceinline__ s16x4 tr4(const LAS bf16* p) { return __builtin_bit_cast(s16x4, __builtin_amdgcn_ds_read_tr16_b64_v4i16((LAS v4i16_t*)p)); }
__device__ __forceinline__ bf16x8s cat8(s16x4 lo, s16x4 hi) { return (bf16x8s){lo[0], lo[1], lo[2], lo[3], hi[0], hi[1], hi[2], hi[3]}; }
__device__ __forceinline__ f32x4 mfma16(bf16x8s a, bf16x8s b, f32x4 c) { return __builtin_amdgcn_mfma_f32_16x16x32_bf16(a, b, c, 0, 0, 0); }
__device__ __forceinline__ void hg_stage_v(const bf16* VH, int r0, int h, LAS bf16* Vt, int lane) {
#pragma unroll
    for (int it = 0; it < 8; ++it) { const int row = it * 8 + (lane >> 3), ch = lane & 7; const v4u w = *(const v4u*)(VH + (size_t)(r0 + row) * HW + h * HD + ch * 8); *(LAS v4u*)(Vt + row * HRS + ch * 8) = w; }
}
__device__ __forceinline__ void hgrn_h1(const Ctx& C, int cid) {
    const float* LF = (const float*)(C.ws + WS_LF); const bf16* VH = (const bf16*)(C.ws + WS_VH);
    float* UCT = (float*)(C.ws + WS_UCT); float* DC = (float*)(C.ws + WS_DC);
    const int lane = C.lane, i = lane & 15, g = lane >> 4;
    const int chain = cid >> 7, ci = cid & 127, b = chain >> 3, h = chain & 7, r0 = b * SEQ + ci * 64;
    LAS bf16* Vt = (LAS bf16*)(C.lds + RING_OFF + C.wave * 18432); LAS bf16* Kt = Vt + 64 * HRS;
    hg_stage_v(VH, r0, h, Vt, lane);
    const float* lfp = LF + (size_t)r0 * HW + h * HD + lane;
    float bl = 0.f;
#pragma unroll 16
    for (int t = 0; t < 64; ++t) bl += lfp[(size_t)t * HW];
    { float run = 0.f;
#pragma unroll 16
      for (int s = 0; s < 64; ++s) { const float lf = lfp[(size_t)s * HW]; run += lf; Kt[s * HRS + lane] = f2bf((1.f - __expf(lf)) * __expf(bl - run)); } }
    DC[(size_t)cid * 64 + lane] = __expf(bl);
    LDS_WAIT();
#pragma unroll
    for (int kb = 0; kb < 4; ++kb) {
        bf16x8s af[2];
#pragma unroll
        for (int ks = 0; ks < 2; ++ks) af[ks] = cat8(tr4(Kt + (32 * ks + 8 * g + (i >> 2)) * HRS + 16 * kb + (i & 3) * 4), tr4(Kt + (32 * ks + 8 * g + 4 + (i >> 2)) * HRS + 16 * kb + (i & 3) * 4));
#pragma unroll
        for (int db = 0; db < 4; ++db) {
            f32x4 acc = {0.f, 0.f, 0.f, 0.f};
#pragma unroll
            for (int ks = 0; ks < 2; ++ks) { const bf16x8s bfr = cat8(tr4(Vt + (32 * ks + 8 * g + (i >> 2)) * HRS + 16 * db + (i & 3) * 4), tr4(Vt + (32 * ks + 8 * g + 4 + (i >> 2)) * HRS + 16 * db + (i & 3) * 4));
                acc = mfma16(af[ks], bfr, acc); }
            *(f32x4*)(UCT + ((size_t)cid * 64 + 16 * db + i) * 64 + 16 * kb + 4 * g) = acc;
        }
    }
    LDS_WAIT();
}
__device__ __forceinline__ void hgrn_h2(const Ctx& C) {
    const float* UCT = (const float*)(C.ws + WS_UCT); const float* DC = (const float*)(C.ws + WS_DC); bf16* SCT = (bf16*)(C.ws + WS_SCT);
    const int lane = C.lane;
    for (int w = C.gw; w < NBATCH * NH * 64; w += C.ngw) {
        const int chain = w >> 6, d = w & 63; float S = 0.f;
        for (int c0 = 0; c0 < 128; c0 += 16) {
            float u[16], dc[16];
#pragma unroll
            for (int j = 0; j < 16; ++j) { const size_t cid = (size_t)chain * 128 + c0 + j; u[j] = UCT[(cid * 64 + d) * 64 + lane]; dc[j] = DC[cid * 64 + lane]; }
#pragma unroll
            for (int j = 0; j < 16; ++j) { const size_t cid = (size_t)chain * 128 + c0 + j; SCT[(cid * 64 + d) * 64 + lane] = f2bf(S); S = dc[j] * S + u[j]; }
        }
        C.out[O_HP + (size_t)chain * 4096 + lane * 64 + d] = S;
    }
}
__device__ __forceinline__ void hgrn_h3(const Ctx& C, int cid) {
    const float* LF = (const float*)(C.ws + WS_LF); const bf16* QH = (const bf16*)(C.ws + WS_QH); const bf16* VH = (const bf16*)(C.ws + WS_VH); const bf16* GH = (const bf16*)(C.ws + WS_GH);
    const bf16* SCT = (const bf16*)(C.ws + WS_SCT); bf16* OMIX = (bf16*)(C.ws + WS_OMIX); const float* hgn = (const float*)C.in[I_HGN];
    const int lane = C.lane, i = lane & 15, g = lane >> 4;
    const int chain = cid >> 7, ci = cid & 127, b = chain >> 3, h = chain & 7, r0 = b * SEQ + ci * 64;
    LAS bf16* Vt = (LAS bf16*)(C.lds + RING_OFF + C.wave * 18432); LAS bf16* Kb = Vt + 64 * HRS; LAS bf16* Qh = Kb + 16 * HRS; LAS bf16* Qt = Qh + 16 * HRS;
    hg_stage_v(VH, r0, h, Vt, lane);
    const float* lfp = LF + (size_t)r0 * HW + h * HD + lane; const bf16* qp = QH + (size_t)r0 * HW + h * HD + lane;
    float eb[4];
    bf16x8s sfr[4][2];
#pragma unroll
    for (int db = 0; db < 4; ++db)
#pragma unroll
        for (int ks = 0; ks < 2; ++ks) sfr[db][ks] = *(const bf16x8s*)(SCT + ((size_t)cid * 64 + 16 * db + i) * 64 + 32 * ks + 8 * g);
#pragma unroll
    for (int is = 0; is < 4; ++is) {
        const float ri = is ? eb[is - 1] : 0.f, er = __expf(ri);
        { float run = 0.f;
#pragma unroll
          for (int tt = 0; tt < 16; ++tt) { const int t = 16 * is + tt; run += lfp[(size_t)t * HW]; const float qt = bf2f(qp[(size_t)t * HW]) * __expf(run);
              Qt[tt * HRS + lane] = f2bf(qt); Qh[tt * HRS + lane] = f2bf(qt * er); }
          eb[is] = ri + run; }
        LDS_WAIT();
        bf16x8s qhf[2], qtf[2];
#pragma unroll
        for (int ks = 0; ks < 2; ++ks) { qhf[ks] = *(const LAS bf16x8s*)(Qh + i * HRS + 32 * ks + 8 * g); qtf[ks] = *(const LAS bf16x8s*)(Qt + i * HRS + 32 * ks + 8 * g); }
        f32x4 o[4];
#pragma unroll
        for (int db = 0; db < 4; ++db) { o[db] = (f32x4){0.f, 0.f, 0.f, 0.f};
#pragma unroll
            for (int ks = 0; ks < 2; ++ks) o[db] = mfma16(sfr[db][ks], qhf[ks], o[db]); }
#pragma unroll
        for (int jp = 0; jp <= is / 2; ++jp) {
            f32x4 x[2];
#pragma unroll
            for (int jj = 0; jj < 2; ++jj) {
                const int j = 2 * jp + jj; x[jj] = (f32x4){0.f, 0.f, 0.f, 0.f};
                if (j <= is) {
                    { float run = (j ? eb[j - 1] : 0.f) - ri;
#pragma unroll
                      for (int ss = 0; ss < 16; ++ss) { const int s = 16 * j + ss; const float lf = lfp[(size_t)s * HW]; run += lf; Kb[ss * HRS + lane] = f2bf((1.f - __expf(lf)) * __expf(-run)); } }
                    LDS_WAIT();
#pragma unroll
                    for (int ks = 0; ks < 2; ++ks) { const bf16x8s kf = *(const LAS bf16x8s*)(Kb + i * HRS + 32 * ks + 8 * g); x[jj] = mfma16(kf, qtf[ks], x[jj]); }
                    if (j == is) {
#pragma unroll
                        for (int e = 0; e < 4; ++e) if (4 * g + e > i) x[jj][e] = 0.f;
                    }
                    LDS_WAIT();
                }
            }
            bf16x8s pb; { const unsigned w0 = pk_bf16(x[0][0], x[0][1]), w1 = pk_bf16(x[0][2], x[0][3]), w2 = pk_bf16(x[1][0], x[1][1]), w3 = pk_bf16(x[1][2], x[1][3]); const v4u ww = {w0, w1, w2, w3}; pb = __builtin_bit_cast(bf16x8s, ww); }
            const int j0 = 2 * jp, j1 = (2 * jp + 1 <= is) ? 2 * jp + 1 : 2 * jp;
#pragma unroll
            for (int db = 0; db < 4; ++db) { const bf16x8s vf = cat8(tr4(Vt + (16 * j0 + 4 * g + (i >> 2)) * HRS + 16 * db + (i & 3) * 4), tr4(Vt + (16 * j1 + 4 * g + (i >> 2)) * HRS + 16 * db + (i & 3) * 4));
                o[db] = mfma16(vf, pb, o[db]); }
        }
        float ss = 0.f;
#pragma unroll
        for (int db = 0; db < 4; ++db) ss += (o[db][0] * o[db][0] + o[db][1] * o[db][1]) + (o[db][2] * o[db][2] + o[db][3] * o[db][3]);
        ss += __shfl_xor(ss, 16); ss += __shfl_xor(ss, 32);
        const float r = rsqrtf(ss * (1.f / HD) + RMS_EPS); const size_t row = (size_t)(r0 + 16 * is + i);
#pragma unroll
        for (int db = 0; db < 4; ++db) { const int d0 = h * HD + 16 * db + 4 * g; const v2u gw = *(const v2u*)(GH + row * HW + d0); const f32x4 gn = *(const f32x4*)(hgn + d0);
            const float g0 = bflo(gw.x), g1 = bfhi(gw.x), g2 = bflo(gw.y), g3 = bfhi(gw.y);
            v2u w; w.x = pk_bf16(o[db][0] * r * gn.x * (g0 / (1.f + __expf(-g0))), o[db][1] * r * gn.y * (g1 / (1.f + __expf(-g1))));
            w.y = pk_bf16(o[db][2] * r * gn.z * (g2 / (1.f + __expf(-g2))), o[db][3] * r * gn.w * (g3 / (1.f + __expf(-g3))));
            *(v2u*)(OMIX + row * DM + d0) = w; }
    }
    LDS_WAIT();
}
typedef float f32x16 __attribute__((ext_vector_type(16)));
constexpr int SB_RS = 72;
constexpr int SB_TILE = 64 * SB_RS;
__device__ __forceinline__ f32x16 mfma32(bf16x8s a, bf16x8s b, f32x16 c) { return __builtin_amdgcn_mfma_f32_32x32x16_bf16(a, b, c, 0, 0, 0); }
__device__ __forceinline__ int sb_crow(int r, int hi) { return (r & 3) + 8 * (r >> 2) + 4 * hi; }
__device__ __forceinline__ void sb_unit(const Ctx& C, int b, int h, int qb) {
    const bf16* SQ = (const bf16*)(C.ws + WS_SQ); const bf16* SK = (const bf16*)(C.ws + WS_SK); const bf16* SV = (const bf16*)(C.ws + WS_SV); bf16* OMIX = (bf16*)(C.ws + WS_OMIX);
    const int tid = C.tid, lane = C.lane, r32 = lane & 31, hi = lane >> 5, w = C.wave;
    const int q0 = qb * 256, qlo = q0 + 32 * w, qpos = qlo + r32;
    LAS bf16* Kl = (LAS bf16*)(C.lds + RING_OFF); LAS bf16* Vl = Kl + 2 * SB_TILE;
    const float bias2 = ((const float*)C.in[I_SBB])[h] * LOG2E;
    bf16x8s qf[4];
#pragma unroll
    for (int ks = 0; ks < 4; ++ks) qf[ks] = *(const bf16x8s*)(SQ + (size_t)(b * SEQ + qpos) * HW + h * HD + 16 * ks + 8 * hi);
    const int srow = tid >> 3, sch = tid & 7;
    const bf16* gk = SK + (size_t)(b * SEQ + srow) * HW + h * HD + sch * 8; const bf16* gv = SV + (size_t)(b * SEQ + srow) * HW + h * HD + sch * 8;
    const int soff = srow * SB_RS + sch * 8;
    const int nt = (q0 + 256) / 64;
    v4u rk = *(const v4u*)(gk + (size_t)(nt - 1) * 64 * HW), rv = *(const v4u*)(gv + (size_t)(nt - 1) * 64 * HW);
    *(LAS v4u*)(Kl + soff) = rk; *(LAS v4u*)(Vl + soff) = rv;
    __syncthreads();
    f32x16 o0, o1;
#pragma unroll
    for (int r = 0; r < 16; ++r) { o0[r] = 0.f; o1[r] = 0.f; }
    float Cc = 1.f;
    const int kap = 16 * ((r32 >> 2) & 1) + (r32 & 3) + 4 * (r32 >> 3);
    const int koff = kap * SB_RS + 8 * hi;
    const int gi = lane >> 4, i16 = lane & 15;
    const int voff = (16 * hi + (i16 >> 2)) * SB_RS + 16 * (gi & 1) + (i16 & 3) * 4;
    int cur = 0;
    for (int t = nt - 1; t >= 0; --t) {
        if (t > 0) { rk = *(const v4u*)(gk + (size_t)(t - 1) * 64 * HW); rv = *(const v4u*)(gv + (size_t)(t - 1) * 64 * HW); }
        const LAS bf16* Kc = Kl + cur * SB_TILE; const LAS bf16* Vc = Vl + cur * SB_TILE;
        if (64 * t <= qlo + 30) {
            const bool diag = 64 * t + 63 >= qlo;
#pragma unroll
            for (int sub = 1; sub >= 0; --sub) {
                if (diag && 64 * t + 32 * sub > qlo + 30) continue;
                f32x16 p;
#pragma unroll
                for (int r = 0; r < 16; ++r) p[r] = bias2;
#pragma unroll
                for (int ks = 0; ks < 4; ++ks) { const bf16x8s kf = *(const LAS bf16x8s*)(Kc + sub * 32 * SB_RS + koff + 16 * ks); p = mfma32(kf, qf[ks], p); }
                float E = 1.f;
                const int key0 = 64 * t + 32 * sub + 16 * hi;
#pragma unroll
                for (int r = 0; r < 16; ++r) { float u = __builtin_amdgcn_exp2f(p[r]); if (diag) u = (key0 + r < qpos) ? u : 0.f; const float tt = E * u; E += tt; p[r] = tt; }
                const float Ti = __builtin_amdgcn_rcpf(E), Tp = __shfl_xor(Ti, 32);
                const float G = Ti * (hi ? Cc : Cc * Tp);
                Cc = Cc * Ti * Tp;
#pragma unroll
                for (int r = 0; r < 16; ++r) p[r] *= G;
                bf16x8s pa[2];
#pragma unroll
                for (int s = 0; s < 2; ++s) { const v4u ww = {pk_bf16(p[8 * s], p[8 * s + 1]), pk_bf16(p[8 * s + 2], p[8 * s + 3]), pk_bf16(p[8 * s + 4], p[8 * s + 5]), pk_bf16(p[8 * s + 6], p[8 * s + 7])}; pa[s] = __builtin_bit_cast(bf16x8s, ww); }
#pragma unroll
                for (int s = 0; s < 2; ++s) {
                    const LAS bf16* vb = Vc + (sub * 32 + 8 * s) * SB_RS + voff;
                    const bf16x8s v0 = cat8(tr4(vb), tr4(vb + 4 * SB_RS)), v1 = cat8(tr4(vb + 32), tr4(vb + 4 * SB_RS + 32));
                    o0 = mfma32(pa[s], v0, o0); o1 = mfma32(pa[s], v1, o1);
                }
            }
        }
        if (t > 0) { *(LAS v4u*)(Kl + (cur ^ 1) * SB_TILE + soff) = rk; *(LAS v4u*)(Vl + (cur ^ 1) * SB_TILE + soff) = rv; }
        __syncthreads();
        cur ^= 1;
    }
    bf16* orow = OMIX + (size_t)(b * SEQ + qlo) * DM + HW + h * HD + r32;
#pragma unroll
    for (int r = 0; r < 16; ++r) { const int q = sb_crow(r, hi); orow[(size_t)q * DM] = f2bf(o0[r]); orow[(size_t)q * DM + 32] = f2bf(o1[r]); }
}
__device__ __forceinline__ void sb_prompt_phase(const Ctx& C) {
    const int G = gridDim.x, bid = blockIdx.x;
    const int vcu = (G % 8 == 0) ? (bid % 8) * (G / 8) + bid / 8 : bid;
    for (int p = vcu; p < NBATCH * NH * 16; p += G) {
        const int bh = p >> 4, s = p & 15;
        sb_unit(C, bh >> 3, bh & 7, 31 - s);
        sb_unit(C, bh >> 3, bh & 7, s);
    }
}
__device__ __forceinline__ void hgrn_chain(const Ctx& C, int rowbase, int T, int h, const float* S0, float* Sout) {
    const float* LF = (const float*)(C.ws + WS_LF); const bf16* QH = (const bf16*)(C.ws + WS_QH); const bf16* VH = (const bf16*)(C.ws + WS_VH); const bf16* GH = (const bf16*)(C.ws + WS_GH);
    bf16* OMIX = (bf16*)(C.ws + WS_OMIX); const float* hgn = (const float*)C.in[I_HGN];
    const int lane = C.lane; const float gn = hgn[h * HD + lane];
    float S[64];
#pragma unroll
    for (int k = 0; k < 64; ++k) S[k] = S0 ? S0[k * 64 + lane] : 0.f;
    for (int t = 0; t < T; ++t) {
        const size_t off = (size_t)(rowbase + t) * HW + h * HD + lane;
        const float fk = __expf(LF[off]), kk = 1.f - fk, qk = bf2f(QH[off]), vd = bf2f(VH[off]), g = bf2f(GH[off]);
        float o = 0.f;
#pragma unroll
        for (int k = 0; k < 64; ++k) { const float f_ = rdlane(fk, k), k_ = rdlane(kk, k), q_ = rdlane(qk, k); S[k] = f_ * S[k] + k_ * vd; o += S[k] * q_; }
        const float r = rsqrtf(wave_sum(o * o) * (1.f / HD) + RMS_EPS);
        OMIX[(size_t)(rowbase + t) * DM + h * HD + lane] = f2bf(o * r * gn * (g / (1.f + __expf(-g))));
    }
#pragma unroll
    for (int k = 0; k < 64; ++k) Sout[k * 64 + lane] = S[k];
}
template <bool SAMPLE>
__device__ __forceinline__ void sb_query(const Ctx& C, int row, int h, int nkeys, int seq  ) {
    const bf16* SQ = (const bf16*)(C.ws + WS_SQ); const bf16* SK = (const bf16*)(C.ws + WS_SK); const bf16* SV = (const bf16*)(C.ws + WS_SV);
    const float* ck = (const float*)C.in[I_CK]; const float* cv = (const float*)C.in[I_CV]; const int* pt = (const int*)C.in[I_PT];
    bf16* OMIX = (bf16*)(C.ws + WS_OMIX);
    const int lane = C.lane; const float bias2 = ((const float*)C.in[I_SBB])[h] * LOG2E;
    float q[64];
    { const v4u* qp = (const v4u*)(SQ + (size_t)row * HW + h * HD);
#pragma unroll
      for (int c = 0; c < 8; ++c) { const v4u w = qp[c]; q[8 * c] = bflo(w.x); q[8 * c + 1] = bfhi(w.x); q[8 * c + 2] = bflo(w.y); q[8 * c + 3] = bfhi(w.y); q[8 * c + 4] = bflo(w.z); q[8 * c + 5] = bfhi(w.z); q[8 * c + 6] = bflo(w.w); q[8 * c + 7] = bfhi(w.w); } }
    float Cc = 1.f, o = 0.f;
    for (int base = nkeys > 0 ? ((nkeys - 1) & ~63) : -1; base >= 0; base -= 64) {
        const int j = base + lane; const bool valid = j < nkeys; const int jc = valid ? j : nkeys - 1;
        float z = 0.f;
        if (SAMPLE && jc < PAST) {
            const float* kr = ck + (((size_t)pt[seq * NPAGES + (jc >> 7)] * PAGE + (jc & 127)) * NH + h) * HD;
#pragma unroll
            for (int c = 0; c < 16; ++c) { const f32x4 w = ((const f32x4*)kr)[c]; z += q[4 * c] * w.x + q[4 * c + 1] * w.y + q[4 * c + 2] * w.z + q[4 * c + 3] * w.w; }
        } else {
            const size_t krow = SAMPLE ? (size_t)(MP + seq * TDEC + (jc - PAST)) : (size_t)seq * SEQ + jc;
            const v4u* kr = (const v4u*)(SK + krow * HW + h * HD);
#pragma unroll
            for (int c = 0; c < 8; ++c) { const v4u w = kr[c]; z += q[8 * c] * bflo(w.x) + q[8 * c + 1] * bfhi(w.x) + q[8 * c + 2] * bflo(w.y) + q[8 * c + 3] * bfhi(w.y) + q[8 * c + 4] * bflo(w.z) + q[8 * c + 5] * bfhi(w.z) + q[8 * c + 6] * bflo(w.w) + q[8 * c + 7] * bfhi(w.w); }
        }
        const float u = valid ? exp2f(z + bias2) : 0.f;
        float incl = 1.f / (1.f + u);
#pragma unroll
        for (int off = 1; off < 64; off <<= 1) { const float y = __shfl_down(incl, off); if (lane + off < 64) incl *= y; }
        const float a = u * incl * Cc;
        Cc *= __shfl(incl, 0);
        const int nk = nkeys - base < 64 ? nkeys - base : 64;
        for (int jj = 0; jj < nk; ++jj) {
            const float aj = __shfl(a, jj); const int jk = base + jj; float vv;
            if (SAMPLE && jk < PAST) vv = cv[(((size_t)pt[seq * NPAGES + (jk >> 7)] * PAGE + (jk & 127)) * NH + h) * HD + lane];
            else { const size_t vrow = SAMPLE ? (size_t)(MP + seq * TDEC + (jk - PAST)) : (size_t)seq * SEQ + jk; vv = bf2f(SV[vrow * HW + h * HD + lane]); }
            o += aj * vv;
        }
    }
    OMIX[(size_t)row * DM + HW + h * HD + lane] = f2bf(o);
}
__device__ __forceinline__ void p2_mix1(const Ctx& C) {
    for (int cid = C.gw; cid < NBATCH * NH * (SEQ / 64); cid += C.ngw) hgrn_h1(C, cid);
    const int w = C.gw, nw = C.ngw;
    for (int i = w; i < NDEC * NH; i += nw) { const int n = i / NH, h = i % NH; hgrn_chain(C, MP + n * TDEC, TDEC, h, (const float*)C.in[I_SH] + (size_t)i * 4096, C.out + O_HS + (size_t)i * 4096); }
    for (int i = w; i < MS * NH; i += nw) { const int h = i & 7, r = i >> 3, n = r >> 3, t = r & 7; sb_query<true>(C, MP + r, h, PAST + t, n); }
    __syncthreads();
    sb_prompt_phase(C);
}
__device__ __forceinline__ void p4_mix3(const Ctx& C) {
    for (int cid = C.gw; cid < NBATCH * NH * (SEQ / 64); cid += C.ngw) hgrn_h3(C, cid);
}

__device__ __forceinline__ void thin_row(const float* xin, const bf16* br, const float* gpost, float* xout, const float* gpre, bf16* hrow, int lane) {
    const f32x4* xr = (const f32x4*)xin + lane; const v2u* bp = (const v2u*)br + lane; const f32x4* gp = (const f32x4*)gpost + lane;
    f32x4 b[4]; float s = 0.f;
#pragma unroll
    for (int j = 0; j < 4; ++j) { const v2u w = bp[64 * j]; b[j] = (f32x4){bflo(w.x), bfhi(w.x), bflo(w.y), bfhi(w.y)}; s += (b[j].x * b[j].x + b[j].y * b[j].y) + (b[j].z * b[j].z + b[j].w * b[j].w); }
    const float r = rsqrtf(wave_sum(s) * (1.f / DM) + RMS_EPS);
    float s2 = 0.f;
#pragma unroll
    for (int j = 0; j < 4; ++j) { b[j] = xr[64 * j] + b[j] * r * gp[64 * j]; s2 += (b[j].x * b[j].x + b[j].y * b[j].y) + (b[j].z * b[j].z + b[j].w * b[j].w); }
    f32x4* xo = (f32x4*)xout + lane;
#pragma unroll
    for (int j = 0; j < 4; ++j) xo[64 * j] = b[j];
    if (hrow) {
        const float r2 = rsqrtf(wave_sum(s2) * (1.f / DM) + RMS_EPS); const f32x4* g2 = (const f32x4*)gpre + lane; v2u* o8 = (v2u*)hrow + lane;
#pragma unroll
        for (int j = 0; j < 4; ++j) { const f32x4 gg = g2[64 * j]; v2u w; w.x = pk_bf16(b[j].x * r2 * gg.x, b[j].y * r2 * gg.y); w.y = pk_bf16(b[j].z * r2 * gg.z, b[j].w * r2 * gg.w); o8[64 * j] = w; }
    }
}
template <int WHICH>
__device__ __forceinline__ void p_thin(const Ctx& C) {
    const bf16* BR = (const bf16*)(C.ws + WS_BR); bf16* H = (bf16*)(C.ws + WS_H);
    float* X1 = (float*)(C.ws + WS_X1); float* X2 = (float*)(C.ws + WS_X2);
    const float* gpost = (const float*)C.in[WHICH == 0 ? I_GMIXPOST : WHICH == 1 ? I_GCAPOST : I_GFFNPOST];
    const float* gpre = (const float*)C.in[WHICH == 0 ? I_GCAPRE : I_GFFNPRE];
    for (int m = C.gw; m < MT; m += C.ngw) {
        const float* xin; float* xout;
        if (WHICH == 0) { xin = m < MP ? (const float*)C.in[I_XP] + (size_t)m * DM : (const float*)C.in[I_XS] + (size_t)(m - MP) * DM; xout = X1 + (size_t)m * DM; }
        else if (WHICH == 1) { xin = X1 + (size_t)m * DM; xout = X2 + (size_t)m * DM; }
        else { xin = X2 + (size_t)m * DM; xout = m < MP ? C.out + O_YP + (size_t)m * DM : C.out + O_YS + (size_t)(m - MP) * DM; }
        thin_row(xin, BR + (size_t)m * DM, gpost, xout, gpre, WHICH == 2 ? nullptr : H + (size_t)m * DM, C.lane);
    }
}

__device__ __forceinline__ void p6_naive(const Ctx& C) {
    const bf16* QCA = (const bf16*)(C.ws + WS_QCA); const bf16* MK = (const bf16*)(C.ws + WS_MK); const bf16* MV = (const bf16*)(C.ws + WS_MV);
    const float* cmk = (const float*)C.in[I_MK]; const float* cmv = (const float*)C.in[I_MV]; bf16* OCA = (bf16*)(C.ws + WS_OMIX);
    const int lane = C.lane;
    for (int it = C.gw; it < MT * CAH; it += C.ngw) {
        const int row = it >> 2, h = it & 3;
        const v2u qw = *((const v2u*)(QCA + (size_t)row * DM + h * CAD) + lane);
        const float q0 = bflo(qw.x), q1 = bfhi(qw.x), q2 = bflo(qw.y), q3 = bfhi(qw.y);
        float mx = -1e30f, l = 0.f, o0 = 0.f, o1 = 0.f, o2 = 0.f, o3 = 0.f;
        for (int m = 0; m < NMEM; ++m) {
            float k0, k1, k2, k3, v0, v1, v2, v3;
            if (row < MP) { const size_t off = ((size_t)((row >> 13) * NMEM + m)) * DM + h * CAD; const v2u kw = *((const v2u*)(MK + off) + lane), vw = *((const v2u*)(MV + off) + lane);
                k0 = bflo(kw.x); k1 = bfhi(kw.x); k2 = bflo(kw.y); k3 = bfhi(kw.y); v0 = bflo(vw.x); v1 = bfhi(vw.x); v2 = bflo(vw.y); v3 = bfhi(vw.y); }
            else { const size_t off = ((size_t)(((row - MP) >> 3) * NMEM + m)) * DM + h * CAD; const f32x4 kw = *((const f32x4*)(cmk + off) + lane), vw = *((const f32x4*)(cmv + off) + lane);
                k0 = kw.x; k1 = kw.y; k2 = kw.z; k3 = kw.w; v0 = vw.x; v1 = vw.y; v2 = vw.z; v3 = vw.w; }
            const float s = wave_sum(q0 * k0 + q1 * k1 + q2 * k2 + q3 * k3);
            const float mn = fmaxf(mx, s), sc = exp2f(mx - mn), p = exp2f(s - mn);
            l = l * sc + p; o0 = o0 * sc + p * v0; o1 = o1 * sc + p * v1; o2 = o2 * sc + p * v2; o3 = o3 * sc + p * v3; mx = mn;
        }
        const float il = 1.f / l; v2u w; w.x = pk_bf16(o0 * il, o1 * il); w.y = pk_bf16(o2 * il, o3 * il);
        *((v2u*)(OCA + (size_t)row * DM + h * CAD) + lane) = w;
    }
}

__device__ __forceinline__ float gelu_tanh(float x) { return x / (1.f + __expf(-1.5957691216057308f * (x + 0.044715f * x * x * x))); }
__device__ __forceinline__ void ld8(const bf16* p, float (&v)[8]) { const v4u w = *(const v4u*)p; v[0] = bflo(w.x); v[1] = bfhi(w.x); v[2] = bflo(w.y); v[3] = bfhi(w.y); v[4] = bflo(w.z); v[5] = bfhi(w.z); v[6] = bflo(w.w); v[7] = bfhi(w.w); }
__device__ __forceinline__ void ld8f(const float* p, float (&v)[8]) { const f32x4 a = *(const f32x4*)p, b = *(const f32x4*)(p + 4); v[0] = a.x; v[1] = a.y; v[2] = a.z; v[3] = a.w; v[4] = b.x; v[5] = b.y; v[6] = b.z; v[7] = b.w; }
__device__ __forceinline__ void p10_convgate(const Ctx& C) {
    const bf16* U = (const bf16*)(C.ws + WS_U); bf16* G = (bf16*)(C.ws + WS_G);
    const float* cw = (const float*)C.in[I_CONVW]; const float* cb = (const float*)C.in[I_CONVB]; const float* sc = (const float*)C.in[I_SC];
    constexpr int NCH = DFF / 8;
    const int gt = C.gw * 64 + C.lane, ngt = C.ngw * 64;
    for (int it = gt; it < MT * NCH; it += ngt) {
        const int row = it / NCH, c = (it % NCH) * 8;
        const int t = row < MP ? (row & (SEQ - 1)) : ((row - MP) & 7);
        float res[2][8];
#pragma unroll
        for (int half = 0; half < 2; ++half) {
            const int col = c + half * DFF;
            float u0[8], u1[8], u2[8], w0[8], w1[8], w2[8], bb[8];
            ld8(U + (size_t)row * DFF2 + col, u2);
            if (t >= 1) ld8(U + (size_t)(row - 1) * DFF2 + col, u1);
            else if (row < MP) {
#pragma unroll
                for (int e = 0; e < 8; ++e) u1[e] = 0.f;
            } else ld8f(sc + ((size_t)((row - MP) >> 3) * 2 + 1) * DFF2 + col, u1);
            if (t >= 2) ld8(U + (size_t)(row - 2) * DFF2 + col, u0);
            else if (row < MP) {
#pragma unroll
                for (int e = 0; e < 8; ++e) u0[e] = 0.f;
            } else ld8f(sc + ((size_t)((row - MP) >> 3) * 2 + t) * DFF2 + col, u0);
            ld8f(cw + col, w0); ld8f(cw + DFF2 + col, w1); ld8f(cw + 2 * DFF2 + col, w2); ld8f(cb + col, bb);
#pragma unroll
            for (int e = 0; e < 8; ++e) res[half][e] = bb[e] + w0[e] * u0[e] + w1[e] * u1[e] + w2[e] * u2[e];
        }
        v4u o;
        o.x = pk_bf16(gelu_tanh(res[0][0]) * res[1][0], gelu_tanh(res[0][1]) * res[1][1]); o.y = pk_bf16(gelu_tanh(res[0][2]) * res[1][2], gelu_tanh(res[0][3]) * res[1][3]);
        o.z = pk_bf16(gelu_tanh(res[0][4]) * res[1][4], gelu_tanh(res[0][5]) * res[1][5]); o.w = pk_bf16(gelu_tanh(res[0][6]) * res[1][6], gelu_tanh(res[0][7]) * res[1][7]);
        *(v4u*)(G + (size_t)row * DFF + c) = o;
    }
}
enum { PH_PRO = 0, PH_INPROJ, PH_MIX1, PH_SCAN, PH_MIX3, PH_OPROJ, PH_THIN0, PH_CQ, PH_CA, PH_CO, PH_THIN1, PH_UP, PH_CONV, PH_DOWN, PH_THIN2, NPH };
#ifndef MK_ONE_LAUNCH
#define MK_ONE_LAUNCH 1
#endif
__global__ void __launch_bounds__(NTHREADS, 2) fwd(Args args) {
    extern __shared__ __attribute__((aligned(16))) unsigned char lds_raw[];
    Ctx C;
    C.in = args.in; C.out = args.out; C.ws = args.ws; C.lds = (LAS unsigned char*)lds_raw;
    C.tid = threadIdx.x; C.lane = C.tid & 63; C.wave = __builtin_amdgcn_readfirstlane(C.tid >> 6);
    C.gw = blockIdx.x * NWAVES + C.wave; C.ngw = gridDim.x * NWAVES;
    const int G = gridDim.x, bid = blockIdx.x;
    volatile LAS unsigned* MISC = (volatile LAS unsigned*)(C.lds + MISC_OFF);
    for (int u = C.tid; u < (LDS_BYTES - LDSCTL_OFF) / 4; u += NTHREADS) ((LAS unsigned*)(C.lds + LDSCTL_OFF))[u] = 0u;
    __syncthreads();
    const int lo = args.ph_lo, hi = args.ph_hi;
    XcdBarrier bar; bar.bar = (unsigned*)(C.ws + WS_CTL) + CW_BAR; bar.x = 0; bar.st = nullptr;
    if (hi - lo > 1) bar = xcd_barrier_post((unsigned*)(C.ws + WS_CTL) + CW_BAR, MISC + 8);
#define IN(k) (lo <= (k) && (k) < hi)
#define SEAM(k) do { if (IN(k) && IN((k) + 1)) xcd_barrier(bar); } while (0)
    bf16* H = (bf16*)(C.ws + WS_H);
    if (IN(PH_PRO)) { p0_prologue(C); } SEAM(PH_PRO);
    if (IN(PH_INPROJ)) {
        { pg8::Gemm g{H, (const bf16*)(C.ws + WS_WIN), MT, DIN, DM}; pg8::StaticOrder S; S.init(MT, DIN, G, bid);
          pg8::EpiInProj E{(bf16*)(C.ws + WS_QH), (bf16*)(C.ws + WS_VH), (bf16*)(C.ws + WS_GH), (bf16*)(C.ws + WS_SQ), (bf16*)(C.ws + WS_SK), (bf16*)(C.ws + WS_SV), (float*)(C.ws + WS_LF),
                           (const float*)(C.ws + WS_LB), C.out + O_KP, C.out + O_VP, C.out + O_KS, C.out + O_VS, SQ_SCALE};
          pg8::gemm_phase<pg8::EpiInProj, pg8::StaticOrder, true, true>(C.lds + RING_OFF, g, S, E); }
        { pg8::Gemm g{(const bf16*)(C.ws + WS_MN), (const bf16*)(C.ws + WS_WCKV), NBATCH * NMEM, 2 * DM, DM}; pg8::StaticOrder S; S.init(NBATCH * NMEM, 2 * DM, G, (bid + G - 184 % G) % G);
          pg8::EpiMemKV E{(bf16*)(C.ws + WS_MK), (bf16*)(C.ws + WS_MV), C.out + O_MKP, C.out + O_MVP};
          pg8::gemm_phase<pg8::EpiMemKV, pg8::StaticOrder, true, true>(C.lds + RING_OFF, g, S, E); }
    } SEAM(PH_INPROJ);
    if (IN(PH_MIX1)) { p2_mix1(C); } SEAM(PH_MIX1);
    if (IN(PH_SCAN)) { hgrn_h2(C); } SEAM(PH_SCAN);
    if (IN(PH_MIX3)) { p4_mix3(C); } SEAM(PH_MIX3);
    if (IN(PH_OPROJ)) { pg8::Gemm g{(const bf16*)(C.ws + WS_OMIX), (const bf16*)(C.ws + WS_WO), MT, DM, DM}; pg8::StaticOrder S; S.init(MT, DM, G, bid);
        pg8::EpiStore E{(bf16*)(C.ws + WS_BR), DM, 1.f, nullptr, nullptr};
        pg8::gemm_phase<pg8::EpiStore, pg8::StaticOrder, true, true>(C.lds + RING_OFF, g, S, E); } SEAM(PH_OPROJ);
    if (IN(PH_THIN0)) { p_thin<0>(C); } SEAM(PH_THIN0);
    if (IN(PH_CQ)) { pg8::Gemm g{H, (const bf16*)(C.ws + WS_WCQ), MT, DM, DM}; pg8::StaticOrder S; S.init(MT, DM, G, bid);
        pg8::EpiStore E{(bf16*)(C.ws + WS_QCA), DM, CQ_SCALE, nullptr, nullptr};
        pg8::gemm_phase<pg8::EpiStore, pg8::StaticOrder, true, true>(C.lds + RING_OFF, g, S, E); } SEAM(PH_CQ);
    if (IN(PH_CA)) { p6_naive(C); } SEAM(PH_CA);
    if (IN(PH_CO)) { pg8::Gemm g{(const bf16*)(C.ws + WS_OMIX), (const bf16*)(C.ws + WS_WCO), MT, DM, DM}; pg8::StaticOrder S; S.init(MT, DM, G, bid);
        pg8::EpiStore E{(bf16*)(C.ws + WS_BR), DM, 1.f, nullptr, nullptr};
        pg8::gemm_phase<pg8::EpiStore, pg8::StaticOrder, true, true>(C.lds + RING_OFF, g, S, E); } SEAM(PH_CO);
    if (IN(PH_THIN1)) { p_thin<1>(C); } SEAM(PH_THIN1);
    if (IN(PH_UP)) { pg8::Gemm g{H, (const bf16*)(C.ws + WS_WUP), MT, DFF2, DM}; pg8::StaticOrder S; S.init(MT, DFF2, G, bid);
        pg8::EpiStore E{(bf16*)(C.ws + WS_U), DFF2, 1.f, C.out + O_CP, C.out + O_CS};
        pg8::gemm_phase<pg8::EpiStore, pg8::StaticOrder, true, true>(C.lds + RING_OFF, g, S, E); } SEAM(PH_UP);
    if (IN(PH_CONV)) { p10_convgate(C); } SEAM(PH_CONV);
    if (IN(PH_DOWN)) { pg8::Gemm g{(const bf16*)(C.ws + WS_G), (const bf16*)(C.ws + WS_WDN), MT, DM, DFF}; pg8::StaticOrder S; S.init(MT, DM, G, bid);
        pg8::EpiStore E{(bf16*)(C.ws + WS_BR), DM, 1.f, nullptr, nullptr};
        pg8::gemm_phase<pg8::EpiStore, pg8::StaticOrder, true, true>(C.lds + RING_OFF, g, S, E); } SEAM(PH_DOWN);
    if (IN(PH_THIN2)) { p_thin<2>(C); }
#undef IN
#undef SEAM
}

extern "C" void kernel_launch(void* const* d_in, const int* in_sizes, int n_in, void* d_out, int out_size, void* d_ws, size_t ws_size, hipStream_t stream) {
    static int grid = 0;
    if (grid == 0) {
        if (n_in != N_IN || (size_t)out_size != O_END || ws_size < WS_END) { fprintf(stderr, "kernel_launch: unexpected problem: n_in %d out %d ws %zu\n", n_in, out_size, ws_size); grid = -1; return; }
        int dev = 0, cus = 0, per_cu = 0;
        if (hipGetDevice(&dev) != hipSuccess || hipDeviceGetAttribute(&cus, hipDeviceAttributeMultiprocessorCount, dev) != hipSuccess) { grid = -1; return; }
        if (hipFuncSetAttribute((const void*)fwd, hipFuncAttributeMaxDynamicSharedMemorySize, LDS_BYTES) != hipSuccess) { fprintf(stderr, "kernel_launch: hipFuncSetAttribute failed\n"); grid = -1; return; }
        if (hipOccupancyMaxActiveBlocksPerMultiprocessor(&per_cu, (const void*)fwd, NTHREADS, LDS_BYTES) != hipSuccess || per_cu < 1) fprintf(stderr, "kernel_launch: occupancy query says %d\n", per_cu);
        (void)hipGetLastError();
        grid = cus;
    }
    if (grid < 0) return;
    (void)hipMemsetAsync((char*)d_ws + WS_CTL, 0, CTL_ZERO_BYTES, stream);
    Args a{};
    for (int i = 0; i < N_IN; ++i) a.in[i] = d_in[i];
    a.out = (float*)d_out; a.ws = (unsigned char*)d_ws;
#if MK_ONE_LAUNCH
    a.ph_lo = 0; a.ph_hi = NPH;
    hipLaunchKernelGGL(fwd, dim3(grid), dim3(NTHREADS), LDS_BYTES, stream, a);
#else
    for (int p = 0; p < NPH; ++p) { a.ph_lo = p; a.ph_hi = p + 1; hipLaunchKernelGGL(fwd, dim3(grid), dim3(NTHREADS), LDS_BYTES, stream, a); }
#endif
}
```

```cpp
#include <hip/hip_runtime.h>
#include <cstdio>
#include <cstdint>
namespace pg8 {
#define PG8_LAS __attribute__((address_space(3)))
typedef unsigned short bf16_t;
typedef short bf16x8 __attribute__((ext_vector_type(8)));
typedef float f32x4 __attribute__((ext_vector_type(4)));
typedef unsigned u32x4 __attribute__((ext_vector_type(4)));
constexpr int BM = 256, BK = 64, HALF = 128, HTB = HALF * BK * 2  , STAGE_BYTES = 8 * HTB, NXCD = 8, WGM = 8;

__host__ __device__ __forceinline__ int lds_byte(int r, int c) { const int st = (r >> 4) * 2 + (c >> 5), rr = r & 15, cc = c & 31, ob = rr * 64 + cc * 2; return st * 1024 + (ob ^ (((ob >> 9) & 1) << 5)); }
__host__ __device__ __forceinline__ void stage_rc(int b, int& R, int& C) { const int st = b / 1024, sb = b % 1024, swz = sb ^ (((sb >> 9) & 1) << 5); R = (st >> 1) * 16 + swz / 64; C = (st & 1) * 32 + (swz % 64) / 2; }
__host__ __device__ __forceinline__ int perm32(int rho) { const int n = rho >> 4, i = rho & 15; return 8 * (i >> 2) + 4 * n + (i & 3); }

struct Unit { int pm, pn; };
struct Gemm { const bf16_t* A; const bf16_t* Bt; int M, N, K; };

struct StaticOrder {
    int nM, nN, nwg, G, c;
    __host__ __device__ void init(int M, int N, int G_, int c_) { nM = M / BM; nN = N / BM; nwg = nM * nN; G = G_; c = c_; }
    __host__ __device__ bool next(int i, Unit& u) const {
        const long L = (long)i * G + c; if (L >= nwg) return false;
        int wgid = (int)L; { const int q = nwg / NXCD, r = nwg % NXCD, xcd = wgid % NXCD, off = wgid / NXCD; wgid = (xcd < r ? xcd * (q + 1) : r * (q + 1) + (xcd - r) * q) + off; }
        const int nig = WGM * nN, gid = wgid / nig, fm = gid * WGM, gsz = (nM - fm) < WGM ? (nM - fm) : WGM;
        u.pm = fm + ((wgid % nig) % gsz); u.pn = (wgid % nig) / gsz; return true;
    }
    __device__ __forceinline__ void a_ready(const Unit&) const {}
    __device__ __forceinline__ void done(const Unit&) const {}
};

__device__ __forceinline__ unsigned cvt_pk_bf16(float lo, float hi) { unsigned r; asm volatile("v_cvt_pk_bf16_f32 %0, %1, %2" : "=v"(r) : "v"(lo), "v"(hi)); return r; }
typedef float f32x2 __attribute__((ext_vector_type(2)));
typedef __bf16 bf16x2_t __attribute__((ext_vector_type(2)));
__device__ __forceinline__ unsigned pk_bf16(float lo, float hi) { f32x2 v = {lo, hi}; bf16x2_t b = __builtin_convertvector(v, bf16x2_t); return __builtin_bit_cast(unsigned, b); }
__device__ __forceinline__ u32x4 pk8(f32x4 a, f32x4 b) { u32x4 w; w.x = pk_bf16(a[0], a[1]); w.y = pk_bf16(a[2], a[3]); w.z = pk_bf16(b[0], b[1]); w.w = pk_bf16(b[2], b[3]); return w; }

struct EpiStore {
    static constexpr bool PERM = true, AFTER_DRAIN = false;
    bf16_t* O; int ldc; float scale; float* cap_p; float* cap_s;
    __device__ __forceinline__ void operator()(const f32x4 (&acc)[2][2][4][2], const Unit& u, int wr, int wc, int fr, int fq) const {
        const int row0 = u.pm * BM + wr * 64 + fr, col0 = u.pn * BM + wc * 32 + 8 * fq;
#pragma unroll
        for (int ai = 0; ai < 2; ++ai)
#pragma unroll
            for (int m = 0; m < 4; ++m) {
                const int row = row0 + ai * HALF + m * 16;
                float* cap = nullptr;
                if (cap_p) {
                    if (row < 16384) { const int t = row & 8191; if (t >= 8190) cap = cap_p + (size_t)((row >> 13) * 2 + (t - 8190)) * 5632; }
                    else { const int r2 = row - 16384, t = r2 & 7; if (t >= 6) cap = cap_s + (size_t)((r2 >> 3) * 2 + (t - 6)) * 5632; }
                }
#pragma unroll
                for (int bj = 0; bj < 2; ++bj) {
                    const int col = col0 + bj * HALF;
                    const f32x4 v0 = acc[ai][bj][m][0] * scale, v1 = acc[ai][bj][m][1] * scale;
                    *(u32x4*)(O + (size_t)row * ldc + col) = pk8(v0, v1);
                    if (cap) { *(f32x4*)(cap + col) = v0; *(f32x4*)(cap + col + 4) = v1; }
                }
            }
    }
};

struct EpiInProj {
    static constexpr bool PERM = true, AFTER_DRAIN = false;
    bf16_t *QH, *VH, *GH, *SQ, *SK, *SV; float* LF; const float* LB; float* kp; float* vp; float* ks; float* vs; float sqscale;
    __device__ __forceinline__ void operator()(const f32x4 (&acc)[2][2][4][2], const Unit& u, int wr, int wc, int fr, int fq) const {
        const int seg = u.pn >> 1;
        const int row0 = u.pm * BM + wr * 64 + fr, col0 = (u.pn & 1) * BM + wc * 32 + 8 * fq;
        if (seg == 1) {
#pragma unroll
            for (int bj = 0; bj < 2; ++bj) {
                const int col = col0 + bj * HALF;
                const f32x4 l0 = *(const f32x4*)(LB + col), l1 = *(const f32x4*)(LB + col + 4);
#pragma unroll
                for (int ai = 0; ai < 2; ++ai)
#pragma unroll
                    for (int m = 0; m < 4; ++m) {
                        const int row = row0 + ai * HALF + m * 16;
                        f32x4 o0, o1;
#pragma unroll
                        for (int e = 0; e < 4; ++e) {
                            const float s0 = 1.f / (1.f + __expf(-acc[ai][bj][m][0][e])), s1 = 1.f / (1.f + __expf(-acc[ai][bj][m][1][e]));
                            o0[e] = __logf(l0[e] + (1.f - l0[e]) * s0); o1[e] = __logf(l1[e] + (1.f - l1[e]) * s1);
                        }
                        *(f32x4*)(LF + (size_t)row * 512 + col) = o0; *(f32x4*)(LF + (size_t)row * 512 + col + 4) = o1;
                    }
            }
            return;
        }
        bf16_t* dst = seg == 0 ? QH : seg == 2 ? VH : seg == 3 ? GH : seg == 4 ? SQ : seg == 5 ? SK : SV;
        const float sc = seg == 4 ? sqscale : 1.f;
        float* fp = seg == 5 ? kp : seg == 6 ? vp : nullptr;
        float* fs = seg == 5 ? ks : vs;
#pragma unroll
        for (int ai = 0; ai < 2; ++ai)
#pragma unroll
            for (int m = 0; m < 4; ++m) {
                const int row = row0 + ai * HALF + m * 16;
#pragma unroll
                for (int bj = 0; bj < 2; ++bj) {
                    const int col = col0 + bj * HALF;
                    const f32x4 v0 = acc[ai][bj][m][0], v1 = acc[ai][bj][m][1];
                    *(u32x4*)(dst + (size_t)row * 512 + col) = pk8(v0 * sc, v1 * sc);
                    if (fp) { float* f = row < 16384 ? fp + (size_t)row * 512 + col : fs + (size_t)(row - 16384) * 512 + col; *(f32x4*)f = v0; *(f32x4*)(f + 4) = v1; }
                }
            }
    }
};

struct EpiMemKV {
    static constexpr bool PERM = true, AFTER_DRAIN = false;
    bf16_t *MK, *MV; float *ok, *ov;
    __device__ __forceinline__ void operator()(const f32x4 (&acc)[2][2][4][2], const Unit& u, int wr, int wc, int fr, int fq) const {
        const int seg = u.pn >> 2;
        const int row0 = u.pm * BM + wr * 64 + fr, col0 = (u.pn & 3) * BM + wc * 32 + 8 * fq;
        bf16_t* dst = seg == 0 ? MK : MV; float* fo = seg == 0 ? ok : ov;
#pragma unroll
        for (int ai = 0; ai < 2; ++ai)
#pragma unroll
            for (int m = 0; m < 4; ++m) {
                const int row = row0 + ai * HALF + m * 16;
#pragma unroll
                for (int bj = 0; bj < 2; ++bj) {
                    const int col = col0 + bj * HALF;
                    const f32x4 v0 = acc[ai][bj][m][0], v1 = acc[ai][bj][m][1];
                    *(u32x4*)(dst + (size_t)row * 1024 + col) = pk8(v0, v1);
                    *(f32x4*)(fo + (size_t)row * 1024 + col) = v0; *(f32x4*)(fo + (size_t)row * 1024 + col + 4) = v1;
                }
            }
    }
};

template <class Epi, class Sched, bool ALIGN_EPI = false, bool SP2 = false>
__device__ __forceinline__ void gemm_phase(PG8_LAS unsigned char* lds, const Gemm g, const Sched& S, const Epi& E) {
    const int tid = threadIdx.x, wid = __builtin_amdgcn_readfirstlane(tid >> 6), lane = tid & 63, wr = wid >> 2, wc = wid & 3, fr = lane & 15, fq = lane >> 4;
    const int K = g.K, nt = K / BK;
    unsigned voffA[2], voffB[2];
#pragma unroll
    for (int i = 0; i < 2; ++i) { int R, C; stage_rc(tid * 16 + i * 8192, R, C); const int Rb = Epi::PERM ? ((R & ~31) + perm32(R & 31)) : R;
        voffA[i] = (unsigned)(R * K + C) * 2u; voffB[i] = (unsigned)(Rb * K + C) * 2u; }
    const size_t kstep = (size_t)(BK * 2);
    const size_t hstep = (size_t)HALF * K * 2;
    const size_t tstep = 2 * hstep;
    const unsigned ldsw = (unsigned)wid * 1024u;
    const int aoff = lds_byte(wr * 64 + fr, fq * 8), boff = lds_byte(wc * 32 + fr, fq * 8);
#define PG8_SA(b, h) (((b) * 2 + (h)) * HTB)
#define PG8_SB(b, h) ((4 + (b) * 2 + (h)) * HTB)
#define PG8_STAGE(bufoff, gbase, voff) do { _Pragma("unroll") for (int _i = 0; _i < 2; ++_i) \
        __builtin_amdgcn_global_load_lds((const unsigned*)((const char*)(gbase) + (voff)[_i]), (PG8_LAS unsigned*)(lds + (bufoff) + ldsw + _i * 8192), 16, 0, 0); } while (0)
#define PG8_LDA(dst, b, h) do { _Pragma("unroll") for (int m = 0; m < 4; ++m) _Pragma("unroll") for (int k = 0; k < 2; ++k) dst[m][k] = *(const PG8_LAS bf16x8*)(lds + PG8_SA(b, h) + aoff + m * 2048 + k * 1024); } while (0)
#define PG8_LDB(dst, b, h) do { _Pragma("unroll") for (int n = 0; n < 2; ++n) _Pragma("unroll") for (int k = 0; k < 2; ++k) dst[n][k] = *(const PG8_LAS bf16x8*)(lds + PG8_SB(b, h) + boff + n * 2048 + k * 1024); } while (0)
#define PG8_MMA(ai, bj, At, Bt) do { __builtin_amdgcn_s_setprio(1); _Pragma("unroll") for (int m = 0; m < 4; ++m) _Pragma("unroll") for (int n = 0; n < 2; ++n) _Pragma("unroll") for (int k = 0; k < 2; ++k) \
        acc[ai][bj][m][n] = __builtin_amdgcn_mfma_f32_16x16x32_bf16(Bt[n][k], At[m][k], acc[ai][bj][m][n], 0, 0, 0); __builtin_amdgcn_s_setprio(0); } while (0)
#define PG8_WAIT_V(n) asm volatile("s_waitcnt vmcnt(" #n ")" ::: "memory")
#define PG8_WAIT_L(n) asm volatile("s_waitcnt lgkmcnt(" #n ")" ::: "memory")
#define PG8_BAR __builtin_amdgcn_s_barrier()
#define PG8_SCHED __builtin_amdgcn_sched_barrier(0)
    Unit cur, nxt; int ui = 0;
    if (!S.next(0, cur)) return;
    f32x4 acc[2][2][4][2];
#pragma unroll
    for (int a = 0; a < 2; ++a)
#pragma unroll
        for (int b = 0; b < 2; ++b)
#pragma unroll
            for (int m = 0; m < 4; ++m)
#pragma unroll
                for (int n = 0; n < 2; ++n) acc[a][b][m][n] = (f32x4){0.f, 0.f, 0.f, 0.f};
    bf16x8 At[4][2], B0[2][2], B1[2][2];
    const char* cA = (const char*)g.A + (size_t)cur.pm * tstep; const char* cB = (const char*)g.Bt + (size_t)cur.pn * tstep;
    S.a_ready(cur);
    if constexpr (SP2) {
        PG8_STAGE(PG8_SB(0, 0), cB, voffB); PG8_STAGE(PG8_SB(0, 1), cB + hstep, voffB); PG8_STAGE(PG8_SA(0, 0), cA, voffA); PG8_STAGE(PG8_SA(0, 1), cA + hstep, voffA);
        if (wr == 1) PG8_BAR;
        PG8_WAIT_V(2); PG8_BAR;
        PG8_STAGE(PG8_SB(1, 0), cB + kstep, voffB); PG8_STAGE(PG8_SA(1, 0), cA + kstep, voffA); PG8_STAGE(PG8_SB(1, 1), cB + hstep + kstep, voffB);
        PG8_WAIT_V(6); PG8_BAR;
    } else {
        PG8_STAGE(PG8_SB(0, 0), cB, voffB); PG8_STAGE(PG8_SA(0, 0), cA, voffA); PG8_STAGE(PG8_SB(0, 1), cB + hstep, voffB); PG8_STAGE(PG8_SA(0, 1), cA + hstep, voffA);
        if (wr == 1) PG8_BAR;
        PG8_WAIT_V(4); PG8_BAR;
        PG8_STAGE(PG8_SB(1, 0), cB + kstep, voffB); PG8_STAGE(PG8_SA(1, 0), cA + kstep, voffA); PG8_STAGE(PG8_SB(1, 1), cB + hstep + kstep, voffB);
        PG8_WAIT_V(6); PG8_BAR;
    }
    for (;;) {
        const bool has_next = S.next(ui + 1, nxt);
        const char* nA = has_next ? (const char*)g.A + (size_t)nxt.pm * tstep : cA; const char* nB = has_next ? (const char*)g.Bt + (size_t)nxt.pn * tstep : cB;
        for (int t = 0; t < nt; t += 2) {
            const bool last = (t == nt - 2);
            const char* a1 = cA + (size_t)(t + 1) * kstep;
            const char* a2 = last ? nA : cA + (size_t)(t + 2) * kstep; const char* b2 = last ? nB : cB + (size_t)(t + 2) * kstep;
            const char* a3 = a2 + kstep; const char* b3 = b2 + kstep;
            if (last && has_next) S.a_ready(nxt);
            if constexpr (SP2) {
            PG8_LDB(B0, 0, 0); PG8_LDB(B1, 0, 1); PG8_SCHED; PG8_LDA(At, 0, 0); PG8_STAGE(PG8_SA(1, 1), a1 + hstep, voffA);
            PG8_WAIT_V(8); PG8_WAIT_L(0); PG8_BAR; PG8_MMA(0, 0, At, B0); PG8_MMA(0, 1, At, B1); PG8_BAR; PG8_SCHED;
            PG8_LDA(At, 0, 1); PG8_STAGE(PG8_SB(0, 0), b2, voffB); PG8_STAGE(PG8_SB(0, 1), b2 + hstep, voffB); PG8_STAGE(PG8_SA(0, 0), a2, voffA);
            PG8_WAIT_V(8); PG8_WAIT_L(0); PG8_BAR; PG8_MMA(1, 0, At, B0); PG8_MMA(1, 1, At, B1); PG8_BAR; PG8_SCHED;
            PG8_LDB(B0, 1, 0); PG8_LDB(B1, 1, 1); PG8_SCHED; PG8_LDA(At, 1, 0); PG8_STAGE(PG8_SA(0, 1), a2 + hstep, voffA);
            PG8_WAIT_V(8); PG8_WAIT_L(0); PG8_BAR; PG8_MMA(0, 0, At, B0); PG8_MMA(0, 1, At, B1); PG8_BAR; PG8_SCHED;
            PG8_LDA(At, 1, 1); PG8_STAGE(PG8_SB(1, 0), b3, voffB); PG8_STAGE(PG8_SB(1, 1), b3 + hstep, voffB); PG8_STAGE(PG8_SA(1, 0), a3, voffA);
            PG8_WAIT_V(8); PG8_WAIT_L(0); PG8_BAR; PG8_MMA(1, 0, At, B0); PG8_MMA(1, 1, At, B1); PG8_BAR; PG8_SCHED;
            } else {
            PG8_LDB(B0, 0, 0); PG8_SCHED; PG8_LDA(At, 0, 0); PG8_STAGE(PG8_SA(1, 1), a1 + hstep, voffA);
            PG8_WAIT_L(8); PG8_BAR; PG8_WAIT_L(0); PG8_MMA(0, 0, At, B0); PG8_BAR; PG8_SCHED;
            PG8_LDB(B1, 0, 1); PG8_STAGE(PG8_SB(0, 0), b2, voffB);
            PG8_BAR; PG8_WAIT_L(0); PG8_MMA(0, 1, At, B1); PG8_BAR;
            PG8_LDA(At, 0, 1); PG8_STAGE(PG8_SA(0, 0), a2, voffA);
            PG8_BAR; PG8_WAIT_L(0); PG8_MMA(1, 0, At, B0); PG8_BAR; PG8_SCHED;
            PG8_STAGE(PG8_SB(0, 1), b2 + hstep, voffB);
            PG8_WAIT_V(6); PG8_BAR; PG8_MMA(1, 1, At, B1); PG8_BAR;
            PG8_LDB(B0, 1, 0); PG8_SCHED; PG8_LDA(At, 1, 0); PG8_STAGE(PG8_SA(0, 1), a2 + hstep, voffA);
            PG8_WAIT_L(8); PG8_BAR; PG8_WAIT_L(0); PG8_MMA(0, 0, At, B0); PG8_BAR; PG8_SCHED;
            PG8_LDB(B1, 1, 1); PG8_STAGE(PG8_SB(1, 0), b3, voffB);
            PG8_BAR; PG8_WAIT_L(0); PG8_MMA(0, 1, At, B1); PG8_BAR;
            PG8_LDA(At, 1, 1); PG8_STAGE(PG8_SA(1, 0), a3, voffA);
            PG8_BAR; PG8_WAIT_L(0); PG8_MMA(1, 0, At, B0); PG8_BAR; PG8_SCHED;
            PG8_STAGE(PG8_SB(1, 1), b3 + hstep, voffB);
            PG8_WAIT_V(6); PG8_BAR; PG8_MMA(1, 1, At, B1); PG8_BAR;
            }
        }
        if constexpr (ALIGN_EPI) { if (wr == 0) PG8_BAR; }
        if constexpr (!Epi::AFTER_DRAIN) { E(acc, cur, wr, wc, fr, fq); S.done(cur); }
        if (!has_next) break;
#pragma unroll
        for (int a = 0; a < 2; ++a)
#pragma unroll
            for (int b = 0; b < 2; ++b)
#pragma unroll
                for (int m = 0; m < 4; ++m)
#pragma unroll
                    for (int n = 0; n < 2; ++n) acc[a][b][m][n] = (f32x4){0.f, 0.f, 0.f, 0.f};
        cur = nxt; cA = nA; cB = nB; ++ui;
        if constexpr (ALIGN_EPI) { if (wr == 1) PG8_BAR; }
    }
    PG8_WAIT_V(0);
    if constexpr (!ALIGN_EPI) { if (wr == 0) PG8_BAR; }
    PG8_BAR;
    if constexpr (Epi::AFTER_DRAIN) { E.fused(acc, cur, wr, wc, fr, fq, lds, wid, lane); S.done(cur); }
#undef PG8_SA
#undef PG8_SB
#undef PG8_STAGE
#undef PG8_LDA
#undef PG8_LDB
#undef PG8_MMA
#undef PG8_WAIT_V
#undef PG8_WAIT_L
#undef PG8_BAR
#undef PG8_SCHED
}
}
#define GAS __attribute__((address_space(1)))
#define LAS __attribute__((address_space(3)))
#define LDS_WAIT() asm volatile("s_waitcnt lgkmcnt(0)" ::: "memory")
#define VM_WAIT() asm volatile("s_waitcnt vmcnt(0)" ::: "memory")
#define XB_TMO      128
#define XB_XCNT(j)  (256  + 64 * (j))
#define XB_XSUB(j)  (1280 + 64 * (j))
#define XB_XGEN(j)  (2304 + 64 * (j))
#define XB_TOP      3328
#define XB_TOPGEN   3392
#define XCD_BAR_WORDS 3456
#define XB_SPIN_CAP (1u << 23)

__device__ __forceinline__ unsigned xb_ld(unsigned* p)              { return __hip_atomic_load(p, __ATOMIC_RELAXED, __HIP_MEMORY_SCOPE_AGENT); }
__device__ __forceinline__ unsigned xb_add(unsigned* p, unsigned v) { return __hip_atomic_fetch_add(p, v, __ATOMIC_RELAXED, __HIP_MEMORY_SCOPE_AGENT); }
__device__ __forceinline__ unsigned xb_xcc_id() { return (unsigned)__builtin_amdgcn_s_getreg((3 << 11) | 20) & 0xFu; }
#define XB_SPIN(cond, bar) do { unsigned _sp = 0; while (cond) { __builtin_amdgcn_s_sleep(1); \
    if ((++_sp & 255u) == 0u) { if (xb_ld(&(bar)[XB_TMO])) break; if (_sp > XB_SPIN_CAP) { atomicAdd(&(bar)[XB_TMO], 1u); break; } } } } while (0)

struct XcdBarrier {
    unsigned* bar; unsigned x;
    volatile LAS unsigned* st;
};

__device__ __forceinline__ XcdBarrier xcd_barrier_post(unsigned* bar, volatile LAS unsigned* st) {
    XcdBarrier b; b.bar = bar; b.x = xb_xcc_id(); b.st = st;
    if (threadIdx.x == 0) (void)xb_add(&bar[XB_XCNT(b.x)], 1u);
    return b;
}
__device__ __forceinline__ void xcd_barrier_complete(unsigned* bar, unsigned x, unsigned& nloc, unsigned& nx) {
    const unsigned G = gridDim.x * gridDim.y * gridDim.z;
    unsigned sum, cnt, mine, sp = 0u;
    for (;;) {
        sum = 0u; cnt = 0u; mine = 0u;
#pragma unroll
        for (unsigned j = 0; j < 16; ++j) { const unsigned c = xb_ld(&bar[XB_XCNT(j)]); sum += c; cnt += (c > 0u) ? 1u : 0u; mine = (j == x) ? c : mine; }
        if (sum == G) break;
        __builtin_amdgcn_s_sleep(1);
        if ((++sp & 255u) == 0u) { if (xb_ld(&bar[XB_TMO])) break; if (sp > XB_SPIN_CAP) { atomicAdd(&bar[XB_TMO], 1u); break; } }
    }
    nloc = mine > 0u ? mine : 1u; nx = cnt > 0u ? cnt : 1u;
}

__device__ __forceinline__ void xcd_barrier(const XcdBarrier& b) {
    asm volatile("s_waitcnt vmcnt(0)" ::: "memory");
    __syncthreads();
    if (threadIdx.x == 0) {
        unsigned* bar = b.bar;
        __builtin_amdgcn_s_waitcnt(0);
        unsigned nloc = b.st[0], nx = b.st[1];
        if (nloc == 0u) { xcd_barrier_complete(bar, b.x, nloc, nx); b.st[0] = nloc; b.st[1] = nx; }
        const unsigned old = xb_add(&bar[XB_XSUB(b.x)], 1u);
        const unsigned gen = old / nloc;
        if (old + 1u == (gen + 1u) * nloc) {
            __builtin_amdgcn_fence(__ATOMIC_RELEASE, "agent");
            asm volatile("s_waitcnt vmcnt(0)" ::: "memory");
            const unsigned og = xb_add(&bar[XB_TOP], 1u);
            const unsigned tg = og / nx;
            if (og + 1u == (tg + 1u) * nx) xb_add(&bar[XB_TOPGEN], 1u);
            else XB_SPIN(xb_ld(&bar[XB_TOPGEN]) == tg, bar);
            __builtin_amdgcn_fence(__ATOMIC_ACQUIRE, "agent");
            xb_add(&bar[XB_XGEN(b.x)], 1u);
            asm volatile("s_waitcnt vmcnt(0)" ::: "memory");
        } else {
            XB_SPIN(xb_ld(&bar[XB_XGEN(b.x)]) == gen, bar);
            __builtin_amdgcn_fence(__ATOMIC_ACQUIRE, "agent");
            asm volatile("s_waitcnt vmcnt(0)" ::: "memory");
        }
    }
    __syncthreads();
}
constexpr int NWAVES = 8, NTHREADS = 512;
constexpr int DM = 1024, SEQ = 8192, NBATCH = 2, MP = NBATCH * SEQ, NDEC = 128, TDEC = 8, MS = NDEC * TDEC, MT = MP + MS;
constexpr int DIN = 3584, HW = 512, NH = 8, HD = 64;
constexpr int NMEM = 256, CAH = 4, CAD = 256, DFF = 2816, DFF2 = 5632;
constexpr int PAST = 2048, PAGE = 128, NPAGES = 16;
constexpr float RMS_EPS = 1e-6f, LOG2E = 1.4426950408889634f;
constexpr float SQ_SCALE = 0.125f * LOG2E;
constexpr float CQ_SCALE = 0.0625f * LOG2E;
enum { I_XP = 0, I_XS, I_CK, I_CV, I_SH, I_SC, I_MK, I_MV, I_PT, I_MEM, I_WIN, I_HGN, I_HLB, I_SBB, I_WO, I_GMIXPRE, I_GMIXPOST, I_GCAPRE, I_GCAPOST, I_GMEM,
       I_WCQ, I_WCK, I_WCV, I_WCO, I_GFFNPRE, I_GFFNPOST, I_WUP, I_CONVW, I_CONVB, I_WDN, N_IN };
constexpr size_t O_YP = 0, O_YS = 16777216, O_KP = 17825792, O_VP = 26214400, O_HP = 34603008, O_CP = 34668544, O_MKP = 34691072, O_MVP = 35215360,
                 O_KS = 35739648, O_VS = 36263936, O_HS = 36788224, O_CS = 40982528, O_END = 42424320;
constexpr size_t MiB = 1u << 20;
constexpr size_t WS_CTL = 0, CTL_ZERO_BYTES = 1 * MiB;
constexpr size_t WS_WIN = 2 * MiB, WS_WO = 9 * MiB, WS_WCQ = 11 * MiB, WS_WCO = 13 * MiB, WS_WCKV = 15 * MiB, WS_WUP = 19 * MiB, WS_WDN = 30 * MiB;
constexpr size_t WS_LB = 36 * MiB, WS_MN = 37 * MiB, WS_MK = 38 * MiB, WS_MV = 39 * MiB;
constexpr size_t WS_H = 40 * MiB, WS_QH = 74 * MiB, WS_LF = 91 * MiB, WS_VH = 125 * MiB, WS_GH = 142 * MiB, WS_SQ = 159 * MiB, WS_SK = 176 * MiB, WS_SV = 193 * MiB;
constexpr size_t WS_OMIX = 210 * MiB, WS_BR = 244 * MiB, WS_X1 = 278 * MiB, WS_X2 = 346 * MiB, WS_QCA = 414 * MiB, WS_U = 448 * MiB, WS_G = 635 * MiB, WS_UCT = 730 * MiB, WS_DC = 762 * MiB, WS_SCT = 763 * MiB, WS_SBP = 780 * MiB, WS_END = 786 * MiB;
constexpr int CW_BAR = 4096;
constexpr int RING_OFF = 0, RING_BYTES = 162816, LDSCTL_OFF = RING_BYTES, MISC_OFF = LDSCTL_OFF + 320, LDS_BYTES = 163840;

typedef unsigned short bf16;
typedef unsigned v4u __attribute__((ext_vector_type(4)));
typedef unsigned v2u __attribute__((ext_vector_type(2)));
typedef float f32x4 __attribute__((ext_vector_type(4)));
using pg8::pk_bf16;
__device__ __forceinline__ float bf2f(unsigned short b) { return __uint_as_float((unsigned)b << 16); }
__device__ __forceinline__ float bflo(unsigned w) { return __uint_as_float(w << 16); }
__device__ __forceinline__ float bfhi(unsigned w) { return __uint_as_float(w & 0xffff0000u); }
__device__ __forceinline__ unsigned short f2bf(float f) { return (unsigned short)(pk_bf16(f, 0.f) & 0xffffu); }
__device__ __forceinline__ float wave_sum(float v) {
#pragma unroll
    for (int o = 1; o < 64; o <<= 1) v += __shfl_xor(v, o);
    return v;
}
__device__ __forceinline__ float rdlane(float v, int l) { return __uint_as_float((unsigned)__builtin_amdgcn_readlane((int)__float_as_uint(v), l)); }

struct Args { const void* in[N_IN]; float* out; unsigned char* ws; int ph_lo, ph_hi; };
struct Ctx { const void* const* in; float* out; unsigned char* ws; LAS unsigned char* lds; int tid, lane, wave, gw, ngw; };

__device__ __forceinline__ void p0_transpose_item(const float* W, int K, int N, bf16* WT, int row_off, LAS float* scr, int item, int lane) {
    const int nblk = N / 32, kb = item / nblk, nb = item % nblk, k0 = 64 * kb, n0 = 32 * nb;
#pragma unroll 8
    for (int i = 0; i < 32; ++i) { const int kk = 2 * i + (lane >> 5); scr[kk * 33 + (lane & 31)] = W[(size_t)(k0 + kk) * N + n0 + (lane & 31)]; }
    LDS_WAIT(); asm volatile("" ::: "memory");
    const int c = lane & 7;
#pragma unroll
    for (int j = 0; j < 4; ++j) { const int n = (lane >> 3) + 8 * j; const LAS float* s = scr + (8 * c) * 33 + n;
        v4u o; o.x = pk_bf16(s[0 * 33], s[1 * 33]); o.y = pk_bf16(s[2 * 33], s[3 * 33]); o.z = pk_bf16(s[4 * 33], s[5 * 33]); o.w = pk_bf16(s[6 * 33], s[7 * 33]);
        *(v4u*)(WT + (size_t)(row_off + n0 + n) * K + k0 + 8 * c) = o; }
    LDS_WAIT(); asm volatile("" ::: "memory");
}
__device__ __forceinline__ void rms_row_to_bf16(const float* xrow, const float* g, bf16* orow, int lane) {
    const f32x4* xr = (const f32x4*)xrow + lane; const f32x4* gr = (const f32x4*)g + lane;
    f32x4 v[4]; float s = 0.f;
#pragma unroll
    for (int j = 0; j < 4; ++j) { v[j] = xr[64 * j]; s += (v[j].x * v[j].x + v[j].y * v[j].y) + (v[j].z * v[j].z + v[j].w * v[j].w); }
    const float r = rsqrtf(wave_sum(s) * (1.f / DM) + RMS_EPS);
    v2u* o8 = (v2u*)orow + lane;
#pragma unroll
    for (int j = 0; j < 4; ++j) { const f32x4 gg = gr[64 * j]; v2u w; w.x = pk_bf16(v[j].x * r * gg.x, v[j].y * r * gg.y); w.y = pk_bf16(v[j].z * r * gg.z, v[j].w * r * gg.w); o8[64 * j] = w; }
}
__device__ __forceinline__ void p0_prologue(const Ctx& C) {
    LAS float* scr = (LAS float*)(C.lds + RING_OFF + C.wave * 16384);
    const float* w_in = (const float*)C.in[I_WIN]; const float* w_o = (const float*)C.in[I_WO]; const float* w_cq = (const float*)C.in[I_WCQ]; const float* w_ck = (const float*)C.in[I_WCK];
    const float* w_cv = (const float*)C.in[I_WCV]; const float* w_co = (const float*)C.in[I_WCO]; const float* w_up = (const float*)C.in[I_WUP]; const float* w_dn = (const float*)C.in[I_WDN];
    bf16* Win = (bf16*)(C.ws + WS_WIN); bf16* Wo = (bf16*)(C.ws + WS_WO); bf16* Wcq = (bf16*)(C.ws + WS_WCQ); bf16* Wco = (bf16*)(C.ws + WS_WCO); bf16* Wckv = (bf16*)(C.ws + WS_WCKV);
    bf16* Wup = (bf16*)(C.ws + WS_WUP); bf16* Wdn = (bf16*)(C.ws + WS_WDN);
    constexpr int I_IN = (DM / 64) * (DIN / 32), I_SQ = (DM / 64) * (DM / 32), I_UP = (DM / 64) * (DFF2 / 32), I_DN = (DFF / 64) * (DM / 32);
    constexpr int NITEMS = I_IN + 5 * I_SQ + I_UP + I_DN;
    for (int it = C.gw; it < NITEMS; it += C.ngw) {
        int r = it;
        if (r < I_IN) { p0_transpose_item(w_in, DM, DIN, Win, 0, scr, r, C.lane); continue; } r -= I_IN;
        if (r < I_SQ) { p0_transpose_item(w_o, DM, DM, Wo, 0, scr, r, C.lane); continue; } r -= I_SQ;
        if (r < I_SQ) { p0_transpose_item(w_cq, DM, DM, Wcq, 0, scr, r, C.lane); continue; } r -= I_SQ;
        if (r < I_SQ) { p0_transpose_item(w_co, DM, DM, Wco, 0, scr, r, C.lane); continue; } r -= I_SQ;
        if (r < I_SQ) { p0_transpose_item(w_ck, DM, DM, Wckv, 0, scr, r, C.lane); continue; } r -= I_SQ;
        if (r < I_SQ) { p0_transpose_item(w_cv, DM, DM, Wckv, DM, scr, r, C.lane); continue; } r -= I_SQ;
        if (r < I_UP) { p0_transpose_item(w_up, DM, DFF2, Wup, 0, scr, r, C.lane); continue; } r -= I_UP;
        p0_transpose_item(w_dn, DFF, DM, Wdn, 0, scr, r, C.lane);
    }
    const float* xp = (const float*)C.in[I_XP]; const float* xs = (const float*)C.in[I_XS]; const float* mem = (const float*)C.in[I_MEM];
    bf16* H = (bf16*)(C.ws + WS_H); bf16* MN = (bf16*)(C.ws + WS_MN);
    const float* g_pre = (const float*)C.in[I_GMIXPRE]; const float* g_mem = (const float*)C.in[I_GMEM];
    for (int m = C.gw; m < MT + NBATCH * NMEM; m += C.ngw) {
        if (m < MP) rms_row_to_bf16(xp + (size_t)m * DM, g_pre, H + (size_t)m * DM, C.lane);
        else if (m < MT) rms_row_to_bf16(xs + (size_t)(m - MP) * DM, g_pre, H + (size_t)m * DM, C.lane);
        else rms_row_to_bf16(mem + (size_t)(m - MT) * DM, g_mem, MN + (size_t)(m - MT) * DM, C.lane);
    }
    if (C.gw == 0) {
        const float* lbp = (const float*)C.in[I_HLB]; float* LB = (float*)(C.ws + WS_LB);
        for (int k = C.lane; k < HW; k += 64) { const float a = lbp[k], b = lbp[HW + k]; LB[k] = 1.f / (1.f + __expf(b - a)); }
    }
}
typedef short bf16x8s __attribute__((ext_vector_type(8)));
typedef short s16x4 __attribute__((ext_vector_type(4)));
typedef short v4i16_t __attribute__((ext_vector_type(4)));
constexpr int HRS = 72;
__device__ __forceinline__ s16x4 tr4(const LAS bf16* p) { return __builtin_bit_cast(s16x4, __builtin_amdgcn_ds_read_tr16_b64_v4i16((LAS v4i16_t*)p)); }
__device__ __forceinline__ bf16x8s cat8(s16x4 lo, s16x4 hi) { return (bf16x8s){lo[0], lo[1], lo[2], lo[3], hi[0], hi[1], hi[2], hi[3]}; }
__device__ __forceinline__ f32x4 mfma16(bf16x8s a, bf16x8s b, f32x4 c) { return __builtin_amdgcn_mfma_f32_16x16x32_bf16(a, b, c, 0, 0, 0); }
__device__ __forceinline__ void hg_stage_v(const bf16* VH, int r0, int h, LAS bf16* Vt, int lane) {
#pragma unroll
    for (int it = 0; it < 8; ++it) { const int row = it * 8 + (lane >> 3), ch = lane & 7; const v4u w = *(const v4u*)(VH + (size_t)(r0 + row) * HW + h * HD + ch * 8); *(LAS v4u*)(Vt + row * HRS + ch * 8) = w; }
}
__device__ __forceinline__ void hgrn_h1(const Ctx& C, int cid) {
    const float* LF = (const float*)(C.ws + WS_LF); const bf16* VH = (const bf16*)(C.ws + WS_VH);
    float* UCT = (float*)(C.ws + WS_UCT); float* DC = (float*)(C.ws + WS_DC);
    const int lane = C.lane, i = lane & 15, g = lane >> 4;
    const int chain = cid >> 7, ci = cid & 127, b = chain >> 3, h = chain & 7, r0 = b * SEQ + ci * 64;
    LAS bf16* Vt = (LAS bf16*)(C.lds + RING_OFF + C.wave * 18432); LAS bf16* Kt = Vt + 64 * HRS;
    hg_stage_v(VH, r0, h, Vt, lane);
    const float* lfp = LF + (size_t)r0 * HW + h * HD + lane;
    float bl = 0.f;
#pragma unroll 16
    for (int t = 0; t < 64; ++t) bl += lfp[(size_t)t * HW];
    { float run = 0.f;
#pragma unroll 16
      for (int s = 0; s < 64; ++s) { const float lf = lfp[(size_t)s * HW]; run += lf; Kt[s * HRS + lane] = f2bf((1.f - __expf(lf)) * __expf(bl - run)); } }
    DC[(size_t)cid * 64 + lane] = __expf(bl);
    LDS_WAIT();
#pragma unroll
    for (int kb = 0; kb < 4; ++kb) {
        bf16x8s af[2];
#pragma unroll
        for (int ks = 0; ks < 2; ++ks) af[ks] = cat8(tr4(Kt + (32 * ks + 8 * g + (i >> 2)) * HRS + 16 * kb + (i & 3) * 4), tr4(Kt + (32 * ks + 8 * g + 4 + (i >> 2)) * HRS + 16 * kb + (i & 3) * 4));
#pragma unroll
        for (int db = 0; db < 4; ++db) {
            f32x4 acc = {0.f, 0.f, 0.f, 0.f};
#pragma unroll
            for (int ks = 0; ks < 2; ++ks) { const bf16x8s bfr = cat8(tr4(Vt + (32 * ks + 8 * g + (i >> 2)) * HRS + 16 * db + (i & 3) * 4), tr4(Vt + (32 * ks + 8 * g + 4 + (i >> 2)) * HRS + 16 * db + (i & 3) * 4));
                acc = mfma16(af[ks], bfr, acc); }
            *(f32x4*)(UCT + ((size_t)cid * 64 + 16 * db + i) * 64 + 16 * kb + 4 * g) = acc;
        }
    }
    LDS_WAIT();
}
__device__ __forceinline__ void hgrn_h2(const Ctx& C) {
    const float* UCT = (const float*)(C.ws + WS_UCT); const float* DC = (const float*)(C.ws + WS_DC); bf16* SCT = (bf16*)(C.ws + WS_SCT);
    const int lane = C.lane;
    for (int w = C.gw; w < NBATCH * NH * 64; w += C.ngw) {
        const int chain = w >> 6, d = w & 63; float S = 0.f;
        for (int c0 = 0; c0 < 128; c0 += 16) {
            float u[16], dc[16];
#pragma unroll
            for (int j = 0; j < 16; ++j) { const size_t cid = (size_t)chain * 128 + c0 + j; u[j] = UCT[(cid * 64 + d) * 64 + lane]; dc[j] = DC[cid * 64 + lane]; }
#pragma unroll
            for (int j = 0; j < 16; ++j) { const size_t cid = (size_t)chain * 128 + c0 + j; SCT[(cid * 64 + d) * 64 + lane] = f2bf(S); S = dc[j] * S + u[j]; }
        }
        C.out[O_HP + (size_t)chain * 4096 + lane * 64 + d] = S;
    }
}
__device__ __forceinline__ void hgrn_h3(const Ctx& C, int cid) {
    const float* LF = (const float*)(C.ws + WS_LF); const bf16* QH = (const bf16*)(C.ws + WS_QH); const bf16* VH = (const bf16*)(C.ws + WS_VH); const bf16* GH = (const bf16*)(C.ws + WS_GH);
    const bf16* SCT = (const bf16*)(C.ws + WS_SCT); bf16* OMIX = (bf16*)(C.ws + WS_OMIX); const float* hgn = (const float*)C.in[I_HGN];
    const int lane = C.lane, i = lane & 15, g = lane >> 4;
    const int chain = cid >> 7, ci = cid & 127, b = chain >> 3, h = chain & 7, r0 = b * SEQ + ci * 64;
    LAS bf16* Vt = (LAS bf16*)(C.lds + RING_OFF + C.wave * 18432); LAS bf16* Kb = Vt + 64 * HRS; LAS bf16* Qh = Kb + 16 * HRS; LAS bf16* Qt = Qh + 16 * HRS;
    hg_stage_v(VH, r0, h, Vt, lane);
    const float* lfp = LF + (size_t)r0 * HW + h * HD + lane; const bf16* qp = QH + (size_t)r0 * HW + h * HD + lane;
    float eb[4];
    bf16x8s sfr[4][2];
#pragma unroll
    for (int db = 0; db < 4; ++db)
#pragma unroll
        for (int ks = 0; ks < 2; ++ks) sfr[db][ks] = *(const bf16x8s*)(SCT + ((size_t)cid * 64 + 16 * db + i) * 64 + 32 * ks + 8 * g);
#pragma unroll
    for (int is = 0; is < 4; ++is) {
        const float ri = is ? eb[is - 1] : 0.f, er = __expf(ri);
        { float run = 0.f;
#pragma unroll
          for (int tt = 0; tt < 16; ++tt) { const int t = 16 * is + tt; run += lfp[(size_t)t * HW]; const float qt = bf2f(qp[(size_t)t * HW]) * __expf(run);
              Qt[tt * HRS + lane] = f2bf(qt); Qh[tt * HRS + lane] = f2bf(qt * er); }
          eb[is] = ri + run; }
        LDS_WAIT();
        bf16x8s qhf[2], qtf[2];
#pragma unroll
        for (int ks = 0; ks < 2; ++ks) { qhf[ks] = *(const LAS bf16x8s*)(Qh + i * HRS + 32 * ks + 8 * g); qtf[ks] = *(const LAS bf16x8s*)(Qt + i * HRS + 32 * ks + 8 * g); }
        f32x4 o[4];
#pragma unroll
        for (int db = 0; db < 4; ++db) { o[db] = (f32x4){0.f, 0.f, 0.f, 0.f};
#pragma unroll
            for (int ks = 0; ks < 2; ++ks) o[db] = mfma16(sfr[db][ks], qhf[ks], o[db]); }
#pragma unroll
        for (int jp = 0; jp <= is / 2; ++jp) {
            f32x4 x[2];
#pragma unroll
            for (int jj = 0; jj < 2; ++jj) {
                const int j = 2 * jp + jj; x[jj] = (f32x4){0.f, 0.f, 0.f, 0.f};
                if (j <= is) {
                    { float run = (j ? eb[j - 1] : 0.f) - ri;
#pragma unroll
                      for (int ss = 0; ss < 16; ++ss) { const int s = 16 * j + ss; const float lf = lfp[(size_t)s * HW]; run += lf; Kb[ss * HRS + lane] = f2bf((1.f - __expf(lf)) * __expf(-run)); } }
                    LDS_WAIT();
#pragma unroll
                    for (int ks = 0; ks < 2; ++ks) { const bf16x8s kf = *(const LAS bf16x8s*)(Kb + i * HRS + 32 * ks + 8 * g); x[jj] = mfma16(kf, qtf[ks], x[jj]); }
                    if (j == is) {
#pragma unroll
                        for (int e = 0; e < 4; ++e) if (4 * g + e > i) x[jj][e] = 0.f;
                    }
                    LDS_WAIT();
                }
            }
            bf16x8s pb; { const unsigned w0 = pk_bf16(x[0][0], x[0][1]), w1 = pk_bf16(x[0][2], x[0][3]), w2 = pk_bf16(x[1][0], x[1][1]), w3 = pk_bf16(x[1][2], x[1][3]); const v4u ww = {w0, w1, w2, w3}; pb = __builtin_bit_cast(bf16x8s, ww); }
            const int j0 = 2 * jp, j1 = (2 * jp + 1 <= is) ? 2 * jp + 1 : 2 * jp;
#pragma unroll
            for (int db = 0; db < 4; ++db) { const bf16x8s vf = cat8(tr4(Vt + (16 * j0 + 4 * g + (i >> 2)) * HRS + 16 * db + (i & 3) * 4), tr4(Vt + (16 * j1 + 4 * g + (i >> 2)) * HRS + 16 * db + (i & 3) * 4));
                o[db] = mfma16(vf, pb, o[db]); }
        }
        float ss = 0.f;
#pragma unroll
        for (int db = 0; db < 4; ++db) ss += (o[db][0] * o[db][0] + o[db][1] * o[db][1]) + (o[db][2] * o[db][2] + o[db][3] * o[db][3]);
        ss += __shfl_xor(ss, 16); ss += __shfl_xor(ss, 32);
        const float r = rsqrtf(ss * (1.f / HD) + RMS_EPS); const size_t row = (size_t)(r0 + 16 * is + i);
#pragma unroll
        for (int db = 0; db < 4; ++db) { const int d0 = h * HD + 16 * db + 4 * g; const v2u gw = *(const v2u*)(GH + row * HW + d0); const f32x4 gn = *(const f32x4*)(hgn + d0);
            const float g0 = bflo(gw.x), g1 = bfhi(gw.x), g2 = bflo(gw.y), g3 = bfhi(gw.y);
            v2u w; w.x = pk_bf16(o[db][0] * r * gn.x * (g0 / (1.f + __expf(-g0))), o[db][1] * r * gn.y * (g1 / (1.f + __expf(-g1))));
            w.y = pk_bf16(o[db][2] * r * gn.z * (g2 / (1.f + __expf(-g2))), o[db][3] * r * gn.w * (g3 / (1.f + __expf(-g3))));
            *(v2u*)(OMIX + row * DM + d0) = w; }
    }
    LDS_WAIT();
}
typedef float f32x16 __attribute__((ext_vector_type(16)));
constexpr int SB_RS = 72;
constexpr int SB_TILE = 64 * SB_RS;
__device__ __forceinline__ f32x16 mfma32(bf16x8s a, bf16x8s b, f32x16 c) { return __builtin_amdgcn_mfma_f32_32x32x16_bf16(a, b, c, 0, 0, 0); }
__device__ __forceinline__ int sb_crow(int r, int hi) { return (r & 3) + 8 * (r >> 2) + 4 * hi; }
__device__ __forceinline__ void sb_subtile(const LAS bf16* Kp, const LAS bf16* Vp, const bf16x8s (&qf)[4], float bias2, bool diag, int key0, int qpos, int hi, float& Cc, f32x16& o0, f32x16& o1) {
    f32x16 p;
#pragma unroll
    for (int r = 0; r < 16; ++r) p[r] = bias2;
#pragma unroll
    for (int ks = 0; ks < 4; ++ks) { const bf16x8s kf = *(const LAS bf16x8s*)(Kp + 16 * ks); p = mfma32(kf, qf[ks], p); }
    float E = 1.f;
#pragma unroll
    for (int r = 0; r < 16; ++r) { float u = __builtin_amdgcn_exp2f(p[r]); if (diag) u = (key0 + r < qpos) ? u : 0.f; const float tt = E * u; E += tt; p[r] = tt; }
    const float Ti = __builtin_amdgcn_rcpf(E), Tp = __shfl_xor(Ti, 32);
    const float G = Ti * (hi ? Cc : Cc * Tp);
    Cc = Cc * Ti * Tp;
#pragma unroll
    for (int r = 0; r < 16; ++r) p[r] *= G;
    bf16x8s pa[2];
#pragma unroll
    for (int s = 0; s < 2; ++s) { const v4u ww = {pk_bf16(p[8 * s], p[8 * s + 1]), pk_bf16(p[8 * s + 2], p[8 * s + 3]), pk_bf16(p[8 * s + 4], p[8 * s + 5]), pk_bf16(p[8 * s + 6], p[8 * s + 7])}; pa[s] = __builtin_bit_cast(bf16x8s, ww); }
#pragma unroll
    for (int s = 0; s < 2; ++s) {
        const LAS bf16* vb = Vp + 8 * s * SB_RS;
        const bf16x8s v0 = cat8(tr4(vb), tr4(vb + 4 * SB_RS)), v1 = cat8(tr4(vb + 32), tr4(vb + 4 * SB_RS + 32));
        o0 = mfma32(pa[s], v0, o0); o1 = mfma32(pa[s], v1, o1);
    }
}
__device__ __forceinline__ void sb_unit(const Ctx& C, int b, int h, int qb) {
    const bf16* SQ = (const bf16*)(C.ws + WS_SQ); const bf16* SK = (const bf16*)(C.ws + WS_SK); const bf16* SV = (const bf16*)(C.ws + WS_SV); bf16* OMIX = (bf16*)(C.ws + WS_OMIX);
    const int tid = C.tid, lane = C.lane, r32 = lane & 31, hi = lane >> 5, w = C.wave;
    const int q0 = qb * 256, qlo = q0 + 32 * w, qpos = qlo + r32;
    LAS bf16* Kl = (LAS bf16*)(C.lds + RING_OFF); LAS bf16* Vl = Kl + 2 * SB_TILE;
    const float bias2 = ((const float*)C.in[I_SBB])[h] * LOG2E;
    bf16x8s qf[4];
#pragma unroll
    for (int ks = 0; ks < 4; ++ks) qf[ks] = *(const bf16x8s*)(SQ + (size_t)(b * SEQ + qpos) * HW + h * HD + 16 * ks + 8 * hi);
    const int srow = tid >> 3, sch = tid & 7;
    const bf16* gk = SK + (size_t)(b * SEQ + srow) * HW + h * HD + sch * 8; const bf16* gv = SV + (size_t)(b * SEQ + srow) * HW + h * HD + sch * 8;
    const int soff = srow * SB_RS + sch * 8;
    const int nt = (q0 + 256) / 64;
    v4u rk = *(const v4u*)(gk + (size_t)(nt - 1) * 64 * HW), rv = *(const v4u*)(gv + (size_t)(nt - 1) * 64 * HW);
    *(LAS v4u*)(Kl + soff) = rk; *(LAS v4u*)(Vl + soff) = rv;
    __syncthreads();
    f32x16 o0, o1;
#pragma unroll
    for (int r = 0; r < 16; ++r) { o0[r] = 0.f; o1[r] = 0.f; }
    float Cc = 1.f;
    const int kap = 16 * ((r32 >> 2) & 1) + (r32 & 3) + 4 * (r32 >> 3);
    const int koff = kap * SB_RS + 8 * hi;
    const int gi = lane >> 4, i16 = lane & 15;
    const int voff = (16 * hi + (i16 >> 2)) * SB_RS + 16 * (gi & 1) + (i16 & 3) * 4;
    int cur = 0;
    for (int t = nt - 1; t >= 0; --t) {
        if (t > 0) { rk = *(const v4u*)(gk + (size_t)(t - 1) * 64 * HW); rv = *(const v4u*)(gv + (size_t)(t - 1) * 64 * HW); }
        const LAS bf16* Kc = Kl + cur * SB_TILE; const LAS bf16* Vc = Vl + cur * SB_TILE;
        if (64 * t <= qlo + 30) {
            const bool diag = 64 * t + 63 >= qlo;
#pragma unroll
            for (int sub = 1; sub >= 0; --sub) {
                if (diag && 64 * t + 32 * sub > qlo + 30) continue;
                sb_subtile(Kc + sub * 32 * SB_RS + koff, Vc + sub * 32 * SB_RS + voff, qf, bias2, diag, 64 * t + 32 * sub + 16 * hi, qpos, hi, Cc, o0, o1);
            }
        }
        if (t > 0) { *(LAS v4u*)(Kl + (cur ^ 1) * SB_TILE + soff) = rk; *(LAS v4u*)(Vl + (cur ^ 1) * SB_TILE + soff) = rv; }
        __syncthreads();
        cur ^= 1;
    }
    bf16* orow = OMIX + (size_t)(b * SEQ + qlo) * DM + HW + h * HD + r32;
#pragma unroll
    for (int r = 0; r < 16; ++r) { const int q = sb_crow(r, hi); orow[(size_t)q * DM] = f2bf(o0[r]); orow[(size_t)q * DM + 32] = f2bf(o1[r]); }
}
__device__ __forceinline__ void sb_prompt_phase(const Ctx& C) {
    const int G = gridDim.x, bid = blockIdx.x;
    const int vcu = (G % 8 == 0) ? (bid % 8) * (G / 8) + bid / 8 : bid;
    for (int p = vcu; p < NBATCH * NH * 16; p += G) {
        const int bh = p >> 4, s = p & 15;
        sb_unit(C, bh >> 3, bh & 7, 31 - s);
        sb_unit(C, bh >> 3, bh & 7, s);
    }
}

__device__ __forceinline__ void sbs_item(const Ctx& C, int n, int half) {
    const bf16* SQ = (const bf16*)(C.ws + WS_SQ); const bf16* SK = (const bf16*)(C.ws + WS_SK); const bf16* SV = (const bf16*)(C.ws + WS_SV);
    const float* ck = (const float*)C.in[I_CK]; const float* cv = (const float*)C.in[I_CV]; const int* pt = (const int*)C.in[I_PT];
    float* PO = (float*)(C.ws + WS_SBP); float* PC = PO + (size_t)NDEC * 2 * NH * TDEC * HD;
    const int lane = C.lane, r32 = lane & 31, hi = lane >> 5, h = C.wave;
    LAS bf16* Kt = (LAS bf16*)(C.lds + RING_OFF + C.wave * 9216); LAS bf16* Vt = Kt + 32 * SB_RS;
    const float bias2 = ((const float*)C.in[I_SBB])[h] * LOG2E;
    const int qpos = PAST + r32;
    bf16x8s qf[4];
#pragma unroll
    for (int ks = 0; ks < 4; ++ks) { qf[ks] = (bf16x8s){0, 0, 0, 0, 0, 0, 0, 0}; if (r32 < TDEC) qf[ks] = *(const bf16x8s*)(SQ + (size_t)(MP + n * TDEC + r32) * HW + h * HD + 16 * ks + 8 * hi); }
    f32x16 o0, o1;
#pragma unroll
    for (int r = 0; r < 16; ++r) { o0[r] = 0.f; o1[r] = 0.f; }
    float Cc = 1.f;
    const int kap = 16 * ((r32 >> 2) & 1) + (r32 & 3) + 4 * (r32 >> 3);
    const LAS bf16* Kp = Kt + kap * SB_RS + 8 * hi;
    const int gi = lane >> 4, i16 = lane & 15;
    const LAS bf16* Vp = Vt + (16 * hi + (i16 >> 2)) * SB_RS + 16 * (gi & 1) + (i16 & 3) * 4;
    const int srow = lane >> 4, sch = lane & 15;
    if (half == 1) {
#pragma unroll
        for (int it = 0; it < 8; ++it) { const int row = it * 4 + srow; v2u kw = {0u, 0u}, vw = {0u, 0u};
            if (row < TDEC) { kw = *(const v2u*)(SK + (size_t)(MP + n * TDEC + row) * HW + h * HD + sch * 4); vw = *(const v2u*)(SV + (size_t)(MP + n * TDEC + row) * HW + h * HD + sch * 4); }
            *(LAS v2u*)(Kt + row * SB_RS + sch * 4) = kw; *(LAS v2u*)(Vt + row * SB_RS + sch * 4) = vw; }
        LDS_WAIT();
        sb_subtile(Kp, Vp, qf, bias2, true, PAST + 16 * hi, qpos, hi, Cc, o0, o1);
        LDS_WAIT();
    }
    const int pg_hi = half ? NPAGES - 1 : NPAGES / 2 - 1, nsteps = (NPAGES / 2) * 4;
    f32x4 rk[8], rv[8];
    { const size_t base = (((size_t)pt[n * NPAGES + pg_hi] * PAGE + 96 + srow) * NH + h) * HD + sch * 4;
#pragma unroll
      for (int it = 0; it < 8; ++it) { rk[it] = *(const f32x4*)(ck + base + (size_t)it * 4 * NH * HD); rv[it] = *(const f32x4*)(cv + base + (size_t)it * 4 * NH * HD); } }
    for (int st = 0; st < nsteps; ++st) {
#pragma unroll
        for (int it = 0; it < 8; ++it) { const int row = it * 4 + srow;
            const v2u kw = {pk_bf16(rk[it].x, rk[it].y), pk_bf16(rk[it].z, rk[it].w)}, vw = {pk_bf16(rv[it].x, rv[it].y), pk_bf16(rv[it].z, rv[it].w)};
            *(LAS v2u*)(Kt + row * SB_RS + sch * 4) = kw; *(LAS v2u*)(Vt + row * SB_RS + sch * 4) = vw; }
        if (st + 1 < nsteps) { const int s2 = st + 1, pg = pg_hi - (s2 >> 2), sub = 3 - (s2 & 3);
            const size_t base = (((size_t)pt[n * NPAGES + pg] * PAGE + 32 * sub + srow) * NH + h) * HD + sch * 4;
#pragma unroll
            for (int it = 0; it < 8; ++it) { rk[it] = *(const f32x4*)(ck + base + (size_t)it * 4 * NH * HD); rv[it] = *(const f32x4*)(cv + base + (size_t)it * 4 * NH * HD); } }
        LDS_WAIT();
        sb_subtile(Kp, Vp, qf, bias2, false, 0, qpos, hi, Cc, o0, o1);
        LDS_WAIT();
    }
    float* po = PO + ((size_t)(n * 2 + half) * NH + h) * TDEC * HD;
#pragma unroll
    for (int r = 0; r < 4; ++r) { po[(r + 4 * hi) * HD + r32] = o0[r]; po[(r + 4 * hi) * HD + 32 + r32] = o1[r]; }
    if (lane < TDEC) PC[((size_t)(n * 2 + half) * NH + h) * TDEC + lane] = Cc;
}
__device__ __forceinline__ void sbs_phase(const Ctx& C) {
    for (int it = blockIdx.x; it < NDEC * 2; it += gridDim.x) sbs_item(C, it >> 1, it & 1);
}
__device__ __forceinline__ void sbs_combine(const Ctx& C) {
    const float* PO = (const float*)(C.ws + WS_SBP); const float* PC = PO + (size_t)NDEC * 2 * NH * TDEC * HD; bf16* OMIX = (bf16*)(C.ws + WS_OMIX);
    const int gt = C.gw * 64 + C.lane, ngt = C.ngw * 64;
    for (int e = gt; e < NDEC * NH * TDEC * HD; e += ngt) {
        const int d = e & 63, q = (e >> 6) & 7, h = (e >> 9) & 7, n = e >> 12;
        const size_t i1 = ((size_t)(n * 2 + 1) * NH + h) * TDEC + q, i0 = ((size_t)(n * 2) * NH + h) * TDEC + q;
        OMIX[(size_t)(MP + n * TDEC + q) * DM + HW + h * HD + d] = f2bf(PO[i1 * HD + d] + PC[i1] * PO[i0 * HD + d]);
    }
}
__device__ __forceinline__ void hgrn_chain(const Ctx& C, int rowbase, int T, int h, const float* S0, float* Sout) {
    const float* LF = (const float*)(C.ws + WS_LF); const bf16* QH = (const bf16*)(C.ws + WS_QH); const bf16* VH = (const bf16*)(C.ws + WS_VH); const bf16* GH = (const bf16*)(C.ws + WS_GH);
    bf16* OMIX = (bf16*)(C.ws + WS_OMIX); const float* hgn = (const float*)C.in[I_HGN];
    const int lane = C.lane; const float gn = hgn[h * HD + lane];
    float S[64];
#pragma unroll
    for (int k = 0; k < 64; ++k) S[k] = S0 ? S0[k * 64 + lane] : 0.f;
    for (int t = 0; t < T; ++t) {
        const size_t off = (size_t)(rowbase + t) * HW + h * HD + lane;
        const float fk = __expf(LF[off]), kk = 1.f - fk, qk = bf2f(QH[off]), vd = bf2f(VH[off]), g = bf2f(GH[off]);
        float o = 0.f;
#pragma unroll
        for (int k = 0; k < 64; ++k) { const float f_ = rdlane(fk, k), k_ = rdlane(kk, k), q_ = rdlane(qk, k); S[k] = f_ * S[k] + k_ * vd; o += S[k] * q_; }
        const float r = rsqrtf(wave_sum(o * o) * (1.f / HD) + RMS_EPS);
        OMIX[(size_t)(rowbase + t) * DM + h * HD + lane] = f2bf(o * r * gn * (g / (1.f + __expf(-g))));
    }
#pragma unroll
    for (int k = 0; k < 64; ++k) Sout[k * 64 + lane] = S[k];
}
template <bool SAMPLE>
__device__ __forceinline__ void sb_query(const Ctx& C, int row, int h, int nkeys, int seq  ) {
    const bf16* SQ = (const bf16*)(C.ws + WS_SQ); const bf16* SK = (const bf16*)(C.ws + WS_SK); const bf16* SV = (const bf16*)(C.ws + WS_SV);
    const float* ck = (const float*)C.in[I_CK]; const float* cv = (const float*)C.in[I_CV]; const int* pt = (const int*)C.in[I_PT];
    bf16* OMIX = (bf16*)(C.ws + WS_OMIX);
    const int lane = C.lane; const float bias2 = ((const float*)C.in[I_SBB])[h] * LOG2E;
    float q[64];
    { const v4u* qp = (const v4u*)(SQ + (size_t)row * HW + h * HD);
#pragma unroll
      for (int c = 0; c < 8; ++c) { const v4u w = qp[c]; q[8 * c] = bflo(w.x); q[8 * c + 1] = bfhi(w.x); q[8 * c + 2] = bflo(w.y); q[8 * c + 3] = bfhi(w.y); q[8 * c + 4] = bflo(w.z); q[8 * c + 5] = bfhi(w.z); q[8 * c + 6] = bflo(w.w); q[8 * c + 7] = bfhi(w.w); } }
    float Cc = 1.f, o = 0.f;
    for (int base = nkeys > 0 ? ((nkeys - 1) & ~63) : -1; base >= 0; base -= 64) {
        const int j = base + lane; const bool valid = j < nkeys; const int jc = valid ? j : nkeys - 1;
        float z = 0.f;
        if (SAMPLE && jc < PAST) {
            const float* kr = ck + (((size_t)pt[seq * NPAGES + (jc >> 7)] * PAGE + (jc & 127)) * NH + h) * HD;
#pragma unroll
            for (int c = 0; c < 16; ++c) { const f32x4 w = ((const f32x4*)kr)[c]; z += q[4 * c] * w.x + q[4 * c + 1] * w.y + q[4 * c + 2] * w.z + q[4 * c + 3] * w.w; }
        } else {
            const size_t krow = SAMPLE ? (size_t)(MP + seq * TDEC + (jc - PAST)) : (size_t)seq * SEQ + jc;
            const v4u* kr = (const v4u*)(SK + krow * HW + h * HD);
#pragma unroll
            for (int c = 0; c < 8; ++c) { const v4u w = kr[c]; z += q[8 * c] * bflo(w.x) + q[8 * c + 1] * bfhi(w.x) + q[8 * c + 2] * bflo(w.y) + q[8 * c + 3] * bfhi(w.y) + q[8 * c + 4] * bflo(w.z) + q[8 * c + 5] * bfhi(w.z) + q[8 * c + 6] * bflo(w.w) + q[8 * c + 7] * bfhi(w.w); }
        }
        const float u = valid ? exp2f(z + bias2) : 0.f;
        float incl = 1.f / (1.f + u);
#pragma unroll
        for (int off = 1; off < 64; off <<= 1) { const float y = __shfl_down(incl, off); if (lane + off < 64) incl *= y; }
        const float a = u * incl * Cc;
        Cc *= __shfl(incl, 0);
        const int nk = nkeys - base < 64 ? nkeys - base : 64;
        for (int jj = 0; jj < nk; ++jj) {
            const float aj = __shfl(a, jj); const int jk = base + jj; float vv;
            if (SAMPLE && jk < PAST) vv = cv[(((size_t)pt[seq * NPAGES + (jk >> 7)] * PAGE + (jk & 127)) * NH + h) * HD + lane];
            else { const size_t vrow = SAMPLE ? (size_t)(MP + seq * TDEC + (jk - PAST)) : (size_t)seq * SEQ + jk; vv = bf2f(SV[vrow * HW + h * HD + lane]); }
            o += aj * vv;
        }
    }
    OMIX[(size_t)row * DM + HW + h * HD + lane] = f2bf(o);
}
__device__ __forceinline__ void p2_mix1(const Ctx& C) {
    for (int cid = C.gw; cid < NBATCH * NH * (SEQ / 64); cid += C.ngw) hgrn_h1(C, cid);
    const int w = C.gw, nw = C.ngw;
    for (int i = w; i < NDEC * NH; i += nw) { const int n = i / NH, h = i % NH; hgrn_chain(C, MP + n * TDEC, TDEC, h, (const float*)C.in[I_SH] + (size_t)i * 4096, C.out + O_HS + (size_t)i * 4096); }
    __syncthreads();
    sbs_phase(C);
    __syncthreads();
    sb_prompt_phase(C);
}
__device__ __forceinline__ void p4_mix3(const Ctx& C) {
    for (int cid = C.gw; cid < NBATCH * NH * (SEQ / 64); cid += C.ngw) hgrn_h3(C, cid);
}

__device__ __forceinline__ void thin_row(const float* xin, const bf16* br, const float* gpost, float* xout, const float* gpre, bf16* hrow, int lane) {
    const f32x4* xr = (const f32x4*)xin + lane; const v2u* bp = (const v2u*)br + lane; const f32x4* gp = (const f32x4*)gpost + lane;
    f32x4 b[4]; float s = 0.f;
#pragma unroll
    for (int j = 0; j < 4; ++j) { const v2u w = bp[64 * j]; b[j] = (f32x4){bflo(w.x), bfhi(w.x), bflo(w.y), bfhi(w.y)}; s += (b[j].x * b[j].x + b[j].y * b[j].y) + (b[j].z * b[j].z + b[j].w * b[j].w); }
    const float r = rsqrtf(wave_sum(s) * (1.f / DM) + RMS_EPS);
    float s2 = 0.f;
#pragma unroll
    for (int j = 0; j < 4; ++j) { b[j] = xr[64 * j] + b[j] * r * gp[64 * j]; s2 += (b[j].x * b[j].x + b[j].y * b[j].y) + (b[j].z * b[j].z + b[j].w * b[j].w); }
    f32x4* xo = (f32x4*)xout + lane;
#pragma unroll
    for (int j = 0; j < 4; ++j) xo[64 * j] = b[j];
    if (hrow) {
        const float r2 = rsqrtf(wave_sum(s2) * (1.f / DM) + RMS_EPS); const f32x4* g2 = (const f32x4*)gpre + lane; v2u* o8 = (v2u*)hrow + lane;
#pragma unroll
        for (int j = 0; j < 4; ++j) { const f32x4 gg = g2[64 * j]; v2u w; w.x = pk_bf16(b[j].x * r2 * gg.x, b[j].y * r2 * gg.y); w.y = pk_bf16(b[j].z * r2 * gg.z, b[j].w * r2 * gg.w); o8[64 * j] = w; }
    }
}
template <int WHICH>
__device__ __forceinline__ void p_thin(const Ctx& C) {
    const bf16* BR = (const bf16*)(C.ws + WS_BR); bf16* H = (bf16*)(C.ws + WS_H);
    float* X1 = (float*)(C.ws + WS_X1); float* X2 = (float*)(C.ws + WS_X2);
    const float* gpost = (const float*)C.in[WHICH == 0 ? I_GMIXPOST : WHICH == 1 ? I_GCAPOST : I_GFFNPOST];
    const float* gpre = (const float*)C.in[WHICH == 0 ? I_GCAPRE : I_GFFNPRE];
    for (int m = C.gw; m < MT; m += C.ngw) {
        const float* xin; float* xout;
        if (WHICH == 0) { xin = m < MP ? (const float*)C.in[I_XP] + (size_t)m * DM : (const float*)C.in[I_XS] + (size_t)(m - MP) * DM; xout = X1 + (size_t)m * DM; }
        else if (WHICH == 1) { xin = X1 + (size_t)m * DM; xout = X2 + (size_t)m * DM; }
        else { xin = X2 + (size_t)m * DM; xout = m < MP ? C.out + O_YP + (size_t)m * DM : C.out + O_YS + (size_t)(m - MP) * DM; }
        thin_row(xin, BR + (size_t)m * DM, gpost, xout, gpre, WHICH == 2 ? nullptr : H + (size_t)m * DM, C.lane);
    }
}

__device__ __forceinline__ void p6_naive(const Ctx& C) {
    const bf16* QCA = (const bf16*)(C.ws + WS_QCA); const bf16* MK = (const bf16*)(C.ws + WS_MK); const bf16* MV = (const bf16*)(C.ws + WS_MV);
    const float* cmk = (const float*)C.in[I_MK]; const float* cmv = (const float*)C.in[I_MV]; bf16* OCA = (bf16*)(C.ws + WS_OMIX);
    const int lane = C.lane;
    for (int it = C.gw; it < MT * CAH; it += C.ngw) {
        const int row = it >> 2, h = it & 3;
        const v2u qw = *((const v2u*)(QCA + (size_t)row * DM + h * CAD) + lane);
        const float q0 = bflo(qw.x), q1 = bfhi(qw.x), q2 = bflo(qw.y), q3 = bfhi(qw.y);
        float mx = -1e30f, l = 0.f, o0 = 0.f, o1 = 0.f, o2 = 0.f, o3 = 0.f;
        for (int m = 0; m < NMEM; ++m) {
            float k0, k1, k2, k3, v0, v1, v2, v3;
            if (row < MP) { const size_t off = ((size_t)((row >> 13) * NMEM + m)) * DM + h * CAD; const v2u kw = *((const v2u*)(MK + off) + lane), vw = *((const v2u*)(MV + off) + lane);
                k0 = bflo(kw.x); k1 = bfhi(kw.x); k2 = bflo(kw.y); k3 = bfhi(kw.y); v0 = bflo(vw.x); v1 = bfhi(vw.x); v2 = bflo(vw.y); v3 = bfhi(vw.y); }
            else { const size_t off = ((size_t)(((row - MP) >> 3) * NMEM + m)) * DM + h * CAD; const f32x4 kw = *((const f32x4*)(cmk + off) + lane), vw = *((const f32x4*)(cmv + off) + lane);
                k0 = kw.x; k1 = kw.y; k2 = kw.z; k3 = kw.w; v0 = vw.x; v1 = vw.y; v2 = vw.z; v3 = vw.w; }
            const float s = wave_sum(q0 * k0 + q1 * k1 + q2 * k2 + q3 * k3);
            const float mn = fmaxf(mx, s), sc = exp2f(mx - mn), p = exp2f(s - mn);
            l = l * sc + p; o0 = o0 * sc + p * v0; o1 = o1 * sc + p * v1; o2 = o2 * sc + p * v2; o3 = o3 * sc + p * v3; mx = mn;
        }
        const float il = 1.f / l; v2u w; w.x = pk_bf16(o0 * il, o1 * il); w.y = pk_bf16(o2 * il, o3 * il);
        *((v2u*)(OCA + (size_t)row * DM + h * CAD) + lane) = w;
    }
}

__device__ __forceinline__ float gelu_tanh(float x) { return x / (1.f + __expf(-1.5957691216057308f * (x + 0.044715f * x * x * x))); }
__device__ __forceinline__ void ld8(const bf16* p, float (&v)[8]) { const v4u w = *(const v4u*)p; v[0] = bflo(w.x); v[1] = bfhi(w.x); v[2] = bflo(w.y); v[3] = bfhi(w.y); v[4] = bflo(w.z); v[5] = bfhi(w.z); v[6] = bflo(w.w); v[7] = bfhi(w.w); }
__device__ __forceinline__ void ld8f(const float* p, float (&v)[8]) { const f32x4 a = *(const f32x4*)p, b = *(const f32x4*)(p + 4); v[0] = a.x; v[1] = a.y; v[2] = a.z; v[3] = a.w; v[4] = b.x; v[5] = b.y; v[6] = b.z; v[7] = b.w; }
__device__ __forceinline__ void p10_convgate(const Ctx& C) {
    const bf16* U = (const bf16*)(C.ws + WS_U); bf16* G = (bf16*)(C.ws + WS_G);
    const float* cw = (const float*)C.in[I_CONVW]; const float* cb = (const float*)C.in[I_CONVB]; const float* sc = (const float*)C.in[I_SC];
    constexpr int NCH = DFF / 8;
    const int gt = C.gw * 64 + C.lane, ngt = C.ngw * 64;
    for (int it = gt; it < MT * NCH; it += ngt) {
        const int row = it / NCH, c = (it % NCH) * 8;
        const int t = row < MP ? (row & (SEQ - 1)) : ((row - MP) & 7);
        float res[2][8];
#pragma unroll
        for (int half = 0; half < 2; ++half) {
            const int col = c + half * DFF;
            float u0[8], u1[8], u2[8], w0[8], w1[8], w2[8], bb[8];
            ld8(U + (size_t)row * DFF2 + col, u2);
            if (t >= 1) ld8(U + (size_t)(row - 1) * DFF2 + col, u1);
            else if (row < MP) {
#pragma unroll
                for (int e = 0; e < 8; ++e) u1[e] = 0.f;
            } else ld8f(sc + ((size_t)((row - MP) >> 3) * 2 + 1) * DFF2 + col, u1);
            if (t >= 2) ld8(U + (size_t)(row - 2) * DFF2 + col, u0);
            else if (row < MP) {
#pragma unroll
                for (int e = 0; e < 8; ++e) u0[e] = 0.f;
            } else ld8f(sc + ((size_t)((row - MP) >> 3) * 2 + t) * DFF2 + col, u0);
            ld8f(cw + col, w0); ld8f(cw + DFF2 + col, w1); ld8f(cw + 2 * DFF2 + col, w2); ld8f(cb + col, bb);
#pragma unroll
            for (int e = 0; e < 8; ++e) res[half][e] = bb[e] + w0[e] * u0[e] + w1[e] * u1[e] + w2[e] * u2[e];
        }
        v4u o;
        o.x = pk_bf16(gelu_tanh(res[0][0]) * res[1][0], gelu_tanh(res[0][1]) * res[1][1]); o.y = pk_bf16(gelu_tanh(res[0][2]) * res[1][2], gelu_tanh(res[0][3]) * res[1][3]);
        o.z = pk_bf16(gelu_tanh(res[0][4]) * res[1][4], gelu_tanh(res[0][5]) * res[1][5]); o.w = pk_bf16(gelu_tanh(res[0][6]) * res[1][6], gelu_tanh(res[0][7]) * res[1][7]);
        *(v4u*)(G + (size_t)row * DFF + c) = o;
    }
}
enum { PH_PRO = 0, PH_INPROJ, PH_MIX1, PH_SCAN, PH_MIX3, PH_OPROJ, PH_THIN0, PH_CQ, PH_CA, PH_CO, PH_THIN1, PH_UP, PH_CONV, PH_DOWN, PH_THIN2, NPH };
#ifndef MK_ONE_LAUNCH
#define MK_ONE_LAUNCH 1
#endif
__global__ void __launch_bounds__(NTHREADS, 2) fwd(Args args) {
    extern __shared__ __attribute__((aligned(16))) unsigned char lds_raw[];
    Ctx C;
    C.in = args.in; C.out = args.out; C.ws = args.ws; C.lds = (LAS unsigned char*)lds_raw;
    C.tid = threadIdx.x; C.lane = C.tid & 63; C.wave = __builtin_amdgcn_readfirstlane(C.tid >> 6);
    C.gw = blockIdx.x * NWAVES + C.wave; C.ngw = gridDim.x * NWAVES;
    const int G = gridDim.x, bid = blockIdx.x;
    volatile LAS unsigned* MISC = (volatile LAS unsigned*)(C.lds + MISC_OFF);
    for (int u = C.tid; u < (LDS_BYTES - LDSCTL_OFF) / 4; u += NTHREADS) ((LAS unsigned*)(C.lds + LDSCTL_OFF))[u] = 0u;
    __syncthreads();
    const int lo = args.ph_lo, hi = args.ph_hi;
    XcdBarrier bar; bar.bar = (unsigned*)(C.ws + WS_CTL) + CW_BAR; bar.x = 0; bar.st = nullptr;
    if (hi - lo > 1) bar = xcd_barrier_post((unsigned*)(C.ws + WS_CTL) + CW_BAR, MISC + 8);
#define IN(k) (lo <= (k) && (k) < hi)
#define SEAM(k) do { if (IN(k) && IN((k) + 1)) xcd_barrier(bar); } while (0)
    bf16* H = (bf16*)(C.ws + WS_H);
    if (IN(PH_PRO)) { p0_prologue(C); } SEAM(PH_PRO);
    if (IN(PH_INPROJ)) {
        { pg8::Gemm g{H, (const bf16*)(C.ws + WS_WIN), MT, DIN, DM}; pg8::StaticOrder S; S.init(MT, DIN, G, bid);
          pg8::EpiInProj E{(bf16*)(C.ws + WS_QH), (bf16*)(C.ws + WS_VH), (bf16*)(C.ws + WS_GH), (bf16*)(C.ws + WS_SQ), (bf16*)(C.ws + WS_SK), (bf16*)(C.ws + WS_SV), (float*)(C.ws + WS_LF),
                           (const float*)(C.ws + WS_LB), C.out + O_KP, C.out + O_VP, C.out + O_KS, C.out + O_VS, SQ_SCALE};
          pg8::gemm_phase<pg8::EpiInProj, pg8::StaticOrder, true, true>(C.lds + RING_OFF, g, S, E); }
        { pg8::Gemm g{(const bf16*)(C.ws + WS_MN), (const bf16*)(C.ws + WS_WCKV), NBATCH * NMEM, 2 * DM, DM}; pg8::StaticOrder S; S.init(NBATCH * NMEM, 2 * DM, G, (bid + G - 184 % G) % G);
          pg8::EpiMemKV E{(bf16*)(C.ws + WS_MK), (bf16*)(C.ws + WS_MV), C.out + O_MKP, C.out + O_MVP};
          pg8::gemm_phase<pg8::EpiMemKV, pg8::StaticOrder, true, true>(C.lds + RING_OFF, g, S, E); }
    } SEAM(PH_INPROJ);
    if (IN(PH_MIX1)) { p2_mix1(C); } SEAM(PH_MIX1);
    if (IN(PH_SCAN)) { hgrn_h2(C); sbs_combine(C); } SEAM(PH_SCAN);
    if (IN(PH_MIX3)) { p4_mix3(C); } SEAM(PH_MIX3);
    if (IN(PH_OPROJ)) { pg8::Gemm g{(const bf16*)(C.ws + WS_OMIX), (const bf16*)(C.ws + WS_WO), MT, DM, DM}; pg8::StaticOrder S; S.init(MT, DM, G, bid);
        pg8::EpiStore E{(bf16*)(C.ws + WS_BR), DM, 1.f, nullptr, nullptr};
        pg8::gemm_phase<pg8::EpiStore, pg8::StaticOrder, true, true>(C.lds + RING_OFF, g, S, E); } SEAM(PH_OPROJ);
    if (IN(PH_THIN0)) { p_thin<0>(C); } SEAM(PH_THIN0);
    if (IN(PH_CQ)) { pg8::Gemm g{H, (const bf16*)(C.ws + WS_WCQ), MT, DM, DM}; pg8::StaticOrder S; S.init(MT, DM, G, bid);
        pg8::EpiStore E{(bf16*)(C.ws + WS_QCA), DM, CQ_SCALE, nullptr, nullptr};
        pg8::gemm_phase<pg8::EpiStore, pg8::StaticOrder, true, true>(C.lds + RING_OFF, g, S, E); } SEAM(PH_CQ);
    if (IN(PH_CA)) { p6_naive(C); } SEAM(PH_CA);
    if (IN(PH_CO)) { pg8::Gemm g{(const bf16*)(C.ws + WS_OMIX), (const bf16*)(C.ws + WS_WCO), MT, DM, DM}; pg8::StaticOrder S; S.init(MT, DM, G, bid);
        pg8::EpiStore E{(bf16*)(C.ws + WS_BR), DM, 1.f, nullptr, nullptr};
        pg8::gemm_phase<pg8::EpiStore, pg8::StaticOrder, true, true>(C.lds + RING_OFF, g, S, E); } SEAM(PH_CO);
    if (IN(PH_THIN1)) { p_thin<1>(C); } SEAM(PH_THIN1);
    if (IN(PH_UP)) { pg8::Gemm g{H, (const bf16*)(C.ws + WS_WUP), MT, DFF2, DM}; pg8::StaticOrder S; S.init(MT, DFF2, G, bid);
        pg8::EpiStore E{(bf16*)(C.ws + WS_U), DFF2, 1.f, C.out + O_CP, C.out + O_CS};
        pg8::gemm_phase<pg8::EpiStore, pg8::StaticOrder, true, true>(C.lds + RING_OFF, g, S, E); } SEAM(PH_UP);
    if (IN(PH_CONV)) { p10_convgate(C); } SEAM(PH_CONV);
    if (IN(PH_DOWN)) { pg8::Gemm g{(const bf16*)(C.ws + WS_G), (const bf16*)(C.ws + WS_WDN), MT, DM, DFF}; pg8::StaticOrder S; S.init(MT, DM, G, bid);
        pg8::EpiStore E{(bf16*)(C.ws + WS_BR), DM, 1.f, nullptr, nullptr};
        pg8::gemm_phase<pg8::EpiStore, pg8::StaticOrder, true, true>(C.lds + RING_OFF, g, S, E); } SEAM(PH_DOWN);
    if (IN(PH_THIN2)) { p_thin<2>(C); }
#undef IN
#undef SEAM
}

extern "C" void kernel_launch(void* const* d_in, const int* in_sizes, int n_in, void* d_out, int out_size, void* d_ws, size_t ws_size, hipStream_t stream) {
    static int grid = 0;
    if (grid == 0) {
        if (n_in != N_IN || (size_t)out_size != O_END || ws_size < WS_END) { fprintf(stderr, "kernel_launch: unexpected problem: n_in %d out %d ws %zu\n", n_in, out_size, ws_size); grid = -1; return; }
        int dev = 0, cus = 0, per_cu = 0;
        if (hipGetDevice(&dev) != hipSuccess || hipDeviceGetAttribute(&cus, hipDeviceAttributeMultiprocessorCount, dev) != hipSuccess) { grid = -1; return; }
        if (hipFuncSetAttribute((const void*)fwd, hipFuncAttributeMaxDynamicSharedMemorySize, LDS_BYTES) != hipSuccess) { fprintf(stderr, "kernel_launch: hipFuncSetAttribute failed\n"); grid = -1; return; }
        if (hipOccupancyMaxActiveBlocksPerMultiprocessor(&per_cu, (const void*)fwd, NTHREADS, LDS_BYTES) != hipSuccess || per_cu < 1) fprintf(stderr, "kernel_launch: occupancy query says %d\n", per_cu);
        (void)hipGetLastError();
        grid = cus;
    }
    if (grid < 0) return;
    (void)hipMemsetAsync((char*)d_ws + WS_CTL, 0, CTL_ZERO_BYTES, stream);
    Args a{};
    for (int i = 0; i < N_IN; ++i) a.in[i] = d_in[i];
    a.out = (float*)d_out; a.ws = (unsigned char*)d_ws;
#if MK_ONE_LAUNCH
    a.ph_lo = 0; a.ph_hi = NPH;
    hipLaunchKernelGGL(fwd, dim3(grid), dim3(NTHREADS), LDS_BYTES, stream, a);
#else
    for (int p = 0; p < NPH; ++p) { a.ph_lo = p; a.ph_hi = p + 1; hipLaunchKernelGGL(fwd, dim3(grid), dim3(NTHREADS), LDS_BYTES, stream, a); }
#endif
}
```

```cpp
#include <hip/hip_runtime.h>
#include <cstdio>
#include <cstdint>
namespace pg8 {
#define PG8_LAS __attribute__((address_space(3)))
typedef unsigned short bf16_t;
typedef short bf16x8 __attribute__((ext_vector_type(8)));
typedef float f32x4 __attribute__((ext_vector_type(4)));
typedef unsigned u32x4 __attribute__((ext_vector_type(4)));
constexpr int BM = 256, BK = 64, HALF = 128, HTB = HALF * BK * 2  , STAGE_BYTES = 8 * HTB, NXCD = 8, WGM = 8;

__host__ __device__ __forceinline__ int lds_byte(int r, int c) { const int st = (r >> 4) * 2 + (c >> 5), rr = r & 15, cc = c & 31, ob = rr * 64 + cc * 2; return st * 1024 + (ob ^ (((ob >> 9) & 1) << 5)); }
__host__ __device__ __forceinline__ void stage_rc(int b, int& R, int& C) { const int st = b / 1024, sb = b % 1024, swz = sb ^ (((sb >> 9) & 1) << 5); R = (st >> 1) * 16 + swz / 64; C = (st & 1) * 32 + (swz % 64) / 2; }
__host__ __device__ __forceinline__ int perm32(int rho) { const int n = rho >> 4, i = rho & 15; return 8 * (i >> 2) + 4 * n + (i & 3); }

struct Unit { int pm, pn; };
struct Gemm { const bf16_t* A; const bf16_t* Bt; int M, N, K; };

struct StaticOrder {
    int nM, nN, nwg, G, c;
    __host__ __device__ void init(int M, int N, int G_, int c_) { nM = M / BM; nN = N / BM; nwg = nM * nN; G = G_; c = c_; }
    __host__ __device__ bool next(int i, Unit& u) const {
        const long L = (long)i * G + c; if (L >= nwg) return false;
        int wgid = (int)L; { const int q = nwg / NXCD, r = nwg % NXCD, xcd = wgid % NXCD, off = wgid / NXCD; wgid = (xcd < r ? xcd * (q + 1) : r * (q + 1) + (xcd - r) * q) + off; }
        const int nig = WGM * nN, gid = wgid / nig, fm = gid * WGM, gsz = (nM - fm) < WGM ? (nM - fm) : WGM;
        u.pm = fm + ((wgid % nig) % gsz); u.pn = (wgid % nig) / gsz; return true;
    }
    __device__ __forceinline__ void a_ready(const Unit&) const {}
    __device__ __forceinline__ void done(const Unit&) const {}
};

__device__ __forceinline__ unsigned cvt_pk_bf16(float lo, float hi) { unsigned r; asm volatile("v_cvt_pk_bf16_f32 %0, %1, %2" : "=v"(r) : "v"(lo), "v"(hi)); return r; }
typedef float f32x2 __attribute__((ext_vector_type(2)));
typedef __bf16 bf16x2_t __attribute__((ext_vector_type(2)));
__device__ __forceinline__ unsigned pk_bf16(float lo, float hi) { f32x2 v = {lo, hi}; bf16x2_t b = __builtin_convertvector(v, bf16x2_t); return __builtin_bit_cast(unsigned, b); }
__device__ __forceinline__ u32x4 pk8(f32x4 a, f32x4 b) { u32x4 w; w.x = pk_bf16(a[0], a[1]); w.y = pk_bf16(a[2], a[3]); w.z = pk_bf16(b[0], b[1]); w.w = pk_bf16(b[2], b[3]); return w; }

template <bool CAP> struct EpiStore {
    static constexpr bool PERM = true, AFTER_DRAIN = false;
    bf16_t* O; int ldc; float scale; float* outb;
    __device__ __forceinline__ void operator()(const f32x4 (&acc)[2][2][4][2], const Unit& u, int wr, int wc, int fr, int fq) const {
        const int row0 = u.pm * BM + wr * 64 + fr, col0 = u.pn * BM + wc * 32 + 8 * fq;
#pragma unroll
        for (int ai = 0; ai < 2; ++ai)
#pragma unroll
            for (int m = 0; m < 4; ++m) {
                const int row = row0 + ai * HALF + m * 16;
                float* cap = nullptr;
                if constexpr (CAP) {
                    if (row < 16384) { const int t = row & 8191; if (t >= 8190) cap = outb + 34668544 + (size_t)((row >> 13) * 2 + (t - 8190)) * 5632; }
                    else { const int r2 = row - 16384, t = r2 & 7; if (t >= 6) cap = outb + 40982528 + (size_t)((r2 >> 3) * 2 + (t - 6)) * 5632; }
                }
#pragma unroll
                for (int bj = 0; bj < 2; ++bj) {
                    const int col = col0 + bj * HALF;
                    const f32x4 v0 = acc[ai][bj][m][0] * scale, v1 = acc[ai][bj][m][1] * scale;
                    *(u32x4*)(O + (size_t)row * ldc + col) = pk8(v0, v1);
                    if constexpr (CAP) { if (cap) { *(f32x4*)(cap + col) = v0; *(f32x4*)(cap + col + 4) = v1; } }
                }
            }
    }
};

struct EpiInProj {
    static constexpr bool PERM = true, AFTER_DRAIN = false;
    bf16_t *QH, *VH, *GH, *SQ, *SK, *SV; float* LF; const float* LB; float* kp; float* vp; float* ks; float* vs; float sqscale;
    __device__ __forceinline__ void operator()(const f32x4 (&acc)[2][2][4][2], const Unit& u, int wr, int wc, int fr, int fq) const {
        const int seg = u.pn >> 1;
        const int row0 = u.pm * BM + wr * 64 + fr, col0 = (u.pn & 1) * BM + wc * 32 + 8 * fq;
        if (seg == 1) {
#pragma unroll
            for (int bj = 0; bj < 2; ++bj) {
                const int col = col0 + bj * HALF;
                const f32x4 l0 = *(const f32x4*)(LB + col), l1 = *(const f32x4*)(LB + col + 4);
#pragma unroll
                for (int ai = 0; ai < 2; ++ai)
#pragma unroll
                    for (int m = 0; m < 4; ++m) {
                        const int row = row0 + ai * HALF + m * 16;
                        f32x4 o0, o1;
#pragma unroll
                        for (int e = 0; e < 4; ++e) {
                            const float s0 = 1.f / (1.f + __expf(-acc[ai][bj][m][0][e])), s1 = 1.f / (1.f + __expf(-acc[ai][bj][m][1][e]));
                            o0[e] = __logf(l0[e] + (1.f - l0[e]) * s0); o1[e] = __logf(l1[e] + (1.f - l1[e]) * s1);
                        }
                        *(f32x4*)(LF + (size_t)row * 512 + col) = o0; *(f32x4*)(LF + (size_t)row * 512 + col + 4) = o1;
                    }
            }
            return;
        }
        bf16_t* dst = seg == 0 ? QH : seg == 2 ? VH : seg == 3 ? GH : seg == 4 ? SQ : seg == 5 ? SK : SV;
        const float sc = seg == 4 ? sqscale : 1.f;
        float* fp = seg == 5 ? kp : seg == 6 ? vp : nullptr;
        float* fs = seg == 5 ? ks : vs;
#pragma unroll
        for (int ai = 0; ai < 2; ++ai)
#pragma unroll
            for (int m = 0; m < 4; ++m) {
                const int row = row0 + ai * HALF + m * 16;
#pragma unroll
                for (int bj = 0; bj < 2; ++bj) {
                    const int col = col0 + bj * HALF;
                    const f32x4 v0 = acc[ai][bj][m][0], v1 = acc[ai][bj][m][1];
                    *(u32x4*)(dst + (size_t)row * 512 + col) = pk8(v0 * sc, v1 * sc);
                    if (fp) { float* f = row < 16384 ? fp + (size_t)row * 512 + col : fs + (size_t)(row - 16384) * 512 + col; *(f32x4*)f = v0; *(f32x4*)(f + 4) = v1; }
                }
            }
    }
};

struct EpiMemKV {
    static constexpr bool PERM = true, AFTER_DRAIN = false;
    bf16_t *MK, *MV; float *ok, *ov;
    __device__ __forceinline__ void operator()(const f32x4 (&acc)[2][2][4][2], const Unit& u, int wr, int wc, int fr, int fq) const {
        const int seg = u.pn >> 2;
        const int row0 = u.pm * BM + wr * 64 + fr, col0 = (u.pn & 3) * BM + wc * 32 + 8 * fq;
        bf16_t* dst = seg == 0 ? MK : MV; float* fo = seg == 0 ? ok : ov;
#pragma unroll
        for (int ai = 0; ai < 2; ++ai)
#pragma unroll
            for (int m = 0; m < 4; ++m) {
                const int row = row0 + ai * HALF + m * 16;
#pragma unroll
                for (int bj = 0; bj < 2; ++bj) {
                    const int col = col0 + bj * HALF;
                    const f32x4 v0 = acc[ai][bj][m][0], v1 = acc[ai][bj][m][1];
                    *(u32x4*)(dst + (size_t)row * 1024 + col) = pk8(v0, v1);
                    *(f32x4*)(fo + (size_t)row * 1024 + col) = v0; *(f32x4*)(fo + (size_t)row * 1024 + col + 4) = v1;
                }
            }
    }
};

template <class Epi, class Sched, bool ALIGN_EPI = false, bool SP2 = false>
__device__ __forceinline__ void gemm_phase(PG8_LAS unsigned char* lds, const Gemm g, const Sched& S, const Epi& E) {
    const int tid = threadIdx.x, wid = __builtin_amdgcn_readfirstlane(tid >> 6), lane = tid & 63, wr = wid >> 2, wc = wid & 3, fr = lane & 15, fq = lane >> 4;
    const int K = g.K, nt = K / BK;
    unsigned voffA[2], voffB[2];
#pragma unroll
    for (int i = 0; i < 2; ++i) { int R, C; stage_rc(tid * 16 + i * 8192, R, C); const int Rb = Epi::PERM ? ((R & ~31) + perm32(R & 31)) : R;
        voffA[i] = (unsigned)(R * K + C) * 2u; voffB[i] = (unsigned)(Rb * K + C) * 2u; }
    const size_t kstep = (size_t)(BK * 2);
    const size_t hstep = (size_t)HALF * K * 2;
    const size_t tstep = 2 * hstep;
    const unsigned ldsw = (unsigned)wid * 1024u;
    const int aoff = lds_byte(wr * 64 + fr, fq * 8), boff = lds_byte(wc * 32 + fr, fq * 8);
#define PG8_SA(b, h) (((b) * 2 + (h)) * HTB)
#define PG8_SB(b, h) ((4 + (b) * 2 + (h)) * HTB)
#define PG8_STAGE(bufoff, gbase, voff) do { _Pragma("unroll") for (int _i = 0; _i < 2; ++_i) \
        __builtin_amdgcn_global_load_lds((const unsigned*)((const char*)(gbase) + (voff)[_i]), (PG8_LAS unsigned*)(lds + (bufoff) + ldsw + _i * 8192), 16, 0, 0); } while (0)
#define PG8_LDA(dst, b, h) do { _Pragma("unroll") for (int m = 0; m < 4; ++m) _Pragma("unroll") for (int k = 0; k < 2; ++k) dst[m][k] = *(const PG8_LAS bf16x8*)(lds + PG8_SA(b, h) + aoff + m * 2048 + k * 1024); } while (0)
#define PG8_LDB(dst, b, h) do { _Pragma("unroll") for (int n = 0; n < 2; ++n) _Pragma("unroll") for (int k = 0; k < 2; ++k) dst[n][k] = *(const PG8_LAS bf16x8*)(lds + PG8_SB(b, h) + boff + n * 2048 + k * 1024); } while (0)
#define PG8_MMA(ai, bj, At, Bt) do { __builtin_amdgcn_s_setprio(1); _Pragma("unroll") for (int m = 0; m < 4; ++m) _Pragma("unroll") for (int n = 0; n < 2; ++n) _Pragma("unroll") for (int k = 0; k < 2; ++k) \
        acc[ai][bj][m][n] = __builtin_amdgcn_mfma_f32_16x16x32_bf16(Bt[n][k], At[m][k], acc[ai][bj][m][n], 0, 0, 0); __builtin_amdgcn_s_setprio(0); } while (0)
#define PG8_WAIT_V(n) asm volatile("s_waitcnt vmcnt(" #n ")" ::: "memory")
#define PG8_WAIT_L(n) asm volatile("s_waitcnt lgkmcnt(" #n ")" ::: "memory")
#define PG8_BAR __builtin_amdgcn_s_barrier()
#define PG8_SCHED __builtin_amdgcn_sched_barrier(0)
    Unit cur, nxt; int ui = 0;
    if (!S.next(0, cur)) return;
    f32x4 acc[2][2][4][2];
#pragma unroll
    for (int a = 0; a < 2; ++a)
#pragma unroll
        for (int b = 0; b < 2; ++b)
#pragma unroll
            for (int m = 0; m < 4; ++m)
#pragma unroll
                for (int n = 0; n < 2; ++n) acc[a][b][m][n] = (f32x4){0.f, 0.f, 0.f, 0.f};
    bf16x8 At[4][2], B0[2][2], B1[2][2];
    const char* cA = (const char*)g.A + (size_t)cur.pm * tstep; const char* cB = (const char*)g.Bt + (size_t)cur.pn * tstep;
    S.a_ready(cur);
    if constexpr (SP2) {
        PG8_STAGE(PG8_SB(0, 0), cB, voffB); PG8_STAGE(PG8_SB(0, 1), cB + hstep, voffB); PG8_STAGE(PG8_SA(0, 0), cA, voffA); PG8_STAGE(PG8_SA(0, 1), cA + hstep, voffA);
        if (wr == 1) PG8_BAR;
        PG8_WAIT_V(2); PG8_BAR;
        PG8_STAGE(PG8_SB(1, 0), cB + kstep, voffB); PG8_STAGE(PG8_SA(1, 0), cA + kstep, voffA); PG8_STAGE(PG8_SB(1, 1), cB + hstep + kstep, voffB);
        PG8_WAIT_V(6); PG8_BAR;
    } else {
        PG8_STAGE(PG8_SB(0, 0), cB, voffB); PG8_STAGE(PG8_SA(0, 0), cA, voffA); PG8_STAGE(PG8_SB(0, 1), cB + hstep, voffB); PG8_STAGE(PG8_SA(0, 1), cA + hstep, voffA);
        if (wr == 1) PG8_BAR;
        PG8_WAIT_V(4); PG8_BAR;
        PG8_STAGE(PG8_SB(1, 0), cB + kstep, voffB); PG8_STAGE(PG8_SA(1, 0), cA + kstep, voffA); PG8_STAGE(PG8_SB(1, 1), cB + hstep + kstep, voffB);
        PG8_WAIT_V(6); PG8_BAR;
    }
    for (;;) {
        const bool has_next = S.next(ui + 1, nxt);
        const char* nA = has_next ? (const char*)g.A + (size_t)nxt.pm * tstep : cA; const char* nB = has_next ? (const char*)g.Bt + (size_t)nxt.pn * tstep : cB;
        for (int t = 0; t < nt; t += 2) {
            const bool last = (t == nt - 2);
            const char* a1 = cA + (size_t)(t + 1) * kstep;
            const char* a2 = last ? nA : cA + (size_t)(t + 2) * kstep; const char* b2 = last ? nB : cB + (size_t)(t + 2) * kstep;
            const char* a3 = a2 + kstep; const char* b3 = b2 + kstep;
            if (last && has_next) S.a_ready(nxt);
            if constexpr (SP2) {
            PG8_LDB(B0, 0, 0); PG8_LDB(B1, 0, 1); PG8_SCHED; PG8_LDA(At, 0, 0); PG8_STAGE(PG8_SA(1, 1), a1 + hstep, voffA);
            PG8_WAIT_V(8); PG8_WAIT_L(0); PG8_BAR; PG8_MMA(0, 0, At, B0); PG8_MMA(0, 1, At, B1); PG8_BAR; PG8_SCHED;
            PG8_LDA(At, 0, 1); PG8_STAGE(PG8_SB(0, 0), b2, voffB); PG8_STAGE(PG8_SB(0, 1), b2 + hstep, voffB); PG8_STAGE(PG8_SA(0, 0), a2, voffA);
            PG8_WAIT_V(8); PG8_WAIT_L(0); PG8_BAR; PG8_MMA(1, 0, At, B0); PG8_MMA(1, 1, At, B1); PG8_BAR; PG8_SCHED;
            PG8_LDB(B0, 1, 0); PG8_LDB(B1, 1, 1); PG8_SCHED; PG8_LDA(At, 1, 0); PG8_STAGE(PG8_SA(0, 1), a2 + hstep, voffA);
            PG8_WAIT_V(8); PG8_WAIT_L(0); PG8_BAR; PG8_MMA(0, 0, At, B0); PG8_MMA(0, 1, At, B1); PG8_BAR; PG8_SCHED;
            PG8_LDA(At, 1, 1); PG8_STAGE(PG8_SB(1, 0), b3, voffB); PG8_STAGE(PG8_SB(1, 1), b3 + hstep, voffB); PG8_STAGE(PG8_SA(1, 0), a3, voffA);
            PG8_WAIT_V(8); PG8_WAIT_L(0); PG8_BAR; PG8_MMA(1, 0, At, B0); PG8_MMA(1, 1, At, B1); PG8_BAR; PG8_SCHED;
            } else {
            PG8_LDB(B0, 0, 0); PG8_SCHED; PG8_LDA(At, 0, 0); PG8_STAGE(PG8_SA(1, 1), a1 + hstep, voffA);
            PG8_WAIT_L(8); PG8_BAR; PG8_WAIT_L(0); PG8_MMA(0, 0, At, B0); PG8_BAR; PG8_SCHED;
            PG8_LDB(B1, 0, 1); PG8_STAGE(PG8_SB(0, 0), b2, voffB);
            PG8_BAR; PG8_WAIT_L(0); PG8_MMA(0, 1, At, B1); PG8_BAR;
            PG8_LDA(At, 0, 1); PG8_STAGE(PG8_SA(0, 0), a2, voffA);
            PG8_BAR; PG8_WAIT_L(0); PG8_MMA(1, 0, At, B0); PG8_BAR; PG8_SCHED;
            PG8_STAGE(PG8_SB(0, 1), b2 + hstep, voffB);
            PG8_WAIT_V(6); PG8_BAR; PG8_MMA(1, 1, At, B1); PG8_BAR;
            PG8_LDB(B0, 1, 0); PG8_SCHED; PG8_LDA(At, 1, 0); PG8_STAGE(PG8_SA(0, 1), a2 + hstep, voffA);
            PG8_WAIT_L(8); PG8_BAR; PG8_WAIT_L(0); PG8_MMA(0, 0, At, B0); PG8_BAR; PG8_SCHED;
            PG8_LDB(B1, 1, 1); PG8_STAGE(PG8_SB(1, 0), b3, voffB);
            PG8_BAR; PG8_WAIT_L(0); PG8_MMA(0, 1, At, B1); PG8_BAR;
            PG8_LDA(At, 1, 1); PG8_STAGE(PG8_SA(1, 0), a3, voffA);
            PG8_BAR; PG8_WAIT_L(0); PG8_MMA(1, 0, At, B0); PG8_BAR; PG8_SCHED;
            PG8_STAGE(PG8_SB(1, 1), b3 + hstep, voffB);
            PG8_WAIT_V(6); PG8_BAR; PG8_MMA(1, 1, At, B1); PG8_BAR;
            }
        }
        if constexpr (ALIGN_EPI) { if (wr == 0) PG8_BAR; }
        if constexpr (!Epi::AFTER_DRAIN) { E(acc, cur, wr, wc, fr, fq); S.done(cur); }
        if (!has_next) break;
#pragma unroll
        for (int a = 0; a < 2; ++a)
#pragma unroll
            for (int b = 0; b < 2; ++b)
#pragma unroll
                for (int m = 0; m < 4; ++m)
#pragma unroll
                    for (int n = 0; n < 2; ++n) acc[a][b][m][n] = (f32x4){0.f, 0.f, 0.f, 0.f};
        cur = nxt; cA = nA; cB = nB; ++ui;
        if constexpr (ALIGN_EPI) { if (wr == 1) PG8_BAR; }
    }
    PG8_WAIT_V(0);
    if constexpr (!ALIGN_EPI) { if (wr == 0) PG8_BAR; }
    PG8_BAR;
    if constexpr (Epi::AFTER_DRAIN) { E.fused(acc, cur, wr, wc, fr, fq, lds, wid, lane); S.done(cur); }
#undef PG8_SA
#undef PG8_SB
#undef PG8_STAGE
#undef PG8_LDA
#undef PG8_LDB
#undef PG8_MMA
#undef PG8_WAIT_V
#undef PG8_WAIT_L
#undef PG8_BAR
#undef PG8_SCHED
}
}
#define GAS __attribute__((address_space(1)))
#define LAS __attribute__((address_space(3)))
#define LDS_WAIT() asm volatile("s_waitcnt lgkmcnt(0)" ::: "memory")
#define VM_WAIT() asm volatile("s_waitcnt vmcnt(0)" ::: "memory")
#define XB_TMO      128
#define XB_XCNT(j)  (256  + 64 * (j))
#define XB_XSUB(j)  (1280 + 64 * (j))
#define XB_XGEN(j)  (2304 + 64 * (j))
#define XB_TOP      3328
#define XB_TOPGEN   3392
#define XCD_BAR_WORDS 3456
#define XB_SPIN_CAP (1u << 23)

__device__ __forceinline__ unsigned xb_ld(unsigned* p)              { return __hip_atomic_load(p, __ATOMIC_RELAXED, __HIP_MEMORY_SCOPE_AGENT); }
__device__ __forceinline__ unsigned xb_add(unsigned* p, unsigned v) { return __hip_atomic_fetch_add(p, v, __ATOMIC_RELAXED, __HIP_MEMORY_SCOPE_AGENT); }
__device__ __forceinline__ unsigned xb_xcc_id() { return (unsigned)__builtin_amdgcn_s_getreg((3 << 11) | 20) & 0xFu; }
#define XB_SPIN(cond, bar) do { unsigned _sp = 0; while (cond) { __builtin_amdgcn_s_sleep(1); \
    if ((++_sp & 255u) == 0u) { if (xb_ld(&(bar)[XB_TMO])) break; if (_sp > XB_SPIN_CAP) { atomicAdd(&(bar)[XB_TMO], 1u); break; } } } } while (0)

struct XcdBarrier {
    unsigned* bar; unsigned x;
    volatile LAS unsigned* st;
};

__device__ __forceinline__ XcdBarrier xcd_barrier_post(unsigned* bar, volatile LAS unsigned* st) {
    XcdBarrier b; b.bar = bar; b.x = xb_xcc_id(); b.st = st;
    if (threadIdx.x == 0) (void)xb_add(&bar[XB_XCNT(b.x)], 1u);
    return b;
}
__device__ __forceinline__ void xcd_barrier_complete(unsigned* bar, unsigned x, unsigned& nloc, unsigned& nx) {
    const unsigned G = gridDim.x * gridDim.y * gridDim.z;
    unsigned sum, cnt, mine, sp = 0u;
    for (;;) {
        sum = 0u; cnt = 0u; mine = 0u;
#pragma unroll
        for (unsigned j = 0; j < 16; ++j) { const unsigned c = xb_ld(&bar[XB_XCNT(j)]); sum += c; cnt += (c > 0u) ? 1u : 0u; mine = (j == x) ? c : mine; }
        if (sum == G) break;
        __builtin_amdgcn_s_sleep(1);
        if ((++sp & 255u) == 0u) { if (xb_ld(&bar[XB_TMO])) break; if (sp > XB_SPIN_CAP) { atomicAdd(&bar[XB_TMO], 1u); break; } }
    }
    nloc = mine > 0u ? mine : 1u; nx = cnt > 0u ? cnt : 1u;
}

__device__ __forceinline__ void xcd_barrier(const XcdBarrier& b) {
    asm volatile("s_waitcnt vmcnt(0)" ::: "memory");
    __syncthreads();
    if (threadIdx.x == 0) {
        unsigned* bar = b.bar;
        __builtin_amdgcn_s_waitcnt(0);
        unsigned nloc = b.st[0], nx = b.st[1];
        if (nloc == 0u) { xcd_barrier_complete(bar, b.x, nloc, nx); b.st[0] = nloc; b.st[1] = nx; }
        const unsigned old = xb_add(&bar[XB_XSUB(b.x)], 1u);
        const unsigned gen = old / nloc;
        if (old + 1u == (gen + 1u) * nloc) {
            __builtin_amdgcn_fence(__ATOMIC_RELEASE, "agent");
            asm volatile("s_waitcnt vmcnt(0)" ::: "memory");
            const unsigned og = xb_add(&bar[XB_TOP], 1u);
            const unsigned tg = og / nx;
            if (og + 1u == (tg + 1u) * nx) xb_add(&bar[XB_TOPGEN], 1u);
            else XB_SPIN(xb_ld(&bar[XB_TOPGEN]) == tg, bar);
            __builtin_amdgcn_fence(__ATOMIC_ACQUIRE, "agent");
            xb_add(&bar[XB_XGEN(b.x)], 1u);
            asm volatile("s_waitcnt vmcnt(0)" ::: "memory");
        } else {
            XB_SPIN(xb_ld(&bar[XB_XGEN(b.x)]) == gen, bar);
            __builtin_amdgcn_fence(__ATOMIC_ACQUIRE, "agent");
            asm volatile("s_waitcnt vmcnt(0)" ::: "memory");
        }
    }
    __syncthreads();
}
constexpr int NWAVES = 8, NTHREADS = 512;
constexpr int DM = 1024, SEQ = 8192, NBATCH = 2, MP = NBATCH * SEQ, NDEC = 128, TDEC = 8, MS = NDEC * TDEC, MT = MP + MS;
constexpr int DIN = 3584, HW = 512, NH = 8, HD = 64;
constexpr int NMEM = 256, CAH = 4, CAD = 256, DFF = 2816, DFF2 = 5632;
constexpr int PAST = 2048, PAGE = 128, NPAGES = 16;
constexpr float RMS_EPS = 1e-6f, LOG2E = 1.4426950408889634f;
constexpr float SQ_SCALE = 0.125f * LOG2E;
constexpr float CQ_SCALE = 0.0625f * LOG2E;
enum { I_XP = 0, I_XS, I_CK, I_CV, I_SH, I_SC, I_MK, I_MV, I_PT, I_MEM, I_WIN, I_HGN, I_HLB, I_SBB, I_WO, I_GMIXPRE, I_GMIXPOST, I_GCAPRE, I_GCAPOST, I_GMEM,
       I_WCQ, I_WCK, I_WCV, I_WCO, I_GFFNPRE, I_GFFNPOST, I_WUP, I_CONVW, I_CONVB, I_WDN, N_IN };
constexpr size_t O_YP = 0, O_YS = 16777216, O_KP = 17825792, O_VP = 26214400, O_HP = 34603008, O_CP = 34668544, O_MKP = 34691072, O_MVP = 35215360,
                 O_KS = 35739648, O_VS = 36263936, O_HS = 36788224, O_CS = 40982528, O_END = 42424320;
constexpr size_t MiB = 1u << 20;
constexpr size_t WS_CTL = 0, CTL_ZERO_BYTES = 1 * MiB;
constexpr size_t WS_WIN = 2 * MiB, WS_WO = 9 * MiB, WS_WCQ = 11 * MiB, WS_WCO = 13 * MiB, WS_WCKV = 15 * MiB, WS_WUP = 19 * MiB, WS_WDN = 30 * MiB;
constexpr size_t WS_LB = 36 * MiB, WS_MN = 37 * MiB, WS_MK = 38 * MiB, WS_MV = 39 * MiB;
constexpr size_t WS_H = 40 * MiB, WS_QH = 74 * MiB, WS_LF = 91 * MiB, WS_VH = 125 * MiB, WS_GH = 142 * MiB, WS_SQ = 159 * MiB, WS_SK = 176 * MiB, WS_SV = 193 * MiB;
constexpr size_t WS_OMIX = 210 * MiB, WS_BR = 244 * MiB, WS_X1 = 278 * MiB, WS_X2 = 346 * MiB, WS_QCA = 414 * MiB, WS_U = 448 * MiB, WS_G = 635 * MiB, WS_UCT = 730 * MiB, WS_DC = 762 * MiB, WS_SCT = 763 * MiB, WS_SBP = 780 * MiB, WS_END = 786 * MiB;
constexpr int CW_BAR = 4096;
constexpr int RING_OFF = 0, RING_BYTES = 162816, LDSCTL_OFF = RING_BYTES, MISC_OFF = LDSCTL_OFF + 320, LDS_BYTES = 163840;

typedef unsigned short bf16;
typedef unsigned v4u __attribute__((ext_vector_type(4)));
typedef unsigned v2u __attribute__((ext_vector_type(2)));
typedef float f32x4 __attribute__((ext_vector_type(4)));
using pg8::pk_bf16;
__device__ __forceinline__ float bf2f(unsigned short b) { return __uint_as_float((unsigned)b << 16); }
__device__ __forceinline__ float bflo(unsigned w) { return __uint_as_float(w << 16); }
__device__ __forceinline__ float bfhi(unsigned w) { return __uint_as_float(w & 0xffff0000u); }
__device__ __forceinline__ unsigned short f2bf(float f) { return (unsigned short)(pk_bf16(f, 0.f) & 0xffffu); }
__device__ __forceinline__ float wave_sum(float v) {
#pragma unroll
    for (int o = 1; o < 64; o <<= 1) v += __shfl_xor(v, o);
    return v;
}
__device__ __forceinline__ float rdlane(float v, int l) { return __uint_as_float((unsigned)__builtin_amdgcn_readlane((int)__float_as_uint(v), l)); }

struct Args { const void* in[N_IN]; float* out; unsigned char* ws; int ph_lo, ph_hi; };
struct Ctx { const void* const* in; float* out; unsigned char* ws; LAS unsigned char* lds; int tid, lane, wave, gw, ngw; };

__device__ __forceinline__ void p0_transpose_item(const float* W, int K, int N, bf16* WT, int row_off, LAS float* scr, int item, int lane) {
    const int nblk = N / 32, kb = item / nblk, nb = item % nblk, k0 = 64 * kb, n0 = 32 * nb;
#pragma unroll 8
    for (int i = 0; i < 32; ++i) { const int kk = 2 * i + (lane >> 5); scr[kk * 33 + (lane & 31)] = W[(size_t)(k0 + kk) * N + n0 + (lane & 31)]; }
    LDS_WAIT(); asm volatile("" ::: "memory");
    const int c = lane & 7;
#pragma unroll
    for (int j = 0; j < 4; ++j) { const int n = (lane >> 3) + 8 * j; const LAS float* s = scr + (8 * c) * 33 + n;
        v4u o; o.x = pk_bf16(s[0 * 33], s[1 * 33]); o.y = pk_bf16(s[2 * 33], s[3 * 33]); o.z = pk_bf16(s[4 * 33], s[5 * 33]); o.w = pk_bf16(s[6 * 33], s[7 * 33]);
        *(v4u*)(WT + (size_t)(row_off + n0 + n) * K + k0 + 8 * c) = o; }
    LDS_WAIT(); asm volatile("" ::: "memory");
}
__device__ __forceinline__ void rms_row_to_bf16(const float* xrow, const float* g, bf16* orow, int lane) {
    const f32x4* xr = (const f32x4*)xrow + lane; const f32x4* gr = (const f32x4*)g + lane;
    f32x4 v[4]; float s = 0.f;
#pragma unroll
    for (int j = 0; j < 4; ++j) { v[j] = xr[64 * j]; s += (v[j].x * v[j].x + v[j].y * v[j].y) + (v[j].z * v[j].z + v[j].w * v[j].w); }
    const float r = rsqrtf(wave_sum(s) * (1.f / DM) + RMS_EPS);
    v2u* o8 = (v2u*)orow + lane;
#pragma unroll
    for (int j = 0; j < 4; ++j) { const f32x4 gg = gr[64 * j]; v2u w; w.x = pk_bf16(v[j].x * r * gg.x, v[j].y * r * gg.y); w.y = pk_bf16(v[j].z * r * gg.z, v[j].w * r * gg.w); o8[64 * j] = w; }
}
__device__ __forceinline__ void p0_prologue(const Ctx& C) {
    LAS float* scr = (LAS float*)(C.lds + RING_OFF + C.wave * 16384);
    const float* w_in = (const float*)C.in[I_WIN]; const float* w_o = (const float*)C.in[I_WO]; const float* w_cq = (const float*)C.in[I_WCQ]; const float* w_ck = (const float*)C.in[I_WCK];
    const float* w_cv = (const float*)C.in[I_WCV]; const float* w_co = (const float*)C.in[I_WCO]; const float* w_up = (const float*)C.in[I_WUP]; const float* w_dn = (const float*)C.in[I_WDN];
    bf16* Win = (bf16*)(C.ws + WS_WIN); bf16* Wo = (bf16*)(C.ws + WS_WO); bf16* Wcq = (bf16*)(C.ws + WS_WCQ); bf16* Wco = (bf16*)(C.ws + WS_WCO); bf16* Wckv = (bf16*)(C.ws + WS_WCKV);
    bf16* Wup = (bf16*)(C.ws + WS_WUP); bf16* Wdn = (bf16*)(C.ws + WS_WDN);
    constexpr int I_IN = (DM / 64) * (DIN / 32), I_SQ = (DM / 64) * (DM / 32), I_UP = (DM / 64) * (DFF2 / 32), I_DN = (DFF / 64) * (DM / 32);
    constexpr int NITEMS = I_IN + 5 * I_SQ + I_UP + I_DN;
    for (int it = C.gw; it < NITEMS; it += C.ngw) {
        int r = it;
        if (r < I_IN) { p0_transpose_item(w_in, DM, DIN, Win, 0, scr, r, C.lane); continue; } r -= I_IN;
        if (r < I_SQ) { p0_transpose_item(w_o, DM, DM, Wo, 0, scr, r, C.lane); continue; } r -= I_SQ;
        if (r < I_SQ) { p0_transpose_item(w_cq, DM, DM, Wcq, 0, scr, r, C.lane); continue; } r -= I_SQ;
        if (r < I_SQ) { p0_transpose_item(w_co, DM, DM, Wco, 0, scr, r, C.lane); continue; } r -= I_SQ;
        if (r < I_SQ) { p0_transpose_item(w_ck, DM, DM, Wckv, 0, scr, r, C.lane); continue; } r -= I_SQ;
        if (r < I_SQ) { p0_transpose_item(w_cv, DM, DM, Wckv, DM, scr, r, C.lane); continue; } r -= I_SQ;
        if (r < I_UP) { p0_transpose_item(w_up, DM, DFF2, Wup, 0, scr, r, C.lane); continue; } r -= I_UP;
        p0_transpose_item(w_dn, DFF, DM, Wdn, 0, scr, r, C.lane);
    }
    const float* xp = (const float*)C.in[I_XP]; const float* xs = (const float*)C.in[I_XS]; const float* mem = (const float*)C.in[I_MEM];
    bf16* H = (bf16*)(C.ws + WS_H); bf16* MN = (bf16*)(C.ws + WS_MN);
    const float* g_pre = (const float*)C.in[I_GMIXPRE]; const float* g_mem = (const float*)C.in[I_GMEM];
    for (int m = C.gw; m < MT + NBATCH * NMEM; m += C.ngw) {
        if (m < MP) rms_row_to_bf16(xp + (size_t)m * DM, g_pre, H + (size_t)m * DM, C.lane);
        else if (m < MT) rms_row_to_bf16(xs + (size_t)(m - MP) * DM, g_pre, H + (size_t)m * DM, C.lane);
        else rms_row_to_bf16(mem + (size_t)(m - MT) * DM, g_mem, MN + (size_t)(m - MT) * DM, C.lane);
    }
    if (C.gw == 0) {
        const float* lbp = (const float*)C.in[I_HLB]; float* LB = (float*)(C.ws + WS_LB);
        for (int k = C.lane; k < HW; k += 64) { const float a = lbp[k], b = lbp[HW + k]; LB[k] = 1.f / (1.f + __expf(b - a)); }
    }
}
typedef short bf16x8s __attribute__((ext_vector_type(8)));
typedef short s16x4 __attribute__((ext_vector_type(4)));
typedef short v4i16_t __attribute__((ext_vector_type(4)));
constexpr int HRS = 72;
__device__ __forceinline__ s16x4 tr4(const LAS bf16* p) { return __builtin_bit_cast(s16x4, __builtin_amdgcn_ds_read_tr16_b64_v4i16((LAS v4i16_t*)p)); }
__device__ __forceinline__ bf16x8s cat8(s16x4 lo, s16x4 hi) { return (bf16x8s){lo[0], lo[1], lo[2], lo[3], hi[0], hi[1], hi[2], hi[3]}; }
__device__ __forceinline__ f32x4 mfma16(bf16x8s a, bf16x8s b, f32x4 c) { return __builtin_amdgcn_mfma_f32_16x16x32_bf16(a, b, c, 0, 0, 0); }
__device__ __forceinline__ void hg_stage_v(const bf16* VH, int r0, int h, LAS bf16* Vt, int lane) {
#pragma unroll
    for (int it = 0; it < 8; ++it) { const int row = it * 8 + (lane >> 3), ch = lane & 7; const v4u w = *(const v4u*)(VH + (size_t)(r0 + row) * HW + h * HD + ch * 8); *(LAS v4u*)(Vt + row * HRS + ch * 8) = w; }
}
__device__ __forceinline__ void hgrn_h1(const Ctx& C, int cid) {
    const float* LF = (const float*)(C.ws + WS_LF); const bf16* VH = (const bf16*)(C.ws + WS_VH);
    float* UCT = (float*)(C.ws + WS_UCT); float* DC = (float*)(C.ws + WS_DC);
    const int lane = C.lane, i = lane & 15, g = lane >> 4;
    const int chain = cid >> 7, ci = cid & 127, b = chain >> 3, h = chain & 7, r0 = b * SEQ + ci * 64;
    LAS bf16* Vt = (LAS bf16*)(C.lds + RING_OFF + C.wave * 18432); LAS bf16* Kt = Vt + 64 * HRS;
    hg_stage_v(VH, r0, h, Vt, lane);
    const float* lfp = LF + (size_t)r0 * HW + h * HD + lane;
    float bl = 0.f;
#pragma unroll 16
    for (int t = 0; t < 64; ++t) bl += lfp[(size_t)t * HW];
    { float run = 0.f;
#pragma unroll 16
      for (int s = 0; s < 64; ++s) { const float lf = lfp[(size_t)s * HW]; run += lf; Kt[s * HRS + lane] = f2bf((1.f - __expf(lf)) * __expf(bl - run)); } }
    DC[(size_t)cid * 64 + lane] = __expf(bl);
    LDS_WAIT();
#pragma unroll
    for (int kb = 0; kb < 4; ++kb) {
        bf16x8s af[2];
#pragma unroll
        for (int ks = 0; ks < 2; ++ks) af[ks] = cat8(tr4(Kt + (32 * ks + 8 * g + (i >> 2)) * HRS + 16 * kb + (i & 3) * 4), tr4(Kt + (32 * ks + 8 * g + 4 + (i >> 2)) * HRS + 16 * kb + (i & 3) * 4));
#pragma unroll
        for (int db = 0; db < 4; ++db) {
            f32x4 acc = {0.f, 0.f, 0.f, 0.f};
#pragma unroll
            for (int ks = 0; ks < 2; ++ks) { const bf16x8s bfr = cat8(tr4(Vt + (32 * ks + 8 * g + (i >> 2)) * HRS + 16 * db + (i & 3) * 4), tr4(Vt + (32 * ks + 8 * g + 4 + (i >> 2)) * HRS + 16 * db + (i & 3) * 4));
                acc = mfma16(af[ks], bfr, acc); }
            *(f32x4*)(UCT + ((size_t)cid * 64 + 16 * db + i) * 64 + 16 * kb + 4 * g) = acc;
        }
    }
    LDS_WAIT();
}
__device__ __forceinline__ void hgrn_h2(const Ctx& C) {
    const float* UCT = (const float*)(C.ws + WS_UCT); const float* DC = (const float*)(C.ws + WS_DC); bf16* SCT = (bf16*)(C.ws + WS_SCT);
    const int lane = C.lane;
    for (int w = C.gw; w < NBATCH * NH * 64; w += C.ngw) {
        const int chain = w >> 6, d = w & 63; float S = 0.f;
        for (int c0 = 0; c0 < 128; c0 += 16) {
            float u[16], dc[16];
#pragma unroll
            for (int j = 0; j < 16; ++j) { const size_t cid = (size_t)chain * 128 + c0 + j; u[j] = UCT[(cid * 64 + d) * 64 + lane]; dc[j] = DC[cid * 64 + lane]; }
#pragma unroll
            for (int j = 0; j < 16; ++j) { const size_t cid = (size_t)chain * 128 + c0 + j; SCT[(cid * 64 + d) * 64 + lane] = f2bf(S); S = dc[j] * S + u[j]; }
        }
        C.out[O_HP + (size_t)chain * 4096 + lane * 64 + d] = S;
    }
}
__device__ __forceinline__ void hgrn_h3(const Ctx& C, int cid) {
    const float* LF = (const float*)(C.ws + WS_LF); const bf16* QH = (const bf16*)(C.ws + WS_QH); const bf16* VH = (const bf16*)(C.ws + WS_VH); const bf16* GH = (const bf16*)(C.ws + WS_GH);
    const bf16* SCT = (const bf16*)(C.ws + WS_SCT); bf16* OMIX = (bf16*)(C.ws + WS_OMIX); const float* hgn = (const float*)C.in[I_HGN];
    const int lane = C.lane, i = lane & 15, g = lane >> 4;
    const int chain = cid >> 7, ci = cid & 127, b = chain >> 3, h = chain & 7, r0 = b * SEQ + ci * 64;
    LAS bf16* Vt = (LAS bf16*)(C.lds + RING_OFF + C.wave * 18432); LAS bf16* Kb = Vt + 64 * HRS; LAS bf16* Qh = Kb + 16 * HRS; LAS bf16* Qt = Qh + 16 * HRS;
    hg_stage_v(VH, r0, h, Vt, lane);
    const float* lfp = LF + (size_t)r0 * HW + h * HD + lane; const bf16* qp = QH + (size_t)r0 * HW + h * HD + lane;
    float eb[4];
    bf16x8s sfr[4][2];
#pragma unroll
    for (int db = 0; db < 4; ++db)
#pragma unroll
        for (int ks = 0; ks < 2; ++ks) sfr[db][ks] = *(const bf16x8s*)(SCT + ((size_t)cid * 64 + 16 * db + i) * 64 + 32 * ks + 8 * g);
#pragma unroll
    for (int is = 0; is < 4; ++is) {
        const float ri = is ? eb[is - 1] : 0.f, er = __expf(ri);
        { float run = 0.f;
#pragma unroll
          for (int tt = 0; tt < 16; ++tt) { const int t = 16 * is + tt; run += lfp[(size_t)t * HW]; const float qt = bf2f(qp[(size_t)t * HW]) * __expf(run);
              Qt[tt * HRS + lane] = f2bf(qt); Qh[tt * HRS + lane] = f2bf(qt * er); }
          eb[is] = ri + run; }
        LDS_WAIT();
        bf16x8s qhf[2], qtf[2];
#pragma unroll
        for (int ks = 0; ks < 2; ++ks) { qhf[ks] = *(const LAS bf16x8s*)(Qh + i * HRS + 32 * ks + 8 * g); qtf[ks] = *(const LAS bf16x8s*)(Qt + i * HRS + 32 * ks + 8 * g); }
        f32x4 o[4];
#pragma unroll
        for (int db = 0; db < 4; ++db) { o[db] = (f32x4){0.f, 0.f, 0.f, 0.f};
#pragma unroll
            for (int ks = 0; ks < 2; ++ks) o[db] = mfma16(sfr[db][ks], qhf[ks], o[db]); }
#pragma unroll
        for (int jp = 0; jp <= is / 2; ++jp) {
            f32x4 x[2];
#pragma unroll
            for (int jj = 0; jj < 2; ++jj) {
                const int j = 2 * jp + jj; x[jj] = (f32x4){0.f, 0.f, 0.f, 0.f};
                if (j <= is) {
                    { float run = (j ? eb[j - 1] : 0.f) - ri;
#pragma unroll
                      for (int ss = 0; ss < 16; ++ss) { const int s = 16 * j + ss; const float lf = lfp[(size_t)s * HW]; run += lf; Kb[ss * HRS + lane] = f2bf((1.f - __expf(lf)) * __expf(-run)); } }
                    LDS_WAIT();
#pragma unroll
                    for (int ks = 0; ks < 2; ++ks) { const bf16x8s kf = *(const LAS bf16x8s*)(Kb + i * HRS + 32 * ks + 8 * g); x[jj] = mfma16(kf, qtf[ks], x[jj]); }
                    if (j == is) {
#pragma unroll
                        for (int e = 0; e < 4; ++e) if (4 * g + e > i) x[jj][e] = 0.f;
                    }
                    LDS_WAIT();
                }
            }
            bf16x8s pb; { const unsigned w0 = pk_bf16(x[0][0], x[0][1]), w1 = pk_bf16(x[0][2], x[0][3]), w2 = pk_bf16(x[1][0], x[1][1]), w3 = pk_bf16(x[1][2], x[1][3]); const v4u ww = {w0, w1, w2, w3}; pb = __builtin_bit_cast(bf16x8s, ww); }
            const int j0 = 2 * jp, j1 = (2 * jp + 1 <= is) ? 2 * jp + 1 : 2 * jp;
#pragma unroll
            for (int db = 0; db < 4; ++db) { const bf16x8s vf = cat8(tr4(Vt + (16 * j0 + 4 * g + (i >> 2)) * HRS + 16 * db + (i & 3) * 4), tr4(Vt + (16 * j1 + 4 * g + (i >> 2)) * HRS + 16 * db + (i & 3) * 4));
                o[db] = mfma16(vf, pb, o[db]); }
        }
        float ss = 0.f;
#pragma unroll
        for (int db = 0; db < 4; ++db) ss += (o[db][0] * o[db][0] + o[db][1] * o[db][1]) + (o[db][2] * o[db][2] + o[db][3] * o[db][3]);
        ss += __shfl_xor(ss, 16); ss += __shfl_xor(ss, 32);
        const float r = rsqrtf(ss * (1.f / HD) + RMS_EPS); const size_t row = (size_t)(r0 + 16 * is + i);
#pragma unroll
        for (int db = 0; db < 4; ++db) { const int d0 = h * HD + 16 * db + 4 * g; const v2u gw = *(const v2u*)(GH + row * HW + d0); const f32x4 gn = *(const f32x4*)(hgn + d0);
            const float g0 = bflo(gw.x), g1 = bfhi(gw.x), g2 = bflo(gw.y), g3 = bfhi(gw.y);
            v2u w; w.x = pk_bf16(o[db][0] * r * gn.x * (g0 / (1.f + __expf(-g0))), o[db][1] * r * gn.y * (g1 / (1.f + __expf(-g1))));
            w.y = pk_bf16(o[db][2] * r * gn.z * (g2 / (1.f + __expf(-g2))), o[db][3] * r * gn.w * (g3 / (1.f + __expf(-g3))));
            *(v2u*)(OMIX + row * DM + d0) = w; }
    }
    LDS_WAIT();
}
typedef float f32x16 __attribute__((ext_vector_type(16)));
constexpr int SB_RS = 72;
constexpr int SB_TILE = 64 * SB_RS;
__device__ __forceinline__ f32x16 mfma32(bf16x8s a, bf16x8s b, f32x16 c) { return __builtin_amdgcn_mfma_f32_32x32x16_bf16(a, b, c, 0, 0, 0); }
__device__ __forceinline__ int sb_crow(int r, int hi) { return (r & 3) + 8 * (r >> 2) + 4 * hi; }
__device__ __forceinline__ void sb_subtile(const LAS bf16* Kp, const LAS bf16* Vp, const bf16x8s (&qf)[4], float bias2, bool diag, int key0, int qpos, int hi, float& Cc, f32x16& o0, f32x16& o1) {
    f32x16 p;
#pragma unroll
    for (int r = 0; r < 16; ++r) p[r] = bias2;
#pragma unroll
    for (int ks = 0; ks < 4; ++ks) { const bf16x8s kf = *(const LAS bf16x8s*)(Kp + 16 * ks); p = mfma32(kf, qf[ks], p); }
    float E = 1.f;
#pragma unroll
    for (int r = 0; r < 16; ++r) { float u = __builtin_amdgcn_exp2f(p[r]); if (diag) u = (key0 + r < qpos) ? u : 0.f; const float tt = E * u; E += tt; p[r] = tt; }
    const float Ti = __builtin_amdgcn_rcpf(E), Tp = __shfl_xor(Ti, 32);
    const float G = Ti * (hi ? Cc : Cc * Tp);
    Cc = Cc * Ti * Tp;
#pragma unroll
    for (int r = 0; r < 16; ++r) p[r] *= G;
    bf16x8s pa[2];
#pragma unroll
    for (int s = 0; s < 2; ++s) { const v4u ww = {pk_bf16(p[8 * s], p[8 * s + 1]), pk_bf16(p[8 * s + 2], p[8 * s + 3]), pk_bf16(p[8 * s + 4], p[8 * s + 5]), pk_bf16(p[8 * s + 6], p[8 * s + 7])}; pa[s] = __builtin_bit_cast(bf16x8s, ww); }
#pragma unroll
    for (int s = 0; s < 2; ++s) {
        const LAS bf16* vb = Vp + 8 * s * SB_RS;
        const bf16x8s v0 = cat8(tr4(vb), tr4(vb + 4 * SB_RS)), v1 = cat8(tr4(vb + 32), tr4(vb + 4 * SB_RS + 32));
        o0 = mfma32(pa[s], v0, o0); o1 = mfma32(pa[s], v1, o1);
    }
}
__device__ __forceinline__ void sb_unit(const Ctx& C, int b, int h, int qb) {
    const bf16* SQ = (const bf16*)(C.ws + WS_SQ); const bf16* SK = (const bf16*)(C.ws + WS_SK); const bf16* SV = (const bf16*)(C.ws + WS_SV); bf16* OMIX = (bf16*)(C.ws + WS_OMIX);
    const int tid = C.tid, lane = C.lane, r32 = lane & 31, hi = lane >> 5, w = C.wave;
    const int q0 = qb * 256, qlo = q0 + 32 * w, qpos = qlo + r32;
    LAS bf16* Kl = (LAS bf16*)(C.lds + RING_OFF); LAS bf16* Vl = Kl + 2 * SB_TILE;
    const float bias2 = ((const float*)C.in[I_SBB])[h] * LOG2E;
    bf16x8s qf[4];
#pragma unroll
    for (int ks = 0; ks < 4; ++ks) qf[ks] = *(const bf16x8s*)(SQ + (size_t)(b * SEQ + qpos) * HW + h * HD + 16 * ks + 8 * hi);
    const int srow = tid >> 3, sch = tid & 7;
    const bf16* gk = SK + (size_t)(b * SEQ + srow) * HW + h * HD + sch * 8; const bf16* gv = SV + (size_t)(b * SEQ + srow) * HW + h * HD + sch * 8;
    const int soff = srow * SB_RS + sch * 8;
    const int nt = (q0 + 256) / 64;
    v4u rk = *(const v4u*)(gk + (size_t)(nt - 1) * 64 * HW), rv = *(const v4u*)(gv + (size_t)(nt - 1) * 64 * HW);
    *(LAS v4u*)(Kl + soff) = rk; *(LAS v4u*)(Vl + soff) = rv;
    __syncthreads();
    f32x16 o0, o1;
#pragma unroll
    for (int r = 0; r < 16; ++r) { o0[r] = 0.f; o1[r] = 0.f; }
    float Cc = 1.f;
    const int kap = 16 * ((r32 >> 2) & 1) + (r32 & 3) + 4 * (r32 >> 3);
    const int koff = kap * SB_RS + 8 * hi;
    const int gi = lane >> 4, i16 = lane & 15;
    const int voff = (16 * hi + (i16 >> 2)) * SB_RS + 16 * (gi & 1) + (i16 & 3) * 4;
    int cur = 0;
    for (int t = nt - 1; t >= 0; --t) {
        if (t > 0) { rk = *(const v4u*)(gk + (size_t)(t - 1) * 64 * HW); rv = *(const v4u*)(gv + (size_t)(t - 1) * 64 * HW); }
        const LAS bf16* Kc = Kl + cur * SB_TILE; const LAS bf16* Vc = Vl + cur * SB_TILE;
        if (64 * t <= qlo + 30) {
            const bool diag = 64 * t + 63 >= qlo;
#pragma unroll
            for (int sub = 1; sub >= 0; --sub) {
                if (diag && 64 * t + 32 * sub > qlo + 30) continue;
                sb_subtile(Kc + sub * 32 * SB_RS + koff, Vc + sub * 32 * SB_RS + voff, qf, bias2, diag, 64 * t + 32 * sub + 16 * hi, qpos, hi, Cc, o0, o1);
            }
        }
        if (t > 0) { *(LAS v4u*)(Kl + (cur ^ 1) * SB_TILE + soff) = rk; *(LAS v4u*)(Vl + (cur ^ 1) * SB_TILE + soff) = rv; }
        __syncthreads();
        cur ^= 1;
    }
    bf16* orow = OMIX + (size_t)(b * SEQ + qlo) * DM + HW + h * HD + r32;
#pragma unroll
    for (int r = 0; r < 16; ++r) { const int q = sb_crow(r, hi); orow[(size_t)q * DM] = f2bf(o0[r]); orow[(size_t)q * DM + 32] = f2bf(o1[r]); }
}
__device__ __forceinline__ void sb_prompt_phase(const Ctx& C) {
    const int G = gridDim.x, bid = blockIdx.x;
    const int vcu = (G % 8 == 0) ? (bid % 8) * (G / 8) + bid / 8 : bid;
    for (int p = vcu; p < NBATCH * NH * 16; p += G) {
        const int bh = p >> 4, s = p & 15;
        sb_unit(C, bh >> 3, bh & 7, 31 - s);
        sb_unit(C, bh >> 3, bh & 7, s);
    }
}

__device__ __forceinline__ void sbs_item(const Ctx& C, int n, int half) {
    const bf16* SQ = (const bf16*)(C.ws + WS_SQ); const bf16* SK = (const bf16*)(C.ws + WS_SK); const bf16* SV = (const bf16*)(C.ws + WS_SV);
    const float* ck = (const float*)C.in[I_CK]; const float* cv = (const float*)C.in[I_CV]; const int* pt = (const int*)C.in[I_PT];
    float* PO = (float*)(C.ws + WS_SBP); float* PC = PO + (size_t)NDEC * 2 * NH * TDEC * HD;
    const int lane = C.lane, r32 = lane & 31, hi = lane >> 5, h = C.wave;
    LAS bf16* Kt = (LAS bf16*)(C.lds + RING_OFF + C.wave * 9216); LAS bf16* Vt = Kt + 32 * SB_RS;
    const float bias2 = ((const float*)C.in[I_SBB])[h] * LOG2E;
    const int qpos = PAST + r32;
    bf16x8s qf[4];
#pragma unroll
    for (int ks = 0; ks < 4; ++ks) { qf[ks] = (bf16x8s){0, 0, 0, 0, 0, 0, 0, 0}; if (r32 < TDEC) qf[ks] = *(const bf16x8s*)(SQ + (size_t)(MP + n * TDEC + r32) * HW + h * HD + 16 * ks + 8 * hi); }
    f32x16 o0, o1;
#pragma unroll
    for (int r = 0; r < 16; ++r) { o0[r] = 0.f; o1[r] = 0.f; }
    float Cc = 1.f;
    const int kap = 16 * ((r32 >> 2) & 1) + (r32 & 3) + 4 * (r32 >> 3);
    const LAS bf16* Kp = Kt + kap * SB_RS + 8 * hi;
    const int gi = lane >> 4, i16 = lane & 15;
    const LAS bf16* Vp = Vt + (16 * hi + (i16 >> 2)) * SB_RS + 16 * (gi & 1) + (i16 & 3) * 4;
    const int srow = lane >> 4, sch = lane & 15;
    if (half == 1) {
#pragma unroll
        for (int it = 0; it < 8; ++it) { const int row = it * 4 + srow; v2u kw = {0u, 0u}, vw = {0u, 0u};
            if (row < TDEC) { kw = *(const v2u*)(SK + (size_t)(MP + n * TDEC + row) * HW + h * HD + sch * 4); vw = *(const v2u*)(SV + (size_t)(MP + n * TDEC + row) * HW + h * HD + sch * 4); }
            *(LAS v2u*)(Kt + row * SB_RS + sch * 4) = kw; *(LAS v2u*)(Vt + row * SB_RS + sch * 4) = vw; }
        LDS_WAIT();
        sb_subtile(Kp, Vp, qf, bias2, true, PAST + 16 * hi, qpos, hi, Cc, o0, o1);
        LDS_WAIT();
    }
    const int pg_hi = half ? NPAGES - 1 : NPAGES / 2 - 1, nsteps = (NPAGES / 2) * 4;
    f32x4 rk[8], rv[8];
    { const size_t base = (((size_t)pt[n * NPAGES + pg_hi] * PAGE + 96 + srow) * NH + h) * HD + sch * 4;
#pragma unroll
      for (int it = 0; it < 8; ++it) { rk[it] = *(const f32x4*)(ck + base + (size_t)it * 4 * NH * HD); rv[it] = *(const f32x4*)(cv + base + (size_t)it * 4 * NH * HD); } }
    for (int st = 0; st < nsteps; ++st) {
#pragma unroll
        for (int it = 0; it < 8; ++it) { const int row = it * 4 + srow;
            const v2u kw = {pk_bf16(rk[it].x, rk[it].y), pk_bf16(rk[it].z, rk[it].w)}, vw = {pk_bf16(rv[it].x, rv[it].y), pk_bf16(rv[it].z, rv[it].w)};
            *(LAS v2u*)(Kt + row * SB_RS + sch * 4) = kw; *(LAS v2u*)(Vt + row * SB_RS + sch * 4) = vw; }
        if (st + 1 < nsteps) { const int s2 = st + 1, pg = pg_hi - (s2 >> 2), sub = 3 - (s2 & 3);
            const size_t base = (((size_t)pt[n * NPAGES + pg] * PAGE + 32 * sub + srow) * NH + h) * HD + sch * 4;
#pragma unroll
            for (int it = 0; it < 8; ++it) { rk[it] = *(const f32x4*)(ck + base + (size_t)it * 4 * NH * HD); rv[it] = *(const f32x4*)(cv + base + (size_t)it * 4 * NH * HD); } }
        LDS_WAIT();
        sb_subtile(Kp, Vp, qf, bias2, false, 0, qpos, hi, Cc, o0, o1);
        LDS_WAIT();
    }
    float* po = PO + ((size_t)(n * 2 + half) * NH + h) * TDEC * HD;
#pragma unroll
    for (int r = 0; r < 4; ++r) { po[(r + 4 * hi) * HD + r32] = o0[r]; po[(r + 4 * hi) * HD + 32 + r32] = o1[r]; }
    if (lane < TDEC) PC[((size_t)(n * 2 + half) * NH + h) * TDEC + lane] = Cc;
}
__device__ __forceinline__ void sbs_phase(const Ctx& C) {
    for (int it = blockIdx.x; it < NDEC * 2; it += gridDim.x) sbs_item(C, it >> 1, it & 1);
}
__device__ __forceinline__ void sbs_combine(const Ctx& C) {
    const float* PO = (const float*)(C.ws + WS_SBP); const float* PC = PO + (size_t)NDEC * 2 * NH * TDEC * HD; bf16* OMIX = (bf16*)(C.ws + WS_OMIX);
    const int gt = C.gw * 64 + C.lane, ngt = C.ngw * 64;
    for (int e = gt; e < NDEC * NH * TDEC * HD; e += ngt) {
        const int d = e & 63, q = (e >> 6) & 7, h = (e >> 9) & 7, n = e >> 12;
        const size_t i1 = ((size_t)(n * 2 + 1) * NH + h) * TDEC + q, i0 = ((size_t)(n * 2) * NH + h) * TDEC + q;
        OMIX[(size_t)(MP + n * TDEC + q) * DM + HW + h * HD + d] = f2bf(PO[i1 * HD + d] + PC[i1] * PO[i0 * HD + d]);
    }
}
constexpr int CA_KRS = 264, CA_VRS = 288;
constexpr int CA_KT = 64 * CA_KRS, CA_VT = 64 * CA_VRS;
__device__ __forceinline__ void ca_unit(const Ctx& C, int b, int hh, int qblk) {
    const bf16* QCA = (const bf16*)(C.ws + WS_QCA); const bf16* MK = (const bf16*)(C.ws + WS_MK); const bf16* MV = (const bf16*)(C.ws + WS_MV); bf16* OCA = (bf16*)(C.ws + WS_OMIX);
    const int tid = C.tid, lane = C.lane, r32 = lane & 31, hi = lane >> 5, w = C.wave, gi = lane >> 4, i16 = lane & 15;
    LAS bf16* Kl = (LAS bf16*)(C.lds + RING_OFF); LAS bf16* Vl = Kl + 2 * CA_KT; LAS float* wsf = (LAS float*)(Vl + 2 * CA_VT) + w * 32;
    const size_t qrow = (size_t)b * SEQ + 256 * qblk + 32 * w;
    bf16x8s qf[16];
#pragma unroll
    for (int ks = 0; ks < 16; ++ks) qf[ks] = *(const bf16x8s*)(QCA + (qrow + r32) * DM + hh * CAD + 16 * ks + 8 * hi);
    const bf16* gk = MK + (size_t)(b * NMEM) * DM + hh * CAD; const bf16* gv = MV + (size_t)(b * NMEM) * DM + hh * CAD;
    v4u rg[4];
#define CA_LOAD(i) do { const bf16* src_ = ((i) < 4 ? gk : gv) + (size_t)(((i) & 3) * 64) * DM; _Pragma("unroll") for (int p_ = 0; p_ < 4; ++p_) { const int id_ = tid + 512 * p_; rg[p_] = *(const v4u*)(src_ + (size_t)(id_ >> 5) * DM + (id_ & 31) * 8); } } while (0)
#define CA_WRITE(i) do { _Pragma("unroll") for (int p_ = 0; p_ < 4; ++p_) { const int id_ = tid + 512 * p_; if ((i) < 4) *(LAS v4u*)(Kl + ((i) & 1) * CA_KT + (id_ >> 5) * CA_KRS + (id_ & 31) * 8) = rg[p_]; else *(LAS v4u*)(Vl + ((i) & 1) * CA_VT + (id_ >> 5) * CA_VRS + (id_ & 31) * 8) = rg[p_]; } } while (0)
    CA_LOAD(0); CA_WRITE(0); __syncthreads();
    f32x16 s[8];
#pragma unroll
    for (int j = 0; j < 8; ++j)
#pragma unroll
        for (int r = 0; r < 16; ++r) s[j][r] = 0.f;
#pragma unroll
    for (int kt = 0; kt < 4; ++kt) {
        if (kt < 3) CA_LOAD(kt + 1);
        const LAS bf16* Kc = Kl + (kt & 1) * CA_KT + r32 * CA_KRS + 8 * hi;
#pragma unroll
        for (int sub = 0; sub < 2; ++sub)
#pragma unroll
            for (int ks = 0; ks < 16; ++ks) { const bf16x8s kf = *(const LAS bf16x8s*)(Kc + sub * 32 * CA_KRS + 16 * ks); s[2 * kt + sub] = mfma32(kf, qf[ks], s[2 * kt + sub]); }
        if (kt < 3) { CA_WRITE(kt + 1); } __syncthreads();
    }
    float mx = s[0][0];
#pragma unroll
    for (int j = 0; j < 8; ++j)
#pragma unroll
        for (int r = 0; r < 16; ++r) mx = fmaxf(mx, s[j][r]);
    mx = fmaxf(mx, __shfl_xor(mx, 32));
    float l = 0.f;
#pragma unroll
    for (int j = 0; j < 8; ++j)
#pragma unroll
        for (int r = 0; r < 16; ++r) { s[j][r] = __builtin_amdgcn_exp2f(s[j][r] - mx); l += s[j][r]; }
    l += __shfl_xor(l, 32);
    if (hi == 0) wsf[r32] = l;
    bf16x8s pa[8][2];
#pragma unroll
    for (int j = 0; j < 8; ++j)
#pragma unroll
        for (int s2 = 0; s2 < 2; ++s2) { const v4u ww = {pk_bf16(s[j][8 * s2], s[j][8 * s2 + 1]), pk_bf16(s[j][8 * s2 + 2], s[j][8 * s2 + 3]), pk_bf16(s[j][8 * s2 + 4], s[j][8 * s2 + 5]), pk_bf16(s[j][8 * s2 + 6], s[j][8 * s2 + 7])}; pa[j][s2] = __builtin_bit_cast(bf16x8s, ww); }
    CA_LOAD(4); CA_WRITE(4); __syncthreads();
    f32x16 o[8];
#pragma unroll
    for (int j = 0; j < 8; ++j)
#pragma unroll
        for (int r = 0; r < 16; ++r) o[j][r] = 0.f;
#pragma unroll
    for (int kt = 0; kt < 4; ++kt) {
        if (kt >= 1 && kt < 3) CA_LOAD(kt + 5);
        const LAS bf16* Vc = Vl + (kt & 1) * CA_VT + (4 * hi + (i16 >> 2)) * CA_VRS + 16 * (gi & 1) + (i16 & 3) * 4;
#pragma unroll
        for (int sub = 0; sub < 2; ++sub)
#pragma unroll
            for (int s2 = 0; s2 < 2; ++s2)
#pragma unroll
                for (int dt = 0; dt < 8; ++dt) { const LAS bf16* vb = Vc + (32 * sub + 16 * s2) * CA_VRS + 32 * dt; const bf16x8s vf = cat8(tr4(vb), tr4(vb + 8 * CA_VRS)); o[dt] = mfma32(pa[2 * kt + sub][s2], vf, o[dt]); }
        if (kt == 0) CA_LOAD(5);
        if (kt < 3) { CA_WRITE(kt + 5); }
        __syncthreads();
    }
#undef CA_LOAD
#undef CA_WRITE
    float rl[16];
#pragma unroll
    for (int r = 0; r < 16; ++r) rl[r] = 1.f / wsf[sb_crow(r, hi)];
    bf16* orow = OCA + qrow * DM + hh * CAD + r32;
#pragma unroll
    for (int r = 0; r < 16; ++r) { const int q = sb_crow(r, hi);
#pragma unroll
        for (int dt = 0; dt < 8; ++dt) orow[(size_t)q * DM + 32 * dt] = f2bf(o[dt][r] * rl[r]); }
}
__device__ __forceinline__ void cas_item(const Ctx& C, int n, int hh) {
    const bf16* QCA = (const bf16*)(C.ws + WS_QCA); const float* cmk = (const float*)C.in[I_MK]; const float* cmv = (const float*)C.in[I_MV]; bf16* OCA = (bf16*)(C.ws + WS_OMIX);
    const int tid = C.tid, lane = C.lane, r32 = lane & 31, hi = lane >> 5, w = C.wave, gi = lane >> 4, i16 = lane & 15;
    LAS bf16* Vt = (LAS bf16*)(C.lds + RING_OFF) + w * (32 * CA_VRS);
    LAS float* part = (LAS float*)(C.lds + RING_OFF);
    LAS float* red = (LAS float*)(C.lds + RING_OFF + 8 * 32 * CA_VRS * 2);
    bf16x8s qf[16];
#pragma unroll
    for (int ks = 0; ks < 16; ++ks) { qf[ks] = (bf16x8s){0, 0, 0, 0, 0, 0, 0, 0}; if (r32 < TDEC) qf[ks] = *(const bf16x8s*)(QCA + (size_t)(MP + n * TDEC + r32) * DM + hh * CAD + 16 * ks + 8 * hi); }
    f32x16 s;
#pragma unroll
    for (int r = 0; r < 16; ++r) s[r] = 0.f;
    const float* kr = cmk + ((size_t)(n * NMEM + 32 * w + r32) * CAH + hh) * CAD + 8 * hi;
#pragma unroll
    for (int kb = 0; kb < 2; ++kb) {
        f32x4 ra[8], rb[8];
#pragma unroll
        for (int k8 = 0; k8 < 8; ++k8) { ra[k8] = *(const f32x4*)(kr + 16 * (8 * kb + k8)); rb[k8] = *(const f32x4*)(kr + 16 * (8 * kb + k8) + 4); }
#pragma unroll
        for (int k8 = 0; k8 < 8; ++k8) { const v4u ww = {pk_bf16(ra[k8].x, ra[k8].y), pk_bf16(ra[k8].z, ra[k8].w), pk_bf16(rb[k8].x, rb[k8].y), pk_bf16(rb[k8].z, rb[k8].w)};
            s = mfma32(__builtin_bit_cast(bf16x8s, ww), qf[8 * kb + k8], s); }
    }
    const float* vr = cmv + ((size_t)(n * NMEM + 32 * w) * CAH + hh) * CAD + lane * 4;
#pragma unroll
    for (int vb = 0; vb < 2; ++vb) {
        f32x4 rvv[16];
#pragma unroll
        for (int j = 0; j < 16; ++j) rvv[j] = *(const f32x4*)(vr + (size_t)(16 * vb + j) * CAH * CAD);
#pragma unroll
        for (int j = 0; j < 16; ++j) { const v2u ww = {pk_bf16(rvv[j].x, rvv[j].y), pk_bf16(rvv[j].z, rvv[j].w)}; *(LAS v2u*)(Vt + (16 * vb + j) * CA_VRS + lane * 4) = ww; }
    }
    float mx = s[0];
#pragma unroll
    for (int r = 1; r < 16; ++r) mx = fmaxf(mx, s[r]);
    mx = fmaxf(mx, __shfl_xor(mx, 32));
    if (lane < TDEC) red[w * TDEC + lane] = mx;
    LDS_WAIT(); __syncthreads();
    { float m2 = red[(r32 & 7)];
#pragma unroll
      for (int ww = 1; ww < 8; ++ww) m2 = fmaxf(m2, red[ww * TDEC + (r32 & 7)]);
      mx = m2; }
    float l = 0.f;
#pragma unroll
    for (int r = 0; r < 16; ++r) { s[r] = __builtin_amdgcn_exp2f(s[r] - mx); l += s[r]; }
    l += __shfl_xor(l, 32);
    if (lane < TDEC) red[64 + w * TDEC + lane] = l;
    bf16x8s pa[2];
#pragma unroll
    for (int s2 = 0; s2 < 2; ++s2) { const v4u ww = {pk_bf16(s[8 * s2], s[8 * s2 + 1]), pk_bf16(s[8 * s2 + 2], s[8 * s2 + 3]), pk_bf16(s[8 * s2 + 4], s[8 * s2 + 5]), pk_bf16(s[8 * s2 + 6], s[8 * s2 + 7])}; pa[s2] = __builtin_bit_cast(bf16x8s, ww); }
    LDS_WAIT();
    f32x16 o[8];
#pragma unroll
    for (int j = 0; j < 8; ++j)
#pragma unroll
        for (int r = 0; r < 16; ++r) o[j][r] = 0.f;
    const LAS bf16* Vc = Vt + (4 * hi + (i16 >> 2)) * CA_VRS + 16 * (gi & 1) + (i16 & 3) * 4;
#pragma unroll
    for (int s2 = 0; s2 < 2; ++s2)
#pragma unroll
        for (int dt = 0; dt < 8; ++dt) { const LAS bf16* vb = Vc + 16 * s2 * CA_VRS + 32 * dt; const bf16x8s vf = cat8(tr4(vb), tr4(vb + 8 * CA_VRS)); o[dt] = mfma32(pa[s2], vf, o[dt]); }
    LDS_WAIT(); __syncthreads();
#pragma unroll
    for (int r = 0; r < 4; ++r)
#pragma unroll
        for (int dt = 0; dt < 8; ++dt) part[(w * TDEC + r + 4 * hi) * CAD + 32 * dt + r32] = o[dt][r];
    LDS_WAIT(); __syncthreads();
    { const int q = tid >> 6, d0 = (tid & 63) * 4;
      float lt = 0.f;
#pragma unroll
      for (int ww = 0; ww < 8; ++ww) lt += red[64 + ww * TDEC + q];
      f32x4 a = {0.f, 0.f, 0.f, 0.f};
#pragma unroll
      for (int ww = 0; ww < 8; ++ww) a += *(const LAS f32x4*)(part + (ww * TDEC + q) * CAD + d0);
      const float il = 1.f / lt; const v2u ow = {pk_bf16(a.x * il, a.y * il), pk_bf16(a.z * il, a.w * il)};
      *(v2u*)(OCA + (size_t)(MP + n * TDEC + q) * DM + hh * CAD + d0) = ow; }
    LDS_WAIT(); __syncthreads();
}
__device__ __forceinline__ void ca_phase(const Ctx& C) {
    for (int it = blockIdx.x; it < NDEC * CAH; it += gridDim.x) cas_item(C, it >> 2, it & 3);
    const int G = gridDim.x, bid = blockIdx.x; const int vcu = (G % 8 == 0) ? (bid % 8) * (G / 8) + bid / 8 : bid;
    for (int u = vcu; u < NBATCH * CAH * 32; u += G) ca_unit(C, u >> 7, (u >> 5) & 3, u & 31);
}
__device__ __forceinline__ void hgrn_chain(const Ctx& C, int rowbase, int T, int h, const float* S0, float* Sout) {
    const float* LF = (const float*)(C.ws + WS_LF); const bf16* QH = (const bf16*)(C.ws + WS_QH); const bf16* VH = (const bf16*)(C.ws + WS_VH); const bf16* GH = (const bf16*)(C.ws + WS_GH);
    bf16* OMIX = (bf16*)(C.ws + WS_OMIX); const float* hgn = (const float*)C.in[I_HGN];
    const int lane = C.lane; const float gn = hgn[h * HD + lane];
    float S[64];
#pragma unroll
    for (int k = 0; k < 64; ++k) S[k] = S0 ? S0[k * 64 + lane] : 0.f;
    for (int t = 0; t < T; ++t) {
        const size_t off = (size_t)(rowbase + t) * HW + h * HD + lane;
        const float fk = __expf(LF[off]), kk = 1.f - fk, qk = bf2f(QH[off]), vd = bf2f(VH[off]), g = bf2f(GH[off]);
        float o = 0.f;
#pragma unroll
        for (int k = 0; k < 64; ++k) { const float f_ = rdlane(fk, k), k_ = rdlane(kk, k), q_ = rdlane(qk, k); S[k] = f_ * S[k] + k_ * vd; o += S[k] * q_; }
        const float r = rsqrtf(wave_sum(o * o) * (1.f / HD) + RMS_EPS);
        OMIX[(size_t)(rowbase + t) * DM + h * HD + lane] = f2bf(o * r * gn * (g / (1.f + __expf(-g))));
    }
#pragma unroll
    for (int k = 0; k < 64; ++k) Sout[k * 64 + lane] = S[k];
}
template <bool SAMPLE>
__device__ __forceinline__ void sb_query(const Ctx& C, int row, int h, int nkeys, int seq  ) {
    const bf16* SQ = (const bf16*)(C.ws + WS_SQ); const bf16* SK = (const bf16*)(C.ws + WS_SK); const bf16* SV = (const bf16*)(C.ws + WS_SV);
    const float* ck = (const float*)C.in[I_CK]; const float* cv = (const float*)C.in[I_CV]; const int* pt = (const int*)C.in[I_PT];
    bf16* OMIX = (bf16*)(C.ws + WS_OMIX);
    const int lane = C.lane; const float bias2 = ((const float*)C.in[I_SBB])[h] * LOG2E;
    float q[64];
    { const v4u* qp = (const v4u*)(SQ + (size_t)row * HW + h * HD);
#pragma unroll
      for (int c = 0; c < 8; ++c) { const v4u w = qp[c]; q[8 * c] = bflo(w.x); q[8 * c + 1] = bfhi(w.x); q[8 * c + 2] = bflo(w.y); q[8 * c + 3] = bfhi(w.y); q[8 * c + 4] = bflo(w.z); q[8 * c + 5] = bfhi(w.z); q[8 * c + 6] = bflo(w.w); q[8 * c + 7] = bfhi(w.w); } }
    float Cc = 1.f, o = 0.f;
    for (int base = nkeys > 0 ? ((nkeys - 1) & ~63) : -1; base >= 0; base -= 64) {
        const int j = base + lane; const bool valid = j < nkeys; const int jc = valid ? j : nkeys - 1;
        float z = 0.f;
        if (SAMPLE && jc < PAST) {
            const float* kr = ck + (((size_t)pt[seq * NPAGES + (jc >> 7)] * PAGE + (jc & 127)) * NH + h) * HD;
#pragma unroll
            for (int c = 0; c < 16; ++c) { const f32x4 w = ((const f32x4*)kr)[c]; z += q[4 * c] * w.x + q[4 * c + 1] * w.y + q[4 * c + 2] * w.z + q[4 * c + 3] * w.w; }
        } else {
            const size_t krow = SAMPLE ? (size_t)(MP + seq * TDEC + (jc - PAST)) : (size_t)seq * SEQ + jc;
            const v4u* kr = (const v4u*)(SK + krow * HW + h * HD);
#pragma unroll
            for (int c = 0; c < 8; ++c) { const v4u w = kr[c]; z += q[8 * c] * bflo(w.x) + q[8 * c + 1] * bfhi(w.x) + q[8 * c + 2] * bflo(w.y) + q[8 * c + 3] * bfhi(w.y) + q[8 * c + 4] * bflo(w.z) + q[8 * c + 5] * bfhi(w.z) + q[8 * c + 6] * bflo(w.w) + q[8 * c + 7] * bfhi(w.w); }
        }
        const float u = valid ? exp2f(z + bias2) : 0.f;
        float incl = 1.f / (1.f + u);
#pragma unroll
        for (int off = 1; off < 64; off <<= 1) { const float y = __shfl_down(incl, off); if (lane + off < 64) incl *= y; }
        const float a = u * incl * Cc;
        Cc *= __shfl(incl, 0);
        const int nk = nkeys - base < 64 ? nkeys - base : 64;
        for (int jj = 0; jj < nk; ++jj) {
            const float aj = __shfl(a, jj); const int jk = base + jj; float vv;
            if (SAMPLE && jk < PAST) vv = cv[(((size_t)pt[seq * NPAGES + (jk >> 7)] * PAGE + (jk & 127)) * NH + h) * HD + lane];
            else { const size_t vrow = SAMPLE ? (size_t)(MP + seq * TDEC + (jk - PAST)) : (size_t)seq * SEQ + jk; vv = bf2f(SV[vrow * HW + h * HD + lane]); }
            o += aj * vv;
        }
    }
    OMIX[(size_t)row * DM + HW + h * HD + lane] = f2bf(o);
}
__device__ __forceinline__ void p2_mix1(const Ctx& C) {
    for (int cid = C.gw; cid < NBATCH * NH * (SEQ / 64); cid += C.ngw) hgrn_h1(C, cid);
    const int w = C.gw, nw = C.ngw;
    for (int i = w; i < NDEC * NH; i += nw) { const int n = i / NH, h = i % NH; hgrn_chain(C, MP + n * TDEC, TDEC, h, (const float*)C.in[I_SH] + (size_t)i * 4096, C.out + O_HS + (size_t)i * 4096); }
    __syncthreads();
    sbs_phase(C);
    __syncthreads();
    sb_prompt_phase(C);
}
__device__ __forceinline__ void p4_mix3(const Ctx& C) {
    for (int cid = C.gw; cid < NBATCH * NH * (SEQ / 64); cid += C.ngw) hgrn_h3(C, cid);
}

__device__ __forceinline__ void thin_row(const float* xin, const bf16* br, const float* gpost, float* xout, const float* gpre, bf16* hrow, int lane) {
    const f32x4* xr = (const f32x4*)xin + lane; const v2u* bp = (const v2u*)br + lane; const f32x4* gp = (const f32x4*)gpost + lane;
    f32x4 b[4]; float s = 0.f;
#pragma unroll
    for (int j = 0; j < 4; ++j) { const v2u w = bp[64 * j]; b[j] = (f32x4){bflo(w.x), bfhi(w.x), bflo(w.y), bfhi(w.y)}; s += (b[j].x * b[j].x + b[j].y * b[j].y) + (b[j].z * b[j].z + b[j].w * b[j].w); }
    const float r = rsqrtf(wave_sum(s) * (1.f / DM) + RMS_EPS);
    float s2 = 0.f;
#pragma unroll
    for (int j = 0; j < 4; ++j) { b[j] = xr[64 * j] + b[j] * r * gp[64 * j]; s2 += (b[j].x * b[j].x + b[j].y * b[j].y) + (b[j].z * b[j].z + b[j].w * b[j].w); }
    f32x4* xo = (f32x4*)xout + lane;
#pragma unroll
    for (int j = 0; j < 4; ++j) xo[64 * j] = b[j];
    if (hrow) {
        const float r2 = rsqrtf(wave_sum(s2) * (1.f / DM) + RMS_EPS); const f32x4* g2 = (const f32x4*)gpre + lane; v2u* o8 = (v2u*)hrow + lane;
#pragma unroll
        for (int j = 0; j < 4; ++j) { const f32x4 gg = g2[64 * j]; v2u w; w.x = pk_bf16(b[j].x * r2 * gg.x, b[j].y * r2 * gg.y); w.y = pk_bf16(b[j].z * r2 * gg.z, b[j].w * r2 * gg.w); o8[64 * j] = w; }
    }
}
template <int WHICH>
__device__ __forceinline__ void p_thin(const Ctx& C) {
    const bf16* BR = (const bf16*)(C.ws + WS_BR); bf16* H = (bf16*)(C.ws + WS_H);
    float* X1 = (float*)(C.ws + WS_X1); float* X2 = (float*)(C.ws + WS_X2);
    const float* gpost = (const float*)C.in[WHICH == 0 ? I_GMIXPOST : WHICH == 1 ? I_GCAPOST : I_GFFNPOST];
    const float* gpre = (const float*)C.in[WHICH == 0 ? I_GCAPRE : I_GFFNPRE];
    for (int m = C.gw; m < MT; m += C.ngw) {
        const float* xin; float* xout;
        if (WHICH == 0) { xin = m < MP ? (const float*)C.in[I_XP] + (size_t)m * DM : (const float*)C.in[I_XS] + (size_t)(m - MP) * DM; xout = X1 + (size_t)m * DM; }
        else if (WHICH == 1) { xin = X1 + (size_t)m * DM; xout = X2 + (size_t)m * DM; }
        else { xin = X2 + (size_t)m * DM; xout = m < MP ? C.out + O_YP + (size_t)m * DM : C.out + O_YS + (size_t)(m - MP) * DM; }
        thin_row(xin, BR + (size_t)m * DM, gpost, xout, gpre, WHICH == 2 ? nullptr : H + (size_t)m * DM, C.lane);
    }
}

__device__ __forceinline__ void p6_naive(const Ctx& C) {
    const bf16* QCA = (const bf16*)(C.ws + WS_QCA); const bf16* MK = (const bf16*)(C.ws + WS_MK); const bf16* MV = (const bf16*)(C.ws + WS_MV);
    const float* cmk = (const float*)C.in[I_MK]; const float* cmv = (const float*)C.in[I_MV]; bf16* OCA = (bf16*)(C.ws + WS_OMIX);
    const int lane = C.lane;
    for (int it = C.gw; it < MT * CAH; it += C.ngw) {
        const int row = it >> 2, h = it & 3;
        const v2u qw = *((const v2u*)(QCA + (size_t)row * DM + h * CAD) + lane);
        const float q0 = bflo(qw.x), q1 = bfhi(qw.x), q2 = bflo(qw.y), q3 = bfhi(qw.y);
        float mx = -1e30f, l = 0.f, o0 = 0.f, o1 = 0.f, o2 = 0.f, o3 = 0.f;
        for (int m = 0; m < NMEM; ++m) {
            float k0, k1, k2, k3, v0, v1, v2, v3;
            if (row < MP) { const size_t off = ((size_t)((row >> 13) * NMEM + m)) * DM + h * CAD; const v2u kw = *((const v2u*)(MK + off) + lane), vw = *((const v2u*)(MV + off) + lane);
                k0 = bflo(kw.x); k1 = bfhi(kw.x); k2 = bflo(kw.y); k3 = bfhi(kw.y); v0 = bflo(vw.x); v1 = bfhi(vw.x); v2 = bflo(vw.y); v3 = bfhi(vw.y); }
            else { const size_t off = ((size_t)(((row - MP) >> 3) * NMEM + m)) * DM + h * CAD; const f32x4 kw = *((const f32x4*)(cmk + off) + lane), vw = *((const f32x4*)(cmv + off) + lane);
                k0 = kw.x; k1 = kw.y; k2 = kw.z; k3 = kw.w; v0 = vw.x; v1 = vw.y; v2 = vw.z; v3 = vw.w; }
            const float s = wave_sum(q0 * k0 + q1 * k1 + q2 * k2 + q3 * k3);
            const float mn = fmaxf(mx, s), sc = exp2f(mx - mn), p = exp2f(s - mn);
            l = l * sc + p; o0 = o0 * sc + p * v0; o1 = o1 * sc + p * v1; o2 = o2 * sc + p * v2; o3 = o3 * sc + p * v3; mx = mn;
        }
        const float il = 1.f / l; v2u w; w.x = pk_bf16(o0 * il, o1 * il); w.y = pk_bf16(o2 * il, o3 * il);
        *((v2u*)(OCA + (size_t)row * DM + h * CAD) + lane) = w;
    }
}

__device__ __forceinline__ float gelu_tanh(float x) { return x / (1.f + __expf(-1.5957691216057308f * (x + 0.044715f * x * x * x))); }
__device__ __forceinline__ void ld8(const bf16* p, float (&v)[8]) { const v4u w = *(const v4u*)p; v[0] = bflo(w.x); v[1] = bfhi(w.x); v[2] = bflo(w.y); v[3] = bfhi(w.y); v[4] = bflo(w.z); v[5] = bfhi(w.z); v[6] = bflo(w.w); v[7] = bfhi(w.w); }
__device__ __forceinline__ void ld8f(const float* p, float (&v)[8]) { const f32x4 a = *(const f32x4*)p, b = *(const f32x4*)(p + 4); v[0] = a.x; v[1] = a.y; v[2] = a.z; v[3] = a.w; v[4] = b.x; v[5] = b.y; v[6] = b.z; v[7] = b.w; }
__device__ __forceinline__ void p10_convgate(const Ctx& C) {
    const bf16* U = (const bf16*)(C.ws + WS_U); bf16* G = (bf16*)(C.ws + WS_G);
    const float* cw = (const float*)C.in[I_CONVW]; const float* cb = (const float*)C.in[I_CONVB]; const float* sc = (const float*)C.in[I_SC];
    constexpr int NCH = DFF / 8;
    const int gt = C.gw * 64 + C.lane, ngt = C.ngw * 64;
    for (int it = gt; it < MT * NCH; it += ngt) {
        const int row = it / NCH, c = (it % NCH) * 8;
        const int t = row < MP ? (row & (SEQ - 1)) : ((row - MP) & 7);
        float res[2][8];
#pragma unroll
        for (int half = 0; half < 2; ++half) {
            const int col = c + half * DFF;
            float u0[8], u1[8], u2[8], w0[8], w1[8], w2[8], bb[8];
            ld8(U + (size_t)row * DFF2 + col, u2);
            if (t >= 1) ld8(U + (size_t)(row - 1) * DFF2 + col, u1);
            else if (row < MP) {
#pragma unroll
                for (int e = 0; e < 8; ++e) u1[e] = 0.f;
            } else ld8f(sc + ((size_t)((row - MP) >> 3) * 2 + 1) * DFF2 + col, u1);
            if (t >= 2) ld8(U + (size_t)(row - 2) * DFF2 + col, u0);
            else if (row < MP) {
#pragma unroll
                for (int e = 0; e < 8; ++e) u0[e] = 0.f;
            } else ld8f(sc + ((size_t)((row - MP) >> 3) * 2 + t) * DFF2 + col, u0);
            ld8f(cw + col, w0); ld8f(cw + DFF2 + col, w1); ld8f(cw + 2 * DFF2 + col, w2); ld8f(cb + col, bb);
#pragma unroll
            for (int e = 0; e < 8; ++e) res[half][e] = bb[e] + w0[e] * u0[e] + w1[e] * u1[e] + w2[e] * u2[e];
        }
        v4u o;
        o.x = pk_bf16(gelu_tanh(res[0][0]) * res[1][0], gelu_tanh(res[0][1]) * res[1][1]); o.y = pk_bf16(gelu_tanh(res[0][2]) * res[1][2], gelu_tanh(res[0][3]) * res[1][3]);
        o.z = pk_bf16(gelu_tanh(res[0][4]) * res[1][4], gelu_tanh(res[0][5]) * res[1][5]); o.w = pk_bf16(gelu_tanh(res[0][6]) * res[1][6], gelu_tanh(res[0][7]) * res[1][7]);
        *(v4u*)(G + (size_t)row * DFF + c) = o;
    }
}
enum { PH_PRO = 0, PH_INPROJ, PH_MIX1, PH_SCAN, PH_MIX3, PH_OPROJ, PH_THIN0, PH_CQ, PH_CA, PH_CO, PH_THIN1, PH_UP, PH_CONV, PH_DOWN, PH_THIN2, NPH };
#ifndef MK_ONE_LAUNCH
#define MK_ONE_LAUNCH 1
#endif
__global__ void __launch_bounds__(NTHREADS, 2) fwd(Args args) {
    extern __shared__ __attribute__((aligned(16))) unsigned char lds_raw[];
    Ctx C;
    C.in = args.in; C.out = args.out; C.ws = args.ws; C.lds = (LAS unsigned char*)lds_raw;
    C.tid = threadIdx.x; C.lane = C.tid & 63; C.wave = __builtin_amdgcn_readfirstlane(C.tid >> 6);
    C.gw = blockIdx.x * NWAVES + C.wave; C.ngw = gridDim.x * NWAVES;
    const int G = gridDim.x, bid = blockIdx.x;
    volatile LAS unsigned* MISC = (volatile LAS unsigned*)(C.lds + MISC_OFF);
    for (int u = C.tid; u < (LDS_BYTES - LDSCTL_OFF) / 4; u += NTHREADS) ((LAS unsigned*)(C.lds + LDSCTL_OFF))[u] = 0u;
    __syncthreads();
    const int lo = args.ph_lo, hi = args.ph_hi;
    XcdBarrier bar; bar.bar = (unsigned*)(C.ws + WS_CTL) + CW_BAR; bar.x = 0; bar.st = nullptr;
    if (hi - lo > 1) bar = xcd_barrier_post((unsigned*)(C.ws + WS_CTL) + CW_BAR, MISC + 8);
#define IN(k) (lo <= (k) && (k) < hi)
#define SEAM(k) do { if (IN(k) && IN((k) + 1)) xcd_barrier(bar); } while (0)
    bf16* H = (bf16*)(C.ws + WS_H);
    if (IN(PH_PRO)) { p0_prologue(C); } SEAM(PH_PRO);
    if (IN(PH_INPROJ)) {
        { pg8::Gemm g{H, (const bf16*)(C.ws + WS_WIN), MT, DIN, DM}; pg8::StaticOrder S; S.init(MT, DIN, G, bid);
          pg8::EpiInProj E{(bf16*)(C.ws + WS_QH), (bf16*)(C.ws + WS_VH), (bf16*)(C.ws + WS_GH), (bf16*)(C.ws + WS_SQ), (bf16*)(C.ws + WS_SK), (bf16*)(C.ws + WS_SV), (float*)(C.ws + WS_LF),
                           (const float*)(C.ws + WS_LB), C.out + O_KP, C.out + O_VP, C.out + O_KS, C.out + O_VS, SQ_SCALE};
          pg8::gemm_phase<pg8::EpiInProj, pg8::StaticOrder, true, true>(C.lds + RING_OFF, g, S, E); }
        { pg8::Gemm g{(const bf16*)(C.ws + WS_MN), (const bf16*)(C.ws + WS_WCKV), NBATCH * NMEM, 2 * DM, DM}; pg8::StaticOrder S; S.init(NBATCH * NMEM, 2 * DM, G, (bid + G - 184 % G) % G);
          pg8::EpiMemKV E{(bf16*)(C.ws + WS_MK), (bf16*)(C.ws + WS_MV), C.out + O_MKP, C.out + O_MVP};
          pg8::gemm_phase<pg8::EpiMemKV, pg8::StaticOrder, true, true>(C.lds + RING_OFF, g, S, E); }
    } SEAM(PH_INPROJ);
    if (IN(PH_MIX1)) { p2_mix1(C); } SEAM(PH_MIX1);
    if (IN(PH_SCAN)) { hgrn_h2(C); sbs_combine(C); } SEAM(PH_SCAN);
    if (IN(PH_MIX3)) { p4_mix3(C); } SEAM(PH_MIX3);
    if (IN(PH_OPROJ)) { pg8::Gemm g{(const bf16*)(C.ws + WS_OMIX), (const bf16*)(C.ws + WS_WO), MT, DM, DM}; pg8::StaticOrder S; S.init(MT, DM, G, bid);
        pg8::EpiStore<false> E{(bf16*)(C.ws + WS_BR), DM, 1.f, nullptr};
        pg8::gemm_phase<pg8::EpiStore<false>, pg8::StaticOrder, true, true>(C.lds + RING_OFF, g, S, E); } SEAM(PH_OPROJ);
    if (IN(PH_THIN0)) { p_thin<0>(C); } SEAM(PH_THIN0);
    if (IN(PH_CQ)) { pg8::Gemm g{H, (const bf16*)(C.ws + WS_WCQ), MT, DM, DM}; pg8::StaticOrder S; S.init(MT, DM, G, bid);
        pg8::EpiStore<false> E{(bf16*)(C.ws + WS_QCA), DM, CQ_SCALE, nullptr};
        pg8::gemm_phase<pg8::EpiStore<false>, pg8::StaticOrder, true, true>(C.lds + RING_OFF, g, S, E); } SEAM(PH_CQ);
    if (IN(PH_CA)) { ca_phase(C); } SEAM(PH_CA);
    if (IN(PH_CO)) { pg8::Gemm g{(const bf16*)(C.ws + WS_OMIX), (const bf16*)(C.ws + WS_WCO), MT, DM, DM}; pg8::StaticOrder S; S.init(MT, DM, G, bid);
        pg8::EpiStore<false> E{(bf16*)(C.ws + WS_BR), DM, 1.f, nullptr};
        pg8::gemm_phase<pg8::EpiStore<false>, pg8::StaticOrder, true, true>(C.lds + RING_OFF, g, S, E); } SEAM(PH_CO);
    if (IN(PH_THIN1)) { p_thin<1>(C); } SEAM(PH_THIN1);
    if (IN(PH_UP)) { pg8::Gemm g{H, (const bf16*)(C.ws + WS_WUP), MT, DFF2, DM}; pg8::StaticOrder S; S.init(MT, DFF2, G, bid);
        pg8::EpiStore<true> E{(bf16*)(C.ws + WS_U), DFF2, 1.f, C.out};
        pg8::gemm_phase<pg8::EpiStore<true>, pg8::StaticOrder, true, true>(C.lds + RING_OFF, g, S, E); } SEAM(PH_UP);
    if (IN(PH_CONV)) { p10_convgate(C); } SEAM(PH_CONV);
    if (IN(PH_DOWN)) { pg8::Gemm g{(const bf16*)(C.ws + WS_G), (const bf16*)(C.ws + WS_WDN), MT, DM, DFF}; pg8::StaticOrder S; S.init(MT, DM, G, bid);
        pg8::EpiStore<false> E{(bf16*)(C.ws + WS_BR), DM, 1.f, nullptr};
        pg8::gemm_phase<pg8::EpiStore<false>, pg8::StaticOrder, true, true>(C.lds + RING_OFF, g, S, E); } SEAM(PH_DOWN);
    if (IN(PH_THIN2)) { p_thin<2>(C); }
#undef IN
#undef SEAM
}

extern "C" void kernel_launch(void* const* d_in, const int* in_sizes, int n_in, void* d_out, int out_size, void* d_ws, size_t ws_size, hipStream_t stream) {
    static int grid = 0;
    if (grid == 0) {
        if (n_in != N_IN || (size_t)out_size != O_END || ws_size < WS_END) { fprintf(stderr, "kernel_launch: unexpected problem: n_in %d out %d ws %zu\n", n_in, out_size, ws_size); grid = -1; return; }
        int dev = 0, cus = 0, per_cu = 0;
        if (hipGetDevice(&dev) != hipSuccess || hipDeviceGetAttribute(&cus, hipDeviceAttributeMultiprocessorCount, dev) != hipSuccess) { grid = -1; return; }
        if (hipFuncSetAttribute((const void*)fwd, hipFuncAttributeMaxDynamicSharedMemorySize, LDS_BYTES) != hipSuccess) { fprintf(stderr, "kernel_launch: hipFuncSetAttribute failed\n"); grid = -1; return; }
        if (hipOccupancyMaxActiveBlocksPerMultiprocessor(&per_cu, (const void*)fwd, NTHREADS, LDS_BYTES) != hipSuccess || per_cu < 1) fprintf(stderr, "kernel_launch: occupancy query says %d\n", per_cu);
        (void)hipGetLastError();
        grid = cus;
    }
    if (grid < 0) return;
    (void)hipMemsetAsync((char*)d_ws + WS_CTL, 0, CTL_ZERO_BYTES, stream);
    Args a{};
    for (int i = 0; i < N_IN; ++i) a.in[i] = d_in[i];
    a.out = (float*)d_out; a.ws = (unsigned char*)d_ws;
#if MK_ONE_LAUNCH
    a.ph_lo = 0; a.ph_hi = NPH;
    hipLaunchKernelGGL(fwd, dim3(grid), dim3(NTHREADS), LDS_BYTES, stream, a);
#else
    for (int p = 0; p < NPH; ++p) { a.ph_lo = p; a.ph_hi = p + 1; hipLaunchKernelGGL(fwd, dim3(grid), dim3(NTHREADS), LDS_BYTES, stream, a); }
#endif
}
```

```cpp
#include <hip/hip_runtime.h>
#include <cstdio>
#include <cstdint>
namespace pg8 {
#define PG8_LAS __attribute__((address_space(3)))
typedef unsigned short bf16_t;
typedef short bf16x8 __attribute__((ext_vector_type(8)));
typedef float f32x4 __attribute__((ext_vector_type(4)));
typedef unsigned u32x4 __attribute__((ext_vector_type(4)));
constexpr int BM = 256, BK = 64, HALF = 128, HTB = HALF * BK * 2  , STAGE_BYTES = 8 * HTB, NXCD = 8, WGM = 8;

__host__ __device__ __forceinline__ int lds_byte(int r, int c) { const int st = (r >> 4) * 2 + (c >> 5), rr = r & 15, cc = c & 31, ob = rr * 64 + cc * 2; return st * 1024 + (ob ^ (((ob >> 9) & 1) << 5)); }
__host__ __device__ __forceinline__ void stage_rc(int b, int& R, int& C) { const int st = b / 1024, sb = b % 1024, swz = sb ^ (((sb >> 9) & 1) << 5); R = (st >> 1) * 16 + swz / 64; C = (st & 1) * 32 + (swz % 64) / 2; }
__host__ __device__ __forceinline__ int perm32(int rho) { const int n = rho >> 4, i = rho & 15; return 8 * (i >> 2) + 4 * n + (i & 3); }

struct Unit { int pm, pn; };
struct Gemm { const bf16_t* A; const bf16_t* Bt; int M, N, K; };

struct StaticOrder {
    int nM, nN, nwg, G, c;
    __host__ __device__ void init(int M, int N, int G_, int c_) { nM = M / BM; nN = N / BM; nwg = nM * nN; G = G_; c = c_; }
    __host__ __device__ bool next(int i, Unit& u) const {
        const long L = (long)i * G + c; if (L >= nwg) return false;
        int wgid = (int)L; { const int q = nwg / NXCD, r = nwg % NXCD, xcd = wgid % NXCD, off = wgid / NXCD; wgid = (xcd < r ? xcd * (q + 1) : r * (q + 1) + (xcd - r) * q) + off; }
        const int nig = WGM * nN, gid = wgid / nig, fm = gid * WGM, gsz = (nM - fm) < WGM ? (nM - fm) : WGM;
        u.pm = fm + ((wgid % nig) % gsz); u.pn = (wgid % nig) / gsz; return true;
    }
    __device__ __forceinline__ void a_ready(const Unit&) const {}
    __device__ __forceinline__ void done(const Unit&) const {}
};

__device__ __forceinline__ unsigned cvt_pk_bf16(float lo, float hi) { unsigned r; asm volatile("v_cvt_pk_bf16_f32 %0, %1, %2" : "=v"(r) : "v"(lo), "v"(hi)); return r; }
typedef float f32x2 __attribute__((ext_vector_type(2)));
typedef __bf16 bf16x2_t __attribute__((ext_vector_type(2)));
__device__ __forceinline__ unsigned pk_bf16(float lo, float hi) { f32x2 v = {lo, hi}; bf16x2_t b = __builtin_convertvector(v, bf16x2_t); return __builtin_bit_cast(unsigned, b); }
__device__ __forceinline__ u32x4 pk8(f32x4 a, f32x4 b) { u32x4 w; w.x = pk_bf16(a[0], a[1]); w.y = pk_bf16(a[2], a[3]); w.z = pk_bf16(b[0], b[1]); w.w = pk_bf16(b[2], b[3]); return w; }

template <bool CAP> struct EpiStore {
    static constexpr bool PERM = true, AFTER_DRAIN = false;
    bf16_t* O; int ldc; float scale; float* outb;
    __device__ __forceinline__ void operator()(const f32x4 (&acc)[2][2][4][2], const Unit& u, int wr, int wc, int fr, int fq) const {
        const int row0 = u.pm * BM + wr * 64 + fr, col0 = u.pn * BM + wc * 32 + 8 * fq;
#pragma unroll
        for (int ai = 0; ai < 2; ++ai)
#pragma unroll
            for (int m = 0; m < 4; ++m) {
                const int row = row0 + ai * HALF + m * 16;
                float* cap = nullptr;
                if constexpr (CAP) {
                    if (row < 16384) { const int t = row & 8191; if (t >= 8190) cap = outb + 34668544 + (size_t)((row >> 13) * 2 + (t - 8190)) * 5632; }
                    else { const int r2 = row - 16384, t = r2 & 7; if (t >= 6) cap = outb + 40982528 + (size_t)((r2 >> 3) * 2 + (t - 6)) * 5632; }
                }
#pragma unroll
                for (int bj = 0; bj < 2; ++bj) {
                    const int col = col0 + bj * HALF;
                    const f32x4 v0 = acc[ai][bj][m][0] * scale, v1 = acc[ai][bj][m][1] * scale;
                    *(u32x4*)(O + (size_t)row * ldc + col) = pk8(v0, v1);
                    if constexpr (CAP) { if (cap) { *(f32x4*)(cap + col) = v0; *(f32x4*)(cap + col + 4) = v1; } }
                }
            }
    }
};

struct EpiInProj {
    static constexpr bool PERM = true, AFTER_DRAIN = false;
    bf16_t *QH, *VH, *GH, *SQ, *SK, *SV; float* LF; const float* LB; float* kp; float* vp; float* ks; float* vs; float sqscale;
    __device__ __forceinline__ void operator()(const f32x4 (&acc)[2][2][4][2], const Unit& u, int wr, int wc, int fr, int fq) const {
        const int seg = u.pn >> 1;
        const int row0 = u.pm * BM + wr * 64 + fr, col0 = (u.pn & 1) * BM + wc * 32 + 8 * fq;
        if (seg == 1) {
#pragma unroll
            for (int bj = 0; bj < 2; ++bj) {
                const int col = col0 + bj * HALF;
                const f32x4 l0 = *(const f32x4*)(LB + col), l1 = *(const f32x4*)(LB + col + 4);
#pragma unroll
                for (int ai = 0; ai < 2; ++ai)
#pragma unroll
                    for (int m = 0; m < 4; ++m) {
                        const int row = row0 + ai * HALF + m * 16;
                        f32x4 o0, o1;
#pragma unroll
                        for (int e = 0; e < 4; ++e) {
                            const float s0 = 1.f / (1.f + __expf(-acc[ai][bj][m][0][e])), s1 = 1.f / (1.f + __expf(-acc[ai][bj][m][1][e]));
                            o0[e] = __logf(l0[e] + (1.f - l0[e]) * s0); o1[e] = __logf(l1[e] + (1.f - l1[e]) * s1);
                        }
                        *(f32x4*)(LF + (size_t)row * 512 + col) = o0; *(f32x4*)(LF + (size_t)row * 512 + col + 4) = o1;
                    }
            }
            return;
        }
        bf16_t* dst = seg == 0 ? QH : seg == 2 ? VH : seg == 3 ? GH : seg == 4 ? SQ : seg == 5 ? SK : SV;
        const float sc = seg == 4 ? sqscale : 1.f;
        float* fp = seg == 5 ? kp : seg == 6 ? vp : nullptr;
        float* fs = seg == 5 ? ks : vs;
#pragma unroll
        for (int ai = 0; ai < 2; ++ai)
#pragma unroll
            for (int m = 0; m < 4; ++m) {
                const int row = row0 + ai * HALF + m * 16;
#pragma unroll
                for (int bj = 0; bj < 2; ++bj) {
                    const int col = col0 + bj * HALF;
                    const f32x4 v0 = acc[ai][bj][m][0], v1 = acc[ai][bj][m][1];
                    *(u32x4*)(dst + (size_t)row * 512 + col) = pk8(v0 * sc, v1 * sc);
                    if (fp) { float* f = row < 16384 ? fp + (size_t)row * 512 + col : fs + (size_t)(row - 16384) * 512 + col; *(f32x4*)f = v0; *(f32x4*)(f + 4) = v1; }
                }
            }
    }
};

struct EpiMemKV {
    static constexpr bool PERM = true, AFTER_DRAIN = false;
    bf16_t *MK, *MV; float *ok, *ov;
    __device__ __forceinline__ void operator()(const f32x4 (&acc)[2][2][4][2], const Unit& u, int wr, int wc, int fr, int fq) const {
        const int seg = u.pn >> 2;
        const int row0 = u.pm * BM + wr * 64 + fr, col0 = (u.pn & 3) * BM + wc * 32 + 8 * fq;
        bf16_t* dst = seg == 0 ? MK : MV; float* fo = seg == 0 ? ok : ov;
#pragma unroll
        for (int ai = 0; ai < 2; ++ai)
#pragma unroll
            for (int m = 0; m < 4; ++m) {
                const int row = row0 + ai * HALF + m * 16;
#pragma unroll
                for (int bj = 0; bj < 2; ++bj) {
                    const int col = col0 + bj * HALF;
                    const f32x4 v0 = acc[ai][bj][m][0], v1 = acc[ai][bj][m][1];
                    *(u32x4*)(dst + (size_t)row * 1024 + col) = pk8(v0, v1);
                    *(f32x4*)(fo + (size_t)row * 1024 + col) = v0; *(f32x4*)(fo + (size_t)row * 1024 + col + 4) = v1;
                }
            }
    }
};

template <class Epi, class Sched, bool ALIGN_EPI = false, bool SP2 = false>
__device__ __forceinline__ void gemm_phase(PG8_LAS unsigned char* lds, const Gemm g, const Sched& S, const Epi& E) {
    const int tid = threadIdx.x, wid = __builtin_amdgcn_readfirstlane(tid >> 6), lane = tid & 63, wr = wid >> 2, wc = wid & 3, fr = lane & 15, fq = lane >> 4;
    const int K = g.K, nt = K / BK;
    unsigned voffA[2], voffB[2];
#pragma unroll
    for (int i = 0; i < 2; ++i) { int R, C; stage_rc(tid * 16 + i * 8192, R, C); const int Rb = Epi::PERM ? ((R & ~31) + perm32(R & 31)) : R;
        voffA[i] = (unsigned)(R * K + C) * 2u; voffB[i] = (unsigned)(Rb * K + C) * 2u; }
    const size_t kstep = (size_t)(BK * 2);
    const size_t hstep = (size_t)HALF * K * 2;
    const size_t tstep = 2 * hstep;
    const unsigned ldsw = (unsigned)wid * 1024u;
    const int aoff = lds_byte(wr * 64 + fr, fq * 8), boff = lds_byte(wc * 32 + fr, fq * 8);
#define PG8_SA(b, h) (((b) * 2 + (h)) * HTB)
#define PG8_SB(b, h) ((4 + (b) * 2 + (h)) * HTB)
#define PG8_STAGE(bufoff, gbase, voff) do { _Pragma("unroll") for (int _i = 0; _i < 2; ++_i) \
        __builtin_amdgcn_global_load_lds((const unsigned*)((const char*)(gbase) + (voff)[_i]), (PG8_LAS unsigned*)(lds + (bufoff) + ldsw + _i * 8192), 16, 0, 0); } while (0)
#define PG8_LDA(dst, b, h) do { _Pragma("unroll") for (int m = 0; m < 4; ++m) _Pragma("unroll") for (int k = 0; k < 2; ++k) dst[m][k] = *(const PG8_LAS bf16x8*)(lds + PG8_SA(b, h) + aoff + m * 2048 + k * 1024); } while (0)
#define PG8_LDB(dst, b, h) do { _Pragma("unroll") for (int n = 0; n < 2; ++n) _Pragma("unroll") for (int k = 0; k < 2; ++k) dst[n][k] = *(const PG8_LAS bf16x8*)(lds + PG8_SB(b, h) + boff + n * 2048 + k * 1024); } while (0)
#define PG8_MMA(ai, bj, At, Bt) do { __builtin_amdgcn_s_setprio(1); _Pragma("unroll") for (int m = 0; m < 4; ++m) _Pragma("unroll") for (int n = 0; n < 2; ++n) _Pragma("unroll") for (int k = 0; k < 2; ++k) \
        acc[ai][bj][m][n] = __builtin_amdgcn_mfma_f32_16x16x32_bf16(Bt[n][k], At[m][k], acc[ai][bj][m][n], 0, 0, 0); __builtin_amdgcn_s_setprio(0); } while (0)
#define PG8_WAIT_V(n) asm volatile("s_waitcnt vmcnt(" #n ")" ::: "memory")
#define PG8_WAIT_L(n) asm volatile("s_waitcnt lgkmcnt(" #n ")" ::: "memory")
#define PG8_BAR __builtin_amdgcn_s_barrier()
#define PG8_SCHED __builtin_amdgcn_sched_barrier(0)
    Unit cur, nxt; int ui = 0;
    if (!S.next(0, cur)) return;
    f32x4 acc[2][2][4][2];
#pragma unroll
    for (int a = 0; a < 2; ++a)
#pragma unroll
        for (int b = 0; b < 2; ++b)
#pragma unroll
            for (int m = 0; m < 4; ++m)
#pragma unroll
                for (int n = 0; n < 2; ++n) acc[a][b][m][n] = (f32x4){0.f, 0.f, 0.f, 0.f};
    bf16x8 At[4][2], B0[2][2], B1[2][2];
    const char* cA = (const char*)g.A + (size_t)cur.pm * tstep; const char* cB = (const char*)g.Bt + (size_t)cur.pn * tstep;
    S.a_ready(cur);
    if constexpr (SP2) {
        PG8_STAGE(PG8_SB(0, 0), cB, voffB); PG8_STAGE(PG8_SB(0, 1), cB + hstep, voffB); PG8_STAGE(PG8_SA(0, 0), cA, voffA); PG8_STAGE(PG8_SA(0, 1), cA + hstep, voffA);
        if (wr == 1) PG8_BAR;
        PG8_WAIT_V(2); PG8_BAR;
        PG8_STAGE(PG8_SB(1, 0), cB + kstep, voffB); PG8_STAGE(PG8_SA(1, 0), cA + kstep, voffA); PG8_STAGE(PG8_SB(1, 1), cB + hstep + kstep, voffB);
        PG8_WAIT_V(6); PG8_BAR;
    } else {
        PG8_STAGE(PG8_SB(0, 0), cB, voffB); PG8_STAGE(PG8_SA(0, 0), cA, voffA); PG8_STAGE(PG8_SB(0, 1), cB + hstep, voffB); PG8_STAGE(PG8_SA(0, 1), cA + hstep, voffA);
        if (wr == 1) PG8_BAR;
        PG8_WAIT_V(4); PG8_BAR;
        PG8_STAGE(PG8_SB(1, 0), cB + kstep, voffB); PG8_STAGE(PG8_SA(1, 0), cA + kstep, voffA); PG8_STAGE(PG8_SB(1, 1), cB + hstep + kstep, voffB);
        PG8_WAIT_V(6); PG8_BAR;
    }
    for (;;) {
        const bool has_next = S.next(ui + 1, nxt);
        const char* nA = has_next ? (const char*)g.A + (size_t)nxt.pm * tstep : cA; const char* nB = has_next ? (const char*)g.Bt + (size_t)nxt.pn * tstep : cB;
        for (int t = 0; t < nt; t += 2) {
            const bool last = (t == nt - 2);
            const char* a1 = cA + (size_t)(t + 1) * kstep;
            const char* a2 = last ? nA : cA + (size_t)(t + 2) * kstep; const char* b2 = last ? nB : cB + (size_t)(t + 2) * kstep;
            const char* a3 = a2 + kstep; const char* b3 = b2 + kstep;
            if (last && has_next) S.a_ready(nxt);
            if constexpr (SP2) {
            PG8_LDB(B0, 0, 0); PG8_LDB(B1, 0, 1); PG8_SCHED; PG8_LDA(At, 0, 0); PG8_STAGE(PG8_SA(1, 1), a1 + hstep, voffA);
            PG8_WAIT_V(8); PG8_WAIT_L(0); PG8_BAR; PG8_MMA(0, 0, At, B0); PG8_MMA(0, 1, At, B1); PG8_BAR; PG8_SCHED;
            PG8_LDA(At, 0, 1); PG8_STAGE(PG8_SB(0, 0), b2, voffB); PG8_STAGE(PG8_SB(0, 1), b2 + hstep, voffB); PG8_STAGE(PG8_SA(0, 0), a2, voffA);
            PG8_WAIT_V(8); PG8_WAIT_L(0); PG8_BAR; PG8_MMA(1, 0, At, B0); PG8_MMA(1, 1, At, B1); PG8_BAR; PG8_SCHED;
            PG8_LDB(B0, 1, 0); PG8_LDB(B1, 1, 1); PG8_SCHED; PG8_LDA(At, 1, 0); PG8_STAGE(PG8_SA(0, 1), a2 + hstep, voffA);
            PG8_WAIT_V(8); PG8_WAIT_L(0); PG8_BAR; PG8_MMA(0, 0, At, B0); PG8_MMA(0, 1, At, B1); PG8_BAR; PG8_SCHED;
            PG8_LDA(At, 1, 1); PG8_STAGE(PG8_SB(1, 0), b3, voffB); PG8_STAGE(PG8_SB(1, 1), b3 + hstep, voffB); PG8_STAGE(PG8_SA(1, 0), a3, voffA);
            PG8_WAIT_V(8); PG8_WAIT_L(0); PG8_BAR; PG8_MMA(1, 0, At, B0); PG8_MMA(1, 1, At, B1); PG8_BAR; PG8_SCHED;
            } else {
            PG8_LDB(B0, 0, 0); PG8_SCHED; PG8_LDA(At, 0, 0); PG8_STAGE(PG8_SA(1, 1), a1 + hstep, voffA);
            PG8_WAIT_L(8); PG8_BAR; PG8_WAIT_L(0); PG8_MMA(0, 0, At, B0); PG8_BAR; PG8_SCHED;
            PG8_LDB(B1, 0, 1); PG8_STAGE(PG8_SB(0, 0), b2, voffB);
            PG8_BAR; PG8_WAIT_L(0); PG8_MMA(0, 1, At, B1); PG8_BAR;
            PG8_LDA(At, 0, 1); PG8_STAGE(PG8_SA(0, 0), a2, voffA);
            PG8_BAR; PG8_WAIT_L(0); PG8_MMA(1, 0, At, B0); PG8_BAR; PG8_SCHED;
            PG8_STAGE(PG8_SB(0, 1), b2 + hstep, voffB);
            PG8_WAIT_V(6); PG8_BAR; PG8_MMA(1, 1, At, B1); PG8_BAR;
            PG8_LDB(B0, 1, 0); PG8_SCHED; PG8_LDA(At, 1, 0); PG8_STAGE(PG8_SA(0, 1), a2 + hstep, voffA);
            PG8_WAIT_L(8); PG8_BAR; PG8_WAIT_L(0); PG8_MMA(0, 0, At, B0); PG8_BAR; PG8_SCHED;
            PG8_LDB(B1, 1, 1); PG8_STAGE(PG8_SB(1, 0), b3, voffB);
            PG8_BAR; PG8_WAIT_L(0); PG8_MMA(0, 1, At, B1); PG8_BAR;
            PG8_LDA(At, 1, 1); PG8_STAGE(PG8_SA(1, 0), a3, voffA);
            PG8_BAR; PG8_WAIT_L(0); PG8_MMA(1, 0, At, B0); PG8_BAR; PG8_SCHED;
            PG8_STAGE(PG8_SB(1, 1), b3 + hstep, voffB);
            PG8_WAIT_V(6); PG8_BAR; PG8_MMA(1, 1, At, B1); PG8_BAR;
            }
        }
        if constexpr (ALIGN_EPI) { if (wr == 0) PG8_BAR; }
        if constexpr (!Epi::AFTER_DRAIN) { E(acc, cur, wr, wc, fr, fq); S.done(cur); }
        if (!has_next) break;
#pragma unroll
        for (int a = 0; a < 2; ++a)
#pragma unroll
            for (int b = 0; b < 2; ++b)
#pragma unroll
                for (int m = 0; m < 4; ++m)
#pragma unroll
                    for (int n = 0; n < 2; ++n) acc[a][b][m][n] = (f32x4){0.f, 0.f, 0.f, 0.f};
        cur = nxt; cA = nA; cB = nB; ++ui;
        if constexpr (ALIGN_EPI) { if (wr == 1) PG8_BAR; }
    }
    PG8_WAIT_V(0);
    if constexpr (!ALIGN_EPI) { if (wr == 0) PG8_BAR; }
    PG8_BAR;
    if constexpr (Epi::AFTER_DRAIN) { E.fused(acc, cur, wr, wc, fr, fq, lds, wid, lane); S.done(cur); }
#undef PG8_SA
#undef PG8_SB
#undef PG8_STAGE
#undef PG8_LDA
#undef PG8_LDB
#undef PG8_MMA
#undef PG8_WAIT_V
#undef PG8_WAIT_L
#undef PG8_BAR
#undef PG8_SCHED
}
}
#define GAS __attribute__((address_space(1)))
#define LAS __attribute__((address_space(3)))
#define LDS_WAIT() asm volatile("s_waitcnt lgkmcnt(0)" ::: "memory")
#define VM_WAIT() asm volatile("s_waitcnt vmcnt(0)" ::: "memory")
#define XB_TMO      128
#define XB_XCNT(j)  (256  + 64 * (j))
#define XB_XSUB(j)  (1280 + 64 * (j))
#define XB_XGEN(j)  (2304 + 64 * (j))
#define XB_TOP      3328
#define XB_TOPGEN   3392
#define XCD_BAR_WORDS 3456
#define XB_SPIN_CAP (1u << 23)

__device__ __forceinline__ unsigned xb_ld(unsigned* p)              { return __hip_atomic_load(p, __ATOMIC_RELAXED, __HIP_MEMORY_SCOPE_AGENT); }
__device__ __forceinline__ unsigned xb_add(unsigned* p, unsigned v) { return __hip_atomic_fetch_add(p, v, __ATOMIC_RELAXED, __HIP_MEMORY_SCOPE_AGENT); }
__device__ __forceinline__ unsigned xb_xcc_id() { return (unsigned)__builtin_amdgcn_s_getreg((3 << 11) | 20) & 0xFu; }
#define XB_SPIN(cond, bar) do { unsigned _sp = 0; while (cond) { __builtin_amdgcn_s_sleep(1); \
    if ((++_sp & 255u) == 0u) { if (xb_ld(&(bar)[XB_TMO])) break; if (_sp > XB_SPIN_CAP) { atomicAdd(&(bar)[XB_TMO], 1u); break; } } } } while (0)

struct XcdBarrier {
    unsigned* bar; unsigned x;
    volatile LAS unsigned* st;
};

__device__ __forceinline__ XcdBarrier xcd_barrier_post(unsigned* bar, volatile LAS unsigned* st) {
    XcdBarrier b; b.bar = bar; b.x = xb_xcc_id(); b.st = st;
    if (threadIdx.x == 0) (void)xb_add(&bar[XB_XCNT(b.x)], 1u);
    return b;
}
__device__ __forceinline__ void xcd_barrier_complete(unsigned* bar, unsigned x, unsigned& nloc, unsigned& nx) {
    const unsigned G = gridDim.x * gridDim.y * gridDim.z;
    unsigned sum, cnt, mine, sp = 0u;
    for (;;) {
        sum = 0u; cnt = 0u; mine = 0u;
#pragma unroll
        for (unsigned j = 0; j < 16; ++j) { const unsigned c = xb_ld(&bar[XB_XCNT(j)]); sum += c; cnt += (c > 0u) ? 1u : 0u; mine = (j == x) ? c : mine; }
        if (sum == G) break;
        __builtin_amdgcn_s_sleep(1);
        if ((++sp & 255u) == 0u) { if (xb_ld(&bar[XB_TMO])) break; if (sp > XB_SPIN_CAP) { atomicAdd(&bar[XB_TMO], 1u); break; } }
    }
    nloc = mine > 0u ? mine : 1u; nx = cnt > 0u ? cnt : 1u;
}

__device__ __forceinline__ void xcd_barrier(const XcdBarrier& b) {
    asm volatile("s_waitcnt vmcnt(0)" ::: "memory");
    __syncthreads();
    if (threadIdx.x == 0) {
        unsigned* bar = b.bar;
        __builtin_amdgcn_s_waitcnt(0);
        unsigned nloc = b.st[0], nx = b.st[1];
        if (nloc == 0u) { xcd_barrier_complete(bar, b.x, nloc, nx); b.st[0] = nloc; b.st[1] = nx; }
        const unsigned old = xb_add(&bar[XB_XSUB(b.x)], 1u);
        const unsigned gen = old / nloc;
        if (old + 1u == (gen + 1u) * nloc) {
            __builtin_amdgcn_fence(__ATOMIC_RELEASE, "agent");
            asm volatile("s_waitcnt vmcnt(0)" ::: "memory");
            const unsigned og = xb_add(&bar[XB_TOP], 1u);
            const unsigned tg = og / nx;
            if (og + 1u == (tg + 1u) * nx) xb_add(&bar[XB_TOPGEN], 1u);
            else XB_SPIN(xb_ld(&bar[XB_TOPGEN]) == tg, bar);
            __builtin_amdgcn_fence(__ATOMIC_ACQUIRE, "agent");
            xb_add(&bar[XB_XGEN(b.x)], 1u);
            asm volatile("s_waitcnt vmcnt(0)" ::: "memory");
        } else {
            XB_SPIN(xb_ld(&bar[XB_XGEN(b.x)]) == gen, bar);
            __builtin_amdgcn_fence(__ATOMIC_ACQUIRE, "agent");
            asm volatile("s_waitcnt vmcnt(0)" ::: "memory");
        }
    }
    __syncthreads();
}
#define PROBE_PH -1
constexpr int NWAVES = 8, NTHREADS = 512;
constexpr int DM = 1024, SEQ = 8192, NBATCH = 2, MP = NBATCH * SEQ, NDEC = 128, TDEC = 8, MS = NDEC * TDEC, MT = MP + MS;
constexpr int DIN = 3584, HW = 512, NH = 8, HD = 64;
constexpr int NMEM = 256, CAH = 4, CAD = 256, DFF = 2816, DFF2 = 5632;
constexpr int PAST = 2048, PAGE = 128, NPAGES = 16;
constexpr float RMS_EPS = 1e-6f, LOG2E = 1.4426950408889634f;
constexpr float SQ_SCALE = 0.125f * LOG2E;
constexpr float CQ_SCALE = 0.0625f * LOG2E;
enum { I_XP = 0, I_XS, I_CK, I_CV, I_SH, I_SC, I_MK, I_MV, I_PT, I_MEM, I_WIN, I_HGN, I_HLB, I_SBB, I_WO, I_GMIXPRE, I_GMIXPOST, I_GCAPRE, I_GCAPOST, I_GMEM,
       I_WCQ, I_WCK, I_WCV, I_WCO, I_GFFNPRE, I_GFFNPOST, I_WUP, I_CONVW, I_CONVB, I_WDN, N_IN };
constexpr size_t O_YP = 0, O_YS = 16777216, O_KP = 17825792, O_VP = 26214400, O_HP = 34603008, O_CP = 34668544, O_MKP = 34691072, O_MVP = 35215360,
                 O_KS = 35739648, O_VS = 36263936, O_HS = 36788224, O_CS = 40982528, O_END = 42424320;
constexpr size_t MiB = 1u << 20;
constexpr size_t WS_CTL = 0, CTL_ZERO_BYTES = 1 * MiB;
constexpr size_t WS_WIN = 2 * MiB, WS_WO = 9 * MiB, WS_WCQ = 11 * MiB, WS_WCO = 13 * MiB, WS_WCKV = 15 * MiB, WS_WUP = 19 * MiB, WS_WDN = 30 * MiB;
constexpr size_t WS_LB = 36 * MiB, WS_MN = 37 * MiB, WS_MK = 38 * MiB, WS_MV = 39 * MiB;
constexpr size_t WS_H = 40 * MiB, WS_QH = 74 * MiB, WS_LF = 91 * MiB, WS_VH = 125 * MiB, WS_GH = 142 * MiB, WS_SQ = 159 * MiB, WS_SK = 176 * MiB, WS_SV = 193 * MiB;
constexpr size_t WS_OMIX = 210 * MiB, WS_BR = 244 * MiB, WS_X1 = 278 * MiB, WS_X2 = 346 * MiB, WS_QCA = 414 * MiB, WS_U = 448 * MiB, WS_G = 635 * MiB, WS_UCT = 730 * MiB, WS_DC = 762 * MiB, WS_SCT = 763 * MiB, WS_SBP = 780 * MiB, WS_END = 786 * MiB;
constexpr int CW_BAR = 4096;
constexpr int RING_OFF = 0, RING_BYTES = 162816, LDSCTL_OFF = RING_BYTES, MISC_OFF = LDSCTL_OFF + 320, LDS_BYTES = 163840;

typedef unsigned short bf16;
typedef unsigned v4u __attribute__((ext_vector_type(4)));
typedef unsigned v2u __attribute__((ext_vector_type(2)));
typedef float f32x4 __attribute__((ext_vector_type(4)));
using pg8::pk_bf16;
__device__ __forceinline__ float bf2f(unsigned short b) { return __uint_as_float((unsigned)b << 16); }
__device__ __forceinline__ float bflo(unsigned w) { return __uint_as_float(w << 16); }
__device__ __forceinline__ float bfhi(unsigned w) { return __uint_as_float(w & 0xffff0000u); }
__device__ __forceinline__ unsigned short f2bf(float f) { return (unsigned short)(pk_bf16(f, 0.f) & 0xffffu); }
__device__ __forceinline__ float wave_sum(float v) {
#pragma unroll
    for (int o = 1; o < 64; o <<= 1) v += __shfl_xor(v, o);
    return v;
}
__device__ __forceinline__ float rdlane(float v, int l) { return __uint_as_float((unsigned)__builtin_amdgcn_readlane((int)__float_as_uint(v), l)); }

struct Args { const void* in[N_IN]; float* out; unsigned char* ws; int ph_lo, ph_hi; };
struct Ctx { const void* const* in; float* out; unsigned char* ws; LAS unsigned char* lds; int tid, lane, wave, gw, ngw; };

__device__ __forceinline__ void p0_transpose_item(const float* W, int K, int N, bf16* WT, int row_off, LAS float* scr, int item, int lane) {
    const int nblk = N / 32, kb = item / nblk, nb = item % nblk, k0 = 64 * kb, n0 = 32 * nb;
#pragma unroll 8
    for (int i = 0; i < 32; ++i) { const int kk = 2 * i + (lane >> 5); scr[kk * 33 + (lane & 31)] = W[(size_t)(k0 + kk) * N + n0 + (lane & 31)]; }
    LDS_WAIT(); asm volatile("" ::: "memory");
    const int c = lane & 7;
#pragma unroll
    for (int j = 0; j < 4; ++j) { const int n = (lane >> 3) + 8 * j; const LAS float* s = scr + (8 * c) * 33 + n;
        v4u o; o.x = pk_bf16(s[0 * 33], s[1 * 33]); o.y = pk_bf16(s[2 * 33], s[3 * 33]); o.z = pk_bf16(s[4 * 33], s[5 * 33]); o.w = pk_bf16(s[6 * 33], s[7 * 33]);
        *(v4u*)(WT + (size_t)(row_off + n0 + n) * K + k0 + 8 * c) = o; }
    LDS_WAIT(); asm volatile("" ::: "memory");
}
__device__ __forceinline__ void rms_row_to_bf16(const float* xrow, const float* g, bf16* orow, int lane) {
    const f32x4* xr = (const f32x4*)xrow + lane; const f32x4* gr = (const f32x4*)g + lane;
    f32x4 v[4]; float s = 0.f;
#pragma unroll
    for (int j = 0; j < 4; ++j) { v[j] = xr[64 * j]; s += (v[j].x * v[j].x + v[j].y * v[j].y) + (v[j].z * v[j].z + v[j].w * v[j].w); }
    const float r = rsqrtf(wave_sum(s) * (1.f / DM) + RMS_EPS);
    v2u* o8 = (v2u*)orow + lane;
#pragma unroll
    for (int j = 0; j < 4; ++j) { const f32x4 gg = gr[64 * j]; v2u w; w.x = pk_bf16(v[j].x * r * gg.x, v[j].y * r * gg.y); w.y = pk_bf16(v[j].z * r * gg.z, v[j].w * r * gg.w); o8[64 * j] = w; }
}
__device__ __forceinline__ void p0_prologue(const Ctx& C) {
    LAS float* scr = (LAS float*)(C.lds + RING_OFF + C.wave * 16384);
    const float* w_in = (const float*)C.in[I_WIN]; const float* w_o = (const float*)C.in[I_WO]; const float* w_cq = (const float*)C.in[I_WCQ]; const float* w_ck = (const float*)C.in[I_WCK];
    const float* w_cv = (const float*)C.in[I_WCV]; const float* w_co = (const float*)C.in[I_WCO]; const float* w_up = (const float*)C.in[I_WUP]; const float* w_dn = (const float*)C.in[I_WDN];
    bf16* Win = (bf16*)(C.ws + WS_WIN); bf16* Wo = (bf16*)(C.ws + WS_WO); bf16* Wcq = (bf16*)(C.ws + WS_WCQ); bf16* Wco = (bf16*)(C.ws + WS_WCO); bf16* Wckv = (bf16*)(C.ws + WS_WCKV);
    bf16* Wup = (bf16*)(C.ws + WS_WUP); bf16* Wdn = (bf16*)(C.ws + WS_WDN);
    constexpr int I_IN = (DM / 64) * (DIN / 32), I_SQ = (DM / 64) * (DM / 32), I_UP = (DM / 64) * (DFF2 / 32), I_DN = (DFF / 64) * (DM / 32);
    constexpr int NITEMS = I_IN + 5 * I_SQ + I_UP + I_DN;
    for (int it = C.gw; it < NITEMS; it += C.ngw) {
        int r = it;
        if (r < I_IN) { p0_transpose_item(w_in, DM, DIN, Win, 0, scr, r, C.lane); continue; } r -= I_IN;
        if (r < I_SQ) { p0_transpose_item(w_o, DM, DM, Wo, 0, scr, r, C.lane); continue; } r -= I_SQ;
        if (r < I_SQ) { p0_transpose_item(w_cq, DM, DM, Wcq, 0, scr, r, C.lane); continue; } r -= I_SQ;
        if (r < I_SQ) { p0_transpose_item(w_co, DM, DM, Wco, 0, scr, r, C.lane); continue; } r -= I_SQ;
        if (r < I_SQ) { p0_transpose_item(w_ck, DM, DM, Wckv, 0, scr, r, C.lane); continue; } r -= I_SQ;
        if (r < I_SQ) { p0_transpose_item(w_cv, DM, DM, Wckv, DM, scr, r, C.lane); continue; } r -= I_SQ;
        if (r < I_UP) { p0_transpose_item(w_up, DM, DFF2, Wup, 0, scr, r, C.lane); continue; } r -= I_UP;
        p0_transpose_item(w_dn, DFF, DM, Wdn, 0, scr, r, C.lane);
    }
    const float* xp = (const float*)C.in[I_XP]; const float* xs = (const float*)C.in[I_XS]; const float* mem = (const float*)C.in[I_MEM];
    bf16* H = (bf16*)(C.ws + WS_H); bf16* MN = (bf16*)(C.ws + WS_MN);
    const float* g_pre = (const float*)C.in[I_GMIXPRE]; const float* g_mem = (const float*)C.in[I_GMEM];
    for (int m = C.gw; m < MT + NBATCH * NMEM; m += C.ngw) {
        if (m < MP) rms_row_to_bf16(xp + (size_t)m * DM, g_pre, H + (size_t)m * DM, C.lane);
        else if (m < MT) rms_row_to_bf16(xs + (size_t)(m - MP) * DM, g_pre, H + (size_t)m * DM, C.lane);
        else rms_row_to_bf16(mem + (size_t)(m - MT) * DM, g_mem, MN + (size_t)(m - MT) * DM, C.lane);
    }
    if (C.gw == 0) {
        const float* lbp = (const float*)C.in[I_HLB]; float* LB = (float*)(C.ws + WS_LB);
        for (int k = C.lane; k < HW; k += 64) { const float a = lbp[k], b = lbp[HW + k]; LB[k] = 1.f / (1.f + __expf(b - a)); }
    }
}
typedef short bf16x8s __attribute__((ext_vector_type(8)));
typedef short s16x4 __attribute__((ext_vector_type(4)));
typedef short v4i16_t __attribute__((ext_vector_type(4)));
constexpr int HRS = 72;
__device__ __forceinline__ s16x4 tr4(const LAS bf16* p) { return __builtin_bit_cast(s16x4, __builtin_amdgcn_ds_read_tr16_b64_v4i16((LAS v4i16_t*)p)); }
__device__ __forceinline__ bf16x8s cat8(s16x4 lo, s16x4 hi) { return (bf16x8s){lo[0], lo[1], lo[2], lo[3], hi[0], hi[1], hi[2], hi[3]}; }
__device__ __forceinline__ f32x4 mfma16(bf16x8s a, bf16x8s b, f32x4 c) { return __builtin_amdgcn_mfma_f32_16x16x32_bf16(a, b, c, 0, 0, 0); }
__device__ __forceinline__ void hg_stage_v(const bf16* VH, int r0, int h, LAS bf16* Vt, int lane) {
#pragma unroll
    for (int it = 0; it < 8; ++it) { const int row = it * 8 + (lane >> 3), ch = lane & 7; const v4u w = *(const v4u*)(VH + (size_t)(r0 + row) * HW + h * HD + ch * 8); *(LAS v4u*)(Vt + row * HRS + ch * 8) = w; }
}
__device__ __forceinline__ void hgrn_h1(const Ctx& C, int cid) {
    const float* LF = (const float*)(C.ws + WS_LF); const bf16* VH = (const bf16*)(C.ws + WS_VH);
    float* UCT = (float*)(C.ws + WS_UCT); float* DC = (float*)(C.ws + WS_DC);
    const int lane = C.lane, i = lane & 15, g = lane >> 4;
    const int chain = cid >> 7, ci = cid & 127, b = chain >> 3, h = chain & 7, r0 = b * SEQ + ci * 64;
    LAS bf16* Vt = (LAS bf16*)(C.lds + RING_OFF + C.wave * 18432); LAS bf16* Kt = Vt + 64 * HRS;
    hg_stage_v(VH, r0, h, Vt, lane);
    const float* lfp = LF + (size_t)r0 * HW + h * HD + lane;
    float bl = 0.f;
#pragma unroll 16
    for (int t = 0; t < 64; ++t) bl += lfp[(size_t)t * HW];
    { float run = 0.f;
#pragma unroll 16
      for (int s = 0; s < 64; ++s) { const float lf = lfp[(size_t)s * HW]; run += lf; Kt[s * HRS + lane] = f2bf((1.f - __expf(lf)) * __expf(bl - run)); } }
    DC[(size_t)cid * 64 + lane] = __expf(bl);
    LDS_WAIT();
#pragma unroll
    for (int kb = 0; kb < 4; ++kb) {
        bf16x8s af[2];
#pragma unroll
        for (int ks = 0; ks < 2; ++ks) af[ks] = cat8(tr4(Kt + (32 * ks + 8 * g + (i >> 2)) * HRS + 16 * kb + (i & 3) * 4), tr4(Kt + (32 * ks + 8 * g + 4 + (i >> 2)) * HRS + 16 * kb + (i & 3) * 4));
#pragma unroll
        for (int db = 0; db < 4; ++db) {
            f32x4 acc = {0.f, 0.f, 0.f, 0.f};
#pragma unroll
            for (int ks = 0; ks < 2; ++ks) { const bf16x8s bfr = cat8(tr4(Vt + (32 * ks + 8 * g + (i >> 2)) * HRS + 16 * db + (i & 3) * 4), tr4(Vt + (32 * ks + 8 * g + 4 + (i >> 2)) * HRS + 16 * db + (i & 3) * 4));
                acc = mfma16(af[ks], bfr, acc); }
            *(f32x4*)(UCT + ((size_t)cid * 64 + 16 * db + i) * 64 + 16 * kb + 4 * g) = acc;
        }
    }
    LDS_WAIT();
}
__device__ __forceinline__ void hgrn_h2(const Ctx& C) {
    const float* UCT = (const float*)(C.ws + WS_UCT); const float* DC = (const float*)(C.ws + WS_DC); bf16* SCT = (bf16*)(C.ws + WS_SCT);
    const int lane = C.lane;
    for (int w = C.gw; w < NBATCH * NH * 64; w += C.ngw) {
        const int chain = w >> 6, d = w & 63; float S = 0.f;
        for (int c0 = 0; c0 < 128; c0 += 16) {
            float u[16], dc[16];
#pragma unroll
            for (int j = 0; j < 16; ++j) { const size_t cid = (size_t)chain * 128 + c0 + j; u[j] = UCT[(cid * 64 + d) * 64 + lane]; dc[j] = DC[cid * 64 + lane]; }
#pragma unroll
            for (int j = 0; j < 16; ++j) { const size_t cid = (size_t)chain * 128 + c0 + j; SCT[(cid * 64 + d) * 64 + lane] = f2bf(S); S = dc[j] * S + u[j]; }
        }
        C.out[O_HP + (size_t)chain * 4096 + lane * 64 + d] = S;
    }
}
__device__ __forceinline__ void hgrn_h3(const Ctx& C, int cid) {
    const float* LF = (const float*)(C.ws + WS_LF); const bf16* QH = (const bf16*)(C.ws + WS_QH); const bf16* VH = (const bf16*)(C.ws + WS_VH); const bf16* GH = (const bf16*)(C.ws + WS_GH);
    const bf16* SCT = (const bf16*)(C.ws + WS_SCT); bf16* OMIX = (bf16*)(C.ws + WS_OMIX); const float* hgn = (const float*)C.in[I_HGN];
    const int lane = C.lane, i = lane & 15, g = lane >> 4;
    const int chain = cid >> 7, ci = cid & 127, b = chain >> 3, h = chain & 7, r0 = b * SEQ + ci * 64;
    LAS bf16* Vt = (LAS bf16*)(C.lds + RING_OFF + C.wave * 18432); LAS bf16* Kb = Vt + 64 * HRS; LAS bf16* Qh = Kb + 16 * HRS; LAS bf16* Qt = Qh + 16 * HRS;
    hg_stage_v(VH, r0, h, Vt, lane);
    const float* lfp = LF + (size_t)r0 * HW + h * HD + lane; const bf16* qp = QH + (size_t)r0 * HW + h * HD + lane;
    float eb[4];
    bf16x8s sfr[4][2];
#pragma unroll
    for (int db = 0; db < 4; ++db)
#pragma unroll
        for (int ks = 0; ks < 2; ++ks) sfr[db][ks] = *(const bf16x8s*)(SCT + ((size_t)cid * 64 + 16 * db + i) * 64 + 32 * ks + 8 * g);
#pragma unroll
    for (int is = 0; is < 4; ++is) {
        const float ri = is ? eb[is - 1] : 0.f, er = __expf(ri);
        { float run = 0.f;
#pragma unroll
          for (int tt = 0; tt < 16; ++tt) { const int t = 16 * is + tt; run += lfp[(size_t)t * HW]; const float qt = bf2f(qp[(size_t)t * HW]) * __expf(run);
              Qt[tt * HRS + lane] = f2bf(qt); Qh[tt * HRS + lane] = f2bf(qt * er); }
          eb[is] = ri + run; }
        LDS_WAIT();
        bf16x8s qhf[2], qtf[2];
#pragma unroll
        for (int ks = 0; ks < 2; ++ks) { qhf[ks] = *(const LAS bf16x8s*)(Qh + i * HRS + 32 * ks + 8 * g); qtf[ks] = *(const LAS bf16x8s*)(Qt + i * HRS + 32 * ks + 8 * g); }
        f32x4 o[4];
#pragma unroll
        for (int db = 0; db < 4; ++db) { o[db] = (f32x4){0.f, 0.f, 0.f, 0.f};
#pragma unroll
            for (int ks = 0; ks < 2; ++ks) o[db] = mfma16(sfr[db][ks], qhf[ks], o[db]); }
#pragma unroll
        for (int jp = 0; jp <= is / 2; ++jp) {
            f32x4 x[2];
#pragma unroll
            for (int jj = 0; jj < 2; ++jj) {
                const int j = 2 * jp + jj; x[jj] = (f32x4){0.f, 0.f, 0.f, 0.f};
                if (j <= is) {
                    { float run = (j ? eb[j - 1] : 0.f) - ri;
#pragma unroll
                      for (int ss = 0; ss < 16; ++ss) { const int s = 16 * j + ss; const float lf = lfp[(size_t)s * HW]; run += lf; Kb[ss * HRS + lane] = f2bf((1.f - __expf(lf)) * __expf(-run)); } }
                    LDS_WAIT();
#pragma unroll
                    for (int ks = 0; ks < 2; ++ks) { const bf16x8s kf = *(const LAS bf16x8s*)(Kb + i * HRS + 32 * ks + 8 * g); x[jj] = mfma16(kf, qtf[ks], x[jj]); }
                    if (j == is) {
#pragma unroll
                        for (int e = 0; e < 4; ++e) if (4 * g + e > i) x[jj][e] = 0.f;
                    }
                    LDS_WAIT();
                }
            }
            bf16x8s pb; { const unsigned w0 = pk_bf16(x[0][0], x[0][1]), w1 = pk_bf16(x[0][2], x[0][3]), w2 = pk_bf16(x[1][0], x[1][1]), w3 = pk_bf16(x[1][2], x[1][3]); const v4u ww = {w0, w1, w2, w3}; pb = __builtin_bit_cast(bf16x8s, ww); }
            const int j0 = 2 * jp, j1 = (2 * jp + 1 <= is) ? 2 * jp + 1 : 2 * jp;
#pragma unroll
            for (int db = 0; db < 4; ++db) { const bf16x8s vf = cat8(tr4(Vt + (16 * j0 + 4 * g + (i >> 2)) * HRS + 16 * db + (i & 3) * 4), tr4(Vt + (16 * j1 + 4 * g + (i >> 2)) * HRS + 16 * db + (i & 3) * 4));
                o[db] = mfma16(vf, pb, o[db]); }
        }
        float ss = 0.f;
#pragma unroll
        for (int db = 0; db < 4; ++db) ss += (o[db][0] * o[db][0] + o[db][1] * o[db][1]) + (o[db][2] * o[db][2] + o[db][3] * o[db][3]);
        ss += __shfl_xor(ss, 16); ss += __shfl_xor(ss, 32);
        const float r = rsqrtf(ss * (1.f / HD) + RMS_EPS); const size_t row = (size_t)(r0 + 16 * is + i);
#pragma unroll
        for (int db = 0; db < 4; ++db) { const int d0 = h * HD + 16 * db + 4 * g; const v2u gw = *(const v2u*)(GH + row * HW + d0); const f32x4 gn = *(const f32x4*)(hgn + d0);
            const float g0 = bflo(gw.x), g1 = bfhi(gw.x), g2 = bflo(gw.y), g3 = bfhi(gw.y);
            v2u w; w.x = pk_bf16(o[db][0] * r * gn.x * (g0 / (1.f + __expf(-g0))), o[db][1] * r * gn.y * (g1 / (1.f + __expf(-g1))));
            w.y = pk_bf16(o[db][2] * r * gn.z * (g2 / (1.f + __expf(-g2))), o[db][3] * r * gn.w * (g3 / (1.f + __expf(-g3))));
            *(v2u*)(OMIX + row * DM + d0) = w; }
    }
    LDS_WAIT();
}
typedef float f32x16 __attribute__((ext_vector_type(16)));
constexpr int SB_RS = 72;
constexpr int SB_TILE = 64 * SB_RS;
__device__ __forceinline__ f32x16 mfma32(bf16x8s a, bf16x8s b, f32x16 c) { return __builtin_amdgcn_mfma_f32_32x32x16_bf16(a, b, c, 0, 0, 0); }
__device__ __forceinline__ int sb_crow(int r, int hi) { return (r & 3) + 8 * (r >> 2) + 4 * hi; }
__device__ __forceinline__ void sb_subtile(const LAS bf16* Kp, const LAS bf16* Vp, const bf16x8s (&qf)[4], float bias2, bool diag, int key0, int qpos, int hi, float& Cc, f32x16& o0, f32x16& o1) {
    f32x16 p;
#pragma unroll
    for (int r = 0; r < 16; ++r) p[r] = bias2;
#pragma unroll
    for (int ks = 0; ks < 4; ++ks) { const bf16x8s kf = *(const LAS bf16x8s*)(Kp + 16 * ks); p = mfma32(kf, qf[ks], p); }
    float E = 1.f;
#pragma unroll
    for (int r = 0; r < 16; ++r) { float u = __builtin_amdgcn_exp2f(p[r]); if (diag) u = (key0 + r < qpos) ? u : 0.f; const float tt = E * u; E += tt; p[r] = tt; }
    const float Ti = __builtin_amdgcn_rcpf(E), Tp = __shfl_xor(Ti, 32);
    const float G = Ti * (hi ? Cc : Cc * Tp);
    Cc = Cc * Ti * Tp;
#pragma unroll
    for (int r = 0; r < 16; ++r) p[r] *= G;
    bf16x8s pa[2];
#pragma unroll
    for (int s = 0; s < 2; ++s) { const v4u ww = {pk_bf16(p[8 * s], p[8 * s + 1]), pk_bf16(p[8 * s + 2], p[8 * s + 3]), pk_bf16(p[8 * s + 4], p[8 * s + 5]), pk_bf16(p[8 * s + 6], p[8 * s + 7])}; pa[s] = __builtin_bit_cast(bf16x8s, ww); }
#pragma unroll
    for (int s = 0; s < 2; ++s) {
        const LAS bf16* vb = Vp + 8 * s * SB_RS;
        const bf16x8s v0 = cat8(tr4(vb), tr4(vb + 4 * SB_RS)), v1 = cat8(tr4(vb + 32), tr4(vb + 4 * SB_RS + 32));
        o0 = mfma32(pa[s], v0, o0); o1 = mfma32(pa[s], v1, o1);
    }
}
__device__ __forceinline__ void sb_unit(const Ctx& C, int b, int h, int qb) {
    const bf16* SQ = (const bf16*)(C.ws + WS_SQ); const bf16* SK = (const bf16*)(C.ws + WS_SK); const bf16* SV = (const bf16*)(C.ws + WS_SV); bf16* OMIX = (bf16*)(C.ws + WS_OMIX);
    const int tid = C.tid, lane = C.lane, r32 = lane & 31, hi = lane >> 5, w = C.wave;
    const int q0 = qb * 256, qlo = q0 + 32 * w, qpos = qlo + r32;
    LAS bf16* Kl = (LAS bf16*)(C.lds + RING_OFF); LAS bf16* Vl = Kl + 2 * SB_TILE;
    const float bias2 = ((const float*)C.in[I_SBB])[h] * LOG2E;
    bf16x8s qf[4];
#pragma unroll
    for (int ks = 0; ks < 4; ++ks) qf[ks] = *(const bf16x8s*)(SQ + (size_t)(b * SEQ + qpos) * HW + h * HD + 16 * ks + 8 * hi);
    const int srow = tid >> 3, sch = tid & 7;
    const bf16* gk = SK + (size_t)(b * SEQ + srow) * HW + h * HD + sch * 8; const bf16* gv = SV + (size_t)(b * SEQ + srow) * HW + h * HD + sch * 8;
    const int soff = srow * SB_RS + sch * 8;
    const int nt = (q0 + 256) / 64;
    v4u rk = *(const v4u*)(gk + (size_t)(nt - 1) * 64 * HW), rv = *(const v4u*)(gv + (size_t)(nt - 1) * 64 * HW);
    *(LAS v4u*)(Kl + soff) = rk; *(LAS v4u*)(Vl + soff) = rv;
    __syncthreads();
    f32x16 o0, o1;
#pragma unroll
    for (int r = 0; r < 16; ++r) { o0[r] = 0.f; o1[r] = 0.f; }
    float Cc = 1.f;
    const int kap = 16 * ((r32 >> 2) & 1) + (r32 & 3) + 4 * (r32 >> 3);
    const int koff = kap * SB_RS + 8 * hi;
    const int gi = lane >> 4, i16 = lane & 15;
    const int voff = (16 * hi + (i16 >> 2)) * SB_RS + 16 * (gi & 1) + (i16 & 3) * 4;
    int cur = 0;
    for (int t = nt - 1; t >= 0; --t) {
        if (t > 0) { rk = *(const v4u*)(gk + (size_t)(t - 1) * 64 * HW); rv = *(const v4u*)(gv + (size_t)(t - 1) * 64 * HW); }
        const LAS bf16* Kc = Kl + cur * SB_TILE; const LAS bf16* Vc = Vl + cur * SB_TILE;
        if (64 * t <= qlo + 30) {
            const bool diag = 64 * t + 63 >= qlo;
#pragma unroll
            for (int sub = 1; sub >= 0; --sub) {
                if (diag && 64 * t + 32 * sub > qlo + 30) continue;
                sb_subtile(Kc + sub * 32 * SB_RS + koff, Vc + sub * 32 * SB_RS + voff, qf, bias2, diag, 64 * t + 32 * sub + 16 * hi, qpos, hi, Cc, o0, o1);
            }
        }
        if (t > 0) { *(LAS v4u*)(Kl + (cur ^ 1) * SB_TILE + soff) = rk; *(LAS v4u*)(Vl + (cur ^ 1) * SB_TILE + soff) = rv; }
        __syncthreads();
        cur ^= 1;
    }
    bf16* orow = OMIX + (size_t)(b * SEQ + qlo) * DM + HW + h * HD + r32;
#pragma unroll
    for (int r = 0; r < 16; ++r) { const int q = sb_crow(r, hi); orow[(size_t)q * DM] = f2bf(o0[r]); orow[(size_t)q * DM + 32] = f2bf(o1[r]); }
}
__device__ __forceinline__ void sb_prompt_phase(const Ctx& C) {
    const int G = gridDim.x, bid = blockIdx.x;
    const int vcu = (G % 8 == 0) ? (bid % 8) * (G / 8) + bid / 8 : bid;
    for (int p = vcu; p < NBATCH * NH * 16; p += G) {
        const int bh = p >> 4, s = p & 15;
        sb_unit(C, bh >> 3, bh & 7, 31 - s);
        sb_unit(C, bh >> 3, bh & 7, s);
    }
}

__device__ __forceinline__ void sbs_item(const Ctx& C, int n, int half) {
    const bf16* SQ = (const bf16*)(C.ws + WS_SQ); const bf16* SK = (const bf16*)(C.ws + WS_SK); const bf16* SV = (const bf16*)(C.ws + WS_SV);
    const float* ck = (const float*)C.in[I_CK]; const float* cv = (const float*)C.in[I_CV]; const int* pt = (const int*)C.in[I_PT];
    float* PO = (float*)(C.ws + WS_SBP); float* PC = PO + (size_t)NDEC * 2 * NH * TDEC * HD;
    const int lane = C.lane, r32 = lane & 31, hi = lane >> 5, h = C.wave;
    LAS bf16* Kt = (LAS bf16*)(C.lds + RING_OFF + C.wave * 9216); LAS bf16* Vt = Kt + 32 * SB_RS;
    const float bias2 = ((const float*)C.in[I_SBB])[h] * LOG2E;
    const int qpos = PAST + r32;
    bf16x8s qf[4];
#pragma unroll
    for (int ks = 0; ks < 4; ++ks) { qf[ks] = (bf16x8s){0, 0, 0, 0, 0, 0, 0, 0}; if (r32 < TDEC) qf[ks] = *(const bf16x8s*)(SQ + (size_t)(MP + n * TDEC + r32) * HW + h * HD + 16 * ks + 8 * hi); }
    f32x16 o0, o1;
#pragma unroll
    for (int r = 0; r < 16; ++r) { o0[r] = 0.f; o1[r] = 0.f; }
    float Cc = 1.f;
    const int kap = 16 * ((r32 >> 2) & 1) + (r32 & 3) + 4 * (r32 >> 3);
    const LAS bf16* Kp = Kt + kap * SB_RS + 8 * hi;
    const int gi = lane >> 4, i16 = lane & 15;
    const LAS bf16* Vp = Vt + (16 * hi + (i16 >> 2)) * SB_RS + 16 * (gi & 1) + (i16 & 3) * 4;
    const int srow = lane >> 4, sch = lane & 15;
    if (half == 1) {
#pragma unroll
        for (int it = 0; it < 8; ++it) { const int row = it * 4 + srow; v2u kw = {0u, 0u}, vw = {0u, 0u};
            if (row < TDEC) { kw = *(const v2u*)(SK + (size_t)(MP + n * TDEC + row) * HW + h * HD + sch * 4); vw = *(const v2u*)(SV + (size_t)(MP + n * TDEC + row) * HW + h * HD + sch * 4); }
            *(LAS v2u*)(Kt + row * SB_RS + sch * 4) = kw; *(LAS v2u*)(Vt + row * SB_RS + sch * 4) = vw; }
        LDS_WAIT();
        sb_subtile(Kp, Vp, qf, bias2, true, PAST + 16 * hi, qpos, hi, Cc, o0, o1);
        LDS_WAIT();
    }
    const int pg_hi = half ? NPAGES - 1 : NPAGES / 2 - 1, nsteps = (NPAGES / 2) * 4;
    f32x4 rk[8], rv[8];
    { const size_t base = (((size_t)pt[n * NPAGES + pg_hi] * PAGE + 96 + srow) * NH + h) * HD + sch * 4;
#pragma unroll
      for (int it = 0; it < 8; ++it) { rk[it] = *(const f32x4*)(ck + base + (size_t)it * 4 * NH * HD); rv[it] = *(const f32x4*)(cv + base + (size_t)it * 4 * NH * HD); } }
    for (int st = 0; st < nsteps; ++st) {
#pragma unroll
        for (int it = 0; it < 8; ++it) { const int row = it * 4 + srow;
            const v2u kw = {pk_bf16(rk[it].x, rk[it].y), pk_bf16(rk[it].z, rk[it].w)}, vw = {pk_bf16(rv[it].x, rv[it].y), pk_bf16(rv[it].z, rv[it].w)};
            *(LAS v2u*)(Kt + row * SB_RS + sch * 4) = kw; *(LAS v2u*)(Vt + row * SB_RS + sch * 4) = vw; }
        if (st + 1 < nsteps) { const int s2 = st + 1, pg = pg_hi - (s2 >> 2), sub = 3 - (s2 & 3);
            const size_t base = (((size_t)pt[n * NPAGES + pg] * PAGE + 32 * sub + srow) * NH + h) * HD + sch * 4;
#pragma unroll
            for (int it = 0; it < 8; ++it) { rk[it] = *(const f32x4*)(ck + base + (size_t)it * 4 * NH * HD); rv[it] = *(const f32x4*)(cv + base + (size_t)it * 4 * NH * HD); } }
        LDS_WAIT();
        sb_subtile(Kp, Vp, qf, bias2, false, 0, qpos, hi, Cc, o0, o1);
        LDS_WAIT();
    }
    float* po = PO + ((size_t)(n * 2 + half) * NH + h) * TDEC * HD;
#pragma unroll
    for (int r = 0; r < 4; ++r) { po[(r + 4 * hi) * HD + r32] = o0[r]; po[(r + 4 * hi) * HD + 32 + r32] = o1[r]; }
    if (lane < TDEC) PC[((size_t)(n * 2 + half) * NH + h) * TDEC + lane] = Cc;
}
__device__ __forceinline__ void sbs_phase(const Ctx& C) {
    for (int it = blockIdx.x; it < NDEC * 2; it += gridDim.x) sbs_item(C, it >> 1, it & 1);
}
__device__ __forceinline__ void sbs_combine(const Ctx& C) {
    const float* PO = (const float*)(C.ws + WS_SBP); const float* PC = PO + (size_t)NDEC * 2 * NH * TDEC * HD; bf16* OMIX = (bf16*)(C.ws + WS_OMIX);
    const int gt = C.gw * 64 + C.lane, ngt = C.ngw * 64;
    for (int e = gt; e < NDEC * NH * TDEC * HD; e += ngt) {
        const int d = e & 63, q = (e >> 6) & 7, h = (e >> 9) & 7, n = e >> 12;
        const size_t i1 = ((size_t)(n * 2 + 1) * NH + h) * TDEC + q, i0 = ((size_t)(n * 2) * NH + h) * TDEC + q;
        OMIX[(size_t)(MP + n * TDEC + q) * DM + HW + h * HD + d] = f2bf(PO[i1 * HD + d] + PC[i1] * PO[i0 * HD + d]);
    }
}
constexpr int CA_KRS = 264, CA_VRS = 288;
constexpr int CA_KT = 64 * CA_KRS, CA_VT = 64 * CA_VRS;
__device__ __forceinline__ void ca_unit(const Ctx& C, int b, int hh, int qblk) {
    const bf16* QCA = (const bf16*)(C.ws + WS_QCA); const bf16* MK = (const bf16*)(C.ws + WS_MK); const bf16* MV = (const bf16*)(C.ws + WS_MV); bf16* OCA = (bf16*)(C.ws + WS_OMIX);
    const int tid = C.tid, lane = C.lane, r32 = lane & 31, hi = lane >> 5, w = C.wave, gi = lane >> 4, i16 = lane & 15;
    LAS bf16* Kl = (LAS bf16*)(C.lds + RING_OFF); LAS bf16* Vl = Kl + 2 * CA_KT; LAS float* wsf = (LAS float*)(Vl + 2 * CA_VT) + w * 32;
    const size_t qrow = (size_t)b * SEQ + 256 * qblk + 32 * w;
    bf16x8s qf[16];
#pragma unroll
    for (int ks = 0; ks < 16; ++ks) qf[ks] = *(const bf16x8s*)(QCA + (qrow + r32) * DM + hh * CAD + 16 * ks + 8 * hi);
    const bf16* gk = MK + (size_t)(b * NMEM) * DM + hh * CAD; const bf16* gv = MV + (size_t)(b * NMEM) * DM + hh * CAD;
    v4u rg[4];
#define CA_LOAD(i) do { const bf16* src_ = ((i) < 4 ? gk : gv) + (size_t)(((i) & 3) * 64) * DM; _Pragma("unroll") for (int p_ = 0; p_ < 4; ++p_) { const int id_ = tid + 512 * p_; rg[p_] = *(const v4u*)(src_ + (size_t)(id_ >> 5) * DM + (id_ & 31) * 8); } } while (0)
#define CA_WRITE(i) do { _Pragma("unroll") for (int p_ = 0; p_ < 4; ++p_) { const int id_ = tid + 512 * p_; if ((i) < 4) *(LAS v4u*)(Kl + ((i) & 1) * CA_KT + (id_ >> 5) * CA_KRS + (id_ & 31) * 8) = rg[p_]; else *(LAS v4u*)(Vl + ((i) & 1) * CA_VT + (id_ >> 5) * CA_VRS + (id_ & 31) * 8) = rg[p_]; } } while (0)
    CA_LOAD(0); CA_WRITE(0); __syncthreads();
    f32x16 s[8];
#pragma unroll
    for (int j = 0; j < 8; ++j)
#pragma unroll
        for (int r = 0; r < 16; ++r) s[j][r] = 0.f;
#pragma unroll
    for (int kt = 0; kt < 4; ++kt) {
        if (kt < 3) CA_LOAD(kt + 1);
        const LAS bf16* Kc = Kl + (kt & 1) * CA_KT + r32 * CA_KRS + 8 * hi;
#pragma unroll
        for (int sub = 0; sub < 2; ++sub)
#pragma unroll
            for (int ks = 0; ks < 16; ++ks) { const bf16x8s kf = *(const LAS bf16x8s*)(Kc + sub * 32 * CA_KRS + 16 * ks); s[2 * kt + sub] = mfma32(kf, qf[ks], s[2 * kt + sub]); }
        if (kt < 3) { CA_WRITE(kt + 1); } __syncthreads();
    }
    float mx = s[0][0];
#pragma unroll
    for (int j = 0; j < 8; ++j)
#pragma unroll
        for (int r = 0; r < 16; ++r) mx = fmaxf(mx, s[j][r]);
    mx = fmaxf(mx, __shfl_xor(mx, 32));
    float l = 0.f;
#pragma unroll
    for (int j = 0; j < 8; ++j)
#pragma unroll
        for (int r = 0; r < 16; ++r) { s[j][r] = __builtin_amdgcn_exp2f(s[j][r] - mx); l += s[j][r]; }
    l += __shfl_xor(l, 32);
    if (hi == 0) wsf[r32] = l;
    bf16x8s pa[8][2];
#pragma unroll
    for (int j = 0; j < 8; ++j)
#pragma unroll
        for (int s2 = 0; s2 < 2; ++s2) { const v4u ww = {pk_bf16(s[j][8 * s2], s[j][8 * s2 + 1]), pk_bf16(s[j][8 * s2 + 2], s[j][8 * s2 + 3]), pk_bf16(s[j][8 * s2 + 4], s[j][8 * s2 + 5]), pk_bf16(s[j][8 * s2 + 6], s[j][8 * s2 + 7])}; pa[j][s2] = __builtin_bit_cast(bf16x8s, ww); }
    CA_LOAD(4); CA_WRITE(4); __syncthreads();
    f32x16 o[8];
#pragma unroll
    for (int j = 0; j < 8; ++j)
#pragma unroll
        for (int r = 0; r < 16; ++r) o[j][r] = 0.f;
#pragma unroll
    for (int kt = 0; kt < 4; ++kt) {
        if (kt >= 1 && kt < 3) CA_LOAD(kt + 5);
        const LAS bf16* Vc = Vl + (kt & 1) * CA_VT + (4 * hi + (i16 >> 2)) * CA_VRS + 16 * (gi & 1) + (i16 & 3) * 4;
#pragma unroll
        for (int sub = 0; sub < 2; ++sub)
#pragma unroll
            for (int s2 = 0; s2 < 2; ++s2)
#pragma unroll
                for (int dt = 0; dt < 8; ++dt) { const LAS bf16* vb = Vc + (32 * sub + 16 * s2) * CA_VRS + 32 * dt; const bf16x8s vf = cat8(tr4(vb), tr4(vb + 8 * CA_VRS)); o[dt] = mfma32(pa[2 * kt + sub][s2], vf, o[dt]); }
        if (kt == 0) CA_LOAD(5);
        if (kt < 3) { CA_WRITE(kt + 5); }
        __syncthreads();
    }
#undef CA_LOAD
#undef CA_WRITE
    float rl[16];
#pragma unroll
    for (int r = 0; r < 16; ++r) rl[r] = 1.f / wsf[sb_crow(r, hi)];
    bf16* orow = OCA + qrow * DM + hh * CAD + r32;
#pragma unroll
    for (int r = 0; r < 16; ++r) { const int q = sb_crow(r, hi);
#pragma unroll
        for (int dt = 0; dt < 8; ++dt) orow[(size_t)q * DM + 32 * dt] = f2bf(o[dt][r] * rl[r]); }
}
__device__ __forceinline__ void cas_item(const Ctx& C, int n, int hh) {
    const bf16* QCA = (const bf16*)(C.ws + WS_QCA); const float* cmk = (const float*)C.in[I_MK]; const float* cmv = (const float*)C.in[I_MV]; bf16* OCA = (bf16*)(C.ws + WS_OMIX);
    const int tid = C.tid, lane = C.lane, r32 = lane & 31, hi = lane >> 5, w = C.wave, gi = lane >> 4, i16 = lane & 15;
    LAS bf16* Vt = (LAS bf16*)(C.lds + RING_OFF) + w * (32 * CA_VRS);
    LAS float* part = (LAS float*)(C.lds + RING_OFF);
    LAS float* red = (LAS float*)(C.lds + RING_OFF + 8 * 32 * CA_VRS * 2);
    bf16x8s qf[16];
#pragma unroll
    for (int ks = 0; ks < 16; ++ks) { qf[ks] = (bf16x8s){0, 0, 0, 0, 0, 0, 0, 0}; if (r32 < TDEC) qf[ks] = *(const bf16x8s*)(QCA + (size_t)(MP + n * TDEC + r32) * DM + hh * CAD + 16 * ks + 8 * hi); }
    f32x16 s;
#pragma unroll
    for (int r = 0; r < 16; ++r) s[r] = 0.f;
    const float* kr = cmk + ((size_t)(n * NMEM + 32 * w + r32) * CAH + hh) * CAD + 8 * hi;
#pragma unroll
    for (int kb = 0; kb < 2; ++kb) {
        f32x4 ra[8], rb[8];
#pragma unroll
        for (int k8 = 0; k8 < 8; ++k8) { ra[k8] = *(const f32x4*)(kr + 16 * (8 * kb + k8)); rb[k8] = *(const f32x4*)(kr + 16 * (8 * kb + k8) + 4); }
#pragma unroll
        for (int k8 = 0; k8 < 8; ++k8) { const v4u ww = {pk_bf16(ra[k8].x, ra[k8].y), pk_bf16(ra[k8].z, ra[k8].w), pk_bf16(rb[k8].x, rb[k8].y), pk_bf16(rb[k8].z, rb[k8].w)};
            s = mfma32(__builtin_bit_cast(bf16x8s, ww), qf[8 * kb + k8], s); }
    }
    const float* vr = cmv + ((size_t)(n * NMEM + 32 * w) * CAH + hh) * CAD + lane * 4;
#pragma unroll
    for (int vb = 0; vb < 2; ++vb) {
        f32x4 rvv[16];
#pragma unroll
        for (int j = 0; j < 16; ++j) rvv[j] = *(const f32x4*)(vr + (size_t)(16 * vb + j) * CAH * CAD);
#pragma unroll
        for (int j = 0; j < 16; ++j) { const v2u ww = {pk_bf16(rvv[j].x, rvv[j].y), pk_bf16(rvv[j].z, rvv[j].w)}; *(LAS v2u*)(Vt + (16 * vb + j) * CA_VRS + lane * 4) = ww; }
    }
    float mx = s[0];
#pragma unroll
    for (int r = 1; r < 16; ++r) mx = fmaxf(mx, s[r]);
    mx = fmaxf(mx, __shfl_xor(mx, 32));
    if (lane < TDEC) red[w * TDEC + lane] = mx;
    LDS_WAIT(); __syncthreads();
    { float m2 = red[(r32 & 7)];
#pragma unroll
      for (int ww = 1; ww < 8; ++ww) m2 = fmaxf(m2, red[ww * TDEC + (r32 & 7)]);
      mx = m2; }
    float l = 0.f;
#pragma unroll
    for (int r = 0; r < 16; ++r) { s[r] = __builtin_amdgcn_exp2f(s[r] - mx); l += s[r]; }
    l += __shfl_xor(l, 32);
    if (lane < TDEC) red[64 + w * TDEC + lane] = l;
    bf16x8s pa[2];
#pragma unroll
    for (int s2 = 0; s2 < 2; ++s2) { const v4u ww = {pk_bf16(s[8 * s2], s[8 * s2 + 1]), pk_bf16(s[8 * s2 + 2], s[8 * s2 + 3]), pk_bf16(s[8 * s2 + 4], s[8 * s2 + 5]), pk_bf16(s[8 * s2 + 6], s[8 * s2 + 7])}; pa[s2] = __builtin_bit_cast(bf16x8s, ww); }
    LDS_WAIT();
    f32x16 o[8];
#pragma unroll
    for (int j = 0; j < 8; ++j)
#pragma unroll
        for (int r = 0; r < 16; ++r) o[j][r] = 0.f;
    const LAS bf16* Vc = Vt + (4 * hi + (i16 >> 2)) * CA_VRS + 16 * (gi & 1) + (i16 & 3) * 4;
#pragma unroll
    for (int s2 = 0; s2 < 2; ++s2)
#pragma unroll
        for (int dt = 0; dt < 8; ++dt) { const LAS bf16* vb = Vc + 16 * s2 * CA_VRS + 32 * dt; const bf16x8s vf = cat8(tr4(vb), tr4(vb + 8 * CA_VRS)); o[dt] = mfma32(pa[s2], vf, o[dt]); }
    LDS_WAIT(); __syncthreads();
#pragma unroll
    for (int r = 0; r < 4; ++r)
#pragma unroll
        for (int dt = 0; dt < 8; ++dt) part[(w * TDEC + r + 4 * hi) * CAD + 32 * dt + r32] = o[dt][r];
    LDS_WAIT(); __syncthreads();
    { const int q = tid >> 6, d0 = (tid & 63) * 4;
      float lt = 0.f;
#pragma unroll
      for (int ww = 0; ww < 8; ++ww) lt += red[64 + ww * TDEC + q];
      f32x4 a = {0.f, 0.f, 0.f, 0.f};
#pragma unroll
      for (int ww = 0; ww < 8; ++ww) a += *(const LAS f32x4*)(part + (ww * TDEC + q) * CAD + d0);
      const float il = 1.f / lt; const v2u ow = {pk_bf16(a.x * il, a.y * il), pk_bf16(a.z * il, a.w * il)};
      *(v2u*)(OCA + (size_t)(MP + n * TDEC + q) * DM + hh * CAD + d0) = ow; }
    LDS_WAIT(); __syncthreads();
}
__device__ __forceinline__ void ca_phase(const Ctx& C) {
    for (int it = blockIdx.x; it < NDEC * CAH; it += gridDim.x) cas_item(C, it >> 2, it & 3);
    const int G = gridDim.x, bid = blockIdx.x; const int vcu = (G % 8 == 0) ? (bid % 8) * (G / 8) + bid / 8 : bid;
    for (int u = vcu; u < NBATCH * CAH * 32; u += G) ca_unit(C, u >> 7, (u >> 5) & 3, u & 31);
}
__device__ __forceinline__ void hgrn_chain(const Ctx& C, int rowbase, int T, int h, const float* S0, float* Sout) {
    const float* LF = (const float*)(C.ws + WS_LF); const bf16* QH = (const bf16*)(C.ws + WS_QH); const bf16* VH = (const bf16*)(C.ws + WS_VH); const bf16* GH = (const bf16*)(C.ws + WS_GH);
    bf16* OMIX = (bf16*)(C.ws + WS_OMIX); const float* hgn = (const float*)C.in[I_HGN];
    const int lane = C.lane; const float gn = hgn[h * HD + lane];
    float S[64];
#pragma unroll
    for (int k = 0; k < 64; ++k) S[k] = S0 ? S0[k * 64 + lane] : 0.f;
    for (int t = 0; t < T; ++t) {
        const size_t off = (size_t)(rowbase + t) * HW + h * HD + lane;
        const float fk = __expf(LF[off]), kk = 1.f - fk, qk = bf2f(QH[off]), vd = bf2f(VH[off]), g = bf2f(GH[off]);
        float o = 0.f;
#pragma unroll
        for (int k = 0; k < 64; ++k) { const float f_ = rdlane(fk, k), k_ = rdlane(kk, k), q_ = rdlane(qk, k); S[k] = f_ * S[k] + k_ * vd; o += S[k] * q_; }
        const float r = rsqrtf(wave_sum(o * o) * (1.f / HD) + RMS_EPS);
        OMIX[(size_t)(rowbase + t) * DM + h * HD + lane] = f2bf(o * r * gn * (g / (1.f + __expf(-g))));
    }
#pragma unroll
    for (int k = 0; k < 64; ++k) Sout[k * 64 + lane] = S[k];
}
template <bool SAMPLE>
__device__ __forceinline__ void sb_query(const Ctx& C, int row, int h, int nkeys, int seq  ) {
    const bf16* SQ = (const bf16*)(C.ws + WS_SQ); const bf16* SK = (const bf16*)(C.ws + WS_SK); const bf16* SV = (const bf16*)(C.ws + WS_SV);
    const float* ck = (const float*)C.in[I_CK]; const float* cv = (const float*)C.in[I_CV]; const int* pt = (const int*)C.in[I_PT];
    bf16* OMIX = (bf16*)(C.ws + WS_OMIX);
    const int lane = C.lane; const float bias2 = ((const float*)C.in[I_SBB])[h] * LOG2E;
    float q[64];
    { const v4u* qp = (const v4u*)(SQ + (size_t)row * HW + h * HD);
#pragma unroll
      for (int c = 0; c < 8; ++c) { const v4u w = qp[c]; q[8 * c] = bflo(w.x); q[8 * c + 1] = bfhi(w.x); q[8 * c + 2] = bflo(w.y); q[8 * c + 3] = bfhi(w.y); q[8 * c + 4] = bflo(w.z); q[8 * c + 5] = bfhi(w.z); q[8 * c + 6] = bflo(w.w); q[8 * c + 7] = bfhi(w.w); } }
    float Cc = 1.f, o = 0.f;
    for (int base = nkeys > 0 ? ((nkeys - 1) & ~63) : -1; base >= 0; base -= 64) {
        const int j = base + lane; const bool valid = j < nkeys; const int jc = valid ? j : nkeys - 1;
        float z = 0.f;
        if (SAMPLE && jc < PAST) {
            const float* kr = ck + (((size_t)pt[seq * NPAGES + (jc >> 7)] * PAGE + (jc & 127)) * NH + h) * HD;
#pragma unroll
            for (int c = 0; c < 16; ++c) { const f32x4 w = ((const f32x4*)kr)[c]; z += q[4 * c] * w.x + q[4 * c + 1] * w.y + q[4 * c + 2] * w.z + q[4 * c + 3] * w.w; }
        } else {
            const size_t krow = SAMPLE ? (size_t)(MP + seq * TDEC + (jc - PAST)) : (size_t)seq * SEQ + jc;
            const v4u* kr = (const v4u*)(SK + krow * HW + h * HD);
#pragma unroll
            for (int c = 0; c < 8; ++c) { const v4u w = kr[c]; z += q[8 * c] * bflo(w.x) + q[8 * c + 1] * bfhi(w.x) + q[8 * c + 2] * bflo(w.y) + q[8 * c + 3] * bfhi(w.y) + q[8 * c + 4] * bflo(w.z) + q[8 * c + 5] * bfhi(w.z) + q[8 * c + 6] * bflo(w.w) + q[8 * c + 7] * bfhi(w.w); }
        }
        const float u = valid ? exp2f(z + bias2) : 0.f;
        float incl = 1.f / (1.f + u);
#pragma unroll
        for (int off = 1; off < 64; off <<= 1) { const float y = __shfl_down(incl, off); if (lane + off < 64) incl *= y; }
        const float a = u * incl * Cc;
        Cc *= __shfl(incl, 0);
        const int nk = nkeys - base < 64 ? nkeys - base : 64;
        for (int jj = 0; jj < nk; ++jj) {
            const float aj = __shfl(a, jj); const int jk = base + jj; float vv;
            if (SAMPLE && jk < PAST) vv = cv[(((size_t)pt[seq * NPAGES + (jk >> 7)] * PAGE + (jk & 127)) * NH + h) * HD + lane];
            else { const size_t vrow = SAMPLE ? (size_t)(MP + seq * TDEC + (jk - PAST)) : (size_t)seq * SEQ + jk; vv = bf2f(SV[vrow * HW + h * HD + lane]); }
            o += aj * vv;
        }
    }
    OMIX[(size_t)row * DM + HW + h * HD + lane] = f2bf(o);
}
__device__ __forceinline__ void p2_mix1(const Ctx& C) {
    for (int rep = 0; rep < (PROBE_PH == 102 ? 2 : 1); ++rep) {
    for (int cid = C.gw; cid < NBATCH * NH * (SEQ / 64); cid += C.ngw) hgrn_h1(C, cid);
    const int w = C.gw, nw = C.ngw;
    for (int i = w; i < NDEC * NH; i += nw) { const int n = i / NH, h = i % NH; hgrn_chain(C, MP + n * TDEC, TDEC, h, (const float*)C.in[I_SH] + (size_t)i * 4096, C.out + O_HS + (size_t)i * 4096); }
    }
    __syncthreads();
    for (int rep = 0; rep < (PROBE_PH == 101 ? 2 : 1); ++rep) sbs_phase(C);
    __syncthreads();
    for (int rep = 0; rep < (PROBE_PH == 100 ? 2 : 1); ++rep) sb_prompt_phase(C);
}
__device__ __forceinline__ void p4_mix3(const Ctx& C) {
    for (int cid = C.gw; cid < NBATCH * NH * (SEQ / 64); cid += C.ngw) hgrn_h3(C, cid);
}

__device__ __forceinline__ void thin_row(const float* xin, const bf16* br, const float* gpost, float* xout, const float* gpre, bf16* hrow, int lane) {
    const f32x4* xr = (const f32x4*)xin + lane; const v2u* bp = (const v2u*)br + lane; const f32x4* gp = (const f32x4*)gpost + lane;
    f32x4 b[4]; float s = 0.f;
#pragma unroll
    for (int j = 0; j < 4; ++j) { const v2u w = bp[64 * j]; b[j] = (f32x4){bflo(w.x), bfhi(w.x), bflo(w.y), bfhi(w.y)}; s += (b[j].x * b[j].x + b[j].y * b[j].y) + (b[j].z * b[j].z + b[j].w * b[j].w); }
    const float r = rsqrtf(wave_sum(s) * (1.f / DM) + RMS_EPS);
    float s2 = 0.f;
#pragma unroll
    for (int j = 0; j < 4; ++j) { b[j] = xr[64 * j] + b[j] * r * gp[64 * j]; s2 += (b[j].x * b[j].x + b[j].y * b[j].y) + (b[j].z * b[j].z + b[j].w * b[j].w); }
    f32x4* xo = (f32x4*)xout + lane;
#pragma unroll
    for (int j = 0; j < 4; ++j) xo[64 * j] = b[j];
    if (hrow) {
        const float r2 = rsqrtf(wave_sum(s2) * (1.f / DM) + RMS_EPS); const f32x4* g2 = (const f32x4*)gpre + lane; v2u* o8 = (v2u*)hrow + lane;
#pragma unroll
        for (int j = 0; j < 4; ++j) { const f32x4 gg = g2[64 * j]; v2u w; w.x = pk_bf16(b[j].x * r2 * gg.x, b[j].y * r2 * gg.y); w.y = pk_bf16(b[j].z * r2 * gg.z, b[j].w * r2 * gg.w); o8[64 * j] = w; }
    }
}
template <int WHICH>
__device__ __forceinline__ void p_thin(const Ctx& C) {
    const bf16* BR = (const bf16*)(C.ws + WS_BR); bf16* H = (bf16*)(C.ws + WS_H);
    float* X1 = (float*)(C.ws + WS_X1); float* X2 = (float*)(C.ws + WS_X2);
    const float* gpost = (const float*)C.in[WHICH == 0 ? I_GMIXPOST : WHICH == 1 ? I_GCAPOST : I_GFFNPOST];
    const float* gpre = (const float*)C.in[WHICH == 0 ? I_GCAPRE : I_GFFNPRE];
    for (int m = C.gw; m < MT; m += C.ngw) {
        const float* xin; float* xout;
        if (WHICH == 0) { xin = m < MP ? (const float*)C.in[I_XP] + (size_t)m * DM : (const float*)C.in[I_XS] + (size_t)(m - MP) * DM; xout = X1 + (size_t)m * DM; }
        else if (WHICH == 1) { xin = X1 + (size_t)m * DM; xout = X2 + (size_t)m * DM; }
        else { xin = X2 + (size_t)m * DM; xout = m < MP ? C.out + O_YP + (size_t)m * DM : C.out + O_YS + (size_t)(m - MP) * DM; }
        thin_row(xin, BR + (size_t)m * DM, gpost, xout, gpre, WHICH == 2 ? nullptr : H + (size_t)m * DM, C.lane);
    }
}

__device__ __forceinline__ void p6_naive(const Ctx& C) {
    const bf16* QCA = (const bf16*)(C.ws + WS_QCA); const bf16* MK = (const bf16*)(C.ws + WS_MK); const bf16* MV = (const bf16*)(C.ws + WS_MV);
    const float* cmk = (const float*)C.in[I_MK]; const float* cmv = (const float*)C.in[I_MV]; bf16* OCA = (bf16*)(C.ws + WS_OMIX);
    const int lane = C.lane;
    for (int it = C.gw; it < MT * CAH; it += C.ngw) {
        const int row = it >> 2, h = it & 3;
        const v2u qw = *((const v2u*)(QCA + (size_t)row * DM + h * CAD) + lane);
        const float q0 = bflo(qw.x), q1 = bfhi(qw.x), q2 = bflo(qw.y), q3 = bfhi(qw.y);
        float mx = -1e30f, l = 0.f, o0 = 0.f, o1 = 0.f, o2 = 0.f, o3 = 0.f;
        for (int m = 0; m < NMEM; ++m) {
            float k0, k1, k2, k3, v0, v1, v2, v3;
            if (row < MP) { const size_t off = ((size_t)((row >> 13) * NMEM + m)) * DM + h * CAD; const v2u kw = *((const v2u*)(MK + off) + lane), vw = *((const v2u*)(MV + off) + lane);
                k0 = bflo(kw.x); k1 = bfhi(kw.x); k2 = bflo(kw.y); k3 = bfhi(kw.y); v0 = bflo(vw.x); v1 = bfhi(vw.x); v2 = bflo(vw.y); v3 = bfhi(vw.y); }
            else { const size_t off = ((size_t)(((row - MP) >> 3) * NMEM + m)) * DM + h * CAD; const f32x4 kw = *((const f32x4*)(cmk + off) + lane), vw = *((const f32x4*)(cmv + off) + lane);
                k0 = kw.x; k1 = kw.y; k2 = kw.z; k3 = kw.w; v0 = vw.x; v1 = vw.y; v2 = vw.z; v3 = vw.w; }
            const float s = wave_sum(q0 * k0 + q1 * k1 + q2 * k2 + q3 * k3);
            const float mn = fmaxf(mx, s), sc = exp2f(mx - mn), p = exp2f(s - mn);
            l = l * sc + p; o0 = o0 * sc + p * v0; o1 = o1 * sc + p * v1; o2 = o2 * sc + p * v2; o3 = o3 * sc + p * v3; mx = mn;
        }
        const float il = 1.f / l; v2u w; w.x = pk_bf16(o0 * il, o1 * il); w.y = pk_bf16(o2 * il, o3 * il);
        *((v2u*)(OCA + (size_t)row * DM + h * CAD) + lane) = w;
    }
}

__device__ __forceinline__ float gelu_tanh(float x) { return x / (1.f + __expf(-1.5957691216057308f * (x + 0.044715f * x * x * x))); }
__device__ __forceinline__ void ld8(const bf16* p, float (&v)[8]) { const v4u w = *(const v4u*)p; v[0] = bflo(w.x); v[1] = bfhi(w.x); v[2] = bflo(w.y); v[3] = bfhi(w.y); v[4] = bflo(w.z); v[5] = bfhi(w.z); v[6] = bflo(w.w); v[7] = bfhi(w.w); }
__device__ __forceinline__ void ld8f(const float* p, float (&v)[8]) { const f32x4 a = *(const f32x4*)p, b = *(const f32x4*)(p + 4); v[0] = a.x; v[1] = a.y; v[2] = a.z; v[3] = a.w; v[4] = b.x; v[5] = b.y; v[6] = b.z; v[7] = b.w; }
__device__ __forceinline__ void p10_convgate(const Ctx& C) {
    const bf16* U = (const bf16*)(C.ws + WS_U); bf16* G = (bf16*)(C.ws + WS_G);
    const float* cw = (const float*)C.in[I_CONVW]; const float* cb = (const float*)C.in[I_CONVB]; const float* sc = (const float*)C.in[I_SC];
    constexpr int NCH = DFF / 8, NPI = (MP / 32) * NCH, NSI = NDEC * NCH;
    const int gt = C.gw * 64 + C.lane, ngt = C.ngw * 64;
    for (int it = gt; it < NPI + NSI; it += ngt) {
        int row0, nrows, c; float m1[2][8], m2[2][8];
        if (it < NPI) { const int seg = it / NCH; c = (it % NCH) * 8; row0 = seg * 32; nrows = 32;
            if ((row0 & (SEQ - 1)) == 0) {
#pragma unroll
                for (int hf = 0; hf < 2; ++hf)
#pragma unroll
                    for (int e = 0; e < 8; ++e) { m1[hf][e] = 0.f; m2[hf][e] = 0.f; }
            } else {
#pragma unroll
                for (int hf = 0; hf < 2; ++hf) { ld8(U + (size_t)(row0 - 1) * DFF2 + c + hf * DFF, m1[hf]); ld8(U + (size_t)(row0 - 2) * DFF2 + c + hf * DFF, m2[hf]); }
            }
        } else { const int j = it - NPI, n = j / NCH; c = (j % NCH) * 8; row0 = MP + n * TDEC; nrows = TDEC;
#pragma unroll
            for (int hf = 0; hf < 2; ++hf) { ld8f(sc + ((size_t)n * 2 + 1) * DFF2 + c + hf * DFF, m1[hf]); ld8f(sc + ((size_t)n * 2) * DFF2 + c + hf * DFF, m2[hf]); }
        }
        float w0[2][8], w1[2][8], w2[2][8], bb[2][8];
#pragma unroll
        for (int hf = 0; hf < 2; ++hf) { ld8f(cw + c + hf * DFF, w0[hf]); ld8f(cw + DFF2 + c + hf * DFF, w1[hf]); ld8f(cw + 2 * DFF2 + c + hf * DFF, w2[hf]); ld8f(cb + c + hf * DFF, bb[hf]); }
        const bf16* up = U + (size_t)row0 * DFF2 + c; bf16* gp = G + (size_t)row0 * DFF + c;
#pragma unroll 4
        for (int r = 0; r < nrows; ++r) {
            float u[2][8], res[2][8];
            ld8(up + (size_t)r * DFF2, u[0]); ld8(up + (size_t)r * DFF2 + DFF, u[1]);
#pragma unroll
            for (int hf = 0; hf < 2; ++hf)
#pragma unroll
                for (int e = 0; e < 8; ++e) { res[hf][e] = bb[hf][e] + w0[hf][e] * m2[hf][e] + w1[hf][e] * m1[hf][e] + w2[hf][e] * u[hf][e]; m2[hf][e] = m1[hf][e]; m1[hf][e] = u[hf][e]; }
            v4u o;
            o.x = pk_bf16(gelu_tanh(res[0][0]) * res[1][0], gelu_tanh(res[0][1]) * res[1][1]); o.y = pk_bf16(gelu_tanh(res[0][2]) * res[1][2], gelu_tanh(res[0][3]) * res[1][3]);
            o.z = pk_bf16(gelu_tanh(res[0][4]) * res[1][4], gelu_tanh(res[0][5]) * res[1][5]); o.w = pk_bf16(gelu_tanh(res[0][6]) * res[1][6], gelu_tanh(res[0][7]) * res[1][7]);
            *(v4u*)(gp + (size_t)r * DFF) = o;
        }
    }
}
enum { PH_PRO = 0, PH_INPROJ, PH_MIX1, PH_SCAN, PH_MIX3, PH_OPROJ, PH_THIN0, PH_CQ, PH_CA, PH_CO, PH_THIN1, PH_UP, PH_CONV, PH_DOWN, PH_THIN2, NPH };
#ifndef MK_ONE_LAUNCH
#define MK_ONE_LAUNCH 1
#endif
__global__ void __launch_bounds__(NTHREADS, 2) fwd(Args args) {
    extern __shared__ __attribute__((aligned(16))) unsigned char lds_raw[];
    Ctx C;
    C.in = args.in; C.out = args.out; C.ws = args.ws; C.lds = (LAS unsigned char*)lds_raw;
    C.tid = threadIdx.x; C.lane = C.tid & 63; C.wave = __builtin_amdgcn_readfirstlane(C.tid >> 6);
    C.gw = blockIdx.x * NWAVES + C.wave; C.ngw = gridDim.x * NWAVES;
    const int G = gridDim.x, bid = blockIdx.x;
    volatile LAS unsigned* MISC = (volatile LAS unsigned*)(C.lds + MISC_OFF);
    for (int u = C.tid; u < (LDS_BYTES - LDSCTL_OFF) / 4; u += NTHREADS) ((LAS unsigned*)(C.lds + LDSCTL_OFF))[u] = 0u;
    __syncthreads();
    const int lo = args.ph_lo, hi = args.ph_hi;
    XcdBarrier bar; bar.bar = (unsigned*)(C.ws + WS_CTL) + CW_BAR; bar.x = 0; bar.st = nullptr;
    bar = xcd_barrier_post((unsigned*)(C.ws + WS_CTL) + CW_BAR, MISC + 8);
#define IN(k) (lo <= (k) && (k) < hi)
#define SEAM(k) do { if (IN(k) && IN((k) + 1)) xcd_barrier(bar); } while (0)
#define PHASE(k, ...) do { if (IN(k)) { __VA_ARGS__ if constexpr (PROBE_PH == (k)) { __VA_ARGS__ } } } while (0)
    bf16* H = (bf16*)(C.ws + WS_H);
    PHASE(PH_PRO, p0_prologue(C);); SEAM(PH_PRO);
    PHASE(PH_INPROJ, { pg8::Gemm g{H, (const bf16*)(C.ws + WS_WIN), MT, DIN, DM}; pg8::StaticOrder S; S.init(MT, DIN, G, bid);
          pg8::EpiInProj E{(bf16*)(C.ws + WS_QH), (bf16*)(C.ws + WS_VH), (bf16*)(C.ws + WS_GH), (bf16*)(C.ws + WS_SQ), (bf16*)(C.ws + WS_SK), (bf16*)(C.ws + WS_SV), (float*)(C.ws + WS_LF),
                           (const float*)(C.ws + WS_LB), C.out + O_KP, C.out + O_VP, C.out + O_KS, C.out + O_VS, SQ_SCALE};
          pg8::gemm_phase<pg8::EpiInProj, pg8::StaticOrder, true, true>(C.lds + RING_OFF, g, S, E); }
        { pg8::Gemm g{(const bf16*)(C.ws + WS_MN), (const bf16*)(C.ws + WS_WCKV), NBATCH * NMEM, 2 * DM, DM}; pg8::StaticOrder S; S.init(NBATCH * NMEM, 2 * DM, G, (bid + G - 184 % G) % G);
          pg8::EpiMemKV E{(bf16*)(C.ws + WS_MK), (bf16*)(C.ws + WS_MV), C.out + O_MKP, C.out + O_MVP};
          pg8::gemm_phase<pg8::EpiMemKV, pg8::StaticOrder, true, true>(C.lds + RING_OFF, g, S, E); }); SEAM(PH_INPROJ);
    PHASE(PH_MIX1, p2_mix1(C);); SEAM(PH_MIX1);
    PHASE(PH_SCAN, hgrn_h2(C); sbs_combine(C);); SEAM(PH_SCAN);
    PHASE(PH_MIX3, p4_mix3(C);); SEAM(PH_MIX3);
    PHASE(PH_OPROJ, pg8::Gemm g{(const bf16*)(C.ws + WS_OMIX), (const bf16*)(C.ws + WS_WO), MT, DM, DM}; pg8::StaticOrder S; S.init(MT, DM, G, bid);
        pg8::EpiStore<false> E{(bf16*)(C.ws + WS_BR), DM, 1.f, nullptr};
        pg8::gemm_phase<pg8::EpiStore<false>, pg8::StaticOrder, true, true>(C.lds + RING_OFF, g, S, E);); SEAM(PH_OPROJ);
    PHASE(PH_THIN0, p_thin<0>(C);); SEAM(PH_THIN0);
    PHASE(PH_CQ, pg8::Gemm g{H, (const bf16*)(C.ws + WS_WCQ), MT, DM, DM}; pg8::StaticOrder S; S.init(MT, DM, G, bid);
        pg8::EpiStore<false> E{(bf16*)(C.ws + WS_QCA), DM, CQ_SCALE, nullptr};
        pg8::gemm_phase<pg8::EpiStore<false>, pg8::StaticOrder, true, true>(C.lds + RING_OFF, g, S, E);); SEAM(PH_CQ);
    PHASE(PH_CA, ca_phase(C);); SEAM(PH_CA);
    PHASE(PH_CO, pg8::Gemm g{(const bf16*)(C.ws + WS_OMIX), (const bf16*)(C.ws + WS_WCO), MT, DM, DM}; pg8::StaticOrder S; S.init(MT, DM, G, bid);
        pg8::EpiStore<false> E{(bf16*)(C.ws + WS_BR), DM, 1.f, nullptr};
        pg8::gemm_phase<pg8::EpiStore<false>, pg8::StaticOrder, true, true>(C.lds + RING_OFF, g, S, E);); SEAM(PH_CO);
    PHASE(PH_THIN1, p_thin<1>(C);); SEAM(PH_THIN1);
    PHASE(PH_UP, pg8::Gemm g{H, (const bf16*)(C.ws + WS_WUP), MT, DFF2, DM}; pg8::StaticOrder S; S.init(MT, DFF2, G, bid);
        pg8::EpiStore<true> E{(bf16*)(C.ws + WS_U), DFF2, 1.f, C.out};
        pg8::gemm_phase<pg8::EpiStore<true>, pg8::StaticOrder, true, true>(C.lds + RING_OFF, g, S, E);); SEAM(PH_UP);
    PHASE(PH_CONV, p10_convgate(C);); SEAM(PH_CONV);
    PHASE(PH_DOWN, pg8::Gemm g{(const bf16*)(C.ws + WS_G), (const bf16*)(C.ws + WS_WDN), MT, DM, DFF}; pg8::StaticOrder S; S.init(MT, DM, G, bid);
        pg8::EpiStore<false> E{(bf16*)(C.ws + WS_BR), DM, 1.f, nullptr};
        pg8::gemm_phase<pg8::EpiStore<false>, pg8::StaticOrder, true, true>(C.lds + RING_OFF, g, S, E);); SEAM(PH_DOWN);
    PHASE(PH_THIN2, p_thin<2>(C););
#undef IN
#undef PHASE
#undef SEAM
}

extern "C" void kernel_launch(void* const* d_in, const int* in_sizes, int n_in, void* d_out, int out_size, void* d_ws, size_t ws_size, hipStream_t stream) {
    static int grid = 0;
    if (grid == 0) {
        if (n_in != N_IN || (size_t)out_size != O_END || ws_size < WS_END) { fprintf(stderr, "kernel_launch: unexpected problem: n_in %d out %d ws %zu\n", n_in, out_size, ws_size); grid = -1; return; }
        int dev = 0, cus = 0, per_cu = 0;
        if (hipGetDevice(&dev) != hipSuccess || hipDeviceGetAttribute(&cus, hipDeviceAttributeMultiprocessorCount, dev) != hipSuccess) { grid = -1; return; }
        if (hipFuncSetAttribute((const void*)fwd, hipFuncAttributeMaxDynamicSharedMemorySize, LDS_BYTES) != hipSuccess) { fprintf(stderr, "kernel_launch: hipFuncSetAttribute failed\n"); grid = -1; return; }
        if (hipOccupancyMaxActiveBlocksPerMultiprocessor(&per_cu, (const void*)fwd, NTHREADS, LDS_BYTES) != hipSuccess || per_cu < 1) fprintf(stderr, "kernel_launch: occupancy query says %d\n", per_cu);
        (void)hipGetLastError();
        grid = cus;
    }
    if (grid < 0) return;
    (void)hipMemsetAsync((char*)d_ws + WS_CTL, 0, CTL_ZERO_BYTES, stream);
    Args a{};
    for (int i = 0; i < N_IN; ++i) a.in[i] = d_in[i];
    a.out = (float*)d_out; a.ws = (unsigned char*)d_ws;
    a.ph_lo = 0; a.ph_hi = NPH;
    hipLaunchKernelGGL(fwd, dim3(grid), dim3(NTHREADS), LDS_BYTES, stream, a);
}
```

```cpp
#include <hip/hip_runtime.h>
#include <cstdio>
#include <cstdint>
namespace pg8 {
#define PG8_LAS __attribute__((address_space(3)))
typedef unsigned short bf16_t;
typedef short bf16x8 __attribute__((ext_vector_type(8)));
typedef float f32x4 __attribute__((ext_vector_type(4)));
typedef unsigned u32x4 __attribute__((ext_vector_type(4)));
constexpr int BM = 256, BK = 64, HALF = 128, HTB = HALF * BK * 2  , STAGE_BYTES = 8 * HTB, NXCD = 8, WGM = 8;

__host__ __device__ __forceinline__ int lds_byte(int r, int c) { const int st = (r >> 4) * 2 + (c >> 5), rr = r & 15, cc = c & 31, ob = rr * 64 + cc * 2; return st * 1024 + (ob ^ (((ob >> 9) & 1) << 5)); }
__host__ __device__ __forceinline__ void stage_rc(int b, int& R, int& C) { const int st = b / 1024, sb = b % 1024, swz = sb ^ (((sb >> 9) & 1) << 5); R = (st >> 1) * 16 + swz / 64; C = (st & 1) * 32 + (swz % 64) / 2; }
__host__ __device__ __forceinline__ int perm32(int rho) { const int n = rho >> 4, i = rho & 15; return 8 * (i >> 2) + 4 * n + (i & 3); }

struct Unit { int pm, pn; };
struct Gemm { const bf16_t* A; const bf16_t* Bt; int M, N, K; };

struct StaticOrder {
    int nM, nN, nwg, G, c;
    __host__ __device__ void init(int M, int N, int G_, int c_) { nM = M / BM; nN = N / BM; nwg = nM * nN; G = G_; c = c_; }
    __host__ __device__ bool next(int i, Unit& u) const {
        const long L = (long)i * G + c; if (L >= nwg) return false;
        int wgid = (int)L; { const int q = nwg / NXCD, r = nwg % NXCD, xcd = wgid % NXCD, off = wgid / NXCD; wgid = (xcd < r ? xcd * (q + 1) : r * (q + 1) + (xcd - r) * q) + off; }
        const int nig = WGM * nN, gid = wgid / nig, fm = gid * WGM, gsz = (nM - fm) < WGM ? (nM - fm) : WGM;
        u.pm = fm + ((wgid % nig) % gsz); u.pn = (wgid % nig) / gsz; return true;
    }
    __device__ __forceinline__ void a_ready(const Unit&) const {}
    __device__ __forceinline__ void done(const Unit&) const {}
};

__device__ __forceinline__ unsigned cvt_pk_bf16(float lo, float hi) { unsigned r; asm volatile("v_cvt_pk_bf16_f32 %0, %1, %2" : "=v"(r) : "v"(lo), "v"(hi)); return r; }
typedef float f32x2 __attribute__((ext_vector_type(2)));
typedef __bf16 bf16x2_t __attribute__((ext_vector_type(2)));
__device__ __forceinline__ unsigned pk_bf16(float lo, float hi) { f32x2 v = {lo, hi}; bf16x2_t b = __builtin_convertvector(v, bf16x2_t); return __builtin_bit_cast(unsigned, b); }
__device__ __forceinline__ u32x4 pk8(f32x4 a, f32x4 b) { u32x4 w; w.x = pk_bf16(a[0], a[1]); w.y = pk_bf16(a[2], a[3]); w.z = pk_bf16(b[0], b[1]); w.w = pk_bf16(b[2], b[3]); return w; }

template <bool CAP> struct EpiStore {
    static constexpr bool PERM = true, AFTER_DRAIN = false;
    bf16_t* O; int ldc; float scale; float* outb;
    __device__ __forceinline__ void operator()(const f32x4 (&acc)[2][2][4][2], const Unit& u, int wr, int wc, int fr, int fq) const {
        const int row0 = u.pm * BM + wr * 64 + fr, col0 = u.pn * BM + wc * 32 + 8 * fq;
#pragma unroll
        for (int ai = 0; ai < 2; ++ai)
#pragma unroll
            for (int m = 0; m < 4; ++m) {
                const int row = row0 + ai * HALF + m * 16;
                float* cap = nullptr;
                if constexpr (CAP) {
                    if (row < 16384) { const int t = row & 8191; if (t >= 8190) cap = outb + 34668544 + (size_t)((row >> 13) * 2 + (t - 8190)) * 5632; }
                    else { const int r2 = row - 16384, t = r2 & 7; if (t >= 6) cap = outb + 40982528 + (size_t)((r2 >> 3) * 2 + (t - 6)) * 5632; }
                }
#pragma unroll
                for (int bj = 0; bj < 2; ++bj) {
                    const int col = col0 + bj * HALF;
                    const f32x4 v0 = acc[ai][bj][m][0] * scale, v1 = acc[ai][bj][m][1] * scale;
                    *(u32x4*)(O + (size_t)row * ldc + col) = pk8(v0, v1);
                    if constexpr (CAP) { if (cap) { *(f32x4*)(cap + col) = v0; *(f32x4*)(cap + col + 4) = v1; } }
                }
            }
    }
};

struct EpiInProj {
    static constexpr bool PERM = true, AFTER_DRAIN = false;
    bf16_t *QH, *VH, *GH, *SQ, *SK, *SV; float* LF; const float* LB; float* kp; float* vp; float* ks; float* vs; float sqscale;
    __device__ __forceinline__ void operator()(const f32x4 (&acc)[2][2][4][2], const Unit& u, int wr, int wc, int fr, int fq) const {
        const int seg = u.pn >> 1;
        const int row0 = u.pm * BM + wr * 64 + fr, col0 = (u.pn & 1) * BM + wc * 32 + 8 * fq;
        if (seg == 1) {
#pragma unroll
            for (int bj = 0; bj < 2; ++bj) {
                const int col = col0 + bj * HALF;
                const f32x4 l0 = *(const f32x4*)(LB + col), l1 = *(const f32x4*)(LB + col + 4);
#pragma unroll
                for (int ai = 0; ai < 2; ++ai)
#pragma unroll
                    for (int m = 0; m < 4; ++m) {
                        const int row = row0 + ai * HALF + m * 16;
                        f32x4 o0, o1;
#pragma unroll
                        for (int e = 0; e < 4; ++e) {
                            const float s0 = 1.f / (1.f + __expf(-acc[ai][bj][m][0][e])), s1 = 1.f / (1.f + __expf(-acc[ai][bj][m][1][e]));
                            o0[e] = __logf(l0[e] + (1.f - l0[e]) * s0); o1[e] = __logf(l1[e] + (1.f - l1[e]) * s1);
                        }
                        *(f32x4*)(LF + (size_t)row * 512 + col) = o0; *(f32x4*)(LF + (size_t)row * 512 + col + 4) = o1;
                    }
            }
            return;
        }
        bf16_t* dst = seg == 0 ? QH : seg == 2 ? VH : seg == 3 ? GH : seg == 4 ? SQ : seg == 5 ? SK : SV;
        const float sc = seg == 4 ? sqscale : 1.f;
        float* fp = seg == 5 ? kp : seg == 6 ? vp : nullptr;
        float* fs = seg == 5 ? ks : vs;
#pragma unroll
        for (int ai = 0; ai < 2; ++ai)
#pragma unroll
            for (int m = 0; m < 4; ++m) {
                const int row = row0 + ai * HALF + m * 16;
#pragma unroll
                for (int bj = 0; bj < 2; ++bj) {
                    const int col = col0 + bj * HALF;
                    const f32x4 v0 = acc[ai][bj][m][0], v1 = acc[ai][bj][m][1];
                    *(u32x4*)(dst + (size_t)row * 512 + col) = pk8(v0 * sc, v1 * sc);
                    if (fp) { float* f = row < 16384 ? fp + (size_t)row * 512 + col : fs + (size_t)(row - 16384) * 512 + col; *(f32x4*)f = v0; *(f32x4*)(f + 4) = v1; }
                }
            }
    }
};

struct EpiMemKV {
    static constexpr bool PERM = true, AFTER_DRAIN = false;
    bf16_t *MK, *MV; float *ok, *ov;
    __device__ __forceinline__ void operator()(const f32x4 (&acc)[2][2][4][2], const Unit& u, int wr, int wc, int fr, int fq) const {
        const int seg = u.pn >> 2;
        const int row0 = u.pm * BM + wr * 64 + fr, col0 = (u.pn & 3) * BM + wc * 32 + 8 * fq;
        bf16_t* dst = seg == 0 ? MK : MV; float* fo = seg == 0 ? ok : ov;
#pragma unroll
        for (int ai = 0; ai < 2; ++ai)
#pragma unroll
            for (int m = 0; m < 4; ++m) {
                const int row = row0 + ai * HALF + m * 16;
#pragma unroll
                for (int bj = 0; bj < 2; ++bj) {
                    const int col = col0 + bj * HALF;
                    const f32x4 v0 = acc[ai][bj][m][0], v1 = acc[ai][bj][m][1];
                    *(u32x4*)(dst + (size_t)row * 1024 + col) = pk8(v0, v1);
                    *(f32x4*)(fo + (size_t)row * 1024 + col) = v0; *(f32x4*)(fo + (size_t)row * 1024 + col + 4) = v1;
                }
            }
    }
};

template <class Epi, class Sched, bool ALIGN_EPI = false, bool SP2 = false>
__device__ __forceinline__ void gemm_phase(PG8_LAS unsigned char* lds, const Gemm g, const Sched& S, const Epi& E) {
    const int tid = threadIdx.x, wid = __builtin_amdgcn_readfirstlane(tid >> 6), lane = tid & 63, wr = wid >> 2, wc = wid & 3, fr = lane & 15, fq = lane >> 4;
    const int K = g.K, nt = K / BK;
    unsigned voffA[2], voffB[2];
#pragma unroll
    for (int i = 0; i < 2; ++i) { int R, C; stage_rc(tid * 16 + i * 8192, R, C); const int Rb = Epi::PERM ? ((R & ~31) + perm32(R & 31)) : R;
        voffA[i] = (unsigned)(R * K + C) * 2u; voffB[i] = (unsigned)(Rb * K + C) * 2u; }
    const size_t kstep = (size_t)(BK * 2);
    const size_t hstep = (size_t)HALF * K * 2;
    const size_t tstep = 2 * hstep;
    const unsigned ldsw = (unsigned)wid * 1024u;
    const int aoff = lds_byte(wr * 64 + fr, fq * 8), boff = lds_byte(wc * 32 + fr, fq * 8);
#define PG8_SA(b, h) (((b) * 2 + (h)) * HTB)
#define PG8_SB(b, h) ((4 + (b) * 2 + (h)) * HTB)
#define PG8_STAGE(bufoff, gbase, voff) do { _Pragma("unroll") for (int _i = 0; _i < 2; ++_i) \
        __builtin_amdgcn_global_load_lds((const unsigned*)((const char*)(gbase) + (voff)[_i]), (PG8_LAS unsigned*)(lds + (bufoff) + ldsw + _i * 8192), 16, 0, 0); } while (0)
#define PG8_LDA(dst, b, h) do { _Pragma("unroll") for (int m = 0; m < 4; ++m) _Pragma("unroll") for (int k = 0; k < 2; ++k) dst[m][k] = *(const PG8_LAS bf16x8*)(lds + PG8_SA(b, h) + aoff + m * 2048 + k * 1024); } while (0)
#define PG8_LDB(dst, b, h) do { _Pragma("unroll") for (int n = 0; n < 2; ++n) _Pragma("unroll") for (int k = 0; k < 2; ++k) dst[n][k] = *(const PG8_LAS bf16x8*)(lds + PG8_SB(b, h) + boff + n * 2048 + k * 1024); } while (0)
#define PG8_MMA(ai, bj, At, Bt) do { __builtin_amdgcn_s_setprio(1); _Pragma("unroll") for (int m = 0; m < 4; ++m) _Pragma("unroll") for (int n = 0; n < 2; ++n) _Pragma("unroll") for (int k = 0; k < 2; ++k) \
        acc[ai][bj][m][n] = __builtin_amdgcn_mfma_f32_16x16x32_bf16(Bt[n][k], At[m][k], acc[ai][bj][m][n], 0, 0, 0); __builtin_amdgcn_s_setprio(0); } while (0)
#define PG8_WAIT_V(n) asm volatile("s_waitcnt vmcnt(" #n ")" ::: "memory")
#define PG8_WAIT_L(n) asm volatile("s_waitcnt lgkmcnt(" #n ")" ::: "memory")
#define PG8_BAR __builtin_amdgcn_s_barrier()
#define PG8_SCHED __builtin_amdgcn_sched_barrier(0)
    Unit cur, nxt; int ui = 0;
    if (!S.next(0, cur)) return;
    f32x4 acc[2][2][4][2];
#pragma unroll
    for (int a = 0; a < 2; ++a)
#pragma unroll
        for (int b = 0; b < 2; ++b)
#pragma unroll
            for (int m = 0; m < 4; ++m)
#pragma unroll
                for (int n = 0; n < 2; ++n) acc[a][b][m][n] = (f32x4){0.f, 0.f, 0.f, 0.f};
    bf16x8 At[4][2], B0[2][2], B1[2][2];
    const char* cA = (const char*)g.A + (size_t)cur.pm * tstep; const char* cB = (const char*)g.Bt + (size_t)cur.pn * tstep;
    S.a_ready(cur);
    if constexpr (SP2) {
        PG8_STAGE(PG8_SB(0, 0), cB, voffB); PG8_STAGE(PG8_SB(0, 1), cB + hstep, voffB); PG8_STAGE(PG8_SA(0, 0), cA, voffA); PG8_STAGE(PG8_SA(0, 1), cA + hstep, voffA);
        if (wr == 1) PG8_BAR;
        PG8_WAIT_V(2); PG8_BAR;
        PG8_STAGE(PG8_SB(1, 0), cB + kstep, voffB); PG8_STAGE(PG8_SA(1, 0), cA + kstep, voffA); PG8_STAGE(PG8_SB(1, 1), cB + hstep + kstep, voffB);
        PG8_WAIT_V(6); PG8_BAR;
    } else {
        PG8_STAGE(PG8_SB(0, 0), cB, voffB); PG8_STAGE(PG8_SA(0, 0), cA, voffA); PG8_STAGE(PG8_SB(0, 1), cB + hstep, voffB); PG8_STAGE(PG8_SA(0, 1), cA + hstep, voffA);
        if (wr == 1) PG8_BAR;
        PG8_WAIT_V(4); PG8_BAR;
        PG8_STAGE(PG8_SB(1, 0), cB + kstep, voffB); PG8_STAGE(PG8_SA(1, 0), cA + kstep, voffA); PG8_STAGE(PG8_SB(1, 1), cB + hstep + kstep, voffB);
        PG8_WAIT_V(6); PG8_BAR;
    }
    for (;;) {
        const bool has_next = S.next(ui + 1, nxt);
        const char* nA = has_next ? (const char*)g.A + (size_t)nxt.pm * tstep : cA; const char* nB = has_next ? (const char*)g.Bt + (size_t)nxt.pn * tstep : cB;
        for (int t = 0; t < nt; t += 2) {
            const bool last = (t == nt - 2);
            const char* a1 = cA + (size_t)(t + 1) * kstep;
            const char* a2 = last ? nA : cA + (size_t)(t + 2) * kstep; const char* b2 = last ? nB : cB + (size_t)(t + 2) * kstep;
            const char* a3 = a2 + kstep; const char* b3 = b2 + kstep;
            if (last && has_next) S.a_ready(nxt);
            if constexpr (SP2) {
            PG8_LDB(B0, 0, 0); PG8_LDB(B1, 0, 1); PG8_SCHED; PG8_LDA(At, 0, 0); PG8_STAGE(PG8_SA(1, 1), a1 + hstep, voffA);
            PG8_WAIT_V(8); PG8_WAIT_L(0); PG8_BAR; PG8_MMA(0, 0, At, B0); PG8_MMA(0, 1, At, B1); PG8_BAR; PG8_SCHED;
            PG8_LDA(At, 0, 1); PG8_STAGE(PG8_SB(0, 0), b2, voffB); PG8_STAGE(PG8_SB(0, 1), b2 + hstep, voffB); PG8_STAGE(PG8_SA(0, 0), a2, voffA);
            PG8_WAIT_V(8); PG8_WAIT_L(0); PG8_BAR; PG8_MMA(1, 0, At, B0); PG8_MMA(1, 1, At, B1); PG8_BAR; PG8_SCHED;
            PG8_LDB(B0, 1, 0); PG8_LDB(B1, 1, 1); PG8_SCHED; PG8_LDA(At, 1, 0); PG8_STAGE(PG8_SA(0, 1), a2 + hstep, voffA);
            PG8_WAIT_V(8); PG8_WAIT_L(0); PG8_BAR; PG8_MMA(0, 0, At, B0); PG8_MMA(0, 1, At, B1); PG8_BAR; PG8_SCHED;
            PG8_LDA(At, 1, 1); PG8_STAGE(PG8_SB(1, 0), b3, voffB); PG8_STAGE(PG8_SB(1, 1), b3 + hstep, voffB); PG8_STAGE(PG8_SA(1, 0), a3, voffA);
            PG8_WAIT_V(8); PG8_WAIT_L(0); PG8_BAR; PG8_MMA(1, 0, At, B0); PG8_MMA(1, 1, At, B1); PG8_BAR; PG8_SCHED;
            } else {
            PG8_LDB(B0, 0, 0); PG8_SCHED; PG8_LDA(At, 0, 0); PG8_STAGE(PG8_SA(1, 1), a1 + hstep, voffA);
            PG8_WAIT_L(8); PG8_BAR; PG8_WAIT_L(0); PG8_MMA(0, 0, At, B0); PG8_BAR; PG8_SCHED;
            PG8_LDB(B1, 0, 1); PG8_STAGE(PG8_SB(0, 0), b2, voffB);
            PG8_BAR; PG8_WAIT_L(0); PG8_MMA(0, 1, At, B1); PG8_BAR;
            PG8_LDA(At, 0, 1); PG8_STAGE(PG8_SA(0, 0), a2, voffA);
            PG8_BAR; PG8_WAIT_L(0); PG8_MMA(1, 0, At, B0); PG8_BAR; PG8_SCHED;
            PG8_STAGE(PG8_SB(0, 1), b2 + hstep, voffB);
            PG8_WAIT_V(6); PG8_BAR; PG8_MMA(1, 1, At, B1); PG8_BAR;
            PG8_LDB(B0, 1, 0); PG8_SCHED; PG8_LDA(At, 1, 0); PG8_STAGE(PG8_SA(0, 1), a2 + hstep, voffA);
            PG8_WAIT_L(8); PG8_BAR; PG8_WAIT_L(0); PG8_MMA(0, 0, At, B0); PG8_BAR; PG8_SCHED;
            PG8_LDB(B1, 1, 1); PG8_STAGE(PG8_SB(1, 0), b3, voffB);
            PG8_BAR; PG8_WAIT_L(0); PG8_MMA(0, 1, At, B1); PG8_BAR;
            PG8_LDA(At, 1, 1); PG8_STAGE(PG8_SA(1, 0), a3, voffA);
            PG8_BAR; PG8_WAIT_L(0); PG8_MMA(1, 0, At, B0); PG8_BAR; PG8_SCHED;
            PG8_STAGE(PG8_SB(1, 1), b3 + hstep, voffB);
            PG8_WAIT_V(6); PG8_BAR; PG8_MMA(1, 1, At, B1); PG8_BAR;
            }
        }
        if constexpr (ALIGN_EPI) { if (wr == 0) PG8_BAR; }
        if constexpr (!Epi::AFTER_DRAIN) { E(acc, cur, wr, wc, fr, fq); S.done(cur); }
        if (!has_next) break;
#pragma unroll
        for (int a = 0; a < 2; ++a)
#pragma unroll
            for (int b = 0; b < 2; ++b)
#pragma unroll
                for (int m = 0; m < 4; ++m)
#pragma unroll
                    for (int n = 0; n < 2; ++n) acc[a][b][m][n] = (f32x4){0.f, 0.f, 0.f, 0.f};
        cur = nxt; cA = nA; cB = nB; ++ui;
        if constexpr (ALIGN_EPI) { if (wr == 1) PG8_BAR; }
    }
    PG8_WAIT_V(0);
    if constexpr (!ALIGN_EPI) { if (wr == 0) PG8_BAR; }
    PG8_BAR;
    if constexpr (Epi::AFTER_DRAIN) { E.fused(acc, cur, wr, wc, fr, fq, lds, wid, lane); S.done(cur); }
#undef PG8_SA
#undef PG8_SB
#undef PG8_STAGE
#undef PG8_LDA
#undef PG8_LDB
#undef PG8_MMA
#undef PG8_WAIT_V
#undef PG8_WAIT_L
#undef PG8_BAR
#undef PG8_SCHED
}
}
#define GAS __attribute__((address_space(1)))
#define LAS __attribute__((address_space(3)))
#define LDS_WAIT() asm volatile("s_waitcnt lgkmcnt(0)" ::: "memory")
#define VM_WAIT() asm volatile("s_waitcnt vmcnt(0)" ::: "memory")
#define XB_TMO      128
#define XB_XCNT(j)  (256  + 64 * (j))
#define XB_XSUB(j)  (1280 + 64 * (j))
#define XB_XGEN(j)  (2304 + 64 * (j))
#define XB_TOP      3328
#define XB_TOPGEN   3392
#define XCD_BAR_WORDS 3456
#define XB_SPIN_CAP (1u << 23)

__device__ __forceinline__ unsigned xb_ld(unsigned* p)              { return __hip_atomic_load(p, __ATOMIC_RELAXED, __HIP_MEMORY_SCOPE_AGENT); }
__device__ __forceinline__ unsigned xb_add(unsigned* p, unsigned v) { return __hip_atomic_fetch_add(p, v, __ATOMIC_RELAXED, __HIP_MEMORY_SCOPE_AGENT); }
__device__ __forceinline__ unsigned xb_xcc_id() { return (unsigned)__builtin_amdgcn_s_getreg((3 << 11) | 20) & 0xFu; }
#define XB_SPIN(cond, bar) do { unsigned _sp = 0; while (cond) { __builtin_amdgcn_s_sleep(1); \
    if ((++_sp & 255u) == 0u) { if (xb_ld(&(bar)[XB_TMO])) break; if (_sp > XB_SPIN_CAP) { atomicAdd(&(bar)[XB_TMO], 1u); break; } } } } while (0)

struct XcdBarrier {
    unsigned* bar; unsigned x;
    volatile LAS unsigned* st;
};

__device__ __forceinline__ XcdBarrier xcd_barrier_post(unsigned* bar, volatile LAS unsigned* st) {
    XcdBarrier b; b.bar = bar; b.x = xb_xcc_id(); b.st = st;
    if (threadIdx.x == 0) (void)xb_add(&bar[XB_XCNT(b.x)], 1u);
    return b;
}
__device__ __forceinline__ void xcd_barrier_complete(unsigned* bar, unsigned x, unsigned& nloc, unsigned& nx) {
    const unsigned G = gridDim.x * gridDim.y * gridDim.z;
    unsigned sum, cnt, mine, sp = 0u;
    for (;;) {
        sum = 0u; cnt = 0u; mine = 0u;
#pragma unroll
        for (unsigned j = 0; j < 16; ++j) { const unsigned c = xb_ld(&bar[XB_XCNT(j)]); sum += c; cnt += (c > 0u) ? 1u : 0u; mine = (j == x) ? c : mine; }
        if (sum == G) break;
        __builtin_amdgcn_s_sleep(1);
        if ((++sp & 255u) == 0u) { if (xb_ld(&bar[XB_TMO])) break; if (sp > XB_SPIN_CAP) { atomicAdd(&bar[XB_TMO], 1u); break; } }
    }
    nloc = mine > 0u ? mine : 1u; nx = cnt > 0u ? cnt : 1u;
}

__device__ __forceinline__ void xcd_barrier(const XcdBarrier& b) {
    asm volatile("s_waitcnt vmcnt(0)" ::: "memory");
    __syncthreads();
    if (threadIdx.x == 0) {
        unsigned* bar = b.bar;
        __builtin_amdgcn_s_waitcnt(0);
        unsigned nloc = b.st[0], nx = b.st[1];
        if (nloc == 0u) { xcd_barrier_complete(bar, b.x, nloc, nx); b.st[0] = nloc; b.st[1] = nx; }
        const unsigned old = xb_add(&bar[XB_XSUB(b.x)], 1u);
        const unsigned gen = old / nloc;
        if (old + 1u == (gen + 1u) * nloc) {
            __builtin_amdgcn_fence(__ATOMIC_RELEASE, "agent");
            asm volatile("s_waitcnt vmcnt(0)" ::: "memory");
            const unsigned og = xb_add(&bar[XB_TOP], 1u);
            const unsigned tg = og / nx;
            if (og + 1u == (tg + 1u) * nx) xb_add(&bar[XB_TOPGEN], 1u);
            else XB_SPIN(xb_ld(&bar[XB_TOPGEN]) == tg, bar);
            __builtin_amdgcn_fence(__ATOMIC_ACQUIRE, "agent");
            xb_add(&bar[XB_XGEN(b.x)], 1u);
            asm volatile("s_waitcnt vmcnt(0)" ::: "memory");
        } else {
            XB_SPIN(xb_ld(&bar[XB_XGEN(b.x)]) == gen, bar);
            __builtin_amdgcn_fence(__ATOMIC_ACQUIRE, "agent");
            asm volatile("s_waitcnt vmcnt(0)" ::: "memory");
        }
    }
    __syncthreads();
}
#define PROBE_PH -1
constexpr int NWAVES = 8, NTHREADS = 512;
constexpr int DM = 1024, SEQ = 8192, NBATCH = 2, MP = NBATCH * SEQ, NDEC = 128, TDEC = 8, MS = NDEC * TDEC, MT = MP + MS;
constexpr int DIN = 3584, HW = 512, NH = 8, HD = 64;
constexpr int NMEM = 256, CAH = 4, CAD = 256, DFF = 2816, DFF2 = 5632;
constexpr int PAST = 2048, PAGE = 128, NPAGES = 16;
constexpr float RMS_EPS = 1e-6f, LOG2E = 1.4426950408889634f;
constexpr float SQ_SCALE = 0.125f * LOG2E;
constexpr float CQ_SCALE = 0.0625f * LOG2E;
enum { I_XP = 0, I_XS, I_CK, I_CV, I_SH, I_SC, I_MK, I_MV, I_PT, I_MEM, I_WIN, I_HGN, I_HLB, I_SBB, I_WO, I_GMIXPRE, I_GMIXPOST, I_GCAPRE, I_GCAPOST, I_GMEM,
       I_WCQ, I_WCK, I_WCV, I_WCO, I_GFFNPRE, I_GFFNPOST, I_WUP, I_CONVW, I_CONVB, I_WDN, N_IN };
constexpr size_t O_YP = 0, O_YS = 16777216, O_KP = 17825792, O_VP = 26214400, O_HP = 34603008, O_CP = 34668544, O_MKP = 34691072, O_MVP = 35215360,
                 O_KS = 35739648, O_VS = 36263936, O_HS = 36788224, O_CS = 40982528, O_END = 42424320;
constexpr size_t MiB = 1u << 20;
constexpr size_t WS_CTL = 0, CTL_ZERO_BYTES = 1 * MiB;
constexpr size_t WS_WIN = 2 * MiB, WS_WO = 9 * MiB, WS_WCQ = 11 * MiB, WS_WCO = 13 * MiB, WS_WCKV = 15 * MiB, WS_WUP = 19 * MiB, WS_WDN = 30 * MiB;
constexpr size_t WS_LB = 36 * MiB, WS_MN = 37 * MiB, WS_MK = 38 * MiB, WS_MV = 39 * MiB;
constexpr size_t WS_H = 40 * MiB, WS_QH = 74 * MiB, WS_LF = 91 * MiB, WS_VH = 125 * MiB, WS_GH = 142 * MiB, WS_SQ = 159 * MiB, WS_SK = 176 * MiB, WS_SV = 193 * MiB;
constexpr size_t WS_OMIX = 210 * MiB, WS_BR = 244 * MiB, WS_X1 = 278 * MiB, WS_X2 = 346 * MiB, WS_QCA = 414 * MiB, WS_U = 448 * MiB, WS_G = 635 * MiB, WS_UCT = 730 * MiB, WS_DC = 762 * MiB, WS_SCT = 763 * MiB, WS_SBP = 780 * MiB, WS_END = 786 * MiB;
constexpr int CW_BAR = 4096;
constexpr int RING_OFF = 0, RING_BYTES = 162816, LDSCTL_OFF = RING_BYTES, MISC_OFF = LDSCTL_OFF + 320, LDS_BYTES = 163840;

typedef unsigned short bf16;
typedef unsigned v4u __attribute__((ext_vector_type(4)));
typedef unsigned v2u __attribute__((ext_vector_type(2)));
typedef float f32x4 __attribute__((ext_vector_type(4)));
using pg8::pk_bf16;
__device__ __forceinline__ float bf2f(unsigned short b) { return __uint_as_float((unsigned)b << 16); }
__device__ __forceinline__ float bflo(unsigned w) { return __uint_as_float(w << 16); }
__device__ __forceinline__ float bfhi(unsigned w) { return __uint_as_float(w & 0xffff0000u); }
__device__ __forceinline__ unsigned short f2bf(float f) { return (unsigned short)(pk_bf16(f, 0.f) & 0xffffu); }
__device__ __forceinline__ float wave_sum(float v) {
#pragma unroll
    for (int o = 1; o < 64; o <<= 1) v += __shfl_xor(v, o);
    return v;
}
__device__ __forceinline__ float rdlane(float v, int l) { return __uint_as_float((unsigned)__builtin_amdgcn_readlane((int)__float_as_uint(v), l)); }

struct Args { const void* in[N_IN]; float* out; unsigned char* ws; int ph_lo, ph_hi; };
struct Ctx { const void* const* in; float* out; unsigned char* ws; LAS unsigned char* lds; int tid, lane, wave, gw, ngw; };

__device__ __forceinline__ void p0_transpose_item(const float* W, int K, int N, bf16* WT, int row_off, LAS float* scr, int item, int lane) {
    const int nblk = N / 32, kb = item / nblk, nb = item % nblk, k0 = 64 * kb, n0 = 32 * nb;
#pragma unroll 8
    for (int i = 0; i < 32; ++i) { const int kk = 2 * i + (lane >> 5); scr[kk * 33 + (lane & 31)] = W[(size_t)(k0 + kk) * N + n0 + (lane & 31)]; }
    LDS_WAIT(); asm volatile("" ::: "memory");
    const int c = lane & 7;
#pragma unroll
    for (int j = 0; j < 4; ++j) { const int n = (lane >> 3) + 8 * j; const LAS float* s = scr + (8 * c) * 33 + n;
        v4u o; o.x = pk_bf16(s[0 * 33], s[1 * 33]); o.y = pk_bf16(s[2 * 33], s[3 * 33]); o.z = pk_bf16(s[4 * 33], s[5 * 33]); o.w = pk_bf16(s[6 * 33], s[7 * 33]);
        *(v4u*)(WT + (size_t)(row_off + n0 + n) * K + k0 + 8 * c) = o; }
    LDS_WAIT(); asm volatile("" ::: "memory");
}
__device__ __forceinline__ void rms_row_to_bf16(const float* xrow, const float* g, bf16* orow, int lane) {
    const f32x4* xr = (const f32x4*)xrow + lane; const f32x4* gr = (const f32x4*)g + lane;
    f32x4 v[4]; float s = 0.f;
#pragma unroll
    for (int j = 0; j < 4; ++j) { v[j] = xr[64 * j]; s += (v[j].x * v[j].x + v[j].y * v[j].y) + (v[j].z * v[j].z + v[j].w * v[j].w); }
    const float r = rsqrtf(wave_sum(s) * (1.f / DM) + RMS_EPS);
    v2u* o8 = (v2u*)orow + lane;
#pragma unroll
    for (int j = 0; j < 4; ++j) { const f32x4 gg = gr[64 * j]; v2u w; w.x = pk_bf16(v[j].x * r * gg.x, v[j].y * r * gg.y); w.y = pk_bf16(v[j].z * r * gg.z, v[j].w * r * gg.w); o8[64 * j] = w; }
}
__device__ __forceinline__ void p0_prologue(const Ctx& C) {
    LAS float* scr = (LAS float*)(C.lds + RING_OFF + C.wave * 16384);
    const float* w_in = (const float*)C.in[I_WIN]; const float* w_o = (const float*)C.in[I_WO]; const float* w_cq = (const float*)C.in[I_WCQ]; const float* w_ck = (const float*)C.in[I_WCK];
    const float* w_cv = (const float*)C.in[I_WCV]; const float* w_co = (const float*)C.in[I_WCO]; const float* w_up = (const float*)C.in[I_WUP]; const float* w_dn = (const float*)C.in[I_WDN];
    bf16* Win = (bf16*)(C.ws + WS_WIN); bf16* Wo = (bf16*)(C.ws + WS_WO); bf16* Wcq = (bf16*)(C.ws + WS_WCQ); bf16* Wco = (bf16*)(C.ws + WS_WCO); bf16* Wckv = (bf16*)(C.ws + WS_WCKV);
    bf16* Wup = (bf16*)(C.ws + WS_WUP); bf16* Wdn = (bf16*)(C.ws + WS_WDN);
    constexpr int I_IN = (DM / 64) * (DIN / 32), I_SQ = (DM / 64) * (DM / 32), I_UP = (DM / 64) * (DFF2 / 32), I_DN = (DFF / 64) * (DM / 32);
    constexpr int NITEMS = I_IN + 5 * I_SQ + I_UP + I_DN;
    for (int it = C.gw; it < NITEMS; it += C.ngw) {
        int r = it;
        if (r < I_IN) { p0_transpose_item(w_in, DM, DIN, Win, 0, scr, r, C.lane); continue; } r -= I_IN;
        if (r < I_SQ) { p0_transpose_item(w_o, DM, DM, Wo, 0, scr, r, C.lane); continue; } r -= I_SQ;
        if (r < I_SQ) { p0_transpose_item(w_cq, DM, DM, Wcq, 0, scr, r, C.lane); continue; } r -= I_SQ;
        if (r < I_SQ) { p0_transpose_item(w_co, DM, DM, Wco, 0, scr, r, C.lane); continue; } r -= I_SQ;
        if (r < I_SQ) { p0_transpose_item(w_ck, DM, DM, Wckv, 0, scr, r, C.lane); continue; } r -= I_SQ;
        if (r < I_SQ) { p0_transpose_item(w_cv, DM, DM, Wckv, DM, scr, r, C.lane); continue; } r -= I_SQ;
        if (r < I_UP) { p0_transpose_item(w_up, DM, DFF2, Wup, 0, scr, r, C.lane); continue; } r -= I_UP;
        p0_transpose_item(w_dn, DFF, DM, Wdn, 0, scr, r, C.lane);
    }
    const float* xp = (const float*)C.in[I_XP]; const float* xs = (const float*)C.in[I_XS]; const float* mem = (const float*)C.in[I_MEM];
    bf16* H = (bf16*)(C.ws + WS_H); bf16* MN = (bf16*)(C.ws + WS_MN);
    const float* g_pre = (const float*)C.in[I_GMIXPRE]; const float* g_mem = (const float*)C.in[I_GMEM];
    for (int m = C.gw; m < MT + NBATCH * NMEM; m += C.ngw) {
        if (m < MP) rms_row_to_bf16(xp + (size_t)m * DM, g_pre, H + (size_t)m * DM, C.lane);
        else if (m < MT) rms_row_to_bf16(xs + (size_t)(m - MP) * DM, g_pre, H + (size_t)m * DM, C.lane);
        else rms_row_to_bf16(mem + (size_t)(m - MT) * DM, g_mem, MN + (size_t)(m - MT) * DM, C.lane);
    }
    if (C.gw == 0) {
        const float* lbp = (const float*)C.in[I_HLB]; float* LB = (float*)(C.ws + WS_LB);
        for (int k = C.lane; k < HW; k += 64) { const float a = lbp[k], b = lbp[HW + k]; LB[k] = 1.f / (1.f + __expf(b - a)); }
    }
}
typedef short bf16x8s __attribute__((ext_vector_type(8)));
typedef short s16x4 __attribute__((ext_vector_type(4)));
typedef short v4i16_t __attribute__((ext_vector_type(4)));
constexpr int HRS = 72;
__device__ __forceinline__ s16x4 tr4(const LAS bf16* p) { return __builtin_bit_cast(s16x4, __builtin_amdgcn_ds_read_tr16_b64_v4i16((LAS v4i16_t*)p)); }
__device__ __forceinline__ bf16x8s cat8(s16x4 lo, s16x4 hi) { return (bf16x8s){lo[0], lo[1], lo[2], lo[3], hi[0], hi[1], hi[2], hi[3]}; }
__device__ __forceinline__ f32x4 mfma16(bf16x8s a, bf16x8s b, f32x4 c) { return __builtin_amdgcn_mfma_f32_16x16x32_bf16(a, b, c, 0, 0, 0); }
__device__ __forceinline__ void hg_stage_v(const bf16* VH, int r0, int h, LAS bf16* Vt, int lane) {
#pragma unroll
    for (int it = 0; it < 8; ++it) { const int row = it * 8 + (lane >> 3), ch = lane & 7; const v4u w = *(const v4u*)(VH + (size_t)(r0 + row) * HW + h * HD + ch * 8); *(LAS v4u*)(Vt + row * HRS + ch * 8) = w; }
}
__device__ __forceinline__ void hgrn_h1(const Ctx& C, int cid) {
    const float* LF = (const float*)(C.ws + WS_LF); const bf16* VH = (const bf16*)(C.ws + WS_VH);
    float* UCT = (float*)(C.ws + WS_UCT); float* DC = (float*)(C.ws + WS_DC);
    const int lane = C.lane, i = lane & 15, g = lane >> 4;
    const int chain = cid >> 7, ci = cid & 127, b = chain >> 3, h = chain & 7, r0 = b * SEQ + ci * 64;
    LAS bf16* Vt = (LAS bf16*)(C.lds + RING_OFF + C.wave * 18432); LAS bf16* Kt = Vt + 64 * HRS;
    hg_stage_v(VH, r0, h, Vt, lane);
    const float* lfp = LF + (size_t)r0 * HW + h * HD + lane;
    float bl = 0.f;
#pragma unroll 16
    for (int t = 0; t < 64; ++t) bl += lfp[(size_t)t * HW];
    { float run = 0.f;
#pragma unroll 16
      for (int s = 0; s < 64; ++s) { const float lf = lfp[(size_t)s * HW]; run += lf; Kt[s * HRS + lane] = f2bf((1.f - __expf(lf)) * __expf(bl - run)); } }
    DC[(size_t)cid * 64 + lane] = __expf(bl);
    LDS_WAIT();
#pragma unroll
    for (int kb = 0; kb < 4; ++kb) {
        bf16x8s af[2];
#pragma unroll
        for (int ks = 0; ks < 2; ++ks) af[ks] = cat8(tr4(Kt + (32 * ks + 8 * g + (i >> 2)) * HRS + 16 * kb + (i & 3) * 4), tr4(Kt + (32 * ks + 8 * g + 4 + (i >> 2)) * HRS + 16 * kb + (i & 3) * 4));
#pragma unroll
        for (int db = 0; db < 4; ++db) {
            f32x4 acc = {0.f, 0.f, 0.f, 0.f};
#pragma unroll
            for (int ks = 0; ks < 2; ++ks) { const bf16x8s bfr = cat8(tr4(Vt + (32 * ks + 8 * g + (i >> 2)) * HRS + 16 * db + (i & 3) * 4), tr4(Vt + (32 * ks + 8 * g + 4 + (i >> 2)) * HRS + 16 * db + (i & 3) * 4));
                acc = mfma16(af[ks], bfr, acc); }
            *(f32x4*)(UCT + ((size_t)cid * 64 + 16 * db + i) * 64 + 16 * kb + 4 * g) = acc;
        }
    }
    LDS_WAIT();
}
__device__ __forceinline__ void hgrn_h2(const Ctx& C) {
    const float* UCT = (const float*)(C.ws + WS_UCT); const float* DC = (const float*)(C.ws + WS_DC); bf16* SCT = (bf16*)(C.ws + WS_SCT);
    const int lane = C.lane;
    for (int w = C.gw; w < NBATCH * NH * 64; w += C.ngw) {
        const int chain = w >> 6, d = w & 63; float S = 0.f;
        for (int c0 = 0; c0 < 128; c0 += 16) {
            float u[16], dc[16];
#pragma unroll
            for (int j = 0; j < 16; ++j) { const size_t cid = (size_t)chain * 128 + c0 + j; u[j] = UCT[(cid * 64 + d) * 64 + lane]; dc[j] = DC[cid * 64 + lane]; }
#pragma unroll
            for (int j = 0; j < 16; ++j) { const size_t cid = (size_t)chain * 128 + c0 + j; SCT[(cid * 64 + d) * 64 + lane] = f2bf(S); S = dc[j] * S + u[j]; }
        }
        C.out[O_HP + (size_t)chain * 4096 + lane * 64 + d] = S;
    }
}
__device__ __forceinline__ void hgrn_h3(const Ctx& C, int cid) {
    const float* LF = (const float*)(C.ws + WS_LF); const bf16* QH = (const bf16*)(C.ws + WS_QH); const bf16* VH = (const bf16*)(C.ws + WS_VH); const bf16* GH = (const bf16*)(C.ws + WS_GH);
    const bf16* SCT = (const bf16*)(C.ws + WS_SCT); bf16* OMIX = (bf16*)(C.ws + WS_OMIX); const float* hgn = (const float*)C.in[I_HGN];
    const int lane = C.lane, i = lane & 15, g = lane >> 4;
    const int chain = cid >> 7, ci = cid & 127, b = chain >> 3, h = chain & 7, r0 = b * SEQ + ci * 64;
    LAS bf16* Vt = (LAS bf16*)(C.lds + RING_OFF + C.wave * 18432); LAS bf16* Kb = Vt + 64 * HRS; LAS bf16* Qh = Kb + 16 * HRS; LAS bf16* Qt = Qh + 16 * HRS;
    hg_stage_v(VH, r0, h, Vt, lane);
    const float* lfp = LF + (size_t)r0 * HW + h * HD + lane; const bf16* qp = QH + (size_t)r0 * HW + h * HD + lane;
    float eb[4];
    bf16x8s sfr[4][2];
#pragma unroll
    for (int db = 0; db < 4; ++db)
#pragma unroll
        for (int ks = 0; ks < 2; ++ks) sfr[db][ks] = *(const bf16x8s*)(SCT + ((size_t)cid * 64 + 16 * db + i) * 64 + 32 * ks + 8 * g);
#pragma unroll
    for (int is = 0; is < 4; ++is) {
        const float ri = is ? eb[is - 1] : 0.f, er = __expf(ri);
        { float run = 0.f;
#pragma unroll
          for (int tt = 0; tt < 16; ++tt) { const int t = 16 * is + tt; run += lfp[(size_t)t * HW]; const float qt = bf2f(qp[(size_t)t * HW]) * __expf(run);
              Qt[tt * HRS + lane] = f2bf(qt); Qh[tt * HRS + lane] = f2bf(qt * er); }
          eb[is] = ri + run; }
        LDS_WAIT();
        bf16x8s qhf[2], qtf[2];
#pragma unroll
        for (int ks = 0; ks < 2; ++ks) { qhf[ks] = *(const LAS bf16x8s*)(Qh + i * HRS + 32 * ks + 8 * g); qtf[ks] = *(const LAS bf16x8s*)(Qt + i * HRS + 32 * ks + 8 * g); }
        f32x4 o[4];
#pragma unroll
        for (int db = 0; db < 4; ++db) { o[db] = (f32x4){0.f, 0.f, 0.f, 0.f};
#pragma unroll
            for (int ks = 0; ks < 2; ++ks) o[db] = mfma16(sfr[db][ks], qhf[ks], o[db]); }
#pragma unroll
        for (int jp = 0; jp <= is / 2; ++jp) {
            f32x4 x[2];
#pragma unroll
            for (int jj = 0; jj < 2; ++jj) {
                const int j = 2 * jp + jj; x[jj] = (f32x4){0.f, 0.f, 0.f, 0.f};
                if (j <= is) {
                    { float run = (j ? eb[j - 1] : 0.f) - ri;
#pragma unroll
                      for (int ss = 0; ss < 16; ++ss) { const int s = 16 * j + ss; const float lf = lfp[(size_t)s * HW]; run += lf; Kb[ss * HRS + lane] = f2bf((1.f - __expf(lf)) * __expf(-run)); } }
                    LDS_WAIT();
#pragma unroll
                    for (int ks = 0; ks < 2; ++ks) { const bf16x8s kf = *(const LAS bf16x8s*)(Kb + i * HRS + 32 * ks + 8 * g); x[jj] = mfma16(kf, qtf[ks], x[jj]); }
                    if (j == is) {
#pragma unroll
                        for (int e = 0; e < 4; ++e) if (4 * g + e > i) x[jj][e] = 0.f;
                    }
                    LDS_WAIT();
                }
            }
            bf16x8s pb; { const unsigned w0 = pk_bf16(x[0][0], x[0][1]), w1 = pk_bf16(x[0][2], x[0][3]), w2 = pk_bf16(x[1][0], x[1][1]), w3 = pk_bf16(x[1][2], x[1][3]); const v4u ww = {w0, w1, w2, w3}; pb = __builtin_bit_cast(bf16x8s, ww); }
            const int j0 = 2 * jp, j1 = (2 * jp + 1 <= is) ? 2 * jp + 1 : 2 * jp;
#pragma unroll
            for (int db = 0; db < 4; ++db) { const bf16x8s vf = cat8(tr4(Vt + (16 * j0 + 4 * g + (i >> 2)) * HRS + 16 * db + (i & 3) * 4), tr4(Vt + (16 * j1 + 4 * g + (i >> 2)) * HRS + 16 * db + (i & 3) * 4));
                o[db] = mfma16(vf, pb, o[db]); }
        }
        float ss = 0.f;
#pragma unroll
        for (int db = 0; db < 4; ++db) ss += (o[db][0] * o[db][0] + o[db][1] * o[db][1]) + (o[db][2] * o[db][2] + o[db][3] * o[db][3]);
        ss += __shfl_xor(ss, 16); ss += __shfl_xor(ss, 32);
        const float r = rsqrtf(ss * (1.f / HD) + RMS_EPS); const size_t row = (size_t)(r0 + 16 * is + i);
#pragma unroll
        for (int db = 0; db < 4; ++db) { const int d0 = h * HD + 16 * db + 4 * g; const v2u gw = *(const v2u*)(GH + row * HW + d0); const f32x4 gn = *(const f32x4*)(hgn + d0);
            const float g0 = bflo(gw.x), g1 = bfhi(gw.x), g2 = bflo(gw.y), g3 = bfhi(gw.y);
            v2u w; w.x = pk_bf16(o[db][0] * r * gn.x * (g0 / (1.f + __expf(-g0))), o[db][1] * r * gn.y * (g1 / (1.f + __expf(-g1))));
            w.y = pk_bf16(o[db][2] * r * gn.z * (g2 / (1.f + __expf(-g2))), o[db][3] * r * gn.w * (g3 / (1.f + __expf(-g3))));
            *(v2u*)(OMIX + row * DM + d0) = w; }
    }
    LDS_WAIT();
}
typedef float f32x16 __attribute__((ext_vector_type(16)));
constexpr int SB_RS = 72;
constexpr int SB_TILE = 64 * SB_RS;
__device__ __forceinline__ f32x16 mfma32(bf16x8s a, bf16x8s b, f32x16 c) { return __builtin_amdgcn_mfma_f32_32x32x16_bf16(a, b, c, 0, 0, 0); }
__device__ __forceinline__ int sb_crow(int r, int hi) { return (r & 3) + 8 * (r >> 2) + 4 * hi; }
__device__ __forceinline__ void sb_subtile(const LAS bf16* Kp, const LAS bf16* Vp, const bf16x8s (&qf)[4], float bias2, bool diag, int key0, int qpos, int hi, float& Cc, f32x16& o0, f32x16& o1) {
    f32x16 p;
#pragma unroll
    for (int r = 0; r < 16; ++r) p[r] = bias2;
#pragma unroll
    for (int ks = 0; ks < 4; ++ks) { const bf16x8s kf = *(const LAS bf16x8s*)(Kp + 16 * ks); p = mfma32(kf, qf[ks], p); }
    float E = 1.f;
#pragma unroll
    for (int r = 0; r < 16; ++r) { float u = __builtin_amdgcn_exp2f(p[r]); if (diag) u = (key0 + r < qpos) ? u : 0.f; const float tt = E * u; E += tt; p[r] = tt; }
    const float Ti = __builtin_amdgcn_rcpf(E), Tp = __shfl_xor(Ti, 32);
    const float G = Ti * (hi ? Cc : Cc * Tp);
    Cc = Cc * Ti * Tp;
#pragma unroll
    for (int r = 0; r < 16; ++r) p[r] *= G;
    bf16x8s pa[2];
#pragma unroll
    for (int s = 0; s < 2; ++s) { const v4u ww = {pk_bf16(p[8 * s], p[8 * s + 1]), pk_bf16(p[8 * s + 2], p[8 * s + 3]), pk_bf16(p[8 * s + 4], p[8 * s + 5]), pk_bf16(p[8 * s + 6], p[8 * s + 7])}; pa[s] = __builtin_bit_cast(bf16x8s, ww); }
#pragma unroll
    for (int s = 0; s < 2; ++s) {
        const LAS bf16* vb = Vp + 8 * s * SB_RS;
        const bf16x8s v0 = cat8(tr4(vb), tr4(vb + 4 * SB_RS)), v1 = cat8(tr4(vb + 32), tr4(vb + 4 * SB_RS + 32));
        o0 = mfma32(pa[s], v0, o0); o1 = mfma32(pa[s], v1, o1);
    }
}
constexpr int SBK_RS = 72, SBV_RS = 160;
constexpr int SBK_T = 128 * SBK_RS, SBV_T = 128 * SBV_RS;
template <bool MASK>
__device__ __forceinline__ void sb_weights(f32x16& p, int key0, int qpos, int hi, float& Cc, bf16x8s (&pa)[2]) {
    float E = 1.f;
#pragma unroll
    for (int r = 0; r < 16; ++r) { float u = __builtin_amdgcn_exp2f(p[r]); if (MASK) u = (key0 + r < qpos) ? u : 0.f; const float tt = E * u; E += tt; p[r] = tt; }
    const float Ti = __builtin_amdgcn_rcpf(E);
    const auto rr = __builtin_amdgcn_permlane32_swap(__float_as_uint(Ti), __float_as_uint(Ti), false, false);
    const float Tp = __uint_as_float(rr[0] == __float_as_uint(Ti) ? rr[1] : rr[0]);
    const float G = Ti * (hi ? Cc : Cc * Tp);
    Cc = Cc * Ti * Tp;
#pragma unroll
    for (int s = 0; s < 2; ++s) { const v4u ww = {pk_bf16(p[8 * s] * G, p[8 * s + 1] * G), pk_bf16(p[8 * s + 2] * G, p[8 * s + 3] * G), pk_bf16(p[8 * s + 4] * G, p[8 * s + 5] * G), pk_bf16(p[8 * s + 6] * G, p[8 * s + 7] * G)}; pa[s] = __builtin_bit_cast(bf16x8s, ww); }
}
__device__ __forceinline__ void sb_unit(const Ctx& C, int b, int h, int qb) {
    const bf16* SQ = (const bf16*)(C.ws + WS_SQ); const bf16* SK = (const bf16*)(C.ws + WS_SK); const bf16* SV = (const bf16*)(C.ws + WS_SV); bf16* OMIX = (bf16*)(C.ws + WS_OMIX);
    const int tid = C.tid, lane = C.lane, r32 = lane & 31, hi = lane >> 5, w = C.wave;
    const int q0 = qb * 256, qlo = q0 + 32 * w, qpos = qlo + r32;
    LAS bf16* Kl = (LAS bf16*)(C.lds + RING_OFF); LAS bf16* Vl = Kl + 2 * SBK_T;
    const float bias2 = ((const float*)C.in[I_SBB])[h] * LOG2E;
    bf16x8s qf[4];
#pragma unroll
    for (int ks = 0; ks < 4; ++ks) qf[ks] = *(const bf16x8s*)(SQ + (size_t)(b * SEQ + qpos) * HW + h * HD + 16 * ks + 8 * hi);
    const int srow = tid >> 3, sch = tid & 7;
    const bf16* gk = SK + (size_t)(b * SEQ + srow) * HW + h * HD + sch * 8; const bf16* gv = SV + (size_t)(b * SEQ + srow) * HW + h * HD + sch * 8;
    const int skoff = srow * SBK_RS + sch * 8, svoff = srow * SBV_RS + sch * 8;
    const int nt = (q0 + 256) / 128, sd = q0 / 32 + w;
    v4u rk[2], rv[2];
#pragma unroll
    for (int j = 0; j < 2; ++j) { rk[j] = *(const v4u*)(gk + (size_t)((nt - 1) * 128 + 64 * j) * HW); rv[j] = *(const v4u*)(gv + (size_t)((nt - 1) * 128 + 64 * j) * HW); }
#pragma unroll
    for (int j = 0; j < 2; ++j) { *(LAS v4u*)(Kl + skoff + 64 * j * SBK_RS) = rk[j]; *(LAS v4u*)(Vl + svoff + 64 * j * SBV_RS) = rv[j]; }
    asm volatile("" :: "v"(qf[0]), "v"(qf[1]), "v"(qf[2]), "v"(qf[3]));
    __syncthreads();
    f32x16 o0, o1;
#pragma unroll
    for (int r = 0; r < 16; ++r) { o0[r] = 0.f; o1[r] = 0.f; }
    float Cc = 1.f;
    const int kap = 16 * ((r32 >> 2) & 1) + (r32 & 3) + 4 * (r32 >> 3);
    const int koff = kap * SBK_RS + 8 * hi;
    const int gi = lane >> 4, i16 = lane & 15;
    const int voff = (16 * hi + (i16 >> 2)) * SBV_RS + 16 * (gi & 1) + (i16 & 3) * 4;
    f32x16 pinit;
#pragma unroll
    for (int r = 0; r < 16; ++r) pinit[r] = bias2;
#define SB_QK(dst, sub) do { const LAS bf16* kp_ = Kc + (sub) * 32 * SBK_RS + koff; bf16x8s kf_[4]; _Pragma("unroll") for (int ks = 0; ks < 4; ++ks) kf_[ks] = *(const LAS bf16x8s*)(kp_ + 16 * ks); \
        dst = mfma32(kf_[0], qf[0], pinit); dst = mfma32(kf_[1], qf[1], dst); dst = mfma32(kf_[2], qf[2], dst); dst = mfma32(kf_[3], qf[3], dst); } while (0)
#define SB_PV(sub) do { const LAS bf16* vb_ = Vc + (sub) * 32 * SBV_RS + voff; \
        const bf16x8s v00 = cat8(tr4(vb_), tr4(vb_ + 4 * SBV_RS)), v01 = cat8(tr4(vb_ + 32), tr4(vb_ + 4 * SBV_RS + 32)); \
        const bf16x8s v10 = cat8(tr4(vb_ + 8 * SBV_RS), tr4(vb_ + 12 * SBV_RS)), v11 = cat8(tr4(vb_ + 8 * SBV_RS + 32), tr4(vb_ + 12 * SBV_RS + 32)); \
        o0 = mfma32(pa[0], v00, o0); o1 = mfma32(pa[0], v01, o1); o0 = mfma32(pa[1], v10, o0); o1 = mfma32(pa[1], v11, o1); } while (0)
    int cur = 0;
    for (int T = nt - 1; T >= 0; --T) {
        if (T > 0) {
#pragma unroll
            for (int j = 0; j < 2; ++j) { rk[j] = *(const v4u*)(gk + (size_t)((T - 1) * 128 + 64 * j) * HW); rv[j] = *(const v4u*)(gv + (size_t)((T - 1) * 128 + 64 * j) * HW); }
        }
        const LAS bf16* Kc = Kl + cur * SBK_T; const LAS bf16* Vc = Vl + cur * SBV_T;
        const int top = sd - 4 * T;
        if (top >= 0) {
            const int hs = top < 3 ? top : 3;
            f32x16 pc, pn; bf16x8s pa[2];
            if (hs == 3) SB_QK(pc, 3); else if (hs == 2) SB_QK(pc, 2); else if (hs == 1) SB_QK(pc, 1); else SB_QK(pc, 0);
#pragma unroll
            for (int sub = 3; sub >= 0; --sub) {
                if (sub <= hs) {
                    if (sub > 0) SB_QK(pn, sub - 1);
                    const int key0 = 128 * T + 32 * sub + 16 * hi;
                    if (sub == top) sb_weights<true>(pc, key0, qpos, hi, Cc, pa); else sb_weights<false>(pc, key0, qpos, hi, Cc, pa);
                    SB_PV(sub);
                    if (sub > 0) pc = pn;
                }
            }
        }
        if (T > 0) {
#pragma unroll
            for (int j = 0; j < 2; ++j) { *(LAS v4u*)(Kl + (cur ^ 1) * SBK_T + skoff + 64 * j * SBK_RS) = rk[j]; *(LAS v4u*)(Vl + (cur ^ 1) * SBV_T + svoff + 64 * j * SBV_RS) = rv[j]; }
        }
        __syncthreads();
        cur ^= 1;
    }
#undef SB_QK
#undef SB_PV
    bf16* orow = OMIX + (size_t)(b * SEQ + qlo) * DM + HW + h * HD + r32;
#pragma unroll
    for (int r = 0; r < 16; ++r) { const int q = sb_crow(r, hi); orow[(size_t)q * DM] = f2bf(o0[r]); orow[(size_t)q * DM + 32] = f2bf(o1[r]); }
}
__device__ __forceinline__ void sb_prompt_phase(const Ctx& C) {
    const int G = gridDim.x, bid = blockIdx.x;
    const int vcu = (G % 8 == 0) ? (bid % 8) * (G / 8) + bid / 8 : bid;
    for (int p = vcu; p < NBATCH * NH * 16; p += G) {
        const int bh = p >> 4, s = p & 15;
        sb_unit(C, bh >> 3, bh & 7, 31 - s);
        sb_unit(C, bh >> 3, bh & 7, s);
    }
}

__device__ __forceinline__ void sbs_item(const Ctx& C, int n, int half) {
    const bf16* SQ = (const bf16*)(C.ws + WS_SQ); const bf16* SK = (const bf16*)(C.ws + WS_SK); const bf16* SV = (const bf16*)(C.ws + WS_SV);
    const float* ck = (const float*)C.in[I_CK]; const float* cv = (const float*)C.in[I_CV]; const int* pt = (const int*)C.in[I_PT];
    float* PO = (float*)(C.ws + WS_SBP); float* PC = PO + (size_t)NDEC * 2 * NH * TDEC * HD;
    const int lane = C.lane, r32 = lane & 31, hi = lane >> 5, h = C.wave;
    LAS bf16* Kt = (LAS bf16*)(C.lds + RING_OFF + C.wave * 9216); LAS bf16* Vt = Kt + 32 * SB_RS;
    const float bias2 = ((const float*)C.in[I_SBB])[h] * LOG2E;
    const int qpos = PAST + r32;
    bf16x8s qf[4];
#pragma unroll
    for (int ks = 0; ks < 4; ++ks) { qf[ks] = (bf16x8s){0, 0, 0, 0, 0, 0, 0, 0}; if (r32 < TDEC) qf[ks] = *(const bf16x8s*)(SQ + (size_t)(MP + n * TDEC + r32) * HW + h * HD + 16 * ks + 8 * hi); }
    f32x16 o0, o1;
#pragma unroll
    for (int r = 0; r < 16; ++r) { o0[r] = 0.f; o1[r] = 0.f; }
    float Cc = 1.f;
    const int kap = 16 * ((r32 >> 2) & 1) + (r32 & 3) + 4 * (r32 >> 3);
    const LAS bf16* Kp = Kt + kap * SB_RS + 8 * hi;
    const int gi = lane >> 4, i16 = lane & 15;
    const LAS bf16* Vp = Vt + (16 * hi + (i16 >> 2)) * SB_RS + 16 * (gi & 1) + (i16 & 3) * 4;
    const int srow = lane >> 4, sch = lane & 15;
    if (half == 1) {
#pragma unroll
        for (int it = 0; it < 8; ++it) { const int row = it * 4 + srow; v2u kw = {0u, 0u}, vw = {0u, 0u};
            if (row < TDEC) { kw = *(const v2u*)(SK + (size_t)(MP + n * TDEC + row) * HW + h * HD + sch * 4); vw = *(const v2u*)(SV + (size_t)(MP + n * TDEC + row) * HW + h * HD + sch * 4); }
            *(LAS v2u*)(Kt + row * SB_RS + sch * 4) = kw; *(LAS v2u*)(Vt + row * SB_RS + sch * 4) = vw; }
        LDS_WAIT();
        sb_subtile(Kp, Vp, qf, bias2, true, PAST + 16 * hi, qpos, hi, Cc, o0, o1);
        LDS_WAIT();
    }
    const int pg_hi = half ? NPAGES - 1 : NPAGES / 2 - 1, nsteps = (NPAGES / 2) * 4;
    f32x4 rk[8], rv[8];
    { const size_t base = (((size_t)pt[n * NPAGES + pg_hi] * PAGE + 96 + srow) * NH + h) * HD + sch * 4;
#pragma unroll
      for (int it = 0; it < 8; ++it) { rk[it] = *(const f32x4*)(ck + base + (size_t)it * 4 * NH * HD); rv[it] = *(const f32x4*)(cv + base + (size_t)it * 4 * NH * HD); } }
    for (int st = 0; st < nsteps; ++st) {
#pragma unroll
        for (int it = 0; it < 8; ++it) { const int row = it * 4 + srow;
            const v2u kw = {pk_bf16(rk[it].x, rk[it].y), pk_bf16(rk[it].z, rk[it].w)}, vw = {pk_bf16(rv[it].x, rv[it].y), pk_bf16(rv[it].z, rv[it].w)};
            *(LAS v2u*)(Kt + row * SB_RS + sch * 4) = kw; *(LAS v2u*)(Vt + row * SB_RS + sch * 4) = vw; }
        if (st + 1 < nsteps) { const int s2 = st + 1, pg = pg_hi - (s2 >> 2), sub = 3 - (s2 & 3);
            const size_t base = (((size_t)pt[n * NPAGES + pg] * PAGE + 32 * sub + srow) * NH + h) * HD + sch * 4;
#pragma unroll
            for (int it = 0; it < 8; ++it) { rk[it] = *(const f32x4*)(ck + base + (size_t)it * 4 * NH * HD); rv[it] = *(const f32x4*)(cv + base + (size_t)it * 4 * NH * HD); } }
        LDS_WAIT();
        sb_subtile(Kp, Vp, qf, bias2, false, 0, qpos, hi, Cc, o0, o1);
        LDS_WAIT();
    }
    float* po = PO + ((size_t)(n * 2 + half) * NH + h) * TDEC * HD;
#pragma unroll
    for (int r = 0; r < 4; ++r) { po[(r + 4 * hi) * HD + r32] = o0[r]; po[(r + 4 * hi) * HD + 32 + r32] = o1[r]; }
    if (lane < TDEC) PC[((size_t)(n * 2 + half) * NH + h) * TDEC + lane] = Cc;
}
__device__ __forceinline__ void sbs_phase(const Ctx& C) {
    for (int it = blockIdx.x; it < NDEC * 2; it += gridDim.x) sbs_item(C, it >> 1, it & 1);
}
__device__ __forceinline__ void sbs_combine(const Ctx& C) {
    const float* PO = (const float*)(C.ws + WS_SBP); const float* PC = PO + (size_t)NDEC * 2 * NH * TDEC * HD; bf16* OMIX = (bf16*)(C.ws + WS_OMIX);
    const int gt = C.gw * 64 + C.lane, ngt = C.ngw * 64;
    for (int e = gt; e < NDEC * NH * TDEC * HD; e += ngt) {
        const int d = e & 63, q = (e >> 6) & 7, h = (e >> 9) & 7, n = e >> 12;
        const size_t i1 = ((size_t)(n * 2 + 1) * NH + h) * TDEC + q, i0 = ((size_t)(n * 2) * NH + h) * TDEC + q;
        OMIX[(size_t)(MP + n * TDEC + q) * DM + HW + h * HD + d] = f2bf(PO[i1 * HD + d] + PC[i1] * PO[i0 * HD + d]);
    }
}
constexpr int CA_KRS = 264, CA_VRS = 288;
constexpr int CA_KT = 64 * CA_KRS, CA_VT = 64 * CA_VRS;
__device__ __forceinline__ void ca_unit(const Ctx& C, int b, int hh, int qblk) {
    const bf16* QCA = (const bf16*)(C.ws + WS_QCA); const bf16* MK = (const bf16*)(C.ws + WS_MK); const bf16* MV = (const bf16*)(C.ws + WS_MV); bf16* OCA = (bf16*)(C.ws + WS_OMIX);
    const int tid = C.tid, lane = C.lane, r32 = lane & 31, hi = lane >> 5, w = C.wave, gi = lane >> 4, i16 = lane & 15;
    LAS bf16* Kl = (LAS bf16*)(C.lds + RING_OFF); LAS bf16* Vl = Kl + 2 * CA_KT; LAS float* wsf = (LAS float*)(Vl + 2 * CA_VT) + w * 32;
    const size_t qrow = (size_t)b * SEQ + 256 * qblk + 32 * w;
    bf16x8s qf[16];
#pragma unroll
    for (int ks = 0; ks < 16; ++ks) qf[ks] = *(const bf16x8s*)(QCA + (qrow + r32) * DM + hh * CAD + 16 * ks + 8 * hi);
    const bf16* gk = MK + (size_t)(b * NMEM) * DM + hh * CAD; const bf16* gv = MV + (size_t)(b * NMEM) * DM + hh * CAD;
    v4u rg[4];
#define CA_LOAD(i) do { const bf16* src_ = ((i) < 4 ? gk : gv) + (size_t)(((i) & 3) * 64) * DM; _Pragma("unroll") for (int p_ = 0; p_ < 4; ++p_) { const int id_ = tid + 512 * p_; rg[p_] = *(const v4u*)(src_ + (size_t)(id_ >> 5) * DM + (id_ & 31) * 8); } } while (0)
#define CA_WRITE(i) do { _Pragma("unroll") for (int p_ = 0; p_ < 4; ++p_) { const int id_ = tid + 512 * p_; if ((i) < 4) *(LAS v4u*)(Kl + ((i) & 1) * CA_KT + (id_ >> 5) * CA_KRS + (id_ & 31) * 8) = rg[p_]; else *(LAS v4u*)(Vl + ((i) & 1) * CA_VT + (id_ >> 5) * CA_VRS + (id_ & 31) * 8) = rg[p_]; } } while (0)
    CA_LOAD(0); CA_WRITE(0); __syncthreads();
    f32x16 s[8];
#pragma unroll
    for (int j = 0; j < 8; ++j)
#pragma unroll
        for (int r = 0; r < 16; ++r) s[j][r] = 0.f;
#pragma unroll
    for (int kt = 0; kt < 4; ++kt) {
        if (kt < 3) CA_LOAD(kt + 1);
        const LAS bf16* Kc = Kl + (kt & 1) * CA_KT + r32 * CA_KRS + 8 * hi;
#pragma unroll
        for (int sub = 0; sub < 2; ++sub)
#pragma unroll
            for (int ks = 0; ks < 16; ++ks) { const bf16x8s kf = *(const LAS bf16x8s*)(Kc + sub * 32 * CA_KRS + 16 * ks); s[2 * kt + sub] = mfma32(kf, qf[ks], s[2 * kt + sub]); }
        if (kt < 3) { CA_WRITE(kt + 1); } __syncthreads();
    }
    float mx = s[0][0];
#pragma unroll
    for (int j = 0; j < 8; ++j)
#pragma unroll
        for (int r = 0; r < 16; ++r) mx = fmaxf(mx, s[j][r]);
    mx = fmaxf(mx, __shfl_xor(mx, 32));
    float l = 0.f;
#pragma unroll
    for (int j = 0; j < 8; ++j)
#pragma unroll
        for (int r = 0; r < 16; ++r) { s[j][r] = __builtin_amdgcn_exp2f(s[j][r] - mx); l += s[j][r]; }
    l += __shfl_xor(l, 32);
    if (hi == 0) wsf[r32] = l;
    bf16x8s pa[8][2];
#pragma unroll
    for (int j = 0; j < 8; ++j)
#pragma unroll
        for (int s2 = 0; s2 < 2; ++s2) { const v4u ww = {pk_bf16(s[j][8 * s2], s[j][8 * s2 + 1]), pk_bf16(s[j][8 * s2 + 2], s[j][8 * s2 + 3]), pk_bf16(s[j][8 * s2 + 4], s[j][8 * s2 + 5]), pk_bf16(s[j][8 * s2 + 6], s[j][8 * s2 + 7])}; pa[j][s2] = __builtin_bit_cast(bf16x8s, ww); }
    CA_LOAD(4); CA_WRITE(4); __syncthreads();
    f32x16 o[8];
#pragma unroll
    for (int j = 0; j < 8; ++j)
#pragma unroll
        for (int r = 0; r < 16; ++r) o[j][r] = 0.f;
#pragma unroll
    for (int kt = 0; kt < 4; ++kt) {
        if (kt >= 1 && kt < 3) CA_LOAD(kt + 5);
        const LAS bf16* Vc = Vl + (kt & 1) * CA_VT + (4 * hi + (i16 >> 2)) * CA_VRS + 16 * (gi & 1) + (i16 & 3) * 4;
#pragma unroll
        for (int sub = 0; sub < 2; ++sub)
#pragma unroll
            for (int s2 = 0; s2 < 2; ++s2)
#pragma unroll
                for (int dt = 0; dt < 8; ++dt) { const LAS bf16* vb = Vc + (32 * sub + 16 * s2) * CA_VRS + 32 * dt; const bf16x8s vf = cat8(tr4(vb), tr4(vb + 8 * CA_VRS)); o[dt] = mfma32(pa[2 * kt + sub][s2], vf, o[dt]); }
        if (kt == 0) CA_LOAD(5);
        if (kt < 3) { CA_WRITE(kt + 5); }
        __syncthreads();
    }
#undef CA_LOAD
#undef CA_WRITE
    float rl[16];
#pragma unroll
    for (int r = 0; r < 16; ++r) rl[r] = 1.f / wsf[sb_crow(r, hi)];
    bf16* orow = OCA + qrow * DM + hh * CAD + r32;
#pragma unroll
    for (int r = 0; r < 16; ++r) { const int q = sb_crow(r, hi);
#pragma unroll
        for (int dt = 0; dt < 8; ++dt) orow[(size_t)q * DM + 32 * dt] = f2bf(o[dt][r] * rl[r]); }
}
__device__ __forceinline__ void cas_item(const Ctx& C, int n, int hh) {
    const bf16* QCA = (const bf16*)(C.ws + WS_QCA); const float* cmk = (const float*)C.in[I_MK]; const float* cmv = (const float*)C.in[I_MV]; bf16* OCA = (bf16*)(C.ws + WS_OMIX);
    const int tid = C.tid, lane = C.lane, r32 = lane & 31, hi = lane >> 5, w = C.wave, gi = lane >> 4, i16 = lane & 15;
    LAS bf16* Vt = (LAS bf16*)(C.lds + RING_OFF) + w * (32 * CA_VRS);
    LAS float* part = (LAS float*)(C.lds + RING_OFF);
    LAS float* red = (LAS float*)(C.lds + RING_OFF + 8 * 32 * CA_VRS * 2);
    bf16x8s qf[16];
#pragma unroll
    for (int ks = 0; ks < 16; ++ks) { qf[ks] = (bf16x8s){0, 0, 0, 0, 0, 0, 0, 0}; if (r32 < TDEC) qf[ks] = *(const bf16x8s*)(QCA + (size_t)(MP + n * TDEC + r32) * DM + hh * CAD + 16 * ks + 8 * hi); }
    f32x16 s;
#pragma unroll
    for (int r = 0; r < 16; ++r) s[r] = 0.f;
    const float* kr = cmk + ((size_t)(n * NMEM + 32 * w + r32) * CAH + hh) * CAD + 8 * hi;
#pragma unroll
    for (int kb = 0; kb < 2; ++kb) {
        f32x4 ra[8], rb[8];
#pragma unroll
        for (int k8 = 0; k8 < 8; ++k8) { ra[k8] = *(const f32x4*)(kr + 16 * (8 * kb + k8)); rb[k8] = *(const f32x4*)(kr + 16 * (8 * kb + k8) + 4); }
#pragma unroll
        for (int k8 = 0; k8 < 8; ++k8) { const v4u ww = {pk_bf16(ra[k8].x, ra[k8].y), pk_bf16(ra[k8].z, ra[k8].w), pk_bf16(rb[k8].x, rb[k8].y), pk_bf16(rb[k8].z, rb[k8].w)};
            s = mfma32(__builtin_bit_cast(bf16x8s, ww), qf[8 * kb + k8], s); }
    }
    const float* vr = cmv + ((size_t)(n * NMEM + 32 * w) * CAH + hh) * CAD + lane * 4;
#pragma unroll
    for (int vb = 0; vb < 2; ++vb) {
        f32x4 rvv[16];
#pragma unroll
        for (int j = 0; j < 16; ++j) rvv[j] = *(const f32x4*)(vr + (size_t)(16 * vb + j) * CAH * CAD);
#pragma unroll
        for (int j = 0; j < 16; ++j) { const v2u ww = {pk_bf16(rvv[j].x, rvv[j].y), pk_bf16(rvv[j].z, rvv[j].w)}; *(LAS v2u*)(Vt + (16 * vb + j) * CA_VRS + lane * 4) = ww; }
    }
    float mx = s[0];
#pragma unroll
    for (int r = 1; r < 16; ++r) mx = fmaxf(mx, s[r]);
    mx = fmaxf(mx, __shfl_xor(mx, 32));
    if (lane < TDEC) red[w * TDEC + lane] = mx;
    LDS_WAIT(); __syncthreads();
    { float m2 = red[(r32 & 7)];
#pragma unroll
      for (int ww = 1; ww < 8; ++ww) m2 = fmaxf(m2, red[ww * TDEC + (r32 & 7)]);
      mx = m2; }
    float l = 0.f;
#pragma unroll
    for (int r = 0; r < 16; ++r) { s[r] = __builtin_amdgcn_exp2f(s[r] - mx); l += s[r]; }
    l += __shfl_xor(l, 32);
    if (lane < TDEC) red[64 + w * TDEC + lane] = l;
    bf16x8s pa[2];
#pragma unroll
    for (int s2 = 0; s2 < 2; ++s2) { const v4u ww = {pk_bf16(s[8 * s2], s[8 * s2 + 1]), pk_bf16(s[8 * s2 + 2], s[8 * s2 + 3]), pk_bf16(s[8 * s2 + 4], s[8 * s2 + 5]), pk_bf16(s[8 * s2 + 6], s[8 * s2 + 7])}; pa[s2] = __builtin_bit_cast(bf16x8s, ww); }
    LDS_WAIT();
    f32x16 o[8];
#pragma unroll
    for (int j = 0; j < 8; ++j)
#pragma unroll
        for (int r = 0; r < 16; ++r) o[j][r] = 0.f;
    const LAS bf16* Vc = Vt + (4 * hi + (i16 >> 2)) * CA_VRS + 16 * (gi & 1) + (i16 & 3) * 4;
#pragma unroll
    for (int s2 = 0; s2 < 2; ++s2)
#pragma unroll
        for (int dt = 0; dt < 8; ++dt) { const LAS bf16* vb = Vc + 16 * s2 * CA_VRS + 32 * dt; const bf16x8s vf = cat8(tr4(vb), tr4(vb + 8 * CA_VRS)); o[dt] = mfma32(pa[s2], vf, o[dt]); }
    LDS_WAIT(); __syncthreads();
#pragma unroll
    for (int r = 0; r < 4; ++r)
#pragma unroll
        for (int dt = 0; dt < 8; ++dt) part[(w * TDEC + r + 4 * hi) * CAD + 32 * dt + r32] = o[dt][r];
    LDS_WAIT(); __syncthreads();
    { const int q = tid >> 6, d0 = (tid & 63) * 4;
      float lt = 0.f;
#pragma unroll
      for (int ww = 0; ww < 8; ++ww) lt += red[64 + ww * TDEC + q];
      f32x4 a = {0.f, 0.f, 0.f, 0.f};
#pragma unroll
      for (int ww = 0; ww < 8; ++ww) a += *(const LAS f32x4*)(part + (ww * TDEC + q) * CAD + d0);
      const float il = 1.f / lt; const v2u ow = {pk_bf16(a.x * il, a.y * il), pk_bf16(a.z * il, a.w * il)};
      *(v2u*)(OCA + (size_t)(MP + n * TDEC + q) * DM + hh * CAD + d0) = ow; }
    LDS_WAIT(); __syncthreads();
}
__device__ __forceinline__ void ca_phase(const Ctx& C) {
    for (int it = blockIdx.x; it < NDEC * CAH; it += gridDim.x) cas_item(C, it >> 2, it & 3);
    const int G = gridDim.x, bid = blockIdx.x; const int vcu = (G % 8 == 0) ? (bid % 8) * (G / 8) + bid / 8 : bid;
    for (int u = vcu; u < NBATCH * CAH * 32; u += G) ca_unit(C, u >> 7, (u >> 5) & 3, u & 31);
}
__device__ __forceinline__ void hgrn_chain(const Ctx& C, int rowbase, int T, int h, const float* S0, float* Sout) {
    const float* LF = (const float*)(C.ws + WS_LF); const bf16* QH = (const bf16*)(C.ws + WS_QH); const bf16* VH = (const bf16*)(C.ws + WS_VH); const bf16* GH = (const bf16*)(C.ws + WS_GH);
    bf16* OMIX = (bf16*)(C.ws + WS_OMIX); const float* hgn = (const float*)C.in[I_HGN];
    const int lane = C.lane; const float gn = hgn[h * HD + lane];
    float S[64];
#pragma unroll
    for (int k = 0; k < 64; ++k) S[k] = S0 ? S0[k * 64 + lane] : 0.f;
    for (int t = 0; t < T; ++t) {
        const size_t off = (size_t)(rowbase + t) * HW + h * HD + lane;
        const float fk = __expf(LF[off]), kk = 1.f - fk, qk = bf2f(QH[off]), vd = bf2f(VH[off]), g = bf2f(GH[off]);
        float o = 0.f;
#pragma unroll
        for (int k = 0; k < 64; ++k) { const float f_ = rdlane(fk, k), k_ = rdlane(kk, k), q_ = rdlane(qk, k); S[k] = f_ * S[k] + k_ * vd; o += S[k] * q_; }
        const float r = rsqrtf(wave_sum(o * o) * (1.f / HD) + RMS_EPS);
        OMIX[(size_t)(rowbase + t) * DM + h * HD + lane] = f2bf(o * r * gn * (g / (1.f + __expf(-g))));
    }
#pragma unroll
    for (int k = 0; k < 64; ++k) Sout[k * 64 + lane] = S[k];
}
template <bool SAMPLE>
__device__ __forceinline__ void sb_query(const Ctx& C, int row, int h, int nkeys, int seq  ) {
    const bf16* SQ = (const bf16*)(C.ws + WS_SQ); const bf16* SK = (const bf16*)(C.ws + WS_SK); const bf16* SV = (const bf16*)(C.ws + WS_SV);
    const float* ck = (const float*)C.in[I_CK]; const float* cv = (const float*)C.in[I_CV]; const int* pt = (const int*)C.in[I_PT];
    bf16* OMIX = (bf16*)(C.ws + WS_OMIX);
    const int lane = C.lane; const float bias2 = ((const float*)C.in[I_SBB])[h] * LOG2E;
    float q[64];
    { const v4u* qp = (const v4u*)(SQ + (size_t)row * HW + h * HD);
#pragma unroll
      for (int c = 0; c < 8; ++c) { const v4u w = qp[c]; q[8 * c] = bflo(w.x); q[8 * c + 1] = bfhi(w.x); q[8 * c + 2] = bflo(w.y); q[8 * c + 3] = bfhi(w.y); q[8 * c + 4] = bflo(w.z); q[8 * c + 5] = bfhi(w.z); q[8 * c + 6] = bflo(w.w); q[8 * c + 7] = bfhi(w.w); } }
    float Cc = 1.f, o = 0.f;
    for (int base = nkeys > 0 ? ((nkeys - 1) & ~63) : -1; base >= 0; base -= 64) {
        const int j = base + lane; const bool valid = j < nkeys; const int jc = valid ? j : nkeys - 1;
        float z = 0.f;
        if (SAMPLE && jc < PAST) {
            const float* kr = ck + (((size_t)pt[seq * NPAGES + (jc >> 7)] * PAGE + (jc & 127)) * NH + h) * HD;
#pragma unroll
            for (int c = 0; c < 16; ++c) { const f32x4 w = ((const f32x4*)kr)[c]; z += q[4 * c] * w.x + q[4 * c + 1] * w.y + q[4 * c + 2] * w.z + q[4 * c + 3] * w.w; }
        } else {
            const size_t krow = SAMPLE ? (size_t)(MP + seq * TDEC + (jc - PAST)) : (size_t)seq * SEQ + jc;
            const v4u* kr = (const v4u*)(SK + krow * HW + h * HD);
#pragma unroll
            for (int c = 0; c < 8; ++c) { const v4u w = kr[c]; z += q[8 * c] * bflo(w.x) + q[8 * c + 1] * bfhi(w.x) + q[8 * c + 2] * bflo(w.y) + q[8 * c + 3] * bfhi(w.y) + q[8 * c + 4] * bflo(w.z) + q[8 * c + 5] * bfhi(w.z) + q[8 * c + 6] * bflo(w.w) + q[8 * c + 7] * bfhi(w.w); }
        }
        const float u = valid ? exp2f(z + bias2) : 0.f;
        float incl = 1.f / (1.f + u);
#pragma unroll
        for (int off = 1; off < 64; off <<= 1) { const float y = __shfl_down(incl, off); if (lane + off < 64) incl *= y; }
        const float a = u * incl * Cc;
        Cc *= __shfl(incl, 0);
        const int nk = nkeys - base < 64 ? nkeys - base : 64;
        for (int jj = 0; jj < nk; ++jj) {
            const float aj = __shfl(a, jj); const int jk = base + jj; float vv;
            if (SAMPLE && jk < PAST) vv = cv[(((size_t)pt[seq * NPAGES + (jk >> 7)] * PAGE + (jk & 127)) * NH + h) * HD + lane];
            else { const size_t vrow = SAMPLE ? (size_t)(MP + seq * TDEC + (jk - PAST)) : (size_t)seq * SEQ + jk; vv = bf2f(SV[vrow * HW + h * HD + lane]); }
            o += aj * vv;
        }
    }
    OMIX[(size_t)row * DM + HW + h * HD + lane] = f2bf(o);
}
__device__ __forceinline__ void p2_mix1(const Ctx& C) {
    for (int rep = 0; rep < (PROBE_PH == 102 ? 2 : 1); ++rep) {
    for (int cid = C.gw; cid < NBATCH * NH * (SEQ / 64); cid += C.ngw) hgrn_h1(C, cid);
    const int w = C.gw, nw = C.ngw;
    for (int i = w; i < NDEC * NH; i += nw) { const int n = i / NH, h = i % NH; hgrn_chain(C, MP + n * TDEC, TDEC, h, (const float*)C.in[I_SH] + (size_t)i * 4096, C.out + O_HS + (size_t)i * 4096); }
    }
    __syncthreads();
    for (int rep = 0; rep < (PROBE_PH == 101 ? 2 : 1); ++rep) sbs_phase(C);
    __syncthreads();
    for (int rep = 0; rep < (PROBE_PH == 100 ? 2 : 1); ++rep) sb_prompt_phase(C);
}
__device__ __forceinline__ void p4_mix3(const Ctx& C) {
    for (int cid = C.gw; cid < NBATCH * NH * (SEQ / 64); cid += C.ngw) hgrn_h3(C, cid);
}

__device__ __forceinline__ void thin_row(const float* xin, const bf16* br, const float* gpost, float* xout, const float* gpre, bf16* hrow, int lane) {
    const f32x4* xr = (const f32x4*)xin + lane; const v2u* bp = (const v2u*)br + lane; const f32x4* gp = (const f32x4*)gpost + lane;
    f32x4 b[4]; float s = 0.f;
#pragma unroll
    for (int j = 0; j < 4; ++j) { const v2u w = bp[64 * j]; b[j] = (f32x4){bflo(w.x), bfhi(w.x), bflo(w.y), bfhi(w.y)}; s += (b[j].x * b[j].x + b[j].y * b[j].y) + (b[j].z * b[j].z + b[j].w * b[j].w); }
    const float r = rsqrtf(wave_sum(s) * (1.f / DM) + RMS_EPS);
    float s2 = 0.f;
#pragma unroll
    for (int j = 0; j < 4; ++j) { b[j] = xr[64 * j] + b[j] * r * gp[64 * j]; s2 += (b[j].x * b[j].x + b[j].y * b[j].y) + (b[j].z * b[j].z + b[j].w * b[j].w); }
    f32x4* xo = (f32x4*)xout + lane;
#pragma unroll
    for (int j = 0; j < 4; ++j) xo[64 * j] = b[j];
    if (hrow) {
        const float r2 = rsqrtf(wave_sum(s2) * (1.f / DM) + RMS_EPS); const f32x4* g2 = (const f32x4*)gpre + lane; v2u* o8 = (v2u*)hrow + lane;
#pragma unroll
        for (int j = 0; j < 4; ++j) { const f32x4 gg = g2[64 * j]; v2u w; w.x = pk_bf16(b[j].x * r2 * gg.x, b[j].y * r2 * gg.y); w.y = pk_bf16(b[j].z * r2 * gg.z, b[j].w * r2 * gg.w); o8[64 * j] = w; }
    }
}
template <int WHICH>
__device__ __forceinline__ void p_thin(const Ctx& C) {
    const bf16* BR = (const bf16*)(C.ws + WS_BR); bf16* H = (bf16*)(C.ws + WS_H);
    float* X1 = (float*)(C.ws + WS_X1); float* X2 = (float*)(C.ws + WS_X2);
    const float* gpost = (const float*)C.in[WHICH == 0 ? I_GMIXPOST : WHICH == 1 ? I_GCAPOST : I_GFFNPOST];
    const float* gpre = (const float*)C.in[WHICH == 0 ? I_GCAPRE : I_GFFNPRE];
    for (int m = C.gw; m < MT; m += C.ngw) {
        const float* xin; float* xout;
        if (WHICH == 0) { xin = m < MP ? (const float*)C.in[I_XP] + (size_t)m * DM : (const float*)C.in[I_XS] + (size_t)(m - MP) * DM; xout = X1 + (size_t)m * DM; }
        else if (WHICH == 1) { xin = X1 + (size_t)m * DM; xout = X2 + (size_t)m * DM; }
        else { xin = X2 + (size_t)m * DM; xout = m < MP ? C.out + O_YP + (size_t)m * DM : C.out + O_YS + (size_t)(m - MP) * DM; }
        thin_row(xin, BR + (size_t)m * DM, gpost, xout, gpre, WHICH == 2 ? nullptr : H + (size_t)m * DM, C.lane);
    }
}

__device__ __forceinline__ void p6_naive(const Ctx& C) {
    const bf16* QCA = (const bf16*)(C.ws + WS_QCA); const bf16* MK = (const bf16*)(C.ws + WS_MK); const bf16* MV = (const bf16*)(C.ws + WS_MV);
    const float* cmk = (const float*)C.in[I_MK]; const float* cmv = (const float*)C.in[I_MV]; bf16* OCA = (bf16*)(C.ws + WS_OMIX);
    const int lane = C.lane;
    for (int it = C.gw; it < MT * CAH; it += C.ngw) {
        const int row = it >> 2, h = it & 3;
        const v2u qw = *((const v2u*)(QCA + (size_t)row * DM + h * CAD) + lane);
        const float q0 = bflo(qw.x), q1 = bfhi(qw.x), q2 = bflo(qw.y), q3 = bfhi(qw.y);
        float mx = -1e30f, l = 0.f, o0 = 0.f, o1 = 0.f, o2 = 0.f, o3 = 0.f;
        for (int m = 0; m < NMEM; ++m) {
            float k0, k1, k2, k3, v0, v1, v2, v3;
            if (row < MP) { const size_t off = ((size_t)((row >> 13) * NMEM + m)) * DM + h * CAD; const v2u kw = *((const v2u*)(MK + off) + lane), vw = *((const v2u*)(MV + off) + lane);
                k0 = bflo(kw.x); k1 = bfhi(kw.x); k2 = bflo(kw.y); k3 = bfhi(kw.y); v0 = bflo(vw.x); v1 = bfhi(vw.x); v2 = bflo(vw.y); v3 = bfhi(vw.y); }
            else { const size_t off = ((size_t)(((row - MP) >> 3) * NMEM + m)) * DM + h * CAD; const f32x4 kw = *((const f32x4*)(cmk + off) + lane), vw = *((const f32x4*)(cmv + off) + lane);
                k0 = kw.x; k1 = kw.y; k2 = kw.z; k3 = kw.w; v0 = vw.x; v1 = vw.y; v2 = vw.z; v3 = vw.w; }
            const float s = wave_sum(q0 * k0 + q1 * k1 + q2 * k2 + q3 * k3);
            const float mn = fmaxf(mx, s), sc = exp2f(mx - mn), p = exp2f(s - mn);
            l = l * sc + p; o0 = o0 * sc + p * v0; o1 = o1 * sc + p * v1; o2 = o2 * sc + p * v2; o3 = o3 * sc + p * v3; mx = mn;
        }
        const float il = 1.f / l; v2u w; w.x = pk_bf16(o0 * il, o1 * il); w.y = pk_bf16(o2 * il, o3 * il);
        *((v2u*)(OCA + (size_t)row * DM + h * CAD) + lane) = w;
    }
}

__device__ __forceinline__ float gelu_tanh(float x) { return x / (1.f + __expf(-1.5957691216057308f * (x + 0.044715f * x * x * x))); }
__device__ __forceinline__ void ld8(const bf16* p, float (&v)[8]) { const v4u w = *(const v4u*)p; v[0] = bflo(w.x); v[1] = bfhi(w.x); v[2] = bflo(w.y); v[3] = bfhi(w.y); v[4] = bflo(w.z); v[5] = bfhi(w.z); v[6] = bflo(w.w); v[7] = bfhi(w.w); }
__device__ __forceinline__ void ld8f(const float* p, float (&v)[8]) { const f32x4 a = *(const f32x4*)p, b = *(const f32x4*)(p + 4); v[0] = a.x; v[1] = a.y; v[2] = a.z; v[3] = a.w; v[4] = b.x; v[5] = b.y; v[6] = b.z; v[7] = b.w; }
__device__ __forceinline__ void p10_convgate(const Ctx& C) {
    const bf16* U = (const bf16*)(C.ws + WS_U); bf16* G = (bf16*)(C.ws + WS_G);
    const float* cw = (const float*)C.in[I_CONVW]; const float* cb = (const float*)C.in[I_CONVB]; const float* sc = (const float*)C.in[I_SC];
    constexpr int NCH = DFF / 8, NPI = (MP / 32) * NCH, NSI = NDEC * NCH;
    const int gt = C.gw * 64 + C.lane, ngt = C.ngw * 64;
    for (int it = gt; it < NPI + NSI; it += ngt) {
        int row0, nrows, c; float m1[2][8], m2[2][8];
        if (it < NPI) { const int seg = it / NCH; c = (it % NCH) * 8; row0 = seg * 32; nrows = 32;
            if ((row0 & (SEQ - 1)) == 0) {
#pragma unroll
                for (int hf = 0; hf < 2; ++hf)
#pragma unroll
                    for (int e = 0; e < 8; ++e) { m1[hf][e] = 0.f; m2[hf][e] = 0.f; }
            } else {
#pragma unroll
                for (int hf = 0; hf < 2; ++hf) { ld8(U + (size_t)(row0 - 1) * DFF2 + c + hf * DFF, m1[hf]); ld8(U + (size_t)(row0 - 2) * DFF2 + c + hf * DFF, m2[hf]); }
            }
        } else { const int j = it - NPI, n = j / NCH; c = (j % NCH) * 8; row0 = MP + n * TDEC; nrows = TDEC;
#pragma unroll
            for (int hf = 0; hf < 2; ++hf) { ld8f(sc + ((size_t)n * 2 + 1) * DFF2 + c + hf * DFF, m1[hf]); ld8f(sc + ((size_t)n * 2) * DFF2 + c + hf * DFF, m2[hf]); }
        }
        float w0[2][8], w1[2][8], w2[2][8], bb[2][8];
#pragma unroll
        for (int hf = 0; hf < 2; ++hf) { ld8f(cw + c + hf * DFF, w0[hf]); ld8f(cw + DFF2 + c + hf * DFF, w1[hf]); ld8f(cw + 2 * DFF2 + c + hf * DFF, w2[hf]); ld8f(cb + c + hf * DFF, bb[hf]); }
        const bf16* up = U + (size_t)row0 * DFF2 + c; bf16* gp = G + (size_t)row0 * DFF + c;
#pragma unroll 4
        for (int r = 0; r < nrows; ++r) {
            float u[2][8], res[2][8];
            ld8(up + (size_t)r * DFF2, u[0]); ld8(up + (size_t)r * DFF2 + DFF, u[1]);
#pragma unroll
            for (int hf = 0; hf < 2; ++hf)
#pragma unroll
                for (int e = 0; e < 8; ++e) { res[hf][e] = bb[hf][e] + w0[hf][e] * m2[hf][e] + w1[hf][e] * m1[hf][e] + w2[hf][e] * u[hf][e]; m2[hf][e] = m1[hf][e]; m1[hf][e] = u[hf][e]; }
            v4u o;
            o.x = pk_bf16(gelu_tanh(res[0][0]) * res[1][0], gelu_tanh(res[0][1]) * res[1][1]); o.y = pk_bf16(gelu_tanh(res[0][2]) * res[1][2], gelu_tanh(res[0][3]) * res[1][3]);
            o.z = pk_bf16(gelu_tanh(res[0][4]) * res[1][4], gelu_tanh(res[0][5]) * res[1][5]); o.w = pk_bf16(gelu_tanh(res[0][6]) * res[1][6], gelu_tanh(res[0][7]) * res[1][7]);
            *(v4u*)(gp + (size_t)r * DFF) = o;
        }
    }
}
enum { PH_PRO = 0, PH_INPROJ, PH_MIX1, PH_SCAN, PH_MIX3, PH_OPROJ, PH_THIN0, PH_CQ, PH_CA, PH_CO, PH_THIN1, PH_UP, PH_CONV, PH_DOWN, PH_THIN2, NPH };
#ifndef MK_ONE_LAUNCH
#define MK_ONE_LAUNCH 1
#endif
__global__ void __launch_bounds__(NTHREADS, 2) fwd(Args args) {
    extern __shared__ __attribute__((aligned(16))) unsigned char lds_raw[];
    Ctx C;
    C.in = args.in; C.out = args.out; C.ws = args.ws; C.lds = (LAS unsigned char*)lds_raw;
    C.tid = threadIdx.x; C.lane = C.tid & 63; C.wave = __builtin_amdgcn_readfirstlane(C.tid >> 6);
    C.gw = blockIdx.x * NWAVES + C.wave; C.ngw = gridDim.x * NWAVES;
    const int G = gridDim.x, bid = blockIdx.x;
    volatile LAS unsigned* MISC = (volatile LAS unsigned*)(C.lds + MISC_OFF);
    for (int u = C.tid; u < (LDS_BYTES - LDSCTL_OFF) / 4; u += NTHREADS) ((LAS unsigned*)(C.lds + LDSCTL_OFF))[u] = 0u;
    __syncthreads();
    const int lo = args.ph_lo, hi = args.ph_hi;
    XcdBarrier bar; bar.bar = (unsigned*)(C.ws + WS_CTL) + CW_BAR; bar.x = 0; bar.st = nullptr;
    bar = xcd_barrier_post((unsigned*)(C.ws + WS_CTL) + CW_BAR, MISC + 8);
#define IN(k) (lo <= (k) && (k) < hi)
#define SEAM(k) do { if (IN(k) && IN((k) + 1)) xcd_barrier(bar); } while (0)
#define PHASE(k, ...) do { if (IN(k)) { __VA_ARGS__ if constexpr (PROBE_PH == (k)) { __VA_ARGS__ } } } while (0)
    bf16* H = (bf16*)(C.ws + WS_H);
    PHASE(PH_PRO, p0_prologue(C);); SEAM(PH_PRO);
    PHASE(PH_INPROJ, { pg8::Gemm g{H, (const bf16*)(C.ws + WS_WIN), MT, DIN, DM}; pg8::StaticOrder S; S.init(MT, DIN, G, bid);
          pg8::EpiInProj E{(bf16*)(C.ws + WS_QH), (bf16*)(C.ws + WS_VH), (bf16*)(C.ws + WS_GH), (bf16*)(C.ws + WS_SQ), (bf16*)(C.ws + WS_SK), (bf16*)(C.ws + WS_SV), (float*)(C.ws + WS_LF),
                           (const float*)(C.ws + WS_LB), C.out + O_KP, C.out + O_VP, C.out + O_KS, C.out + O_VS, SQ_SCALE};
          pg8::gemm_phase<pg8::EpiInProj, pg8::StaticOrder, true, true>(C.lds + RING_OFF, g, S, E); }
        { pg8::Gemm g{(const bf16*)(C.ws + WS_MN), (const bf16*)(C.ws + WS_WCKV), NBATCH * NMEM, 2 * DM, DM}; pg8::StaticOrder S; S.init(NBATCH * NMEM, 2 * DM, G, (bid + G - 184 % G) % G);
          pg8::EpiMemKV E{(bf16*)(C.ws + WS_MK), (bf16*)(C.ws + WS_MV), C.out + O_MKP, C.out + O_MVP};
          pg8::gemm_phase<pg8::EpiMemKV, pg8::StaticOrder, true, true>(C.lds + RING_OFF, g, S, E); }); SEAM(PH_INPROJ);
    PHASE(PH_MIX1, p2_mix1(C);); SEAM(PH_MIX1);
    PHASE(PH_SCAN, hgrn_h2(C); sbs_combine(C);); SEAM(PH_SCAN);
    PHASE(PH_MIX3, p4_mix3(C);); SEAM(PH_MIX3);
    PHASE(PH_OPROJ, pg8::Gemm g{(const bf16*)(C.ws + WS_OMIX), (const bf16*)(C.ws + WS_WO), MT, DM, DM}; pg8::StaticOrder S; S.init(MT, DM, G, bid);
        pg8::EpiStore<false> E{(bf16*)(C.ws + WS_BR), DM, 1.f, nullptr};
        pg8::gemm_phase<pg8::EpiStore<false>, pg8::StaticOrder, true, true>(C.lds + RING_OFF, g, S, E);); SEAM(PH_OPROJ);
    PHASE(PH_THIN0, p_thin<0>(C);); SEAM(PH_THIN0);
    PHASE(PH_CQ, pg8::Gemm g{H, (const bf16*)(C.ws + WS_WCQ), MT, DM, DM}; pg8::StaticOrder S; S.init(MT, DM, G, bid);
        pg8::EpiStore<false> E{(bf16*)(C.ws + WS_QCA), DM, CQ_SCALE, nullptr};
        pg8::gemm_phase<pg8::EpiStore<false>, pg8::StaticOrder, true, true>(C.lds + RING_OFF, g, S, E);); SEAM(PH_CQ);
    PHASE(PH_CA, ca_phase(C);); SEAM(PH_CA);
    PHASE(PH_CO, pg8::Gemm g{(const bf16*)(C.ws + WS_OMIX), (const bf16*)(C.ws + WS_WCO), MT, DM, DM}; pg8::StaticOrder S; S.init(MT, DM, G, bid);
        pg8::EpiStore<false> E{(bf16*)(C.ws + WS_BR), DM, 1.f, nullptr};
        pg8::gemm_phase<pg8::EpiStore<false>, pg8::StaticOrder, true, true>(C.lds + RING_OFF, g, S, E);); SEAM(PH_CO);
    PHASE(PH_THIN1, p_thin<1>(C);); SEAM(PH_THIN1);
    PHASE(PH_UP, pg8::Gemm g{H, (const bf16*)(C.ws + WS_WUP), MT, DFF2, DM}; pg8::StaticOrder S; S.init(MT, DFF2, G, bid);
        pg8::EpiStore<true> E{(bf16*)(C.ws + WS_U), DFF2, 1.f, C.out};
        pg8::gemm_phase<pg8::EpiStore<true>, pg8::StaticOrder, true, true>(C.lds + RING_OFF, g, S, E);); SEAM(PH_UP);
    PHASE(PH_CONV, p10_convgate(C);); SEAM(PH_CONV);
    PHASE(PH_DOWN, pg8::Gemm g{(const bf16*)(C.ws + WS_G), (const bf16*)(C.ws + WS_WDN), MT, DM, DFF}; pg8::StaticOrder S; S.init(MT, DM, G, bid);
        pg8::EpiStore<false> E{(bf16*)(C.ws + WS_BR), DM, 1.f, nullptr};
        pg8::gemm_phase<pg8::EpiStore<false>, pg8::StaticOrder, true, true>(C.lds + RING_OFF, g, S, E);); SEAM(PH_DOWN);
    PHASE(PH_THIN2, p_thin<2>(C););
#undef IN
#undef PHASE
#undef SEAM
}

extern "C" void kernel_launch(void* const* d_in, const int* in_sizes, int n_in, void* d_out, int out_size, void* d_ws, size_t ws_size, hipStream_t stream) {
    static int grid = 0;
    if (grid == 0) {
        if (n_in != N_IN || (size_t)out_size != O_END || ws_size < WS_END) { fprintf(stderr, "kernel_launch: unexpected problem: n_in %d out %d ws %zu\n", n_in, out_size, ws_size); grid = -1; return; }
        int dev = 0, cus = 0, per_cu = 0;
        if (hipGetDevice(&dev) != hipSuccess || hipDeviceGetAttribute(&cus, hipDeviceAttributeMultiprocessorCount, dev) != hipSuccess) { grid = -1; return; }
        if (hipFuncSetAttribute((const void*)fwd, hipFuncAttributeMaxDynamicSharedMemorySize, LDS_BYTES) != hipSuccess) { fprintf(stderr, "kernel_launch: hipFuncSetAttribute failed\n"); grid = -1; return; }
        if (hipOccupancyMaxActiveBlocksPerMultiprocessor(&per_cu, (const void*)fwd, NTHREADS, LDS_BYTES) != hipSuccess || per_cu < 1) fprintf(stderr, "kernel_launch: occupancy query says %d\n", per_cu);
        (void)hipGetLastError();
        grid = cus;
    }
    if (grid < 0) return;
    (void)hipMemsetAsync((char*)d_ws + WS_CTL, 0, CTL_ZERO_BYTES, stream);
    Args a{};
    for (int i = 0; i < N_IN; ++i) a.in[i] = d_in[i];
    a.out = (float*)d_out; a.ws = (unsigned char*)d_ws;
    a.ph_lo = 0; a.ph_hi = NPH;
    hipLaunchKernelGGL(fwd, dim3(grid), dim3(NTHREADS), LDS_BYTES, stream, a);
}
```

```cpp
#include <hip/hip_runtime.h>
#include <cstdio>
#include <cstdint>
namespace pg8 {
#define PG8_LAS __attribute__((address_space(3)))
typedef unsigned short bf16_t;
typedef short bf16x8 __attribute__((ext_vector_type(8)));
typedef float f32x4 __attribute__((ext_vector_type(4)));
typedef unsigned u32x4 __attribute__((ext_vector_type(4)));
constexpr int BM = 256, BK = 64, HALF = 128, HTB = HALF * BK * 2  , STAGE_BYTES = 8 * HTB, NXCD = 8, WGM = 8;

__host__ __device__ __forceinline__ int lds_byte(int r, int c) { const int st = (r >> 4) * 2 + (c >> 5), rr = r & 15, cc = c & 31, ob = rr * 64 + cc * 2; return st * 1024 + (ob ^ (((ob >> 9) & 1) << 5)); }
__host__ __device__ __forceinline__ void stage_rc(int b, int& R, int& C) { const int st = b / 1024, sb = b % 1024, swz = sb ^ (((sb >> 9) & 1) << 5); R = (st >> 1) * 16 + swz / 64; C = (st & 1) * 32 + (swz % 64) / 2; }
__host__ __device__ __forceinline__ int perm32(int rho) { const int n = rho >> 4, i = rho & 15; return 8 * (i >> 2) + 4 * n + (i & 3); }

struct Unit { int pm, pn; };
struct Gemm { const bf16_t* A; const bf16_t* Bt; int M, N, K; };

struct StaticOrder {
    int nM, nN, nwg, G, c;
    __host__ __device__ void init(int M, int N, int G_, int c_) { nM = M / BM; nN = N / BM; nwg = nM * nN; G = G_; c = c_; }
    __host__ __device__ bool next(int i, Unit& u) const {
        const long L = (long)i * G + c; if (L >= nwg) return false;
        int wgid = (int)L; { const int q = nwg / NXCD, r = nwg % NXCD, xcd = wgid % NXCD, off = wgid / NXCD; wgid = (xcd < r ? xcd * (q + 1) : r * (q + 1) + (xcd - r) * q) + off; }
        const int nig = WGM * nN, gid = wgid / nig, fm = gid * WGM, gsz = (nM - fm) < WGM ? (nM - fm) : WGM;
        u.pm = fm + ((wgid % nig) % gsz); u.pn = (wgid % nig) / gsz; return true;
    }
    __device__ __forceinline__ void a_ready(const Unit&) const {}
    __device__ __forceinline__ void done(const Unit&) const {}
};

__device__ __forceinline__ unsigned cvt_pk_bf16(float lo, float hi) { unsigned r; asm volatile("v_cvt_pk_bf16_f32 %0, %1, %2" : "=v"(r) : "v"(lo), "v"(hi)); return r; }
typedef float f32x2 __attribute__((ext_vector_type(2)));
typedef __bf16 bf16x2_t __attribute__((ext_vector_type(2)));
__device__ __forceinline__ unsigned pk_bf16(float lo, float hi) { f32x2 v = {lo, hi}; bf16x2_t b = __builtin_convertvector(v, bf16x2_t); return __builtin_bit_cast(unsigned, b); }
__device__ __forceinline__ u32x4 pk8(f32x4 a, f32x4 b) { u32x4 w; w.x = pk_bf16(a[0], a[1]); w.y = pk_bf16(a[2], a[3]); w.z = pk_bf16(b[0], b[1]); w.w = pk_bf16(b[2], b[3]); return w; }

template <bool CAP> struct EpiStore {
    static constexpr bool PERM = true, AFTER_DRAIN = false;
    bf16_t* O; int ldc; float scale; float* outb;
    __device__ __forceinline__ void operator()(const f32x4 (&acc)[2][2][4][2], const Unit& u, int wr, int wc, int fr, int fq) const {
        const int row0 = u.pm * BM + wr * 64 + fr, col0 = u.pn * BM + wc * 32 + 8 * fq;
#pragma unroll
        for (int ai = 0; ai < 2; ++ai)
#pragma unroll
            for (int m = 0; m < 4; ++m) {
                const int row = row0 + ai * HALF + m * 16;
                float* cap = nullptr;
                if constexpr (CAP) {
                    if (row < 16384) { const int t = row & 8191; if (t >= 8190) cap = outb + 34668544 + (size_t)((row >> 13) * 2 + (t - 8190)) * 5632; }
                    else { const int r2 = row - 16384, t = r2 & 7; if (t >= 6) cap = outb + 40982528 + (size_t)((r2 >> 3) * 2 + (t - 6)) * 5632; }
                }
#pragma unroll
                for (int bj = 0; bj < 2; ++bj) {
                    const int col = col0 + bj * HALF;
                    const f32x4 v0 = acc[ai][bj][m][0] * scale, v1 = acc[ai][bj][m][1] * scale;
                    *(u32x4*)(O + (size_t)row * ldc + col) = pk8(v0, v1);
                    if constexpr (CAP) { if (cap) { *(f32x4*)(cap + col) = v0; *(f32x4*)(cap + col + 4) = v1; } }
                }
            }
    }
};

struct EpiInProj {
    static constexpr bool PERM = true, AFTER_DRAIN = false;
    bf16_t *QH, *VH, *GH, *SQ, *SK, *SV; float* LF; const float* LB; float* kp; float* vp; float* ks; float* vs; float sqscale;
    __device__ __forceinline__ void operator()(const f32x4 (&acc)[2][2][4][2], const Unit& u, int wr, int wc, int fr, int fq) const {
        const int seg = u.pn >> 1;
        const int row0 = u.pm * BM + wr * 64 + fr, col0 = (u.pn & 1) * BM + wc * 32 + 8 * fq;
        if (seg == 1) {
#pragma unroll
            for (int bj = 0; bj < 2; ++bj) {
                const int col = col0 + bj * HALF;
                const f32x4 l0 = *(const f32x4*)(LB + col), l1 = *(const f32x4*)(LB + col + 4);
#pragma unroll
                for (int ai = 0; ai < 2; ++ai)
#pragma unroll
                    for (int m = 0; m < 4; ++m) {
                        const int row = row0 + ai * HALF + m * 16;
                        f32x4 o0, o1;
#pragma unroll
                        for (int e = 0; e < 4; ++e) {
                            const float s0 = 1.f / (1.f + __expf(-acc[ai][bj][m][0][e])), s1 = 1.f / (1.f + __expf(-acc[ai][bj][m][1][e]));
                            o0[e] = __logf(l0[e] + (1.f - l0[e]) * s0); o1[e] = __logf(l1[e] + (1.f - l1[e]) * s1);
                        }
                        *(f32x4*)(LF + (size_t)row * 512 + col) = o0; *(f32x4*)(LF + (size_t)row * 512 + col + 4) = o1;
                    }
            }
            return;
        }
        bf16_t* dst = seg == 0 ? QH : seg == 2 ? VH : seg == 3 ? GH : seg == 4 ? SQ : seg == 5 ? SK : SV;
        const float sc = seg == 4 ? sqscale : 1.f;
        float* fp = seg == 5 ? kp : seg == 6 ? vp : nullptr;
        float* fs = seg == 5 ? ks : vs;
#pragma unroll
        for (int ai = 0; ai < 2; ++ai)
#pragma unroll
            for (int m = 0; m < 4; ++m) {
                const int row = row0 + ai * HALF + m * 16;
#pragma unroll
                for (int bj = 0; bj < 2; ++bj) {
                    const int col = col0 + bj * HALF;
                    const f32x4 v0 = acc[ai][bj][m][0], v1 = acc[ai][bj][m][1];
                    *(u32x4*)(dst + (size_t)row * 512 + col) = pk8(v0 * sc, v1 * sc);
                    if (fp) { float* f = row < 16384 ? fp + (size_t)row * 512 + col : fs + (size_t)(row - 16384) * 512 + col; *(f32x4*)f = v0; *(f32x4*)(f + 4) = v1; }
                }
            }
    }
};

struct EpiMemKV {
    static constexpr bool PERM = true, AFTER_DRAIN = false;
    bf16_t *MK, *MV; float *ok, *ov;
    __device__ __forceinline__ void operator()(const f32x4 (&acc)[2][2][4][2], const Unit& u, int wr, int wc, int fr, int fq) const {
        const int seg = u.pn >> 2;
        const int row0 = u.pm * BM + wr * 64 + fr, col0 = (u.pn & 3) * BM + wc * 32 + 8 * fq;
        bf16_t* dst = seg == 0 ? MK : MV; float* fo = seg == 0 ? ok : ov;
#pragma unroll
        for (int ai = 0; ai < 2; ++ai)
#pragma unroll
            for (int m = 0; m < 4; ++m) {
                const int row = row0 + ai * HALF + m * 16;
#pragma unroll
                for (int bj = 0; bj < 2; ++bj) {
                    const int col = col0 + bj * HALF;
                    const f32x4 v0 = acc[ai][bj][m][0], v1 = acc[ai][bj][m][1];
                    *(u32x4*)(dst + (size_t)row * 1024 + col) = pk8(v0, v1);
                    *(f32x4*)(fo + (size_t)row * 1024 + col) = v0; *(f32x4*)(fo + (size_t)row * 1024 + col + 4) = v1;
                }
            }
    }
};

template <class Epi, class Sched, bool ALIGN_EPI = false, bool SP2 = false>
__device__ __forceinline__ void gemm_phase(PG8_LAS unsigned char* lds, const Gemm g, const Sched& S, const Epi& E) {
    const int tid = threadIdx.x, wid = __builtin_amdgcn_readfirstlane(tid >> 6), lane = tid & 63, wr = wid >> 2, wc = wid & 3, fr = lane & 15, fq = lane >> 4;
    const int K = g.K, nt = K / BK;
    unsigned voffA[2], voffB[2];
#pragma unroll
    for (int i = 0; i < 2; ++i) { int R, C; stage_rc(tid * 16 + i * 8192, R, C); const int Rb = Epi::PERM ? ((R & ~31) + perm32(R & 31)) : R;
        voffA[i] = (unsigned)(R * K + C) * 2u; voffB[i] = (unsigned)(Rb * K + C) * 2u; }
    const size_t kstep = (size_t)(BK * 2);
    const size_t hstep = (size_t)HALF * K * 2;
    const size_t tstep = 2 * hstep;
    const unsigned ldsw = (unsigned)wid * 1024u;
    const int aoff = lds_byte(wr * 64 + fr, fq * 8), boff = lds_byte(wc * 32 + fr, fq * 8);
#define PG8_SA(b, h) (((b) * 2 + (h)) * HTB)
#define PG8_SB(b, h) ((4 + (b) * 2 + (h)) * HTB)
#define PG8_STAGE(bufoff, gbase, voff) do { _Pragma("unroll") for (int _i = 0; _i < 2; ++_i) \
        __builtin_amdgcn_global_load_lds((const unsigned*)((const char*)(gbase) + (voff)[_i]), (PG8_LAS unsigned*)(lds + (bufoff) + ldsw + _i * 8192), 16, 0, 0); } while (0)
#define PG8_LDA(dst, b, h) do { _Pragma("unroll") for (int m = 0; m < 4; ++m) _Pragma("unroll") for (int k = 0; k < 2; ++k) dst[m][k] = *(const PG8_LAS bf16x8*)(lds + PG8_SA(b, h) + aoff + m * 2048 + k * 1024); } while (0)
#define PG8_LDB(dst, b, h) do { _Pragma("unroll") for (int n = 0; n < 2; ++n) _Pragma("unroll") for (int k = 0; k < 2; ++k) dst[n][k] = *(const PG8_LAS bf16x8*)(lds + PG8_SB(b, h) + boff + n * 2048 + k * 1024); } while (0)
#define PG8_MMA(ai, bj, At, Bt) do { __builtin_amdgcn_s_setprio(1); _Pragma("unroll") for (int m = 0; m < 4; ++m) _Pragma("unroll") for (int n = 0; n < 2; ++n) _Pragma("unroll") for (int k = 0; k < 2; ++k) \
        acc[ai][bj][m][n] = __builtin_amdgcn_mfma_f32_16x16x32_bf16(Bt[n][k], At[m][k], acc[ai][bj][m][n], 0, 0, 0); __builtin_amdgcn_s_setprio(0); } while (0)
#define PG8_WAIT_V(n) asm volatile("s_waitcnt vmcnt(" #n ")" ::: "memory")
#define PG8_WAIT_L(n) asm volatile("s_waitcnt lgkmcnt(" #n ")" ::: "memory")
#define PG8_BAR __builtin_amdgcn_s_barrier()
#define PG8_SCHED __builtin_amdgcn_sched_barrier(0)
    Unit cur, nxt; int ui = 0;
    if (!S.next(0, cur)) return;
    f32x4 acc[2][2][4][2];
#pragma unroll
    for (int a = 0; a < 2; ++a)
#pragma unroll
        for (int b = 0; b < 2; ++b)
#pragma unroll
            for (int m = 0; m < 4; ++m)
#pragma unroll
                for (int n = 0; n < 2; ++n) acc[a][b][m][n] = (f32x4){0.f, 0.f, 0.f, 0.f};
    bf16x8 At[4][2], B0[2][2], B1[2][2];
    const char* cA = (const char*)g.A + (size_t)cur.pm * tstep; const char* cB = (const char*)g.Bt + (size_t)cur.pn * tstep;
    S.a_ready(cur);
    if constexpr (SP2) {
        PG8_STAGE(PG8_SB(0, 0), cB, voffB); PG8_STAGE(PG8_SB(0, 1), cB + hstep, voffB); PG8_STAGE(PG8_SA(0, 0), cA, voffA); PG8_STAGE(PG8_SA(0, 1), cA + hstep, voffA);
        if (wr == 1) PG8_BAR;
        PG8_WAIT_V(2); PG8_BAR;
        PG8_STAGE(PG8_SB(1, 0), cB + kstep, voffB); PG8_STAGE(PG8_SA(1, 0), cA + kstep, voffA); PG8_STAGE(PG8_SB(1, 1), cB + hstep + kstep, voffB);
        PG8_WAIT_V(6); PG8_BAR;
    } else {
        PG8_STAGE(PG8_SB(0, 0), cB, voffB); PG8_STAGE(PG8_SA(0, 0), cA, voffA); PG8_STAGE(PG8_SB(0, 1), cB + hstep, voffB); PG8_STAGE(PG8_SA(0, 1), cA + hstep, voffA);
        if (wr == 1) PG8_BAR;
        PG8_WAIT_V(4); PG8_BAR;
        PG8_STAGE(PG8_SB(1, 0), cB + kstep, voffB); PG8_STAGE(PG8_SA(1, 0), cA + kstep, voffA); PG8_STAGE(PG8_SB(1, 1), cB + hstep + kstep, voffB);
        PG8_WAIT_V(6); PG8_BAR;
    }
    for (;;) {
        const bool has_next = S.next(ui + 1, nxt);
        const char* nA = has_next ? (const char*)g.A + (size_t)nxt.pm * tstep : cA; const char* nB = has_next ? (const char*)g.Bt + (size_t)nxt.pn * tstep : cB;
        for (int t = 0; t < nt; t += 2) {
            const bool last = (t == nt - 2);
            const char* a1 = cA + (size_t)(t + 1) * kstep;
            const char* a2 = last ? nA : cA + (size_t)(t + 2) * kstep; const char* b2 = last ? nB : cB + (size_t)(t + 2) * kstep;
            const char* a3 = a2 + kstep; const char* b3 = b2 + kstep;
            if (last && has_next) S.a_ready(nxt);
            if constexpr (SP2) {
            PG8_LDB(B0, 0, 0); PG8_LDB(B1, 0, 1); PG8_SCHED; PG8_LDA(At, 0, 0); PG8_STAGE(PG8_SA(1, 1), a1 + hstep, voffA);
            PG8_WAIT_V(8); PG8_WAIT_L(0); PG8_BAR; PG8_MMA(0, 0, At, B0); PG8_MMA(0, 1, At, B1); PG8_BAR; PG8_SCHED;
            PG8_LDA(At, 0, 1); PG8_STAGE(PG8_SB(0, 0), b2, voffB); PG8_STAGE(PG8_SB(0, 1), b2 + hstep, voffB); PG8_STAGE(PG8_SA(0, 0), a2, voffA);
            PG8_WAIT_V(8); PG8_WAIT_L(0); PG8_BAR; PG8_MMA(1, 0, At, B0); PG8_MMA(1, 1, At, B1); PG8_BAR; PG8_SCHED;
            PG8_LDB(B0, 1, 0); PG8_LDB(B1, 1, 1); PG8_SCHED; PG8_LDA(At, 1, 0); PG8_STAGE(PG8_SA(0, 1), a2 + hstep, voffA);
            PG8_WAIT_V(8); PG8_WAIT_L(0); PG8_BAR; PG8_MMA(0, 0, At, B0); PG8_MMA(0, 1, At, B1); PG8_BAR; PG8_SCHED;
            PG8_LDA(At, 1, 1); PG8_STAGE(PG8_SB(1, 0), b3, voffB); PG8_STAGE(PG8_SB(1, 1), b3 + hstep, voffB); PG8_STAGE(PG8_SA(1, 0), a3, voffA);
            PG8_WAIT_V(8); PG8_WAIT_L(0); PG8_BAR; PG8_MMA(1, 0, At, B0); PG8_MMA(1, 1, At, B1); PG8_BAR; PG8_SCHED;
            } else {
            PG8_LDB(B0, 0, 0); PG8_SCHED; PG8_LDA(At, 0, 0); PG8_STAGE(PG8_SA(1, 1), a1 + hstep, voffA);
            PG8_WAIT_L(8); PG8_BAR; PG8_WAIT_L(0); PG8_MMA(0, 0, At, B0); PG8_BAR; PG8_SCHED;
            PG8_LDB(B1, 0, 1); PG8_STAGE(PG8_SB(0, 0), b2, voffB);
            PG8_BAR; PG8_WAIT_L(0); PG8_MMA(0, 1, At, B1); PG8_BAR;
            PG8_LDA(At, 0, 1); PG8_STAGE(PG8_SA(0, 0), a2, voffA);
            PG8_BAR; PG8_WAIT_L(0); PG8_MMA(1, 0, At, B0); PG8_BAR; PG8_SCHED;
            PG8_STAGE(PG8_SB(0, 1), b2 + hstep, voffB);
            PG8_WAIT_V(6); PG8_BAR; PG8_MMA(1, 1, At, B1); PG8_BAR;
            PG8_LDB(B0, 1, 0); PG8_SCHED; PG8_LDA(At, 1, 0); PG8_STAGE(PG8_SA(0, 1), a2 + hstep, voffA);
            PG8_WAIT_L(8); PG8_BAR; PG8_WAIT_L(0); PG8_MMA(0, 0, At, B0); PG8_BAR; PG8_SCHED;
            PG8_LDB(B1, 1, 1); PG8_STAGE(PG8_SB(1, 0), b3, voffB);
            PG8_BAR; PG8_WAIT_L(0); PG8_MMA(0, 1, At, B1); PG8_BAR;
            PG8_LDA(At, 1, 1); PG8_STAGE(PG8_SA(1, 0), a3, voffA);
            PG8_BAR; PG8_WAIT_L(0); PG8_MMA(1, 0, At, B0); PG8_BAR; PG8_SCHED;
            PG8_STAGE(PG8_SB(1, 1), b3 + hstep, voffB);
            PG8_WAIT_V(6); PG8_BAR; PG8_MMA(1, 1, At, B1); PG8_BAR;
            }
        }
        if constexpr (ALIGN_EPI) { if (wr == 0) PG8_BAR; }
        if constexpr (!Epi::AFTER_DRAIN) { E(acc, cur, wr, wc, fr, fq); S.done(cur); }
        if (!has_next) break;
#pragma unroll
        for (int a = 0; a < 2; ++a)
#pragma unroll
            for (int b = 0; b < 2; ++b)
#pragma unroll
                for (int m = 0; m < 4; ++m)
#pragma unroll
                    for (int n = 0; n < 2; ++n) acc[a][b][m][n] = (f32x4){0.f, 0.f, 0.f, 0.f};
        cur = nxt; cA = nA; cB = nB; ++ui;
        if constexpr (ALIGN_EPI) { if (wr == 1) PG8_BAR; }
    }
    PG8_WAIT_V(0);
    if constexpr (!ALIGN_EPI) { if (wr == 0) PG8_BAR; }
    PG8_BAR;
    if constexpr (Epi::AFTER_DRAIN) { E.fused(acc, cur, wr, wc, fr, fq, lds, wid, lane); S.done(cur); }
#undef PG8_SA
#undef PG8_SB
#undef PG8_STAGE
#undef PG8_LDA
#undef PG8_LDB
#undef PG8_MMA
#undef PG8_WAIT_V
#undef PG8_WAIT_L
#undef PG8_BAR
#undef PG8_SCHED
}
}
#define GAS __attribute__((address_space(1)))
#define LAS __attribute__((address_space(3)))
#define LDS_WAIT() asm volatile("s_waitcnt lgkmcnt(0)" ::: "memory")
#define VM_WAIT() asm volatile("s_waitcnt vmcnt(0)" ::: "memory")
#define XB_TMO      128
#define XB_XCNT(j)  (256  + 64 * (j))
#define XB_XSUB(j)  (1280 + 64 * (j))
#define XB_XGEN(j)  (2304 + 64 * (j))
#define XB_TOP      3328
#define XB_TOPGEN   3392
#define XCD_BAR_WORDS 3456
#define XB_SPIN_CAP (1u << 23)

__device__ __forceinline__ unsigned xb_ld(unsigned* p)              { return __hip_atomic_load(p, __ATOMIC_RELAXED, __HIP_MEMORY_SCOPE_AGENT); }
__device__ __forceinline__ unsigned xb_add(unsigned* p, unsigned v) { return __hip_atomic_fetch_add(p, v, __ATOMIC_RELAXED, __HIP_MEMORY_SCOPE_AGENT); }
__device__ __forceinline__ unsigned xb_xcc_id() { return (unsigned)__builtin_amdgcn_s_getreg((3 << 11) | 20) & 0xFu; }
#define XB_SPIN(cond, bar) do { unsigned _sp = 0; while (cond) { __builtin_amdgcn_s_sleep(1); \
    if ((++_sp & 255u) == 0u) { if (xb_ld(&(bar)[XB_TMO])) break; if (_sp > XB_SPIN_CAP) { atomicAdd(&(bar)[XB_TMO], 1u); break; } } } } while (0)

struct XcdBarrier {
    unsigned* bar; unsigned x;
    volatile LAS unsigned* st;
};

__device__ __forceinline__ XcdBarrier xcd_barrier_post(unsigned* bar, volatile LAS unsigned* st) {
    XcdBarrier b; b.bar = bar; b.x = xb_xcc_id(); b.st = st;
    if (threadIdx.x == 0) (void)xb_add(&bar[XB_XCNT(b.x)], 1u);
    return b;
}
__device__ __forceinline__ void xcd_barrier_complete(unsigned* bar, unsigned x, unsigned& nloc, unsigned& nx) {
    const unsigned G = gridDim.x * gridDim.y * gridDim.z;
    unsigned sum, cnt, mine, sp = 0u;
    for (;;) {
        sum = 0u; cnt = 0u; mine = 0u;
#pragma unroll
        for (unsigned j = 0; j < 16; ++j) { const unsigned c = xb_ld(&bar[XB_XCNT(j)]); sum += c; cnt += (c > 0u) ? 1u : 0u; mine = (j == x) ? c : mine; }
        if (sum == G) break;
        __builtin_amdgcn_s_sleep(1);
        if ((++sp & 255u) == 0u) { if (xb_ld(&bar[XB_TMO])) break; if (sp > XB_SPIN_CAP) { atomicAdd(&bar[XB_TMO], 1u); break; } }
    }
    nloc = mine > 0u ? mine : 1u; nx = cnt > 0u ? cnt : 1u;
}

__device__ __forceinline__ void xcd_barrier(const XcdBarrier& b) {
    asm volatile("s_waitcnt vmcnt(0)" ::: "memory");
    __syncthreads();
    if (threadIdx.x == 0) {
        unsigned* bar = b.bar;
        __builtin_amdgcn_s_waitcnt(0);
        unsigned nloc = b.st[0], nx = b.st[1];
        if (nloc == 0u) { xcd_barrier_complete(bar, b.x, nloc, nx); b.st[0] = nloc; b.st[1] = nx; }
        const unsigned old = xb_add(&bar[XB_XSUB(b.x)], 1u);
        const unsigned gen = old / nloc;
        if (old + 1u == (gen + 1u) * nloc) {
            __builtin_amdgcn_fence(__ATOMIC_RELEASE, "agent");
            asm volatile("s_waitcnt vmcnt(0)" ::: "memory");
            const unsigned og = xb_add(&bar[XB_TOP], 1u);
            const unsigned tg = og / nx;
            if (og + 1u == (tg + 1u) * nx) xb_add(&bar[XB_TOPGEN], 1u);
            else XB_SPIN(xb_ld(&bar[XB_TOPGEN]) == tg, bar);
            __builtin_amdgcn_fence(__ATOMIC_ACQUIRE, "agent");
            xb_add(&bar[XB_XGEN(b.x)], 1u);
            asm volatile("s_waitcnt vmcnt(0)" ::: "memory");
        } else {
            XB_SPIN(xb_ld(&bar[XB_XGEN(b.x)]) == gen, bar);
            __builtin_amdgcn_fence(__ATOMIC_ACQUIRE, "agent");
            asm volatile("s_waitcnt vmcnt(0)" ::: "memory");
        }
    }
    __syncthreads();
}
#define PROBE_PH -1
constexpr int NWAVES = 8, NTHREADS = 512;
constexpr int DM = 1024, SEQ = 8192, NBATCH = 2, MP = NBATCH * SEQ, NDEC = 128, TDEC = 8, MS = NDEC * TDEC, MT = MP + MS;
constexpr int DIN = 3584, HW = 512, NH = 8, HD = 64;
constexpr int NMEM = 256, CAH = 4, CAD = 256, DFF = 2816, DFF2 = 5632;
constexpr int PAST = 2048, PAGE = 128, NPAGES = 16;
constexpr float RMS_EPS = 1e-6f, LOG2E = 1.4426950408889634f;
constexpr float SQ_SCALE = 0.125f * LOG2E;
constexpr float CQ_SCALE = 0.0625f * LOG2E;
enum { I_XP = 0, I_XS, I_CK, I_CV, I_SH, I_SC, I_MK, I_MV, I_PT, I_MEM, I_WIN, I_HGN, I_HLB, I_SBB, I_WO, I_GMIXPRE, I_GMIXPOST, I_GCAPRE, I_GCAPOST, I_GMEM,
       I_WCQ, I_WCK, I_WCV, I_WCO, I_GFFNPRE, I_GFFNPOST, I_WUP, I_CONVW, I_CONVB, I_WDN, N_IN };
constexpr size_t O_YP = 0, O_YS = 16777216, O_KP = 17825792, O_VP = 26214400, O_HP = 34603008, O_CP = 34668544, O_MKP = 34691072, O_MVP = 35215360,
                 O_KS = 35739648, O_VS = 36263936, O_HS = 36788224, O_CS = 40982528, O_END = 42424320;
constexpr size_t MiB = 1u << 20;
constexpr size_t WS_CTL = 0, CTL_ZERO_BYTES = 1 * MiB;
constexpr size_t WS_WIN = 2 * MiB, WS_WO = 9 * MiB, WS_WCQ = 11 * MiB, WS_WCO = 13 * MiB, WS_WCKV = 15 * MiB, WS_WUP = 19 * MiB, WS_WDN = 30 * MiB;
constexpr size_t WS_LB = 36 * MiB, WS_MN = 37 * MiB, WS_MK = 38 * MiB, WS_MV = 39 * MiB;
constexpr size_t WS_H = 40 * MiB, WS_QH = 74 * MiB, WS_LF = 91 * MiB, WS_VH = 125 * MiB, WS_GH = 142 * MiB, WS_SQ = 159 * MiB, WS_SK = 176 * MiB, WS_SV = 193 * MiB;
constexpr size_t WS_OMIX = 210 * MiB, WS_BR = 244 * MiB, WS_X1 = 278 * MiB, WS_X2 = 346 * MiB, WS_QCA = 414 * MiB, WS_U = 448 * MiB, WS_G = 635 * MiB, WS_UCT = 730 * MiB, WS_DC = 762 * MiB, WS_SCT = 763 * MiB, WS_SBP = 780 * MiB, WS_END = 786 * MiB;
constexpr int CW_BAR = 4096;
constexpr int RING_OFF = 0, RING_BYTES = 162816, LDSCTL_OFF = RING_BYTES, MISC_OFF = LDSCTL_OFF + 320, LDS_BYTES = 163840;

typedef unsigned short bf16;
typedef unsigned v4u __attribute__((ext_vector_type(4)));
typedef unsigned v2u __attribute__((ext_vector_type(2)));
typedef float f32x4 __attribute__((ext_vector_type(4)));
using pg8::pk_bf16;
__device__ __forceinline__ float bf2f(unsigned short b) { return __uint_as_float((unsigned)b << 16); }
__device__ __forceinline__ float bflo(unsigned w) { return __uint_as_float(w << 16); }
__device__ __forceinline__ float bfhi(unsigned w) { return __uint_as_float(w & 0xffff0000u); }
__device__ __forceinline__ unsigned short f2bf(float f) { return (unsigned short)(pk_bf16(f, 0.f) & 0xffffu); }
__device__ __forceinline__ float wave_sum(float v) {
#pragma unroll
    for (int o = 1; o < 64; o <<= 1) v += __shfl_xor(v, o);
    return v;
}
__device__ __forceinline__ float rdlane(float v, int l) { return __uint_as_float((unsigned)__builtin_amdgcn_readlane((int)__float_as_uint(v), l)); }

struct Args { const void* in[N_IN]; float* out; unsigned char* ws; int ph_lo, ph_hi; };
struct Ctx { const void* const* in; float* out; unsigned char* ws; LAS unsigned char* lds; int tid, lane, wave, gw, ngw; };

__device__ __forceinline__ void p0_transpose_item(const float* W, int K, int N, bf16* WT, int row_off, LAS float* scr, int item, int lane) {
    const int nblk = N / 32, kb = item / nblk, nb = item % nblk, k0 = 64 * kb, n0 = 32 * nb;
#pragma unroll 8
    for (int i = 0; i < 32; ++i) { const int kk = 2 * i + (lane >> 5); scr[kk * 33 + (lane & 31)] = W[(size_t)(k0 + kk) * N + n0 + (lane & 31)]; }
    LDS_WAIT(); asm volatile("" ::: "memory");
    const int c = lane & 7;
#pragma unroll
    for (int j = 0; j < 4; ++j) { const int n = (lane >> 3) + 8 * j; const LAS float* s = scr + (8 * c) * 33 + n;
        v4u o; o.x = pk_bf16(s[0 * 33], s[1 * 33]); o.y = pk_bf16(s[2 * 33], s[3 * 33]); o.z = pk_bf16(s[4 * 33], s[5 * 33]); o.w = pk_bf16(s[6 * 33], s[7 * 33]);
        *(v4u*)(WT + (size_t)(row_off + n0 + n) * K + k0 + 8 * c) = o; }
    LDS_WAIT(); asm volatile("" ::: "memory");
}
__device__ __forceinline__ void rms_row_to_bf16(const float* xrow, const float* g, bf16* orow, int lane) {
    const f32x4* xr = (const f32x4*)xrow + lane; const f32x4* gr = (const f32x4*)g + lane;
    f32x4 v[4]; float s = 0.f;
#pragma unroll
    for (int j = 0; j < 4; ++j) { v[j] = xr[64 * j]; s += (v[j].x * v[j].x + v[j].y * v[j].y) + (v[j].z * v[j].z + v[j].w * v[j].w); }
    const float r = rsqrtf(wave_sum(s) * (1.f / DM) + RMS_EPS);
    v2u* o8 = (v2u*)orow + lane;
#pragma unroll
    for (int j = 0; j < 4; ++j) { const f32x4 gg = gr[64 * j]; v2u w; w.x = pk_bf16(v[j].x * r * gg.x, v[j].y * r * gg.y); w.y = pk_bf16(v[j].z * r * gg.z, v[j].w * r * gg.w); o8[64 * j] = w; }
}
__device__ __forceinline__ void p0_prologue(const Ctx& C) {
    LAS float* scr = (LAS float*)(C.lds + RING_OFF + C.wave * 16384);
    const float* w_in = (const float*)C.in[I_WIN]; const float* w_o = (const float*)C.in[I_WO]; const float* w_cq = (const float*)C.in[I_WCQ]; const float* w_ck = (const float*)C.in[I_WCK];
    const float* w_cv = (const float*)C.in[I_WCV]; const float* w_co = (const float*)C.in[I_WCO]; const float* w_up = (const float*)C.in[I_WUP]; const float* w_dn = (const float*)C.in[I_WDN];
    bf16* Win = (bf16*)(C.ws + WS_WIN); bf16* Wo = (bf16*)(C.ws + WS_WO); bf16* Wcq = (bf16*)(C.ws + WS_WCQ); bf16* Wco = (bf16*)(C.ws + WS_WCO); bf16* Wckv = (bf16*)(C.ws + WS_WCKV);
    bf16* Wup = (bf16*)(C.ws + WS_WUP); bf16* Wdn = (bf16*)(C.ws + WS_WDN);
    constexpr int I_IN = (DM / 64) * (DIN / 32), I_SQ = (DM / 64) * (DM / 32), I_UP = (DM / 64) * (DFF2 / 32), I_DN = (DFF / 64) * (DM / 32);
    constexpr int NITEMS = I_IN + 5 * I_SQ + I_UP + I_DN;
    for (int it = C.gw; it < NITEMS; it += C.ngw) {
        int r = it;
        if (r < I_IN) { p0_transpose_item(w_in, DM, DIN, Win, 0, scr, r, C.lane); continue; } r -= I_IN;
        if (r < I_SQ) { p0_transpose_item(w_o, DM, DM, Wo, 0, scr, r, C.lane); continue; } r -= I_SQ;
        if (r < I_SQ) { p0_transpose_item(w_cq, DM, DM, Wcq, 0, scr, r, C.lane); continue; } r -= I_SQ;
        if (r < I_SQ) { p0_transpose_item(w_co, DM, DM, Wco, 0, scr, r, C.lane); continue; } r -= I_SQ;
        if (r < I_SQ) { p0_transpose_item(w_ck, DM, DM, Wckv, 0, scr, r, C.lane); continue; } r -= I_SQ;
        if (r < I_SQ) { p0_transpose_item(w_cv, DM, DM, Wckv, DM, scr, r, C.lane); continue; } r -= I_SQ;
        if (r < I_UP) { p0_transpose_item(w_up, DM, DFF2, Wup, 0, scr, r, C.lane); continue; } r -= I_UP;
        p0_transpose_item(w_dn, DFF, DM, Wdn, 0, scr, r, C.lane);
    }
    const float* xp = (const float*)C.in[I_XP]; const float* xs = (const float*)C.in[I_XS]; const float* mem = (const float*)C.in[I_MEM];
    bf16* H = (bf16*)(C.ws + WS_H); bf16* MN = (bf16*)(C.ws + WS_MN);
    const float* g_pre = (const float*)C.in[I_GMIXPRE]; const float* g_mem = (const float*)C.in[I_GMEM];
    for (int m = C.gw; m < MT + NBATCH * NMEM; m += C.ngw) {
        if (m < MP) rms_row_to_bf16(xp + (size_t)m * DM, g_pre, H + (size_t)m * DM, C.lane);
        else if (m < MT) rms_row_to_bf16(xs + (size_t)(m - MP) * DM, g_pre, H + (size_t)m * DM, C.lane);
        else rms_row_to_bf16(mem + (size_t)(m - MT) * DM, g_mem, MN + (size_t)(m - MT) * DM, C.lane);
    }
    if (C.gw == 0) {
        const float* lbp = (const float*)C.in[I_HLB]; float* LB = (float*)(C.ws + WS_LB);
        for (int k = C.lane; k < HW; k += 64) { const float a = lbp[k], b = lbp[HW + k]; LB[k] = 1.f / (1.f + __expf(b - a)); }
    }
}
typedef short bf16x8s __attribute__((ext_vector_type(8)));
typedef short s16x4 __attribute__((ext_vector_type(4)));
typedef short v4i16_t __attribute__((ext_vector_type(4)));
constexpr int HRS = 72;
__device__ __forceinline__ s16x4 tr4(const LAS bf16* p) { return __builtin_bit_cast(s16x4, __builtin_amdgcn_ds_read_tr16_b64_v4i16((LAS v4i16_t*)p)); }
__device__ __forceinline__ bf16x8s cat8(s16x4 lo, s16x4 hi) { return (bf16x8s){lo[0], lo[1], lo[2], lo[3], hi[0], hi[1], hi[2], hi[3]}; }
__device__ __forceinline__ f32x4 mfma16(bf16x8s a, bf16x8s b, f32x4 c) { return __builtin_amdgcn_mfma_f32_16x16x32_bf16(a, b, c, 0, 0, 0); }
__device__ __forceinline__ void hg_stage_v(const bf16* VH, int r0, int h, LAS bf16* Vt, int lane) {
#pragma unroll
    for (int it = 0; it < 8; ++it) { const int row = it * 8 + (lane >> 3), ch = lane & 7; const v4u w = *(const v4u*)(VH + (size_t)(r0 + row) * HW + h * HD + ch * 8); *(LAS v4u*)(Vt + row * HRS + ch * 8) = w; }
}
__device__ __forceinline__ void hgrn_h1(const Ctx& C, int cid) {
    const float* LF = (const float*)(C.ws + WS_LF); const bf16* VH = (const bf16*)(C.ws + WS_VH);
    float* UCT = (float*)(C.ws + WS_UCT); float* DC = (float*)(C.ws + WS_DC);
    const int lane = C.lane, i = lane & 15, g = lane >> 4;
    const int chain = cid >> 7, ci = cid & 127, b = chain >> 3, h = chain & 7, r0 = b * SEQ + ci * 64;
    LAS bf16* Vt = (LAS bf16*)(C.lds + RING_OFF + C.wave * 18432); LAS bf16* Kt = Vt + 64 * HRS;
    hg_stage_v(VH, r0, h, Vt, lane);
    const float* lfp = LF + (size_t)r0 * HW + h * HD + lane;
    float bl = 0.f;
#pragma unroll 16
    for (int t = 0; t < 64; ++t) bl += lfp[(size_t)t * HW];
    { float run = 0.f;
#pragma unroll 16
      for (int s = 0; s < 64; ++s) { const float lf = lfp[(size_t)s * HW]; run += lf; Kt[s * HRS + lane] = f2bf((1.f - __expf(lf)) * __expf(bl - run)); } }
    DC[(size_t)cid * 64 + lane] = __expf(bl);
    LDS_WAIT();
#pragma unroll
    for (int kb = 0; kb < 4; ++kb) {
        bf16x8s af[2];
#pragma unroll
        for (int ks = 0; ks < 2; ++ks) af[ks] = cat8(tr4(Kt + (32 * ks + 8 * g + (i >> 2)) * HRS + 16 * kb + (i & 3) * 4), tr4(Kt + (32 * ks + 8 * g + 4 + (i >> 2)) * HRS + 16 * kb + (i & 3) * 4));
#pragma unroll
        for (int db = 0; db < 4; ++db) {
            f32x4 acc = {0.f, 0.f, 0.f, 0.f};
#pragma unroll
            for (int ks = 0; ks < 2; ++ks) { const bf16x8s bfr = cat8(tr4(Vt + (32 * ks + 8 * g + (i >> 2)) * HRS + 16 * db + (i & 3) * 4), tr4(Vt + (32 * ks + 8 * g + 4 + (i >> 2)) * HRS + 16 * db + (i & 3) * 4));
                acc = mfma16(af[ks], bfr, acc); }
            *(f32x4*)(UCT + ((size_t)cid * 64 + 16 * db + i) * 64 + 16 * kb + 4 * g) = acc;
        }
    }
    LDS_WAIT();
}
__device__ __forceinline__ void hgrn_h2(const Ctx& C) {
    const float* UCT = (const float*)(C.ws + WS_UCT); const float* DC = (const float*)(C.ws + WS_DC); bf16* SCT = (bf16*)(C.ws + WS_SCT);
    const int lane = C.lane;
    for (int w = C.gw; w < NBATCH * NH * 64; w += C.ngw) {
        const int chain = w >> 6, d = w & 63; float S = 0.f;
        for (int c0 = 0; c0 < 128; c0 += 16) {
            float u[16], dc[16];
#pragma unroll
            for (int j = 0; j < 16; ++j) { const size_t cid = (size_t)chain * 128 + c0 + j; u[j] = UCT[(cid * 64 + d) * 64 + lane]; dc[j] = DC[cid * 64 + lane]; }
#pragma unroll
            for (int j = 0; j < 16; ++j) { const size_t cid = (size_t)chain * 128 + c0 + j; SCT[(cid * 64 + d) * 64 + lane] = f2bf(S); S = dc[j] * S + u[j]; }
        }
        C.out[O_HP + (size_t)chain * 4096 + lane * 64 + d] = S;
    }
}
__device__ __forceinline__ void hgrn_h3(const Ctx& C, int cid) {
    const float* LF = (const float*)(C.ws + WS_LF); const bf16* QH = (const bf16*)(C.ws + WS_QH); const bf16* VH = (const bf16*)(C.ws + WS_VH); const bf16* GH = (const bf16*)(C.ws + WS_GH);
    const bf16* SCT = (const bf16*)(C.ws + WS_SCT); bf16* OMIX = (bf16*)(C.ws + WS_OMIX); const float* hgn = (const float*)C.in[I_HGN];
    const int lane = C.lane, i = lane & 15, g = lane >> 4;
    const int chain = cid >> 7, ci = cid & 127, b = chain >> 3, h = chain & 7, r0 = b * SEQ + ci * 64;
    LAS bf16* Vt = (LAS bf16*)(C.lds + RING_OFF + C.wave * 18432); LAS bf16* Kb = Vt + 64 * HRS; LAS bf16* Qh = Kb + 16 * HRS; LAS bf16* Qt = Qh + 16 * HRS;
    hg_stage_v(VH, r0, h, Vt, lane);
    const float* lfp = LF + (size_t)r0 * HW + h * HD + lane; const bf16* qp = QH + (size_t)r0 * HW + h * HD + lane;
    float eb[4];
    bf16x8s sfr[4][2];
#pragma unroll
    for (int db = 0; db < 4; ++db)
#pragma unroll
        for (int ks = 0; ks < 2; ++ks) sfr[db][ks] = *(const bf16x8s*)(SCT + ((size_t)cid * 64 + 16 * db + i) * 64 + 32 * ks + 8 * g);
#pragma unroll
    for (int is = 0; is < 4; ++is) {
        const float ri = is ? eb[is - 1] : 0.f, er = __expf(ri);
        { float run = 0.f;
#pragma unroll
          for (int tt = 0; tt < 16; ++tt) { const int t = 16 * is + tt; run += lfp[(size_t)t * HW]; const float qt = bf2f(qp[(size_t)t * HW]) * __expf(run);
              Qt[tt * HRS + lane] = f2bf(qt); Qh[tt * HRS + lane] = f2bf(qt * er); }
          eb[is] = ri + run; }
        LDS_WAIT();
        bf16x8s qhf[2], qtf[2];
#pragma unroll
        for (int ks = 0; ks < 2; ++ks) { qhf[ks] = *(const LAS bf16x8s*)(Qh + i * HRS + 32 * ks + 8 * g); qtf[ks] = *(const LAS bf16x8s*)(Qt + i * HRS + 32 * ks + 8 * g); }
        f32x4 o[4];
#pragma unroll
        for (int db = 0; db < 4; ++db) { o[db] = (f32x4){0.f, 0.f, 0.f, 0.f};
#pragma unroll
            for (int ks = 0; ks < 2; ++ks) o[db] = mfma16(sfr[db][ks], qhf[ks], o[db]); }
#pragma unroll
        for (int jp = 0; jp <= is / 2; ++jp) {
            f32x4 x[2];
#pragma unroll
            for (int jj = 0; jj < 2; ++jj) {
                const int j = 2 * jp + jj; x[jj] = (f32x4){0.f, 0.f, 0.f, 0.f};
                if (j <= is) {
                    { float run = (j ? eb[j - 1] : 0.f) - ri;
#pragma unroll
                      for (int ss = 0; ss < 16; ++ss) { const int s = 16 * j + ss; const float lf = lfp[(size_t)s * HW]; run += lf; Kb[ss * HRS + lane] = f2bf((1.f - __expf(lf)) * __expf(-run)); } }
                    LDS_WAIT();
#pragma unroll
                    for (int ks = 0; ks < 2; ++ks) { const bf16x8s kf = *(const LAS bf16x8s*)(Kb + i * HRS + 32 * ks + 8 * g); x[jj] = mfma16(kf, qtf[ks], x[jj]); }
                    if (j == is) {
#pragma unroll
                        for (int e = 0; e < 4; ++e) if (4 * g + e > i) x[jj][e] = 0.f;
                    }
                    LDS_WAIT();
                }
            }
            bf16x8s pb; { const unsigned w0 = pk_bf16(x[0][0], x[0][1]), w1 = pk_bf16(x[0][2], x[0][3]), w2 = pk_bf16(x[1][0], x[1][1]), w3 = pk_bf16(x[1][2], x[1][3]); const v4u ww = {w0, w1, w2, w3}; pb = __builtin_bit_cast(bf16x8s, ww); }
            const int j0 = 2 * jp, j1 = (2 * jp + 1 <= is) ? 2 * jp + 1 : 2 * jp;
#pragma unroll
            for (int db = 0; db < 4; ++db) { const bf16x8s vf = cat8(tr4(Vt + (16 * j0 + 4 * g + (i >> 2)) * HRS + 16 * db + (i & 3) * 4), tr4(Vt + (16 * j1 + 4 * g + (i >> 2)) * HRS + 16 * db + (i & 3) * 4));
                o[db] = mfma16(vf, pb, o[db]); }
        }
        float ss = 0.f;
#pragma unroll
        for (int db = 0; db < 4; ++db) ss += (o[db][0] * o[db][0] + o[db][1] * o[db][1]) + (o[db][2] * o[db][2] + o[db][3] * o[db][3]);
        ss += __shfl_xor(ss, 16); ss += __shfl_xor(ss, 32);
        const float r = rsqrtf(ss * (1.f / HD) + RMS_EPS); const size_t row = (size_t)(r0 + 16 * is + i);
#pragma unroll
        for (int db = 0; db < 4; ++db) { const int d0 = h * HD + 16 * db + 4 * g; const v2u gw = *(const v2u*)(GH + row * HW + d0); const f32x4 gn = *(const f32x4*)(hgn + d0);
            const float g0 = bflo(gw.x), g1 = bfhi(gw.x), g2 = bflo(gw.y), g3 = bfhi(gw.y);
            v2u w; w.x = pk_bf16(o[db][0] * r * gn.x * (g0 / (1.f + __expf(-g0))), o[db][1] * r * gn.y * (g1 / (1.f + __expf(-g1))));
            w.y = pk_bf16(o[db][2] * r * gn.z * (g2 / (1.f + __expf(-g2))), o[db][3] * r * gn.w * (g3 / (1.f + __expf(-g3))));
            *(v2u*)(OMIX + row * DM + d0) = w; }
    }
    LDS_WAIT();
}
typedef float f32x16 __attribute__((ext_vector_type(16)));
constexpr int SB_RS = 72;
constexpr int SB_TILE = 64 * SB_RS;
__device__ __forceinline__ f32x16 mfma32(bf16x8s a, bf16x8s b, f32x16 c) { return __builtin_amdgcn_mfma_f32_32x32x16_bf16(a, b, c, 0, 0, 0); }
__device__ __forceinline__ int sb_crow(int r, int hi) { return (r & 3) + 8 * (r >> 2) + 4 * hi; }
__device__ __forceinline__ void sb_subtile(const LAS bf16* Kp, const LAS bf16* Vp, const bf16x8s (&qf)[4], float bias2, bool diag, int key0, int qpos, int hi, float& Cc, f32x16& o0, f32x16& o1) {
    f32x16 p;
#pragma unroll
    for (int r = 0; r < 16; ++r) p[r] = bias2;
#pragma unroll
    for (int ks = 0; ks < 4; ++ks) { const bf16x8s kf = *(const LAS bf16x8s*)(Kp + 16 * ks); p = mfma32(kf, qf[ks], p); }
    float E = 1.f;
#pragma unroll
    for (int r = 0; r < 16; ++r) { float u = __builtin_amdgcn_exp2f(p[r]); if (diag) u = (key0 + r < qpos) ? u : 0.f; const float tt = E * u; E += tt; p[r] = tt; }
    const float Ti = __builtin_amdgcn_rcpf(E), Tp = __shfl_xor(Ti, 32);
    const float G = Ti * (hi ? Cc : Cc * Tp);
    Cc = Cc * Ti * Tp;
#pragma unroll
    for (int r = 0; r < 16; ++r) p[r] *= G;
    bf16x8s pa[2];
#pragma unroll
    for (int s = 0; s < 2; ++s) { const v4u ww = {pk_bf16(p[8 * s], p[8 * s + 1]), pk_bf16(p[8 * s + 2], p[8 * s + 3]), pk_bf16(p[8 * s + 4], p[8 * s + 5]), pk_bf16(p[8 * s + 6], p[8 * s + 7])}; pa[s] = __builtin_bit_cast(bf16x8s, ww); }
#pragma unroll
    for (int s = 0; s < 2; ++s) {
        const LAS bf16* vb = Vp + 8 * s * SB_RS;
        const bf16x8s v0 = cat8(tr4(vb), tr4(vb + 4 * SB_RS)), v1 = cat8(tr4(vb + 32), tr4(vb + 4 * SB_RS + 32));
        o0 = mfma32(pa[s], v0, o0); o1 = mfma32(pa[s], v1, o1);
    }
}
constexpr int SBK_RS = 72, SBV_RS = 160;
constexpr int SBK_T = 128 * SBK_RS, SBV_T = 128 * SBV_RS;
template <bool MASK>
__device__ __forceinline__ void sb_weights(f32x16& p, int key0, int qpos, int hi, float& Cc, bf16x8s (&pa)[2]) {
    float E = 1.f;
#pragma unroll
    for (int r = 0; r < 16; ++r) { float u = __builtin_amdgcn_exp2f(p[r]); if (MASK) u = (key0 + r < qpos) ? u : 0.f; const float tt = E * u; E += tt; p[r] = tt; }
    const float Ti = __builtin_amdgcn_rcpf(E);
    const auto rr = __builtin_amdgcn_permlane32_swap(__float_as_uint(Ti), __float_as_uint(Ti), false, false);
    const float Tp = __uint_as_float(rr[0] == __float_as_uint(Ti) ? rr[1] : rr[0]);
    const float G = Ti * (hi ? Cc : Cc * Tp);
    Cc = Cc * Ti * Tp;
#pragma unroll
    for (int s = 0; s < 2; ++s) { const v4u ww = {pk_bf16(p[8 * s] * G, p[8 * s + 1] * G), pk_bf16(p[8 * s + 2] * G, p[8 * s + 3] * G), pk_bf16(p[8 * s + 4] * G, p[8 * s + 5] * G), pk_bf16(p[8 * s + 6] * G, p[8 * s + 7] * G)}; pa[s] = __builtin_bit_cast(bf16x8s, ww); }
}
__device__ __forceinline__ void grp4_barrier(volatile LAS unsigned* cnt, unsigned& target, int lane) {
    target += 4u;
    if (lane == 0) __hip_atomic_fetch_add((LAS unsigned*)cnt, 1u, __ATOMIC_RELAXED, __HIP_MEMORY_SCOPE_WORKGROUP);
    while (*cnt < target) __builtin_amdgcn_s_sleep(1);
    asm volatile("" ::: "memory");
}
__device__ __forceinline__ void sb_unit4(const Ctx& C, int b, int h, int qb, volatile LAS unsigned* gcnt, unsigned& gtarget) {
    const bf16* SQ = (const bf16*)(C.ws + WS_SQ); const bf16* SK = (const bf16*)(C.ws + WS_SK); const bf16* SV = (const bf16*)(C.ws + WS_SV); bf16* OMIX = (bf16*)(C.ws + WS_OMIX);
    const int tid = C.tid, lane = C.lane, r32 = lane & 31, hi = lane >> 5, w = C.wave;
    const int q0 = qb * 128, qlo = q0 + 32 * w, qpos = qlo + r32;
    LAS bf16* Kl = (LAS bf16*)(C.lds + RING_OFF); LAS bf16* Vl = Kl + 2 * SBK_T;
    const float bias2 = ((const float*)C.in[I_SBB])[h] * LOG2E;
    bf16x8s qf[4];
#pragma unroll
    for (int ks = 0; ks < 4; ++ks) qf[ks] = *(const bf16x8s*)(SQ + (size_t)(b * SEQ + qpos) * HW + h * HD + 16 * ks + 8 * hi);
    const int srow = tid >> 3, sch = tid & 7;
    const bf16* gk = SK + (size_t)(b * SEQ + srow) * HW + h * HD + sch * 8; const bf16* gv = SV + (size_t)(b * SEQ + srow) * HW + h * HD + sch * 8;
    const int skoff = srow * SBK_RS + sch * 8, svoff = srow * SBV_RS + sch * 8;
    const int nt = qb + 1, ntp = nt + (nt & 1), sd = q0 / 32 + w;
    v4u rk[4], rv[4];
#pragma unroll
    for (int j = 0; j < 4; ++j) { rk[j] = *(const v4u*)(gk + (size_t)((ntp - 1) * 128 + 32 * j) * HW); rv[j] = *(const v4u*)(gv + (size_t)((ntp - 1) * 128 + 32 * j) * HW); }
#pragma unroll
    for (int j = 0; j < 4; ++j) { *(LAS v4u*)(Kl + skoff + 32 * j * SBK_RS) = rk[j]; *(LAS v4u*)(Vl + svoff + 32 * j * SBV_RS) = rv[j]; }
    asm volatile("" :: "v"(qf[0]), "v"(qf[1]), "v"(qf[2]), "v"(qf[3]));
    f32x16 o0, o1;
#pragma unroll
    for (int r = 0; r < 16; ++r) { o0[r] = 0.f; o1[r] = 0.f; }
    float Cc = 1.f;
    const int kap = 16 * ((r32 >> 2) & 1) + (r32 & 3) + 4 * (r32 >> 3);
    const int koff = kap * SBK_RS + 8 * hi;
    const int gi = lane >> 4, i16 = lane & 15;
    const int voff = (16 * hi + (i16 >> 2)) * SBV_RS + 16 * (gi & 1) + (i16 & 3) * 4;
    f32x16 pinit;
#pragma unroll
    for (int r = 0; r < 16; ++r) pinit[r] = bias2;
#define SB_QK(dst, sub) do { const LAS bf16* kp_ = Kc + (sub) * 32 * SBK_RS + koff; bf16x8s kf_[4]; _Pragma("unroll") for (int ks = 0; ks < 4; ++ks) kf_[ks] = *(const LAS bf16x8s*)(kp_ + 16 * ks); \
        dst = mfma32(kf_[0], qf[0], pinit); dst = mfma32(kf_[1], qf[1], dst); dst = mfma32(kf_[2], qf[2], dst); dst = mfma32(kf_[3], qf[3], dst); } while (0)
#define SB_PV(sub) do { const LAS bf16* vb_ = Vc + (sub) * 32 * SBV_RS + voff; \
        const bf16x8s v00 = cat8(tr4(vb_), tr4(vb_ + 4 * SBV_RS)), v01 = cat8(tr4(vb_ + 32), tr4(vb_ + 4 * SBV_RS + 32)); \
        const bf16x8s v10 = cat8(tr4(vb_ + 8 * SBV_RS), tr4(vb_ + 12 * SBV_RS)), v11 = cat8(tr4(vb_ + 8 * SBV_RS + 32), tr4(vb_ + 12 * SBV_RS + 32)); \
        o0 = mfma32(pa[0], v00, o0); o1 = mfma32(pa[0], v01, o1); o0 = mfma32(pa[1], v10, o0); o1 = mfma32(pa[1], v11, o1); } while (0)
    v4u rk2[4], rv2[4];
#define SB_ISSUE(RK, RV, t) do { _Pragma("unroll") for (int j = 0; j < 4; ++j) { RK[j] = *(const v4u*)(gk + (size_t)((t) * 128 + 32 * j) * HW); RV[j] = *(const v4u*)(gv + (size_t)((t) * 128 + 32 * j) * HW); } } while (0)
#define SB_WRITE(RK, RV, bufi) do { _Pragma("unroll") for (int j = 0; j < 4; ++j) { *(LAS v4u*)(Kl + (bufi) * SBK_T + skoff + 32 * j * SBK_RS) = RK[j]; *(LAS v4u*)(Vl + (bufi) * SBV_T + svoff + 32 * j * SBV_RS) = RV[j]; } } while (0)
#define SB_TILE(T, bufi) do { \
        const LAS bf16* Kc = Kl + (bufi) * SBK_T; const LAS bf16* Vc = Vl + (bufi) * SBV_T; \
        const int top = sd - 4 * (T); \
        if (top >= 0) { \
            const int hs = top < 3 ? top : 3; \
            f32x16 pc, pn; bf16x8s pa[2]; \
            if (hs == 3) SB_QK(pc, 3); else if (hs == 2) SB_QK(pc, 2); else if (hs == 1) SB_QK(pc, 1); else SB_QK(pc, 0); \
            _Pragma("unroll") for (int sub = 3; sub >= 0; --sub) { \
                if (sub <= hs) { \
                    if (sub > 0) SB_QK(pn, sub - 1); \
                    const int key0 = 128 * (T) + 32 * sub + 16 * hi; \
                    if (sub == top) sb_weights<true>(pc, key0, qpos, hi, Cc, pa); else sb_weights<false>(pc, key0, qpos, hi, Cc, pa); \
                    SB_PV(sub); \
                    if (sub > 0) pc = pn; \
                } } } } while (0)
    SB_ISSUE(rk2, rv2, ntp - 2);
    grp4_barrier(gcnt, gtarget, lane);
    for (int k = 0; k < ntp; k += 2) {
        { const int ti = ntp - 3 - k; SB_ISSUE(rk, rv, (ti > 0 ? ti : 0)); }
        SB_TILE(ntp - 1 - k, 0);
        SB_WRITE(rk2, rv2, 1);
        grp4_barrier(gcnt, gtarget, lane);
        { const int ti = ntp - 4 - k; SB_ISSUE(rk2, rv2, (ti > 0 ? ti : 0)); }
        SB_TILE(ntp - 2 - k, 1);
        SB_WRITE(rk, rv, 0);
        grp4_barrier(gcnt, gtarget, lane);
    }
#undef SB_ISSUE
#undef SB_WRITE
#undef SB_TILE
#undef SB_QK
#undef SB_PV
    bf16* orow = OMIX + (size_t)(b * SEQ + qlo) * DM + HW + h * HD + r32;
#pragma unroll
    for (int r = 0; r < 16; ++r) { const int q = sb_crow(r, hi); orow[(size_t)q * DM] = f2bf(o0[r]); orow[(size_t)q * DM + 32] = f2bf(o1[r]); }
}
__device__ __forceinline__ void sb_prompt_role(const Ctx& C, volatile LAS unsigned* gcnt, unsigned rep) {
    const int G = gridDim.x, bid = blockIdx.x;
    const int vcu = (G % 8 == 0) ? (bid % 8) * (G / 8) + bid / 8 : bid;
    unsigned gtarget = rep * 4u * 2u * 68u;
    for (int p = vcu; p < NBATCH * NH * 32; p += G) {
        const int bh = p >> 5, s = p & 31;
        sb_unit4(C, bh >> 3, bh & 7, 63 - s, gcnt, gtarget);
        sb_unit4(C, bh >> 3, bh & 7, s, gcnt, gtarget);
    }
}
__device__ __forceinline__ void sbs_item4(const Ctx& C, int n, int half) {
    const bf16* SQ = (const bf16*)(C.ws + WS_SQ); const bf16* SK = (const bf16*)(C.ws + WS_SK); const bf16* SV = (const bf16*)(C.ws + WS_SV);
    const float* ck = (const float*)C.in[I_CK]; const float* cv = (const float*)C.in[I_CV]; const int* pt = (const int*)C.in[I_PT];
    float* PO = (float*)(C.ws + WS_SBP); float* PC = PO + (size_t)NDEC * 2 * NH * TDEC * HD;
    const int lane = C.lane, r32 = lane & 31, hi = lane >> 5, ws = C.wave - 4, h0 = 2 * ws;
    LAS bf16* Kt = (LAS bf16*)(C.lds + RING_OFF + 2 * (SBK_T + SBV_T) * 2) + ws * (2 * 32 * SB_RS); LAS bf16* Vt = Kt + 32 * SB_RS;
    const int qpos = PAST + r32;
    bf16x8s qf[2][4]; float bias2[2];
#pragma unroll
    for (int a = 0; a < 2; ++a) { bias2[a] = ((const float*)C.in[I_SBB])[h0 + a] * LOG2E;
#pragma unroll
        for (int ks = 0; ks < 4; ++ks) { qf[a][ks] = (bf16x8s){0, 0, 0, 0, 0, 0, 0, 0}; if (r32 < TDEC) qf[a][ks] = *(const bf16x8s*)(SQ + (size_t)(MP + n * TDEC + r32) * HW + (h0 + a) * HD + 16 * ks + 8 * hi); } }
    f32x16 o0[2], o1[2]; float Cc[2] = {1.f, 1.f};
#pragma unroll
    for (int a = 0; a < 2; ++a)
#pragma unroll
        for (int r = 0; r < 16; ++r) { o0[a][r] = 0.f; o1[a][r] = 0.f; }
    const int kap = 16 * ((r32 >> 2) & 1) + (r32 & 3) + 4 * (r32 >> 3);
    const LAS bf16* Kp = Kt + kap * SB_RS + 8 * hi;
    const int gi = lane >> 4, i16 = lane & 15;
    const LAS bf16* Vp = Vt + (16 * hi + (i16 >> 2)) * SB_RS + 16 * (gi & 1) + (i16 & 3) * 4;
    const int srow = lane >> 4, sch = lane & 15;
    if (half == 1) {
#pragma unroll
        for (int a = 0; a < 2; ++a) {
#pragma unroll
            for (int it = 0; it < 8; ++it) { const int row = it * 4 + srow; v2u kw = {0u, 0u}, vw = {0u, 0u};
                if (row < TDEC) { kw = *(const v2u*)(SK + (size_t)(MP + n * TDEC + row) * HW + (h0 + a) * HD + sch * 4); vw = *(const v2u*)(SV + (size_t)(MP + n * TDEC + row) * HW + (h0 + a) * HD + sch * 4); }
                *(LAS v2u*)(Kt + row * SB_RS + sch * 4) = kw; *(LAS v2u*)(Vt + row * SB_RS + sch * 4) = vw; }
            LDS_WAIT();
            sb_subtile(Kp, Vp, qf[a], bias2[a], true, PAST + 16 * hi, qpos, hi, Cc[a], o0[a], o1[a]);
            LDS_WAIT();
        }
    }
    const int pg_hi = half ? NPAGES - 1 : NPAGES / 2 - 1, nsteps = (NPAGES / 2) * 4 * 2;
    f32x4 rk[8], rv[8];
    { const size_t base = (((size_t)pt[n * NPAGES + pg_hi] * PAGE + 96 + srow) * NH + h0) * HD + sch * 4;
#pragma unroll
      for (int it = 0; it < 8; ++it) { rk[it] = *(const f32x4*)(ck + base + (size_t)it * 4 * NH * HD); rv[it] = *(const f32x4*)(cv + base + (size_t)it * 4 * NH * HD); } }
    for (int st = 0; st < nsteps; st += 2) {
#pragma unroll
        for (int a = 0; a < 2; ++a) {
#pragma unroll
            for (int it = 0; it < 8; ++it) { const int row = it * 4 + srow;
                const v2u kw = {pk_bf16(rk[it].x, rk[it].y), pk_bf16(rk[it].z, rk[it].w)}, vw = {pk_bf16(rv[it].x, rv[it].y), pk_bf16(rv[it].z, rv[it].w)};
                *(LAS v2u*)(Kt + row * SB_RS + sch * 4) = kw; *(LAS v2u*)(Vt + row * SB_RS + sch * 4) = vw; }
            const int s2 = st + a + 1;
            if (s2 < nsteps) { const int sg = s2 >> 1, pg = pg_hi - (sg >> 2), sub = 3 - (sg & 3);
                const size_t base = (((size_t)pt[n * NPAGES + pg] * PAGE + 32 * sub + srow) * NH + h0 + (s2 & 1)) * HD + sch * 4;
#pragma unroll
                for (int it = 0; it < 8; ++it) { rk[it] = *(const f32x4*)(ck + base + (size_t)it * 4 * NH * HD); rv[it] = *(const f32x4*)(cv + base + (size_t)it * 4 * NH * HD); } }
            LDS_WAIT();
            sb_subtile(Kp, Vp, qf[a], bias2[a], false, 0, qpos, hi, Cc[a], o0[a], o1[a]);
            LDS_WAIT();
        }
    }
#pragma unroll
    for (int a = 0; a < 2; ++a) {
        float* po = PO + ((size_t)(n * 2 + half) * NH + h0 + a) * TDEC * HD;
#pragma unroll
        for (int r = 0; r < 4; ++r) { po[(r + 4 * hi) * HD + r32] = o0[a][r]; po[(r + 4 * hi) * HD + 32 + r32] = o1[a][r]; }
        if (lane < TDEC) PC[((size_t)(n * 2 + half) * NH + h0 + a) * TDEC + lane] = Cc[a];
    }
}
__device__ __forceinline__ void sbs_role(const Ctx& C) {
    for (int it = blockIdx.x; it < NDEC * 2; it += gridDim.x) sbs_item4(C, it >> 1, it & 1);
}
__device__ __forceinline__ void sbs_combine(const Ctx& C) {
    const float* PO = (const float*)(C.ws + WS_SBP); const float* PC = PO + (size_t)NDEC * 2 * NH * TDEC * HD; bf16* OMIX = (bf16*)(C.ws + WS_OMIX);
    const int gt = C.gw * 64 + C.lane, ngt = C.ngw * 64;
    for (int e = gt; e < NDEC * NH * TDEC * HD; e += ngt) {
        const int d = e & 63, q = (e >> 6) & 7, h = (e >> 9) & 7, n = e >> 12;
        const size_t i1 = ((size_t)(n * 2 + 1) * NH + h) * TDEC + q, i0 = ((size_t)(n * 2) * NH + h) * TDEC + q;
        OMIX[(size_t)(MP + n * TDEC + q) * DM + HW + h * HD + d] = f2bf(PO[i1 * HD + d] + PC[i1] * PO[i0 * HD + d]);
    }
}
constexpr int CA_KRS = 264, CA_VRS = 288;
constexpr int CA_KT = 64 * CA_KRS, CA_VT = 64 * CA_VRS;
__device__ __forceinline__ void ca_unit(const Ctx& C, int b, int hh, int qblk) {
    const bf16* QCA = (const bf16*)(C.ws + WS_QCA); const bf16* MK = (const bf16*)(C.ws + WS_MK); const bf16* MV = (const bf16*)(C.ws + WS_MV); bf16* OCA = (bf16*)(C.ws + WS_OMIX);
    const int tid = C.tid, lane = C.lane, r32 = lane & 31, hi = lane >> 5, w = C.wave, gi = lane >> 4, i16 = lane & 15;
    LAS bf16* Kl = (LAS bf16*)(C.lds + RING_OFF); LAS bf16* Vl = Kl + 2 * CA_KT; LAS float* wsf = (LAS float*)(Vl + 2 * CA_VT) + w * 32;
    const size_t qrow = (size_t)b * SEQ + 256 * qblk + 32 * w;
    bf16x8s qf[16];
#pragma unroll
    for (int ks = 0; ks < 16; ++ks) qf[ks] = *(const bf16x8s*)(QCA + (qrow + r32) * DM + hh * CAD + 16 * ks + 8 * hi);
    const bf16* gk = MK + (size_t)(b * NMEM) * DM + hh * CAD; const bf16* gv = MV + (size_t)(b * NMEM) * DM + hh * CAD;
    v4u rg[4];
#define CA_LOAD(i) do { const bf16* src_ = ((i) < 4 ? gk : gv) + (size_t)(((i) & 3) * 64) * DM; _Pragma("unroll") for (int p_ = 0; p_ < 4; ++p_) { const int id_ = tid + 512 * p_; rg[p_] = *(const v4u*)(src_ + (size_t)(id_ >> 5) * DM + (id_ & 31) * 8); } } while (0)
#define CA_WRITE(i) do { _Pragma("unroll") for (int p_ = 0; p_ < 4; ++p_) { const int id_ = tid + 512 * p_; if ((i) < 4) *(LAS v4u*)(Kl + ((i) & 1) * CA_KT + (id_ >> 5) * CA_KRS + (id_ & 31) * 8) = rg[p_]; else *(LAS v4u*)(Vl + ((i) & 1) * CA_VT + (id_ >> 5) * CA_VRS + (id_ & 31) * 8) = rg[p_]; } } while (0)
    CA_LOAD(0); CA_WRITE(0); __syncthreads();
    f32x16 s[8];
#pragma unroll
    for (int j = 0; j < 8; ++j)
#pragma unroll
        for (int r = 0; r < 16; ++r) s[j][r] = 0.f;
#pragma unroll
    for (int kt = 0; kt < 4; ++kt) {
        if (kt < 3) CA_LOAD(kt + 1);
        const LAS bf16* Kc = Kl + (kt & 1) * CA_KT + r32 * CA_KRS + 8 * hi;
#pragma unroll
        for (int sub = 0; sub < 2; ++sub)
#pragma unroll
            for (int ks = 0; ks < 16; ++ks) { const bf16x8s kf = *(const LAS bf16x8s*)(Kc + sub * 32 * CA_KRS + 16 * ks); s[2 * kt + sub] = mfma32(kf, qf[ks], s[2 * kt + sub]); }
        if (kt < 3) { CA_WRITE(kt + 1); } __syncthreads();
    }
    float mx = s[0][0];
#pragma unroll
    for (int j = 0; j < 8; ++j)
#pragma unroll
        for (int r = 0; r < 16; ++r) mx = fmaxf(mx, s[j][r]);
    mx = fmaxf(mx, __shfl_xor(mx, 32));
    float l = 0.f;
#pragma unroll
    for (int j = 0; j < 8; ++j)
#pragma unroll
        for (int r = 0; r < 16; ++r) { s[j][r] = __builtin_amdgcn_exp2f(s[j][r] - mx); l += s[j][r]; }
    l += __shfl_xor(l, 32);
    if (hi == 0) wsf[r32] = l;
    bf16x8s pa[8][2];
#pragma unroll
    for (int j = 0; j < 8; ++j)
#pragma unroll
        for (int s2 = 0; s2 < 2; ++s2) { const v4u ww = {pk_bf16(s[j][8 * s2], s[j][8 * s2 + 1]), pk_bf16(s[j][8 * s2 + 2], s[j][8 * s2 + 3]), pk_bf16(s[j][8 * s2 + 4], s[j][8 * s2 + 5]), pk_bf16(s[j][8 * s2 + 6], s[j][8 * s2 + 7])}; pa[j][s2] = __builtin_bit_cast(bf16x8s, ww); }
    CA_LOAD(4); CA_WRITE(4); __syncthreads();
    f32x16 o[8];
#pragma unroll
    for (int j = 0; j < 8; ++j)
#pragma unroll
        for (int r = 0; r < 16; ++r) o[j][r] = 0.f;
#pragma unroll
    for (int kt = 0; kt < 4; ++kt) {
        if (kt >= 1 && kt < 3) CA_LOAD(kt + 5);
        const LAS bf16* Vc = Vl + (kt & 1) * CA_VT + (4 * hi + (i16 >> 2)) * CA_VRS + 16 * (gi & 1) + (i16 & 3) * 4;
#pragma unroll
        for (int sub = 0; sub < 2; ++sub)
#pragma unroll
            for (int s2 = 0; s2 < 2; ++s2)
#pragma unroll
                for (int dt = 0; dt < 8; ++dt) { const LAS bf16* vb = Vc + (32 * sub + 16 * s2) * CA_VRS + 32 * dt; const bf16x8s vf = cat8(tr4(vb), tr4(vb + 8 * CA_VRS)); o[dt] = mfma32(pa[2 * kt + sub][s2], vf, o[dt]); }
        if (kt == 0) CA_LOAD(5);
        if (kt < 3) { CA_WRITE(kt + 5); }
        __syncthreads();
    }
#undef CA_LOAD
#undef CA_WRITE
    float rl[16];
#pragma unroll
    for (int r = 0; r < 16; ++r) rl[r] = 1.f / wsf[sb_crow(r, hi)];
    bf16* orow = OCA + qrow * DM + hh * CAD + r32;
#pragma unroll
    for (int r = 0; r < 16; ++r) { const int q = sb_crow(r, hi);
#pragma unroll
        for (int dt = 0; dt < 8; ++dt) orow[(size_t)q * DM + 32 * dt] = f2bf(o[dt][r] * rl[r]); }
}
__device__ __forceinline__ void cas_item(const Ctx& C, int n, int hh) {
    const bf16* QCA = (const bf16*)(C.ws + WS_QCA); const float* cmk = (const float*)C.in[I_MK]; const float* cmv = (const float*)C.in[I_MV]; bf16* OCA = (bf16*)(C.ws + WS_OMIX);
    const int tid = C.tid, lane = C.lane, r32 = lane & 31, hi = lane >> 5, w = C.wave, gi = lane >> 4, i16 = lane & 15;
    LAS bf16* Vt = (LAS bf16*)(C.lds + RING_OFF) + w * (32 * CA_VRS);
    LAS float* part = (LAS float*)(C.lds + RING_OFF);
    LAS float* red = (LAS float*)(C.lds + RING_OFF + 8 * 32 * CA_VRS * 2);
    bf16x8s qf[16];
#pragma unroll
    for (int ks = 0; ks < 16; ++ks) { qf[ks] = (bf16x8s){0, 0, 0, 0, 0, 0, 0, 0}; if (r32 < TDEC) qf[ks] = *(const bf16x8s*)(QCA + (size_t)(MP + n * TDEC + r32) * DM + hh * CAD + 16 * ks + 8 * hi); }
    f32x16 s;
#pragma unroll
    for (int r = 0; r < 16; ++r) s[r] = 0.f;
    const float* kr = cmk + ((size_t)(n * NMEM + 32 * w + r32) * CAH + hh) * CAD + 8 * hi;
#pragma unroll
    for (int kb = 0; kb < 2; ++kb) {
        f32x4 ra[8], rb[8];
#pragma unroll
        for (int k8 = 0; k8 < 8; ++k8) { ra[k8] = *(const f32x4*)(kr + 16 * (8 * kb + k8)); rb[k8] = *(const f32x4*)(kr + 16 * (8 * kb + k8) + 4); }
#pragma unroll
        for (int k8 = 0; k8 < 8; ++k8) { const v4u ww = {pk_bf16(ra[k8].x, ra[k8].y), pk_bf16(ra[k8].z, ra[k8].w), pk_bf16(rb[k8].x, rb[k8].y), pk_bf16(rb[k8].z, rb[k8].w)};
            s = mfma32(__builtin_bit_cast(bf16x8s, ww), qf[8 * kb + k8], s); }
    }
    const float* vr = cmv + ((size_t)(n * NMEM + 32 * w) * CAH + hh) * CAD + lane * 4;
#pragma unroll
    for (int vb = 0; vb < 2; ++vb) {
        f32x4 rvv[16];
#pragma unroll
        for (int j = 0; j < 16; ++j) rvv[j] = *(const f32x4*)(vr + (size_t)(16 * vb + j) * CAH * CAD);
#pragma unroll
        for (int j = 0; j < 16; ++j) { const v2u ww = {pk_bf16(rvv[j].x, rvv[j].y), pk_bf16(rvv[j].z, rvv[j].w)}; *(LAS v2u*)(Vt + (16 * vb + j) * CA_VRS + lane * 4) = ww; }
    }
    float mx = s[0];
#pragma unroll
    for (int r = 1; r < 16; ++r) mx = fmaxf(mx, s[r]);
    mx = fmaxf(mx, __shfl_xor(mx, 32));
    if (lane < TDEC) red[w * TDEC + lane] = mx;
    LDS_WAIT(); __syncthreads();
    { float m2 = red[(r32 & 7)];
#pragma unroll
      for (int ww = 1; ww < 8; ++ww) m2 = fmaxf(m2, red[ww * TDEC + (r32 & 7)]);
      mx = m2; }
    float l = 0.f;
#pragma unroll
    for (int r = 0; r < 16; ++r) { s[r] = __builtin_amdgcn_exp2f(s[r] - mx); l += s[r]; }
    l += __shfl_xor(l, 32);
    if (lane < TDEC) red[64 + w * TDEC + lane] = l;
    bf16x8s pa[2];
#pragma unroll
    for (int s2 = 0; s2 < 2; ++s2) { const v4u ww = {pk_bf16(s[8 * s2], s[8 * s2 + 1]), pk_bf16(s[8 * s2 + 2], s[8 * s2 + 3]), pk_bf16(s[8 * s2 + 4], s[8 * s2 + 5]), pk_bf16(s[8 * s2 + 6], s[8 * s2 + 7])}; pa[s2] = __builtin_bit_cast(bf16x8s, ww); }
    LDS_WAIT();
    f32x16 o[8];
#pragma unroll
    for (int j = 0; j < 8; ++j)
#pragma unroll
        for (int r = 0; r < 16; ++r) o[j][r] = 0.f;
    const LAS bf16* Vc = Vt + (4 * hi + (i16 >> 2)) * CA_VRS + 16 * (gi & 1) + (i16 & 3) * 4;
#pragma unroll
    for (int s2 = 0; s2 < 2; ++s2)
#pragma unroll
        for (int dt = 0; dt < 8; ++dt) { const LAS bf16* vb = Vc + 16 * s2 * CA_VRS + 32 * dt; const bf16x8s vf = cat8(tr4(vb), tr4(vb + 8 * CA_VRS)); o[dt] = mfma32(pa[s2], vf, o[dt]); }
    LDS_WAIT(); __syncthreads();
#pragma unroll
    for (int r = 0; r < 4; ++r)
#pragma unroll
        for (int dt = 0; dt < 8; ++dt) part[(w * TDEC + r + 4 * hi) * CAD + 32 * dt + r32] = o[dt][r];
    LDS_WAIT(); __syncthreads();
    { const int q = tid >> 6, d0 = (tid & 63) * 4;
      float lt = 0.f;
#pragma unroll
      for (int ww = 0; ww < 8; ++ww) lt += red[64 + ww * TDEC + q];
      f32x4 a = {0.f, 0.f, 0.f, 0.f};
#pragma unroll
      for (int ww = 0; ww < 8; ++ww) a += *(const LAS f32x4*)(part + (ww * TDEC + q) * CAD + d0);
      const float il = 1.f / lt; const v2u ow = {pk_bf16(a.x * il, a.y * il), pk_bf16(a.z * il, a.w * il)};
      *(v2u*)(OCA + (size_t)(MP + n * TDEC + q) * DM + hh * CAD + d0) = ow; }
    LDS_WAIT(); __syncthreads();
}
__device__ __forceinline__ void ca_phase(const Ctx& C) {
    for (int it = blockIdx.x; it < NDEC * CAH; it += gridDim.x) cas_item(C, it >> 2, it & 3);
    const int G = gridDim.x, bid = blockIdx.x; const int vcu = (G % 8 == 0) ? (bid % 8) * (G / 8) + bid / 8 : bid;
    for (int u = vcu; u < NBATCH * CAH * 32; u += G) ca_unit(C, u >> 7, (u >> 5) & 3, u & 31);
}
__device__ __forceinline__ void hgrn_chain(const Ctx& C, int rowbase, int T, int h, const float* S0, float* Sout) {
    const float* LF = (const float*)(C.ws + WS_LF); const bf16* QH = (const bf16*)(C.ws + WS_QH); const bf16* VH = (const bf16*)(C.ws + WS_VH); const bf16* GH = (const bf16*)(C.ws + WS_GH);
    bf16* OMIX = (bf16*)(C.ws + WS_OMIX); const float* hgn = (const float*)C.in[I_HGN];
    const int lane = C.lane; const float gn = hgn[h * HD + lane];
    float S[64];
#pragma unroll
    for (int k = 0; k < 64; ++k) S[k] = S0 ? S0[k * 64 + lane] : 0.f;
    for (int t = 0; t < T; ++t) {
        const size_t off = (size_t)(rowbase + t) * HW + h * HD + lane;
        const float fk = __expf(LF[off]), kk = 1.f - fk, qk = bf2f(QH[off]), vd = bf2f(VH[off]), g = bf2f(GH[off]);
        float o = 0.f;
#pragma unroll
        for (int k = 0; k < 64; ++k) { const float f_ = rdlane(fk, k), k_ = rdlane(kk, k), q_ = rdlane(qk, k); S[k] = f_ * S[k] + k_ * vd; o += S[k] * q_; }
        const float r = rsqrtf(wave_sum(o * o) * (1.f / HD) + RMS_EPS);
        OMIX[(size_t)(rowbase + t) * DM + h * HD + lane] = f2bf(o * r * gn * (g / (1.f + __expf(-g))));
    }
#pragma unroll
    for (int k = 0; k < 64; ++k) Sout[k * 64 + lane] = S[k];
}
template <bool SAMPLE>
__device__ __forceinline__ void sb_query(const Ctx& C, int row, int h, int nkeys, int seq  ) {
    const bf16* SQ = (const bf16*)(C.ws + WS_SQ); const bf16* SK = (const bf16*)(C.ws + WS_SK); const bf16* SV = (const bf16*)(C.ws + WS_SV);
    const float* ck = (const float*)C.in[I_CK]; const float* cv = (const float*)C.in[I_CV]; const int* pt = (const int*)C.in[I_PT];
    bf16* OMIX = (bf16*)(C.ws + WS_OMIX);
    const int lane = C.lane; const float bias2 = ((const float*)C.in[I_SBB])[h] * LOG2E;
    float q[64];
    { const v4u* qp = (const v4u*)(SQ + (size_t)row * HW + h * HD);
#pragma unroll
      for (int c = 0; c < 8; ++c) { const v4u w = qp[c]; q[8 * c] = bflo(w.x); q[8 * c + 1] = bfhi(w.x); q[8 * c + 2] = bflo(w.y); q[8 * c + 3] = bfhi(w.y); q[8 * c + 4] = bflo(w.z); q[8 * c + 5] = bfhi(w.z); q[8 * c + 6] = bflo(w.w); q[8 * c + 7] = bfhi(w.w); } }
    float Cc = 1.f, o = 0.f;
    for (int base = nkeys > 0 ? ((nkeys - 1) & ~63) : -1; base >= 0; base -= 64) {
        const int j = base + lane; const bool valid = j < nkeys; const int jc = valid ? j : nkeys - 1;
        float z = 0.f;
        if (SAMPLE && jc < PAST) {
            const float* kr = ck + (((size_t)pt[seq * NPAGES + (jc >> 7)] * PAGE + (jc & 127)) * NH + h) * HD;
#pragma unroll
            for (int c = 0; c < 16; ++c) { const f32x4 w = ((const f32x4*)kr)[c]; z += q[4 * c] * w.x + q[4 * c + 1] * w.y + q[4 * c + 2] * w.z + q[4 * c + 3] * w.w; }
        } else {
            const size_t krow = SAMPLE ? (size_t)(MP + seq * TDEC + (jc - PAST)) : (size_t)seq * SEQ + jc;
            const v4u* kr = (const v4u*)(SK + krow * HW + h * HD);
#pragma unroll
            for (int c = 0; c < 8; ++c) { const v4u w = kr[c]; z += q[8 * c] * bflo(w.x) + q[8 * c + 1] * bfhi(w.x) + q[8 * c + 2] * bflo(w.y) + q[8 * c + 3] * bfhi(w.y) + q[8 * c + 4] * bflo(w.z) + q[8 * c + 5] * bfhi(w.z) + q[8 * c + 6] * bflo(w.w) + q[8 * c + 7] * bfhi(w.w); }
        }
        const float u = valid ? exp2f(z + bias2) : 0.f;
        float incl = 1.f / (1.f + u);
#pragma unroll
        for (int off = 1; off < 64; off <<= 1) { const float y = __shfl_down(incl, off); if (lane + off < 64) incl *= y; }
        const float a = u * incl * Cc;
        Cc *= __shfl(incl, 0);
        const int nk = nkeys - base < 64 ? nkeys - base : 64;
        for (int jj = 0; jj < nk; ++jj) {
            const float aj = __shfl(a, jj); const int jk = base + jj; float vv;
            if (SAMPLE && jk < PAST) vv = cv[(((size_t)pt[seq * NPAGES + (jk >> 7)] * PAGE + (jk & 127)) * NH + h) * HD + lane];
            else { const size_t vrow = SAMPLE ? (size_t)(MP + seq * TDEC + (jk - PAST)) : (size_t)seq * SEQ + jk; vv = bf2f(SV[vrow * HW + h * HD + lane]); }
            o += aj * vv;
        }
    }
    OMIX[(size_t)row * DM + HW + h * HD + lane] = f2bf(o);
}
__device__ __forceinline__ void p2_mix1(const Ctx& C) {
    for (int cid = C.gw; cid < NBATCH * NH * (SEQ / 64); cid += C.ngw) hgrn_h1(C, cid);
    const int w = C.gw, nw = C.ngw;
    for (int i = w; i < NDEC * NH; i += nw) { const int n = i / NH, h = i % NH; hgrn_chain(C, MP + n * TDEC, TDEC, h, (const float*)C.in[I_SH] + (size_t)i * 4096, C.out + O_HS + (size_t)i * 4096); }
    volatile LAS unsigned* gcnt = (volatile LAS unsigned*)(C.lds + MISC_OFF) + 16;
    if (C.tid == 0) *gcnt = 0u;
    LDS_WAIT(); __syncthreads();
    if (C.wave < 4) { sb_prompt_role(C, gcnt, 0u); if constexpr (PROBE_PH == 120) sb_prompt_role(C, gcnt, 1u); } else { sbs_role(C); if constexpr (PROBE_PH == 121) sbs_role(C); }
    __syncthreads();
}
__device__ __forceinline__ void p4_mix3(const Ctx& C) {
    for (int cid = C.gw; cid < NBATCH * NH * (SEQ / 64); cid += C.ngw) hgrn_h3(C, cid);
}

__device__ __forceinline__ void thin_row(const float* xin, const bf16* br, const float* gpost, float* xout, const float* gpre, bf16* hrow, int lane) {
    const f32x4* xr = (const f32x4*)xin + lane; const v2u* bp = (const v2u*)br + lane; const f32x4* gp = (const f32x4*)gpost + lane;
    f32x4 b[4]; float s = 0.f;
#pragma unroll
    for (int j = 0; j < 4; ++j) { const v2u w = bp[64 * j]; b[j] = (f32x4){bflo(w.x), bfhi(w.x), bflo(w.y), bfhi(w.y)}; s += (b[j].x * b[j].x + b[j].y * b[j].y) + (b[j].z * b[j].z + b[j].w * b[j].w); }
    const float r = rsqrtf(wave_sum(s) * (1.f / DM) + RMS_EPS);
    float s2 = 0.f;
#pragma unroll
    for (int j = 0; j < 4; ++j) { b[j] = xr[64 * j] + b[j] * r * gp[64 * j]; s2 += (b[j].x * b[j].x + b[j].y * b[j].y) + (b[j].z * b[j].z + b[j].w * b[j].w); }
    f32x4* xo = (f32x4*)xout + lane;
#pragma unroll
    for (int j = 0; j < 4; ++j) xo[64 * j] = b[j];
    if (hrow) {
        const float r2 = rsqrtf(wave_sum(s2) * (1.f / DM) + RMS_EPS); const f32x4* g2 = (const f32x4*)gpre + lane; v2u* o8 = (v2u*)hrow + lane;
#pragma unroll
        for (int j = 0; j < 4; ++j) { const f32x4 gg = g2[64 * j]; v2u w; w.x = pk_bf16(b[j].x * r2 * gg.x, b[j].y * r2 * gg.y); w.y = pk_bf16(b[j].z * r2 * gg.z, b[j].w * r2 * gg.w); o8[64 * j] = w; }
    }
}
template <int WHICH>
__device__ __forceinline__ void p_thin(const Ctx& C) {
    const bf16* BR = (const bf16*)(C.ws + WS_BR); bf16* H = (bf16*)(C.ws + WS_H);
    float* X1 = (float*)(C.ws + WS_X1); float* X2 = (float*)(C.ws + WS_X2);
    const float* gpost = (const float*)C.in[WHICH == 0 ? I_GMIXPOST : WHICH == 1 ? I_GCAPOST : I_GFFNPOST];
    const float* gpre = (const float*)C.in[WHICH == 0 ? I_GCAPRE : I_GFFNPRE];
    for (int m = C.gw; m < MT; m += C.ngw) {
        const float* xin; float* xout;
        if (WHICH == 0) { xin = m < MP ? (const float*)C.in[I_XP] + (size_t)m * DM : (const float*)C.in[I_XS] + (size_t)(m - MP) * DM; xout = X1 + (size_t)m * DM; }
        else if (WHICH == 1) { xin = X1 + (size_t)m * DM; xout = X2 + (size_t)m * DM; }
        else { xin = X2 + (size_t)m * DM; xout = m < MP ? C.out + O_YP + (size_t)m * DM : C.out + O_YS + (size_t)(m - MP) * DM; }
        thin_row(xin, BR + (size_t)m * DM, gpost, xout, gpre, WHICH == 2 ? nullptr : H + (size_t)m * DM, C.lane);
    }
}

__device__ __forceinline__ void p6_naive(const Ctx& C) {
    const bf16* QCA = (const bf16*)(C.ws + WS_QCA); const bf16* MK = (const bf16*)(C.ws + WS_MK); const bf16* MV = (const bf16*)(C.ws + WS_MV);
    const float* cmk = (const float*)C.in[I_MK]; const float* cmv = (const float*)C.in[I_MV]; bf16* OCA = (bf16*)(C.ws + WS_OMIX);
    const int lane = C.lane;
    for (int it = C.gw; it < MT * CAH; it += C.ngw) {
        const int row = it >> 2, h = it & 3;
        const v2u qw = *((const v2u*)(QCA + (size_t)row * DM + h * CAD) + lane);
        const float q0 = bflo(qw.x), q1 = bfhi(qw.x), q2 = bflo(qw.y), q3 = bfhi(qw.y);
        float mx = -1e30f, l = 0.f, o0 = 0.f, o1 = 0.f, o2 = 0.f, o3 = 0.f;
        for (int m = 0; m < NMEM; ++m) {
            float k0, k1, k2, k3, v0, v1, v2, v3;
            if (row < MP) { const size_t off = ((size_t)((row >> 13) * NMEM + m)) * DM + h * CAD; const v2u kw = *((const v2u*)(MK + off) + lane), vw = *((const v2u*)(MV + off) + lane);
                k0 = bflo(kw.x); k1 = bfhi(kw.x); k2 = bflo(kw.y); k3 = bfhi(kw.y); v0 = bflo(vw.x); v1 = bfhi(vw.x); v2 = bflo(vw.y); v3 = bfhi(vw.y); }
            else { const size_t off = ((size_t)(((row - MP) >> 3) * NMEM + m)) * DM + h * CAD; const f32x4 kw = *((const f32x4*)(cmk + off) + lane), vw = *((const f32x4*)(cmv + off) + lane);
                k0 = kw.x; k1 = kw.y; k2 = kw.z; k3 = kw.w; v0 = vw.x; v1 = vw.y; v2 = vw.z; v3 = vw.w; }
            const float s = wave_sum(q0 * k0 + q1 * k1 + q2 * k2 + q3 * k3);
            const float mn = fmaxf(mx, s), sc = exp2f(mx - mn), p = exp2f(s - mn);
            l = l * sc + p; o0 = o0 * sc + p * v0; o1 = o1 * sc + p * v1; o2 = o2 * sc + p * v2; o3 = o3 * sc + p * v3; mx = mn;
        }
        const float il = 1.f / l; v2u w; w.x = pk_bf16(o0 * il, o1 * il); w.y = pk_bf16(o2 * il, o3 * il);
        *((v2u*)(OCA + (size_t)row * DM + h * CAD) + lane) = w;
    }
}

__device__ __forceinline__ float gelu_tanh(float x) { return x / (1.f + __expf(-1.5957691216057308f * (x + 0.044715f * x * x * x))); }
__device__ __forceinline__ void ld8(const bf16* p, float (&v)[8]) { const v4u w = *(const v4u*)p; v[0] = bflo(w.x); v[1] = bfhi(w.x); v[2] = bflo(w.y); v[3] = bfhi(w.y); v[4] = bflo(w.z); v[5] = bfhi(w.z); v[6] = bflo(w.w); v[7] = bfhi(w.w); }
__device__ __forceinline__ void ld8f(const float* p, float (&v)[8]) { const f32x4 a = *(const f32x4*)p, b = *(const f32x4*)(p + 4); v[0] = a.x; v[1] = a.y; v[2] = a.z; v[3] = a.w; v[4] = b.x; v[5] = b.y; v[6] = b.z; v[7] = b.w; }
__device__ __forceinline__ void p10_convgate(const Ctx& C) {
    const bf16* U = (const bf16*)(C.ws + WS_U); bf16* G = (bf16*)(C.ws + WS_G);
    const float* cw = (const float*)C.in[I_CONVW]; const float* cb = (const float*)C.in[I_CONVB]; const float* sc = (const float*)C.in[I_SC];
    constexpr int NCH = DFF / 8, NPI = (MP / 32) * NCH, NSI = NDEC * NCH;
    const int gt = C.gw * 64 + C.lane, ngt = C.ngw * 64;
    for (int it = gt; it < NPI + NSI; it += ngt) {
        int row0, nrows, c; float m1[2][8], m2[2][8];
        if (it < NPI) { const int seg = it / NCH; c = (it % NCH) * 8; row0 = seg * 32; nrows = 32;
            if ((row0 & (SEQ - 1)) == 0) {
#pragma unroll
                for (int hf = 0; hf < 2; ++hf)
#pragma unroll
                    for (int e = 0; e < 8; ++e) { m1[hf][e] = 0.f; m2[hf][e] = 0.f; }
            } else {
#pragma unroll
                for (int hf = 0; hf < 2; ++hf) { ld8(U + (size_t)(row0 - 1) * DFF2 + c + hf * DFF, m1[hf]); ld8(U + (size_t)(row0 - 2) * DFF2 + c + hf * DFF, m2[hf]); }
            }
        } else { const int j = it - NPI, n = j / NCH; c = (j % NCH) * 8; row0 = MP + n * TDEC; nrows = TDEC;
#pragma unroll
            for (int hf = 0; hf < 2; ++hf) { ld8f(sc + ((size_t)n * 2 + 1) * DFF2 + c + hf * DFF, m1[hf]); ld8f(sc + ((size_t)n * 2) * DFF2 + c + hf * DFF, m2[hf]); }
        }
        float w0[2][8], w1[2][8], w2[2][8], bb[2][8];
#pragma unroll
        for (int hf = 0; hf < 2; ++hf) { ld8f(cw + c + hf * DFF, w0[hf]); ld8f(cw + DFF2 + c + hf * DFF, w1[hf]); ld8f(cw + 2 * DFF2 + c + hf * DFF, w2[hf]); ld8f(cb + c + hf * DFF, bb[hf]); }
        const bf16* up = U + (size_t)row0 * DFF2 + c; bf16* gp = G + (size_t)row0 * DFF + c;
#pragma unroll 4
        for (int r = 0; r < nrows; ++r) {
            float u[2][8], res[2][8];
            ld8(up + (size_t)r * DFF2, u[0]); ld8(up + (size_t)r * DFF2 + DFF, u[1]);
#pragma unroll
            for (int hf = 0; hf < 2; ++hf)
#pragma unroll
                for (int e = 0; e < 8; ++e) { res[hf][e] = bb[hf][e] + w0[hf][e] * m2[hf][e] + w1[hf][e] * m1[hf][e] + w2[hf][e] * u[hf][e]; m2[hf][e] = m1[hf][e]; m1[hf][e] = u[hf][e]; }
            v4u o;
            o.x = pk_bf16(gelu_tanh(res[0][0]) * res[1][0], gelu_tanh(res[0][1]) * res[1][1]); o.y = pk_bf16(gelu_tanh(res[0][2]) * res[1][2], gelu_tanh(res[0][3]) * res[1][3]);
            o.z = pk_bf16(gelu_tanh(res[0][4]) * res[1][4], gelu_tanh(res[0][5]) * res[1][5]); o.w = pk_bf16(gelu_tanh(res[0][6]) * res[1][6], gelu_tanh(res[0][7]) * res[1][7]);
            *(v4u*)(gp + (size_t)r * DFF) = o;
        }
    }
}
enum { PH_PRO = 0, PH_INPROJ, PH_MIX1, PH_SCAN, PH_MIX3, PH_OPROJ, PH_THIN0, PH_CQ, PH_CA, PH_CO, PH_THIN1, PH_UP, PH_CONV, PH_DOWN, PH_THIN2, NPH };
#ifndef MK_ONE_LAUNCH
#define MK_ONE_LAUNCH 1
#endif
__global__ void __launch_bounds__(NTHREADS, 2) fwd(Args args) {
    extern __shared__ __attribute__((aligned(16))) unsigned char lds_raw[];
    Ctx C;
    C.in = args.in; C.out = args.out; C.ws = args.ws; C.lds = (LAS unsigned char*)lds_raw;
    C.tid = threadIdx.x; C.lane = C.tid & 63; C.wave = __builtin_amdgcn_readfirstlane(C.tid >> 6);
    C.gw = blockIdx.x * NWAVES + C.wave; C.ngw = gridDim.x * NWAVES;
    const int G = gridDim.x, bid = blockIdx.x;
    volatile LAS unsigned* MISC = (volatile LAS unsigned*)(C.lds + MISC_OFF);
    for (int u = C.tid; u < (LDS_BYTES - LDSCTL_OFF) / 4; u += NTHREADS) ((LAS unsigned*)(C.lds + LDSCTL_OFF))[u] = 0u;
    __syncthreads();
    const int lo = args.ph_lo, hi = args.ph_hi;
    XcdBarrier bar; bar.bar = (unsigned*)(C.ws + WS_CTL) + CW_BAR; bar.x = 0; bar.st = nullptr;
    bar = xcd_barrier_post((unsigned*)(C.ws + WS_CTL) + CW_BAR, MISC + 8);
#define IN(k) (lo <= (k) && (k) < hi)
#define SEAM(k) do { if (IN(k) && IN((k) + 1)) xcd_barrier(bar); } while (0)
#define PHASE(k, ...) do { if (IN(k)) { __VA_ARGS__ if constexpr (PROBE_PH == (k)) { __VA_ARGS__ } } } while (0)
    bf16* H = (bf16*)(C.ws + WS_H);
    PHASE(PH_PRO, p0_prologue(C);); SEAM(PH_PRO);
    PHASE(PH_INPROJ, { pg8::Gemm g{H, (const bf16*)(C.ws + WS_WIN), MT, DIN, DM}; pg8::StaticOrder S; S.init(MT, DIN, G, bid);
          pg8::EpiInProj E{(bf16*)(C.ws + WS_QH), (bf16*)(C.ws + WS_VH), (bf16*)(C.ws + WS_GH), (bf16*)(C.ws + WS_SQ), (bf16*)(C.ws + WS_SK), (bf16*)(C.ws + WS_SV), (float*)(C.ws + WS_LF),
                           (const float*)(C.ws + WS_LB), C.out + O_KP, C.out + O_VP, C.out + O_KS, C.out + O_VS, SQ_SCALE};
          pg8::gemm_phase<pg8::EpiInProj, pg8::StaticOrder, true, true>(C.lds + RING_OFF, g, S, E); }
        { pg8::Gemm g{(const bf16*)(C.ws + WS_MN), (const bf16*)(C.ws + WS_WCKV), NBATCH * NMEM, 2 * DM, DM}; pg8::StaticOrder S; S.init(NBATCH * NMEM, 2 * DM, G, (bid + G - 184 % G) % G);
          pg8::EpiMemKV E{(bf16*)(C.ws + WS_MK), (bf16*)(C.ws + WS_MV), C.out + O_MKP, C.out + O_MVP};
          pg8::gemm_phase<pg8::EpiMemKV, pg8::StaticOrder, true, true>(C.lds + RING_OFF, g, S, E); }); SEAM(PH_INPROJ);
    PHASE(PH_MIX1, p2_mix1(C);); SEAM(PH_MIX1);
    PHASE(PH_SCAN, hgrn_h2(C); sbs_combine(C);); SEAM(PH_SCAN);
    PHASE(PH_MIX3, p4_mix3(C);); SEAM(PH_MIX3);
    PHASE(PH_OPROJ, pg8::Gemm g{(const bf16*)(C.ws + WS_OMIX), (const bf16*)(C.ws + WS_WO), MT, DM, DM}; pg8::StaticOrder S; S.init(MT, DM, G, bid);
        pg8::EpiStore<false> E{(bf16*)(C.ws + WS_BR), DM, 1.f, nullptr};
        pg8::gemm_phase<pg8::EpiStore<false>, pg8::StaticOrder, true, true>(C.lds + RING_OFF, g, S, E);); SEAM(PH_OPROJ);
    PHASE(PH_THIN0, p_thin<0>(C);); SEAM(PH_THIN0);
    PHASE(PH_CQ, pg8::Gemm g{H, (const bf16*)(C.ws + WS_WCQ), MT, DM, DM}; pg8::StaticOrder S; S.init(MT, DM, G, bid);
        pg8::EpiStore<false> E{(bf16*)(C.ws + WS_QCA), DM, CQ_SCALE, nullptr};
        pg8::gemm_phase<pg8::EpiStore<false>, pg8::StaticOrder, true, true>(C.lds + RING_OFF, g, S, E);); SEAM(PH_CQ);
    PHASE(PH_CA, ca_phase(C);); SEAM(PH_CA);
    PHASE(PH_CO, pg8::Gemm g{(const bf16*)(C.ws + WS_OMIX), (const bf16*)(C.ws + WS_WCO), MT, DM, DM}; pg8::StaticOrder S; S.init(MT, DM, G, bid);
        pg8::EpiStore<false> E{(bf16*)(C.ws + WS_BR), DM, 1.f, nullptr};
        pg8::gemm_phase<pg8::EpiStore<false>, pg8::StaticOrder, true, true>(C.lds + RING_OFF, g, S, E);); SEAM(PH_CO);
    PHASE(PH_THIN1, p_thin<1>(C);); SEAM(PH_THIN1);
    PHASE(PH_UP, pg8::Gemm g{H, (const bf16*)(C.ws + WS_WUP), MT, DFF2, DM}; pg8::StaticOrder S; S.init(MT, DFF2, G, bid);
        pg8::EpiStore<true> E{(bf16*)(C.ws + WS_U), DFF2, 1.f, C.out};
        pg8::gemm_phase<pg8::EpiStore<true>, pg8::StaticOrder, true, true>(C.lds + RING_OFF, g, S, E);); SEAM(PH_UP);
    PHASE(PH_CONV, p10_convgate(C);); SEAM(PH_CONV);
    PHASE(PH_DOWN, pg8::Gemm g{(const bf16*)(C.ws + WS_G), (const bf16*)(C.ws + WS_WDN), MT, DM, DFF}; pg8::StaticOrder S; S.init(MT, DM, G, bid);
        pg8::EpiStore<false> E{(bf16*)(C.ws + WS_BR), DM, 1.f, nullptr};
        pg8::gemm_phase<pg8::EpiStore<false>, pg8::StaticOrder, true, true>(C.lds + RING_OFF, g, S, E);); SEAM(PH_DOWN);
    PHASE(PH_THIN2, p_thin<2>(C););
#undef IN
#undef PHASE
#undef SEAM
}

extern "C" void kernel_launch(void* const* d_in, const int* in_sizes, int n_in, void* d_out, int out_size, void* d_ws, size_t ws_size, hipStream_t stream) {
    static int grid = 0;
    if (grid == 0) {
        if (n_in != N_IN || (size_t)out_size != O_END || ws_size < WS_END) { fprintf(stderr, "kernel_launch: unexpected problem: n_in %d out %d ws %zu\n", n_in, out_size, ws_size); grid = -1; return; }
        int dev = 0, cus = 0, per_cu = 0;
        if (hipGetDevice(&dev) != hipSuccess || hipDeviceGetAttribute(&cus, hipDeviceAttributeMultiprocessorCount, dev) != hipSuccess) { grid = -1; return; }
        if (hipFuncSetAttribute((const void*)fwd, hipFuncAttributeMaxDynamicSharedMemorySize, LDS_BYTES) != hipSuccess) { fprintf(stderr, "kernel_launch: hipFuncSetAttribute failed\n"); grid = -1; return; }
        if (hipOccupancyMaxActiveBlocksPerMultiprocessor(&per_cu, (const void*)fwd, NTHREADS, LDS_BYTES) != hipSuccess || per_cu < 1) fprintf(stderr, "kernel_launch: occupancy query says %d\n", per_cu);
        (void)hipGetLastError();
        grid = cus;
    }
    if (grid < 0) return;
    (void)hipMemsetAsync((char*)d_ws + WS_CTL, 0, CTL_ZERO_BYTES, stream);
    Args a{};
    for (int i = 0; i < N_IN; ++i) a.in[i] = d_in[i];
    a.out = (float*)d_out; a.ws = (unsigned char*)d_ws;
    a.ph_lo = 0; a.ph_hi = NPH;
    hipLaunchKernelGGL(fwd, dim3(grid), dim3(NTHREADS), LDS_BYTES, stream, a);
}
```

```cpp
#include <hip/hip_runtime.h>
#include <cstdio>
#include <cstdint>
namespace pg8 {
#define PG8_LAS __attribute__((address_space(3)))
typedef unsigned short bf16_t;
typedef short bf16x8 __attribute__((ext_vector_type(8)));
typedef float f32x4 __attribute__((ext_vector_type(4)));
typedef unsigned u32x4 __attribute__((ext_vector_type(4)));
constexpr int BM = 256, BK = 64, HALF = 128, HTB = HALF * BK * 2  , STAGE_BYTES = 8 * HTB, NXCD = 8, WGM = 8;

__host__ __device__ __forceinline__ int lds_byte(int r, int c) { const int st = (r >> 4) * 2 + (c >> 5), rr = r & 15, cc = c & 31, ob = rr * 64 + cc * 2; return st * 1024 + (ob ^ (((ob >> 9) & 1) << 5)); }
__host__ __device__ __forceinline__ void stage_rc(int b, int& R, int& C) { const int st = b / 1024, sb = b % 1024, swz = sb ^ (((sb >> 9) & 1) << 5); R = (st >> 1) * 16 + swz / 64; C = (st & 1) * 32 + (swz % 64) / 2; }
__host__ __device__ __forceinline__ int perm32(int rho) { const int n = rho >> 4, i = rho & 15; return 8 * (i >> 2) + 4 * n + (i & 3); }

struct Unit { int pm, pn; };
struct Gemm { const bf16_t* A; const bf16_t* Bt; int M, N, K; };

struct StaticOrder {
    int nM, nN, nwg, G, c;
    __host__ __device__ void init(int M, int N, int G_, int c_) { nM = M / BM; nN = N / BM; nwg = nM * nN; G = G_; c = c_; }
    __host__ __device__ bool next(int i, Unit& u) const {
        const long L = (long)i * G + c; if (L >= nwg) return false;
        int wgid = (int)L; { const int q = nwg / NXCD, r = nwg % NXCD, xcd = wgid % NXCD, off = wgid / NXCD; wgid = (xcd < r ? xcd * (q + 1) : r * (q + 1) + (xcd - r) * q) + off; }
        const int nig = WGM * nN, gid = wgid / nig, fm = gid * WGM, gsz = (nM - fm) < WGM ? (nM - fm) : WGM;
        u.pm = fm + ((wgid % nig) % gsz); u.pn = (wgid % nig) / gsz; return true;
    }
    __device__ __forceinline__ void a_ready(const Unit&) const {}
    __device__ __forceinline__ void done(const Unit&) const {}
};

__device__ __forceinline__ unsigned cvt_pk_bf16(float lo, float hi) { unsigned r; asm volatile("v_cvt_pk_bf16_f32 %0, %1, %2" : "=v"(r) : "v"(lo), "v"(hi)); return r; }
typedef float f32x2 __attribute__((ext_vector_type(2)));
typedef __bf16 bf16x2_t __attribute__((ext_vector_type(2)));
__device__ __forceinline__ unsigned pk_bf16(float lo, float hi) { f32x2 v = {lo, hi}; bf16x2_t b = __builtin_convertvector(v, bf16x2_t); return __builtin_bit_cast(unsigned, b); }
__device__ __forceinline__ u32x4 pk8(f32x4 a, f32x4 b) { u32x4 w; w.x = pk_bf16(a[0], a[1]); w.y = pk_bf16(a[2], a[3]); w.z = pk_bf16(b[0], b[1]); w.w = pk_bf16(b[2], b[3]); return w; }

template <bool CAP> struct EpiStore {
    static constexpr bool PERM = true, AFTER_DRAIN = false;
    bf16_t* O; int ldc; float scale; float* outb;
    __device__ __forceinline__ void operator()(const f32x4 (&acc)[2][2][4][2], const Unit& u, int wr, int wc, int fr, int fq) const {
        const int row0 = u.pm * BM + wr * 64 + fr, col0 = u.pn * BM + wc * 32 + 8 * fq;
#pragma unroll
        for (int ai = 0; ai < 2; ++ai)
#pragma unroll
            for (int m = 0; m < 4; ++m) {
                const int row = row0 + ai * HALF + m * 16;
                float* cap = nullptr;
                if constexpr (CAP) {
                    if (row < 16384) { const int t = row & 8191; if (t >= 8190) cap = outb + 34668544 + (size_t)((row >> 13) * 2 + (t - 8190)) * 5632; }
                    else { const int r2 = row - 16384, t = r2 & 7; if (t >= 6) cap = outb + 40982528 + (size_t)((r2 >> 3) * 2 + (t - 6)) * 5632; }
                }
#pragma unroll
                for (int bj = 0; bj < 2; ++bj) {
                    const int col = col0 + bj * HALF;
                    const f32x4 v0 = acc[ai][bj][m][0] * scale, v1 = acc[ai][bj][m][1] * scale;
                    *(u32x4*)(O + (size_t)row * ldc + col) = pk8(v0, v1);
                    if constexpr (CAP) { if (cap) { *(f32x4*)(cap + col) = v0; *(f32x4*)(cap + col + 4) = v1; } }
                }
            }
    }
};

struct EpiInProj {
    static constexpr bool PERM = true, AFTER_DRAIN = false;
    bf16_t *QH, *VH, *GH, *SQ, *SK, *SV; float* LF; const float* LB; float* kp; float* vp; float* ks; float* vs; float sqscale;
    __device__ __forceinline__ void operator()(const f32x4 (&acc)[2][2][4][2], const Unit& u, int wr, int wc, int fr, int fq) const {
        const int seg = u.pn >> 1;
        const int row0 = u.pm * BM + wr * 64 + fr, col0 = (u.pn & 1) * BM + wc * 32 + 8 * fq;
        if (seg == 1) {
#pragma unroll
            for (int bj = 0; bj < 2; ++bj) {
                const int col = col0 + bj * HALF;
                const f32x4 l0 = *(const f32x4*)(LB + col), l1 = *(const f32x4*)(LB + col + 4);
#pragma unroll
                for (int ai = 0; ai < 2; ++ai)
#pragma unroll
                    for (int m = 0; m < 4; ++m) {
                        const int row = row0 + ai * HALF + m * 16;
                        f32x4 o0, o1;
#pragma unroll
                        for (int e = 0; e < 4; ++e) {
                            const float s0 = 1.f / (1.f + __expf(-acc[ai][bj][m][0][e])), s1 = 1.f / (1.f + __expf(-acc[ai][bj][m][1][e]));
                            o0[e] = __logf(l0[e] + (1.f - l0[e]) * s0); o1[e] = __logf(l1[e] + (1.f - l1[e]) * s1);
                        }
                        *(f32x4*)(LF + (size_t)row * 512 + col) = o0; *(f32x4*)(LF + (size_t)row * 512 + col + 4) = o1;
                    }
            }
            return;
        }
        bf16_t* dst = seg == 0 ? QH : seg == 2 ? VH : seg == 3 ? GH : seg == 4 ? SQ : seg == 5 ? SK : SV;
        const float sc = seg == 4 ? sqscale : 1.f;
        float* fp = seg == 5 ? kp : seg == 6 ? vp : nullptr;
        float* fs = seg == 5 ? ks : vs;
#pragma unroll
        for (int ai = 0; ai < 2; ++ai)
#pragma unroll
            for (int m = 0; m < 4; ++m) {
                const int row = row0 + ai * HALF + m * 16;
#pragma unroll
                for (int bj = 0; bj < 2; ++bj) {
                    const int col = col0 + bj * HALF;
                    const f32x4 v0 = acc[ai][bj][m][0], v1 = acc[ai][bj][m][1];
                    *(u32x4*)(dst + (size_t)row * 512 + col) = pk8(v0 * sc, v1 * sc);
                    if (fp) { float* f = row < 16384 ? fp + (size_t)row * 512 + col : fs + (size_t)(row - 16384) * 512 + col; *(f32x4*)f = v0; *(f32x4*)(f + 4) = v1; }
                }
            }
    }
};

struct EpiMemKV {
    static constexpr bool PERM = true, AFTER_DRAIN = false;
    bf16_t *MK, *MV; float *ok, *ov;
    __device__ __forceinline__ void operator()(const f32x4 (&acc)[2][2][4][2], const Unit& u, int wr, int wc, int fr, int fq) const {
        const int seg = u.pn >> 2;
        const int row0 = u.pm * BM + wr * 64 + fr, col0 = (u.pn & 3) * BM + wc * 32 + 8 * fq;
        bf16_t* dst = seg == 0 ? MK : MV; float* fo = seg == 0 ? ok : ov;
#pragma unroll
        for (int ai = 0; ai < 2; ++ai)
#pragma unroll
            for (int m = 0; m < 4; ++m) {
                const int row = row0 + ai * HALF + m * 16;
#pragma unroll
                for (int bj = 0; bj < 2; ++bj) {
                    const int col = col0 + bj * HALF;
                    const f32x4 v0 = acc[ai][bj][m][0], v1 = acc[ai][bj][m][1];
                    *(u32x4*)(dst + (size_t)row * 1024 + col) = pk8(v0, v1);
                    *(f32x4*)(fo + (size_t)row * 1024 + col) = v0; *(f32x4*)(fo + (size_t)row * 1024 + col + 4) = v1;
                }
            }
    }
};


__device__ __forceinline__ float dpp_ror(float x, int n) { return n == 1 ? __uint_as_float((unsigned)__builtin_amdgcn_update_dpp(0, (int)__float_as_uint(x), 0x121, 0xf, 0xf, true)) : __uint_as_float((unsigned)__builtin_amdgcn_update_dpp(0, (int)__float_as_uint(x), 0x122, 0xf, 0xf, true)); }
__device__ __forceinline__ float dpp_shr1(float old, float x) { return __uint_as_float((unsigned)__builtin_amdgcn_update_dpp((int)__float_as_uint(old), (int)__float_as_uint(x), 0x111, 0xf, 0xf, false)); }
__device__ __forceinline__ float dpp_shr2(float old, float x) { return __uint_as_float((unsigned)__builtin_amdgcn_update_dpp((int)__float_as_uint(old), (int)__float_as_uint(x), 0x112, 0xf, 0xf, false)); }
__device__ __forceinline__ float gelu_t(float x) { return x / (1.f + __expf(-1.5957691216057308f * (x + 0.044715f * x * x * x))); }
struct EpiUpConv {
    static constexpr bool PERM = true, AFTER_DRAIN = false;
    bf16_t* G; bf16_t* U; float* outb; float* FIX; float* ULAST; const float* cw; const float* cb; PG8_LAS float* XB;
    __device__ __forceinline__ void operator()(const f32x4 (&acc)[2][2][4][2], const Unit& u, int wr, int wc, int fr, int fq) const {
        const int gc0 = u.pn * 128 + wc * 32 + 8 * fq;
        if (u.pm >= 64) {
            const int row0 = u.pm * BM + wr * 64 + fr, colp = u.pn * BM + wc * 32 + 8 * fq;
#pragma unroll
            for (int ai = 0; ai < 2; ++ai)
#pragma unroll
                for (int m = 0; m < 4; ++m) {
                    const int row = row0 + ai * HALF + m * 16, r2 = row - 16384, t = r2 & 7;
                    float* cap = t >= 6 ? outb + 40982528 + (size_t)((r2 >> 3) * 2 + (t - 6)) * 5632 + gc0 : nullptr;
#pragma unroll
                    for (int bj = 0; bj < 2; ++bj) {
                        const f32x4 v0 = acc[ai][bj][m][0], v1 = acc[ai][bj][m][1];
                        *(u32x4*)(U + (size_t)row * 5632 + colp + bj * HALF) = pk8(v0, v1);
                        if (cap) { *(f32x4*)(cap + bj * 2816) = v0; *(f32x4*)(cap + bj * 2816 + 4) = v1; }
                    }
                }
            return;
        }
        if (fr >= 14) {
#pragma unroll
            for (int ai = 0; ai < 2; ++ai)
#pragma unroll
                for (int bj = 0; bj < 2; ++bj)
#pragma unroll
                    for (int n = 0; n < 2; ++n) {
                        const f32x4 v = acc[ai][bj][3][n];
                        *(PG8_LAS f32x4*)(XB + ((2 * ai + wr) * 2 + (fr - 14)) * 256 + bj * HALF + wc * 32 + 8 * fq + 4 * n) = v;
                        if (ai == 1 && wr == 1) {
                            *(f32x4*)(ULAST + (size_t)(u.pm * 2 + fr - 14) * 5632 + bj * 2816 + gc0 + 4 * n) = v;
                            if ((u.pm & 31) == 31) *(f32x4*)(outb + 34668544 + (size_t)((u.pm >> 5) * 2 + fr - 14) * 5632 + bj * 2816 + gc0 + 4 * n) = v;
                        }
                    }
        }
        asm volatile("s_waitcnt lgkmcnt(0)" ::: "memory"); __builtin_amdgcn_s_barrier(); asm volatile("" ::: "memory");
#pragma unroll
        for (int ai = 0; ai < 2; ++ai) {
            const int chunk = 2 * ai + wr;
#pragma unroll
            for (int n = 0; n < 2; ++n) {
                const int gc = gc0 + 4 * n;
                f32x4 w0[2], w1[2], w2[2], bb[2], h1[2], h2[2];
#pragma unroll
                for (int bj = 0; bj < 2; ++bj) {
                    w0[bj] = *(const f32x4*)(cw + bj * 2816 + gc); w1[bj] = *(const f32x4*)(cw + 5632 + bj * 2816 + gc); w2[bj] = *(const f32x4*)(cw + 2 * 5632 + bj * 2816 + gc); bb[bj] = *(const f32x4*)(cb + bj * 2816 + gc);
                    if (chunk > 0) { h1[bj] = *(const PG8_LAS f32x4*)(XB + ((chunk - 1) * 2 + 1) * 256 + bj * HALF + wc * 32 + 8 * fq + 4 * n); h2[bj] = *(const PG8_LAS f32x4*)(XB + ((chunk - 1) * 2) * 256 + bj * HALF + wc * 32 + 8 * fq + 4 * n); }
                    else { h1[bj] = (f32x4){0.f, 0.f, 0.f, 0.f}; h2[bj] = (f32x4){0.f, 0.f, 0.f, 0.f}; }
                }
#pragma unroll
                for (int m = 0; m < 4; ++m) {
                    f32x4 c[2];
#pragma unroll
                    for (int bj = 0; bj < 2; ++bj)
#pragma unroll
                        for (int e = 0; e < 4; ++e) {
                            const float cur = acc[ai][bj][m][n][e];
                            const float o1 = m ? dpp_ror(acc[ai][bj][m ? m - 1 : 0][n][e], 1) : h1[bj][e];
                            const float o2 = m ? dpp_ror(acc[ai][bj][m ? m - 1 : 0][n][e], 2) : (fr == 0 ? h2[bj][e] : h1[bj][e]);
                            const float p1 = dpp_shr1(o1, cur), p2 = dpp_shr2(o2, cur);
                            c[bj][e] = bb[bj][e] + w0[bj][e] * p2 + w1[bj][e] * p1 + w2[bj][e] * cur;
                        }
                    const int row = u.pm * BM + ai * HALF + wr * 64 + m * 16 + fr;
                    if (chunk == 0 && m == 0 && fr < 2) {
                        *(f32x4*)(FIX + (size_t)(u.pm * 2 + fr) * 5632 + gc) = c[0]; *(f32x4*)(FIX + (size_t)(u.pm * 2 + fr) * 5632 + 2816 + gc) = c[1];
                    } else {
                        typedef unsigned u32x2 __attribute__((ext_vector_type(2)));
                        const u32x2 ow = {pk_bf16(gelu_t(c[0][0]) * c[1][0], gelu_t(c[0][1]) * c[1][1]), pk_bf16(gelu_t(c[0][2]) * c[1][2], gelu_t(c[0][3]) * c[1][3])};
                        *(u32x2*)(G + (size_t)row * 2816 + gc) = ow;
                    }
                }
            }
        }
        asm volatile("s_waitcnt lgkmcnt(0)" ::: "memory"); __builtin_amdgcn_s_barrier(); asm volatile("" ::: "memory");
    }
};
template <class Epi, class Sched, bool ALIGN_EPI = false, bool SP2 = false>
__device__ __forceinline__ void gemm_phase(PG8_LAS unsigned char* lds, const Gemm g, const Sched& S, const Epi& E) {
    const int tid = threadIdx.x, wid = __builtin_amdgcn_readfirstlane(tid >> 6), lane = tid & 63, wr = wid >> 2, wc = wid & 3, fr = lane & 15, fq = lane >> 4;
    const int K = g.K, nt = K / BK;
    unsigned voffA[2], voffB[2];
#pragma unroll
    for (int i = 0; i < 2; ++i) { int R, C; stage_rc(tid * 16 + i * 8192, R, C); const int Rb = Epi::PERM ? ((R & ~31) + perm32(R & 31)) : R;
        voffA[i] = (unsigned)(R * K + C) * 2u; voffB[i] = (unsigned)(Rb * K + C) * 2u; }
    const size_t kstep = (size_t)(BK * 2);
    const size_t hstep = (size_t)HALF * K * 2;
    const size_t tstep = 2 * hstep;
    const unsigned ldsw = (unsigned)wid * 1024u;
    const int aoff = lds_byte(wr * 64 + fr, fq * 8), boff = lds_byte(wc * 32 + fr, fq * 8);
#define PG8_SA(b, h) (((b) * 2 + (h)) * HTB)
#define PG8_SB(b, h) ((4 + (b) * 2 + (h)) * HTB)
#define PG8_STAGE(bufoff, gbase, voff) do { _Pragma("unroll") for (int _i = 0; _i < 2; ++_i) \
        __builtin_amdgcn_global_load_lds((const unsigned*)((const char*)(gbase) + (voff)[_i]), (PG8_LAS unsigned*)(lds + (bufoff) + ldsw + _i * 8192), 16, 0, 0); } while (0)
#define PG8_LDA(dst, b, h) do { _Pragma("unroll") for (int m = 0; m < 4; ++m) _Pragma("unroll") for (int k = 0; k < 2; ++k) dst[m][k] = *(const PG8_LAS bf16x8*)(lds + PG8_SA(b, h) + aoff + m * 2048 + k * 1024); } while (0)
#define PG8_LDB(dst, b, h) do { _Pragma("unroll") for (int n = 0; n < 2; ++n) _Pragma("unroll") for (int k = 0; k < 2; ++k) dst[n][k] = *(const PG8_LAS bf16x8*)(lds + PG8_SB(b, h) + boff + n * 2048 + k * 1024); } while (0)
#define PG8_MMA(ai, bj, At, Bt) do { __builtin_amdgcn_s_setprio(1); _Pragma("unroll") for (int m = 0; m < 4; ++m) _Pragma("unroll") for (int n = 0; n < 2; ++n) _Pragma("unroll") for (int k = 0; k < 2; ++k) \
        acc[ai][bj][m][n] = __builtin_amdgcn_mfma_f32_16x16x32_bf16(Bt[n][k], At[m][k], acc[ai][bj][m][n], 0, 0, 0); __builtin_amdgcn_s_setprio(0); } while (0)
#define PG8_WAIT_V(n) asm volatile("s_waitcnt vmcnt(" #n ")" ::: "memory")
#define PG8_WAIT_L(n) asm volatile("s_waitcnt lgkmcnt(" #n ")" ::: "memory")
#define PG8_BAR __builtin_amdgcn_s_barrier()
#define PG8_SCHED __builtin_amdgcn_sched_barrier(0)
    Unit cur, nxt; int ui = 0;
    if (!S.next(0, cur)) return;
    f32x4 acc[2][2][4][2];
#pragma unroll
    for (int a = 0; a < 2; ++a)
#pragma unroll
        for (int b = 0; b < 2; ++b)
#pragma unroll
            for (int m = 0; m < 4; ++m)
#pragma unroll
                for (int n = 0; n < 2; ++n) acc[a][b][m][n] = (f32x4){0.f, 0.f, 0.f, 0.f};
    bf16x8 At[4][2], B0[2][2], B1[2][2];
    const char* cA = (const char*)g.A + (size_t)cur.pm * tstep; const char* cB = (const char*)g.Bt + (size_t)cur.pn * tstep;
    S.a_ready(cur);
    if constexpr (SP2) {
        PG8_STAGE(PG8_SB(0, 0), cB, voffB); PG8_STAGE(PG8_SB(0, 1), cB + hstep, voffB); PG8_STAGE(PG8_SA(0, 0), cA, voffA); PG8_STAGE(PG8_SA(0, 1), cA + hstep, voffA);
        if (wr == 1) PG8_BAR;
        PG8_WAIT_V(2); PG8_BAR;
        PG8_STAGE(PG8_SB(1, 0), cB + kstep, voffB); PG8_STAGE(PG8_SA(1, 0), cA + kstep, voffA); PG8_STAGE(PG8_SB(1, 1), cB + hstep + kstep, voffB);
        PG8_WAIT_V(6); PG8_BAR;
    } else {
        PG8_STAGE(PG8_SB(0, 0), cB, voffB); PG8_STAGE(PG8_SA(0, 0), cA, voffA); PG8_STAGE(PG8_SB(0, 1), cB + hstep, voffB); PG8_STAGE(PG8_SA(0, 1), cA + hstep, voffA);
        if (wr == 1) PG8_BAR;
        PG8_WAIT_V(4); PG8_BAR;
        PG8_STAGE(PG8_SB(1, 0), cB + kstep, voffB); PG8_STAGE(PG8_SA(1, 0), cA + kstep, voffA); PG8_STAGE(PG8_SB(1, 1), cB + hstep + kstep, voffB);
        PG8_WAIT_V(6); PG8_BAR;
    }
    for (;;) {
        const bool has_next = S.next(ui + 1, nxt);
        const char* nA = has_next ? (const char*)g.A + (size_t)nxt.pm * tstep : cA; const char* nB = has_next ? (const char*)g.Bt + (size_t)nxt.pn * tstep : cB;
        for (int t = 0; t < nt; t += 2) {
            const bool last = (t == nt - 2);
            const char* a1 = cA + (size_t)(t + 1) * kstep;
            const char* a2 = last ? nA : cA + (size_t)(t + 2) * kstep; const char* b2 = last ? nB : cB + (size_t)(t + 2) * kstep;
            const char* a3 = a2 + kstep; const char* b3 = b2 + kstep;
            if (last && has_next) S.a_ready(nxt);
            if constexpr (SP2) {
            PG8_LDB(B0, 0, 0); PG8_LDB(B1, 0, 1); PG8_SCHED; PG8_LDA(At, 0, 0); PG8_STAGE(PG8_SA(1, 1), a1 + hstep, voffA);
            PG8_WAIT_V(8); PG8_WAIT_L(0); PG8_BAR; PG8_MMA(0, 0, At, B0); PG8_MMA(0, 1, At, B1); PG8_BAR; PG8_SCHED;
            PG8_LDA(At, 0, 1); PG8_STAGE(PG8_SB(0, 0), b2, voffB); PG8_STAGE(PG8_SB(0, 1), b2 + hstep, voffB); PG8_STAGE(PG8_SA(0, 0), a2, voffA);
            PG8_WAIT_V(8); PG8_WAIT_L(0); PG8_BAR; PG8_MMA(1, 0, At, B0); PG8_MMA(1, 1, At, B1); PG8_BAR; PG8_SCHED;
            PG8_LDB(B0, 1, 0); PG8_LDB(B1, 1, 1); PG8_SCHED; PG8_LDA(At, 1, 0); PG8_STAGE(PG8_SA(0, 1), a2 + hstep, voffA);
            PG8_WAIT_V(8); PG8_WAIT_L(0); PG8_BAR; PG8_MMA(0, 0, At, B0); PG8_MMA(0, 1, At, B1); PG8_BAR; PG8_SCHED;
            PG8_LDA(At, 1, 1); PG8_STAGE(PG8_SB(1, 0), b3, voffB); PG8_STAGE(PG8_SB(1, 1), b3 + hstep, voffB); PG8_STAGE(PG8_SA(1, 0), a3, voffA);
            PG8_WAIT_V(8); PG8_WAIT_L(0); PG8_BAR; PG8_MMA(1, 0, At, B0); PG8_MMA(1, 1, At, B1); PG8_BAR; PG8_SCHED;
            } else {
            PG8_LDB(B0, 0, 0); PG8_SCHED; PG8_LDA(At, 0, 0); PG8_STAGE(PG8_SA(1, 1), a1 + hstep, voffA);
            PG8_WAIT_L(8); PG8_BAR; PG8_WAIT_L(0); PG8_MMA(0, 0, At, B0); PG8_BAR; PG8_SCHED;
            PG8_LDB(B1, 0, 1); PG8_STAGE(PG8_SB(0, 0), b2, voffB);
            PG8_BAR; PG8_WAIT_L(0); PG8_MMA(0, 1, At, B1); PG8_BAR;
            PG8_LDA(At, 0, 1); PG8_STAGE(PG8_SA(0, 0), a2, voffA);
            PG8_BAR; PG8_WAIT_L(0); PG8_MMA(1, 0, At, B0); PG8_BAR; PG8_SCHED;
            PG8_STAGE(PG8_SB(0, 1), b2 + hstep, voffB);
            PG8_WAIT_V(6); PG8_BAR; PG8_MMA(1, 1, At, B1); PG8_BAR;
            PG8_LDB(B0, 1, 0); PG8_SCHED; PG8_LDA(At, 1, 0); PG8_STAGE(PG8_SA(0, 1), a2 + hstep, voffA);
            PG8_WAIT_L(8); PG8_BAR; PG8_WAIT_L(0); PG8_MMA(0, 0, At, B0); PG8_BAR; PG8_SCHED;
            PG8_LDB(B1, 1, 1); PG8_STAGE(PG8_SB(1, 0), b3, voffB);
            PG8_BAR; PG8_WAIT_L(0); PG8_MMA(0, 1, At, B1); PG8_BAR;
            PG8_LDA(At, 1, 1); PG8_STAGE(PG8_SA(1, 0), a3, voffA);
            PG8_BAR; PG8_WAIT_L(0); PG8_MMA(1, 0, At, B0); PG8_BAR; PG8_SCHED;
            PG8_STAGE(PG8_SB(1, 1), b3 + hstep, voffB);
            PG8_WAIT_V(6); PG8_BAR; PG8_MMA(1, 1, At, B1); PG8_BAR;
            }
        }
        if constexpr (ALIGN_EPI) { if (wr == 0) PG8_BAR; }
        if constexpr (!Epi::AFTER_DRAIN) { E(acc, cur, wr, wc, fr, fq); S.done(cur); }
        if (!has_next) break;
#pragma unroll
        for (int a = 0; a < 2; ++a)
#pragma unroll
            for (int b = 0; b < 2; ++b)
#pragma unroll
                for (int m = 0; m < 4; ++m)
#pragma unroll
                    for (int n = 0; n < 2; ++n) acc[a][b][m][n] = (f32x4){0.f, 0.f, 0.f, 0.f};
        cur = nxt; cA = nA; cB = nB; ++ui;
        if constexpr (ALIGN_EPI) { if (wr == 1) PG8_BAR; }
    }
    PG8_WAIT_V(0);
    if constexpr (!ALIGN_EPI) { if (wr == 0) PG8_BAR; }
    PG8_BAR;
    if constexpr (Epi::AFTER_DRAIN) { E.fused(acc, cur, wr, wc, fr, fq, lds, wid, lane); S.done(cur); }
#undef PG8_SA
#undef PG8_SB
#undef PG8_STAGE
#undef PG8_LDA
#undef PG8_LDB
#undef PG8_MMA
#undef PG8_WAIT_V
#undef PG8_WAIT_L
#undef PG8_BAR
#undef PG8_SCHED
}
}
#define GAS __attribute__((address_space(1)))
#define LAS __attribute__((address_space(3)))
#define LDS_WAIT() asm volatile("s_waitcnt lgkmcnt(0)" ::: "memory")
#define VM_WAIT() asm volatile("s_waitcnt vmcnt(0)" ::: "memory")
#define XB_TMO      128
#define XB_XCNT(j)  (256  + 64 * (j))
#define XB_XSUB(j)  (1280 + 64 * (j))
#define XB_XGEN(j)  (2304 + 64 * (j))
#define XB_TOP      3328
#define XB_TOPGEN   3392
#define XCD_BAR_WORDS 3456
#define XB_SPIN_CAP (1u << 23)

__device__ __forceinline__ unsigned xb_ld(unsigned* p)              { return __hip_atomic_load(p, __ATOMIC_RELAXED, __HIP_MEMORY_SCOPE_AGENT); }
__device__ __forceinline__ unsigned xb_add(unsigned* p, unsigned v) { return __hip_atomic_fetch_add(p, v, __ATOMIC_RELAXED, __HIP_MEMORY_SCOPE_AGENT); }
__device__ __forceinline__ unsigned xb_xcc_id() { return (unsigned)__builtin_amdgcn_s_getreg((3 << 11) | 20) & 0xFu; }
#define XB_SPIN(cond, bar) do { unsigned _sp = 0; while (cond) { __builtin_amdgcn_s_sleep(1); \
    if ((++_sp & 255u) == 0u) { if (xb_ld(&(bar)[XB_TMO])) break; if (_sp > XB_SPIN_CAP) { atomicAdd(&(bar)[XB_TMO], 1u); break; } } } } while (0)

struct XcdBarrier {
    unsigned* bar; unsigned x;
    volatile LAS unsigned* st;
};

__device__ __forceinline__ XcdBarrier xcd_barrier_post(unsigned* bar, volatile LAS unsigned* st) {
    XcdBarrier b; b.bar = bar; b.x = xb_xcc_id(); b.st = st;
    if (threadIdx.x == 0) (void)xb_add(&bar[XB_XCNT(b.x)], 1u);
    return b;
}
__device__ __forceinline__ void xcd_barrier_complete(unsigned* bar, unsigned x, unsigned& nloc, unsigned& nx) {
    const unsigned G = gridDim.x * gridDim.y * gridDim.z;
    unsigned sum, cnt, mine, sp = 0u;
    for (;;) {
        sum = 0u; cnt = 0u; mine = 0u;
#pragma unroll
        for (unsigned j = 0; j < 16; ++j) { const unsigned c = xb_ld(&bar[XB_XCNT(j)]); sum += c; cnt += (c > 0u) ? 1u : 0u; mine = (j == x) ? c : mine; }
        if (sum == G) break;
        __builtin_amdgcn_s_sleep(1);
        if ((++sp & 255u) == 0u) { if (xb_ld(&bar[XB_TMO])) break; if (sp > XB_SPIN_CAP) { atomicAdd(&bar[XB_TMO], 1u); break; } }
    }
    nloc = mine > 0u ? mine : 1u; nx = cnt > 0u ? cnt : 1u;
}

__device__ __forceinline__ void xcd_barrier(const XcdBarrier& b) {
    asm volatile("s_waitcnt vmcnt(0)" ::: "memory");
    __syncthreads();
    if (threadIdx.x == 0) {
        unsigned* bar = b.bar;
        __builtin_amdgcn_s_waitcnt(0);
        unsigned nloc = b.st[0], nx = b.st[1];
        if (nloc == 0u) { xcd_barrier_complete(bar, b.x, nloc, nx); b.st[0] = nloc; b.st[1] = nx; }
        const unsigned old = xb_add(&bar[XB_XSUB(b.x)], 1u);
        const unsigned gen = old / nloc;
        if (old + 1u == (gen + 1u) * nloc) {
            __builtin_amdgcn_fence(__ATOMIC_RELEASE, "agent");
            asm volatile("s_waitcnt vmcnt(0)" ::: "memory");
            const unsigned og = xb_add(&bar[XB_TOP], 1u);
            const unsigned tg = og / nx;
            if (og + 1u == (tg + 1u) * nx) xb_add(&bar[XB_TOPGEN], 1u);
            else XB_SPIN(xb_ld(&bar[XB_TOPGEN]) == tg, bar);
            __builtin_amdgcn_fence(__ATOMIC_ACQUIRE, "agent");
            xb_add(&bar[XB_XGEN(b.x)], 1u);
            asm volatile("s_waitcnt vmcnt(0)" ::: "memory");
        } else {
            XB_SPIN(xb_ld(&bar[XB_XGEN(b.x)]) == gen, bar);
            __builtin_amdgcn_fence(__ATOMIC_ACQUIRE, "agent");
            asm volatile("s_waitcnt vmcnt(0)" ::: "memory");
        }
    }
    __syncthreads();
}
#define PROBE_PH -1
constexpr int NWAVES = 8, NTHREADS = 512;
constexpr int DM = 1024, SEQ = 8192, NBATCH = 2, MP = NBATCH * SEQ, NDEC = 128, TDEC = 8, MS = NDEC * TDEC, MT = MP + MS;
constexpr int DIN = 3584, HW = 512, NH = 8, HD = 64;
constexpr int NMEM = 256, CAH = 4, CAD = 256, DFF = 2816, DFF2 = 5632;
constexpr int PAST = 2048, PAGE = 128, NPAGES = 16;
constexpr float RMS_EPS = 1e-6f, LOG2E = 1.4426950408889634f;
constexpr float SQ_SCALE = 0.125f * LOG2E;
constexpr float CQ_SCALE = 0.0625f * LOG2E;
enum { I_XP = 0, I_XS, I_CK, I_CV, I_SH, I_SC, I_MK, I_MV, I_PT, I_MEM, I_WIN, I_HGN, I_HLB, I_SBB, I_WO, I_GMIXPRE, I_GMIXPOST, I_GCAPRE, I_GCAPOST, I_GMEM,
       I_WCQ, I_WCK, I_WCV, I_WCO, I_GFFNPRE, I_GFFNPOST, I_WUP, I_CONVW, I_CONVB, I_WDN, N_IN };
constexpr size_t O_YP = 0, O_YS = 16777216, O_KP = 17825792, O_VP = 26214400, O_HP = 34603008, O_CP = 34668544, O_MKP = 34691072, O_MVP = 35215360,
                 O_KS = 35739648, O_VS = 36263936, O_HS = 36788224, O_CS = 40982528, O_END = 42424320;
constexpr size_t MiB = 1u << 20;
constexpr size_t WS_CTL = 0, CTL_ZERO_BYTES = 1 * MiB;
constexpr size_t WS_WIN = 2 * MiB, WS_WO = 9 * MiB, WS_WCQ = 11 * MiB, WS_WCO = 13 * MiB, WS_WCKV = 15 * MiB, WS_WUP = 19 * MiB, WS_WDN = 30 * MiB;
constexpr size_t WS_LB = 36 * MiB, WS_MN = 37 * MiB, WS_MK = 38 * MiB, WS_MV = 39 * MiB;
constexpr size_t WS_H = 40 * MiB, WS_QH = 74 * MiB, WS_LF = 91 * MiB, WS_VH = 125 * MiB, WS_GH = 142 * MiB, WS_SQ = 159 * MiB, WS_SK = 176 * MiB, WS_SV = 193 * MiB;
constexpr size_t WS_OMIX = 210 * MiB, WS_BR = 244 * MiB, WS_X1 = 278 * MiB, WS_X2 = 346 * MiB, WS_QCA = 414 * MiB, WS_U = 448 * MiB, WS_G = 635 * MiB, WS_UCT = 730 * MiB, WS_DC = 762 * MiB, WS_SCT = 763 * MiB, WS_SBP = 780 * MiB, WS_FIX = 786 * MiB, WS_ULAST = 790 * MiB, WS_END = 794 * MiB;
constexpr int CW_BAR = 4096;
constexpr int XB_OFF = 131072;
constexpr int RING_OFF = 0, RING_BYTES = 162816, LDSCTL_OFF = RING_BYTES, MISC_OFF = LDSCTL_OFF + 320, LDS_BYTES = 163840;

typedef unsigned short bf16;
typedef unsigned v4u __attribute__((ext_vector_type(4)));
typedef unsigned v2u __attribute__((ext_vector_type(2)));
typedef float f32x4 __attribute__((ext_vector_type(4)));
using pg8::pk_bf16;
__device__ __forceinline__ float bf2f(unsigned short b) { return __uint_as_float((unsigned)b << 16); }
__device__ __forceinline__ float bflo(unsigned w) { return __uint_as_float(w << 16); }
__device__ __forceinline__ float bfhi(unsigned w) { return __uint_as_float(w & 0xffff0000u); }
__device__ __forceinline__ unsigned short f2bf(float f) { return (unsigned short)(pk_bf16(f, 0.f) & 0xffffu); }
__device__ __forceinline__ float wave_sum(float v) {
#pragma unroll
    for (int o = 1; o < 64; o <<= 1) v += __shfl_xor(v, o);
    return v;
}
__device__ __forceinline__ float rdlane(float v, int l) { return __uint_as_float((unsigned)__builtin_amdgcn_readlane((int)__float_as_uint(v), l)); }

struct Args { const void* in[N_IN]; float* out; unsigned char* ws; int ph_lo, ph_hi; };
struct Ctx { const void* const* in; float* out; unsigned char* ws; LAS unsigned char* lds; int tid, lane, wave, gw, ngw; };

template <bool UPPERM = false>
__device__ __forceinline__ void p0_transpose_item(const float* W, int K, int N, bf16* WT, int row_off, LAS float* scr, int item, int lane) {
    const int nblk = N / 32, kb = item / nblk, nb = item % nblk, k0 = 64 * kb, n0 = 32 * nb;
    const int r0 = UPPERM ? (n0 < DFF ? 256 * (n0 >> 7) + (n0 & 127) : 256 * ((n0 - DFF) >> 7) + 128 + ((n0 - DFF) & 127)) : n0;
#pragma unroll 8
    for (int i = 0; i < 32; ++i) { const int kk = 2 * i + (lane >> 5); scr[kk * 33 + (lane & 31)] = W[(size_t)(k0 + kk) * N + n0 + (lane & 31)]; }
    LDS_WAIT(); asm volatile("" ::: "memory");
    const int c = lane & 7;
#pragma unroll
    for (int j = 0; j < 4; ++j) { const int n = (lane >> 3) + 8 * j; const LAS float* s = scr + (8 * c) * 33 + n;
        v4u o; o.x = pk_bf16(s[0 * 33], s[1 * 33]); o.y = pk_bf16(s[2 * 33], s[3 * 33]); o.z = pk_bf16(s[4 * 33], s[5 * 33]); o.w = pk_bf16(s[6 * 33], s[7 * 33]);
        *(v4u*)(WT + (size_t)(row_off + r0 + n) * K + k0 + 8 * c) = o; }
    LDS_WAIT(); asm volatile("" ::: "memory");
}
__device__ __forceinline__ void rms_row_to_bf16(const float* xrow, const float* g, bf16* orow, int lane) {
    const f32x4* xr = (const f32x4*)xrow + lane; const f32x4* gr = (const f32x4*)g + lane;
    f32x4 v[4]; float s = 0.f;
#pragma unroll
    for (int j = 0; j < 4; ++j) { v[j] = xr[64 * j]; s += (v[j].x * v[j].x + v[j].y * v[j].y) + (v[j].z * v[j].z + v[j].w * v[j].w); }
    const float r = rsqrtf(wave_sum(s) * (1.f / DM) + RMS_EPS);
    v2u* o8 = (v2u*)orow + lane;
#pragma unroll
    for (int j = 0; j < 4; ++j) { const f32x4 gg = gr[64 * j]; v2u w; w.x = pk_bf16(v[j].x * r * gg.x, v[j].y * r * gg.y); w.y = pk_bf16(v[j].z * r * gg.z, v[j].w * r * gg.w); o8[64 * j] = w; }
}
__device__ __forceinline__ void p0_prologue(const Ctx& C) {
    LAS float* scr = (LAS float*)(C.lds + RING_OFF + C.wave * 16384);
    const float* w_in = (const float*)C.in[I_WIN]; const float* w_o = (const float*)C.in[I_WO]; const float* w_cq = (const float*)C.in[I_WCQ]; const float* w_ck = (const float*)C.in[I_WCK];
    const float* w_cv = (const float*)C.in[I_WCV]; const float* w_co = (const float*)C.in[I_WCO]; const float* w_up = (const float*)C.in[I_WUP]; const float* w_dn = (const float*)C.in[I_WDN];
    bf16* Win = (bf16*)(C.ws + WS_WIN); bf16* Wo = (bf16*)(C.ws + WS_WO); bf16* Wcq = (bf16*)(C.ws + WS_WCQ); bf16* Wco = (bf16*)(C.ws + WS_WCO); bf16* Wckv = (bf16*)(C.ws + WS_WCKV);
    bf16* Wup = (bf16*)(C.ws + WS_WUP); bf16* Wdn = (bf16*)(C.ws + WS_WDN);
    constexpr int I_IN = (DM / 64) * (DIN / 32), I_SQ = (DM / 64) * (DM / 32), I_UP = (DM / 64) * (DFF2 / 32), I_DN = (DFF / 64) * (DM / 32);
    constexpr int NITEMS = I_IN + 5 * I_SQ + I_UP + I_DN;
    for (int it = C.gw; it < NITEMS; it += C.ngw) {
        int r = it;
        if (r < I_IN) { p0_transpose_item(w_in, DM, DIN, Win, 0, scr, r, C.lane); continue; } r -= I_IN;
        if (r < I_SQ) { p0_transpose_item(w_o, DM, DM, Wo, 0, scr, r, C.lane); continue; } r -= I_SQ;
        if (r < I_SQ) { p0_transpose_item(w_cq, DM, DM, Wcq, 0, scr, r, C.lane); continue; } r -= I_SQ;
        if (r < I_SQ) { p0_transpose_item(w_co, DM, DM, Wco, 0, scr, r, C.lane); continue; } r -= I_SQ;
        if (r < I_SQ) { p0_transpose_item(w_ck, DM, DM, Wckv, 0, scr, r, C.lane); continue; } r -= I_SQ;
        if (r < I_SQ) { p0_transpose_item(w_cv, DM, DM, Wckv, DM, scr, r, C.lane); continue; } r -= I_SQ;
        if (r < I_UP) { p0_transpose_item<true>(w_up, DM, DFF2, Wup, 0, scr, r, C.lane); continue; } r -= I_UP;
        p0_transpose_item(w_dn, DFF, DM, Wdn, 0, scr, r, C.lane);
    }
    const float* xp = (const float*)C.in[I_XP]; const float* xs = (const float*)C.in[I_XS]; const float* mem = (const float*)C.in[I_MEM];
    bf16* H = (bf16*)(C.ws + WS_H); bf16* MN = (bf16*)(C.ws + WS_MN);
    const float* g_pre = (const float*)C.in[I_GMIXPRE]; const float* g_mem = (const float*)C.in[I_GMEM];
    for (int m = C.gw; m < MT + NBATCH * NMEM; m += C.ngw) {
        if (m < MP) rms_row_to_bf16(xp + (size_t)m * DM, g_pre, H + (size_t)m * DM, C.lane);
        else if (m < MT) rms_row_to_bf16(xs + (size_t)(m - MP) * DM, g_pre, H + (size_t)m * DM, C.lane);
        else rms_row_to_bf16(mem + (size_t)(m - MT) * DM, g_mem, MN + (size_t)(m - MT) * DM, C.lane);
    }
    if (C.gw == 0) {
        const float* lbp = (const float*)C.in[I_HLB]; float* LB = (float*)(C.ws + WS_LB);
        for (int k = C.lane; k < HW; k += 64) { const float a = lbp[k], b = lbp[HW + k]; LB[k] = 1.f / (1.f + __expf(b - a)); }
    }
}
typedef short bf16x8s __attribute__((ext_vector_type(8)));
typedef short s16x4 __attribute__((ext_vector_type(4)));
typedef short v4i16_t __attribute__((ext_vector_type(4)));
constexpr int HRS = 72;
__device__ __forceinline__ s16x4 tr4(const LAS bf16* p) { return __builtin_bit_cast(s16x4, __builtin_amdgcn_ds_read_tr16_b64_v4i16((LAS v4i16_t*)p)); }
__device__ __forceinline__ bf16x8s cat8(s16x4 lo, s16x4 hi) { return (bf16x8s){lo[0], lo[1], lo[2], lo[3], hi[0], hi[1], hi[2], hi[3]}; }
__device__ __forceinline__ f32x4 mfma16(bf16x8s a, bf16x8s b, f32x4 c) { return __builtin_amdgcn_mfma_f32_16x16x32_bf16(a, b, c, 0, 0, 0); }
__device__ __forceinline__ void hg_stage_v(const bf16* VH, int r0, int h, LAS bf16* Vt, int lane) {
#pragma unroll
    for (int it = 0; it < 8; ++it) { const int row = it * 8 + (lane >> 3), ch = lane & 7; const v4u w = *(const v4u*)(VH + (size_t)(r0 + row) * HW + h * HD + ch * 8); *(LAS v4u*)(Vt + row * HRS + ch * 8) = w; }
}
__device__ __forceinline__ void hgrn_h1(const Ctx& C, int cid) {
    const float* LF = (const float*)(C.ws + WS_LF); const bf16* VH = (const bf16*)(C.ws + WS_VH);
    float* UCT = (float*)(C.ws + WS_UCT); float* DC = (float*)(C.ws + WS_DC);
    const int lane = C.lane, i = lane & 15, g = lane >> 4;
    const int chain = cid >> 7, ci = cid & 127, b = chain >> 3, h = chain & 7, r0 = b * SEQ + ci * 64;
    LAS bf16* Vt = (LAS bf16*)(C.lds + RING_OFF + C.wave * 18432); LAS bf16* Kt = Vt + 64 * HRS;
    hg_stage_v(VH, r0, h, Vt, lane);
    const float* lfp = LF + (size_t)r0 * HW + h * HD + lane;
    float bl = 0.f;
#pragma unroll 16
    for (int t = 0; t < 64; ++t) bl += lfp[(size_t)t * HW];
    { float run = 0.f;
#pragma unroll 16
      for (int s = 0; s < 64; ++s) { const float lf = lfp[(size_t)s * HW]; run += lf; Kt[s * HRS + lane] = f2bf((1.f - __expf(lf)) * __expf(bl - run)); } }
    DC[(size_t)cid * 64 + lane] = __expf(bl);
    LDS_WAIT();
#pragma unroll
    for (int kb = 0; kb < 4; ++kb) {
        bf16x8s af[2];
#pragma unroll
        for (int ks = 0; ks < 2; ++ks) af[ks] = cat8(tr4(Kt + (32 * ks + 8 * g + (i >> 2)) * HRS + 16 * kb + (i & 3) * 4), tr4(Kt + (32 * ks + 8 * g + 4 + (i >> 2)) * HRS + 16 * kb + (i & 3) * 4));
#pragma unroll
        for (int db = 0; db < 4; ++db) {
            f32x4 acc = {0.f, 0.f, 0.f, 0.f};
#pragma unroll
            for (int ks = 0; ks < 2; ++ks) { const bf16x8s bfr = cat8(tr4(Vt + (32 * ks + 8 * g + (i >> 2)) * HRS + 16 * db + (i & 3) * 4), tr4(Vt + (32 * ks + 8 * g + 4 + (i >> 2)) * HRS + 16 * db + (i & 3) * 4));
                acc = mfma16(af[ks], bfr, acc); }
            *(f32x4*)(UCT + ((size_t)cid * 64 + 16 * db + i) * 64 + 16 * kb + 4 * g) = acc;
        }
    }
    LDS_WAIT();
}
__device__ __forceinline__ void hgrn_h2(const Ctx& C) {
    const float* UCT = (const float*)(C.ws + WS_UCT); const float* DC = (const float*)(C.ws + WS_DC); bf16* SCT = (bf16*)(C.ws + WS_SCT);
    const int lane = C.lane;
    for (int w = C.gw; w < NBATCH * NH * 64; w += C.ngw) {
        const int chain = w >> 6, d = w & 63; float S = 0.f;
        for (int c0 = 0; c0 < 128; c0 += 16) {
            float u[16], dc[16];
#pragma unroll
            for (int j = 0; j < 16; ++j) { const size_t cid = (size_t)chain * 128 + c0 + j; u[j] = UCT[(cid * 64 + d) * 64 + lane]; dc[j] = DC[cid * 64 + lane]; }
#pragma unroll
            for (int j = 0; j < 16; ++j) { const size_t cid = (size_t)chain * 128 + c0 + j; SCT[(cid * 64 + d) * 64 + lane] = f2bf(S); S = dc[j] * S + u[j]; }
        }
        C.out[O_HP + (size_t)chain * 4096 + lane * 64 + d] = S;
    }
}
__device__ __forceinline__ void hgrn_h3(const Ctx& C, int cid) {
    const float* LF = (const float*)(C.ws + WS_LF); const bf16* QH = (const bf16*)(C.ws + WS_QH); const bf16* VH = (const bf16*)(C.ws + WS_VH); const bf16* GH = (const bf16*)(C.ws + WS_GH);
    const bf16* SCT = (const bf16*)(C.ws + WS_SCT); bf16* OMIX = (bf16*)(C.ws + WS_OMIX); const float* hgn = (const float*)C.in[I_HGN];
    const int lane = C.lane, i = lane & 15, g = lane >> 4;
    const int chain = cid >> 7, ci = cid & 127, b = chain >> 3, h = chain & 7, r0 = b * SEQ + ci * 64;
    LAS bf16* Vt = (LAS bf16*)(C.lds + RING_OFF + C.wave * 18432); LAS bf16* Kb = Vt + 64 * HRS; LAS bf16* Qh = Kb + 16 * HRS; LAS bf16* Qt = Qh + 16 * HRS;
    hg_stage_v(VH, r0, h, Vt, lane);
    const float* lfp = LF + (size_t)r0 * HW + h * HD + lane; const bf16* qp = QH + (size_t)r0 * HW + h * HD + lane;
    float eb[4];
    bf16x8s sfr[4][2];
#pragma unroll
    for (int db = 0; db < 4; ++db)
#pragma unroll
        for (int ks = 0; ks < 2; ++ks) sfr[db][ks] = *(const bf16x8s*)(SCT + ((size_t)cid * 64 + 16 * db + i) * 64 + 32 * ks + 8 * g);
#pragma unroll
    for (int is = 0; is < 4; ++is) {
        const float ri = is ? eb[is - 1] : 0.f, er = __expf(ri);
        { float run = 0.f;
#pragma unroll
          for (int tt = 0; tt < 16; ++tt) { const int t = 16 * is + tt; run += lfp[(size_t)t * HW]; const float qt = bf2f(qp[(size_t)t * HW]) * __expf(run);
              Qt[tt * HRS + lane] = f2bf(qt); Qh[tt * HRS + lane] = f2bf(qt * er); }
          eb[is] = ri + run; }
        LDS_WAIT();
        bf16x8s qhf[2], qtf[2];
#pragma unroll
        for (int ks = 0; ks < 2; ++ks) { qhf[ks] = *(const LAS bf16x8s*)(Qh + i * HRS + 32 * ks + 8 * g); qtf[ks] = *(const LAS bf16x8s*)(Qt + i * HRS + 32 * ks + 8 * g); }
        f32x4 o[4];
#pragma unroll
        for (int db = 0; db < 4; ++db) { o[db] = (f32x4){0.f, 0.f, 0.f, 0.f};
#pragma unroll
            for (int ks = 0; ks < 2; ++ks) o[db] = mfma16(sfr[db][ks], qhf[ks], o[db]); }
#pragma unroll
        for (int jp = 0; jp <= is / 2; ++jp) {
            f32x4 x[2];
#pragma unroll
            for (int jj = 0; jj < 2; ++jj) {
                const int j = 2 * jp + jj; x[jj] = (f32x4){0.f, 0.f, 0.f, 0.f};
                if (j <= is) {
                    { float run = (j ? eb[j - 1] : 0.f) - ri;
#pragma unroll
                      for (int ss = 0; ss < 16; ++ss) { const int s = 16 * j + ss; const float lf = lfp[(size_t)s * HW]; run += lf; Kb[ss * HRS + lane] = f2bf((1.f - __expf(lf)) * __expf(-run)); } }
                    LDS_WAIT();
#pragma unroll
                    for (int ks = 0; ks < 2; ++ks) { const bf16x8s kf = *(const LAS bf16x8s*)(Kb + i * HRS + 32 * ks + 8 * g); x[jj] = mfma16(kf, qtf[ks], x[jj]); }
                    if (j == is) {
#pragma unroll
                        for (int e = 0; e < 4; ++e) if (4 * g + e > i) x[jj][e] = 0.f;
                    }
                    LDS_WAIT();
                }
            }
            bf16x8s pb; { const unsigned w0 = pk_bf16(x[0][0], x[0][1]), w1 = pk_bf16(x[0][2], x[0][3]), w2 = pk_bf16(x[1][0], x[1][1]), w3 = pk_bf16(x[1][2], x[1][3]); const v4u ww = {w0, w1, w2, w3}; pb = __builtin_bit_cast(bf16x8s, ww); }
            const int j0 = 2 * jp, j1 = (2 * jp + 1 <= is) ? 2 * jp + 1 : 2 * jp;
#pragma unroll
            for (int db = 0; db < 4; ++db) { const bf16x8s vf = cat8(tr4(Vt + (16 * j0 + 4 * g + (i >> 2)) * HRS + 16 * db + (i & 3) * 4), tr4(Vt + (16 * j1 + 4 * g + (i >> 2)) * HRS + 16 * db + (i & 3) * 4));
                o[db] = mfma16(vf, pb, o[db]); }
        }
        float ss = 0.f;
#pragma unroll
        for (int db = 0; db < 4; ++db) ss += (o[db][0] * o[db][0] + o[db][1] * o[db][1]) + (o[db][2] * o[db][2] + o[db][3] * o[db][3]);
        ss += __shfl_xor(ss, 16); ss += __shfl_xor(ss, 32);
        const float r = rsqrtf(ss * (1.f / HD) + RMS_EPS); const size_t row = (size_t)(r0 + 16 * is + i);
#pragma unroll
        for (int db = 0; db < 4; ++db) { const int d0 = h * HD + 16 * db + 4 * g; const v2u gw = *(const v2u*)(GH + row * HW + d0); const f32x4 gn = *(const f32x4*)(hgn + d0);
            const float g0 = bflo(gw.x), g1 = bfhi(gw.x), g2 = bflo(gw.y), g3 = bfhi(gw.y);
            v2u w; w.x = pk_bf16(o[db][0] * r * gn.x * (g0 / (1.f + __expf(-g0))), o[db][1] * r * gn.y * (g1 / (1.f + __expf(-g1))));
            w.y = pk_bf16(o[db][2] * r * gn.z * (g2 / (1.f + __expf(-g2))), o[db][3] * r * gn.w * (g3 / (1.f + __expf(-g3))));
            *(v2u*)(OMIX + row * DM + d0) = w; }
    }
    LDS_WAIT();
}
typedef float f32x16 __attribute__((ext_vector_type(16)));
constexpr int SB_RS = 72;
constexpr int SB_TILE = 64 * SB_RS;
__device__ __forceinline__ f32x16 mfma32(bf16x8s a, bf16x8s b, f32x16 c) { return __builtin_amdgcn_mfma_f32_32x32x16_bf16(a, b, c, 0, 0, 0); }
__device__ __forceinline__ int sb_crow(int r, int hi) { return (r & 3) + 8 * (r >> 2) + 4 * hi; }
__device__ __forceinline__ void sb_subtile(const LAS bf16* Kp, const LAS bf16* Vp, const bf16x8s (&qf)[4], float bias2, bool diag, int key0, int qpos, int hi, float& Cc, f32x16& o0, f32x16& o1) {
    f32x16 p;
#pragma unroll
    for (int r = 0; r < 16; ++r) p[r] = bias2;
#pragma unroll
    for (int ks = 0; ks < 4; ++ks) { const bf16x8s kf = *(const LAS bf16x8s*)(Kp + 16 * ks); p = mfma32(kf, qf[ks], p); }
    float E = 1.f;
#pragma unroll
    for (int r = 0; r < 16; ++r) { float u = __builtin_amdgcn_exp2f(p[r]); if (diag) u = (key0 + r < qpos) ? u : 0.f; const float tt = E * u; E += tt; p[r] = tt; }
    const float Ti = __builtin_amdgcn_rcpf(E), Tp = __shfl_xor(Ti, 32);
    const float G = Ti * (hi ? Cc : Cc * Tp);
    Cc = Cc * Ti * Tp;
#pragma unroll
    for (int r = 0; r < 16; ++r) p[r] *= G;
    bf16x8s pa[2];
#pragma unroll
    for (int s = 0; s < 2; ++s) { const v4u ww = {pk_bf16(p[8 * s], p[8 * s + 1]), pk_bf16(p[8 * s + 2], p[8 * s + 3]), pk_bf16(p[8 * s + 4], p[8 * s + 5]), pk_bf16(p[8 * s + 6], p[8 * s + 7])}; pa[s] = __builtin_bit_cast(bf16x8s, ww); }
#pragma unroll
    for (int s = 0; s < 2; ++s) {
        const LAS bf16* vb = Vp + 8 * s * SB_RS;
        const bf16x8s v0 = cat8(tr4(vb), tr4(vb + 4 * SB_RS)), v1 = cat8(tr4(vb + 32), tr4(vb + 4 * SB_RS + 32));
        o0 = mfma32(pa[s], v0, o0); o1 = mfma32(pa[s], v1, o1);
    }
}
constexpr int SBK_RS = 72, SBV_RS = 160;
constexpr int SBK_T = 128 * SBK_RS, SBV_T = 128 * SBV_RS;
template <bool MASK>
__device__ __forceinline__ void sb_weights(f32x16& p, int key0, int qpos, int hi, float& Cc, bf16x8s (&pa)[2]) {
    float E = 1.f;
#pragma unroll
    for (int r = 0; r < 16; ++r) { float u = __builtin_amdgcn_exp2f(p[r]); if (MASK) u = (key0 + r < qpos) ? u : 0.f; const float tt = E * u; E += tt; p[r] = tt; }
    const float Ti = __builtin_amdgcn_rcpf(E);
    const auto rr = __builtin_amdgcn_permlane32_swap(__float_as_uint(Ti), __float_as_uint(Ti), false, false);
    const float Tp = __uint_as_float(rr[0] == __float_as_uint(Ti) ? rr[1] : rr[0]);
    const float G = Ti * (hi ? Cc : Cc * Tp);
    Cc = Cc * Ti * Tp;
#pragma unroll
    for (int s = 0; s < 2; ++s) { const v4u ww = {pk_bf16(p[8 * s] * G, p[8 * s + 1] * G), pk_bf16(p[8 * s + 2] * G, p[8 * s + 3] * G), pk_bf16(p[8 * s + 4] * G, p[8 * s + 5] * G), pk_bf16(p[8 * s + 6] * G, p[8 * s + 7] * G)}; pa[s] = __builtin_bit_cast(bf16x8s, ww); }
}
__device__ __forceinline__ void grp4_barrier(volatile LAS unsigned* cnt, unsigned& target, int lane) {
    target += 4u;
    if (lane == 0) __hip_atomic_fetch_add((LAS unsigned*)cnt, 1u, __ATOMIC_RELAXED, __HIP_MEMORY_SCOPE_WORKGROUP);
    while (*cnt < target) __builtin_amdgcn_s_sleep(1);
    asm volatile("" ::: "memory");
}
__device__ __forceinline__ void sb_unit4(const Ctx& C, int b, int h, int qb, volatile LAS unsigned* gcnt, unsigned& gtarget) {
    const bf16* SQ = (const bf16*)(C.ws + WS_SQ); const bf16* SK = (const bf16*)(C.ws + WS_SK); const bf16* SV = (const bf16*)(C.ws + WS_SV); bf16* OMIX = (bf16*)(C.ws + WS_OMIX);
    const int tid = C.tid, lane = C.lane, r32 = lane & 31, hi = lane >> 5, w = C.wave;
    const int q0 = qb * 128, qlo = q0 + 32 * w, qpos = qlo + r32;
    LAS bf16* Kl = (LAS bf16*)(C.lds + RING_OFF); LAS bf16* Vl = Kl + 2 * SBK_T;
    const float bias2 = ((const float*)C.in[I_SBB])[h] * LOG2E;
    bf16x8s qf[4];
#pragma unroll
    for (int ks = 0; ks < 4; ++ks) qf[ks] = *(const bf16x8s*)(SQ + (size_t)(b * SEQ + qpos) * HW + h * HD + 16 * ks + 8 * hi);
    const int srow = tid >> 3, sch = tid & 7;
    const bf16* gk = SK + (size_t)(b * SEQ + srow) * HW + h * HD + sch * 8; const bf16* gv = SV + (size_t)(b * SEQ + srow) * HW + h * HD + sch * 8;
    const int skoff = srow * SBK_RS + sch * 8, svoff = srow * SBV_RS + sch * 8;
    const int nt = qb + 1, ntp = nt + (nt & 1), sd = q0 / 32 + w;
    v4u rk[4], rv[4];
#pragma unroll
    for (int j = 0; j < 4; ++j) { rk[j] = *(const v4u*)(gk + (size_t)((ntp - 1) * 128 + 32 * j) * HW); rv[j] = *(const v4u*)(gv + (size_t)((ntp - 1) * 128 + 32 * j) * HW); }
#pragma unroll
    for (int j = 0; j < 4; ++j) { *(LAS v4u*)(Kl + skoff + 32 * j * SBK_RS) = rk[j]; *(LAS v4u*)(Vl + svoff + 32 * j * SBV_RS) = rv[j]; }
    asm volatile("" :: "v"(qf[0]), "v"(qf[1]), "v"(qf[2]), "v"(qf[3]));
    f32x16 o0, o1;
#pragma unroll
    for (int r = 0; r < 16; ++r) { o0[r] = 0.f; o1[r] = 0.f; }
    float Cc = 1.f;
    const int kap = 16 * ((r32 >> 2) & 1) + (r32 & 3) + 4 * (r32 >> 3);
    const int koff = kap * SBK_RS + 8 * hi;
    const int gi = lane >> 4, i16 = lane & 15;
    const int voff = (16 * hi + (i16 >> 2)) * SBV_RS + 16 * (gi & 1) + (i16 & 3) * 4;
    f32x16 pinit;
#pragma unroll
    for (int r = 0; r < 16; ++r) pinit[r] = bias2;
#define SB_QK(dst, sub) do { const LAS bf16* kp_ = Kc + (sub) * 32 * SBK_RS + koff; bf16x8s kf_[4]; _Pragma("unroll") for (int ks = 0; ks < 4; ++ks) kf_[ks] = *(const LAS bf16x8s*)(kp_ + 16 * ks); \
        dst = mfma32(kf_[0], qf[0], pinit); dst = mfma32(kf_[1], qf[1], dst); dst = mfma32(kf_[2], qf[2], dst); dst = mfma32(kf_[3], qf[3], dst); } while (0)
#define SB_PV(sub) do { const LAS bf16* vb_ = Vc + (sub) * 32 * SBV_RS + voff; \
        const bf16x8s v00 = cat8(tr4(vb_), tr4(vb_ + 4 * SBV_RS)), v01 = cat8(tr4(vb_ + 32), tr4(vb_ + 4 * SBV_RS + 32)); \
        const bf16x8s v10 = cat8(tr4(vb_ + 8 * SBV_RS), tr4(vb_ + 12 * SBV_RS)), v11 = cat8(tr4(vb_ + 8 * SBV_RS + 32), tr4(vb_ + 12 * SBV_RS + 32)); \
        o0 = mfma32(pa[0], v00, o0); o1 = mfma32(pa[0], v01, o1); o0 = mfma32(pa[1], v10, o0); o1 = mfma32(pa[1], v11, o1); } while (0)
    v4u rk2[4], rv2[4];
#define SB_ISSUE(RK, RV, t) do { _Pragma("unroll") for (int j = 0; j < 4; ++j) { RK[j] = *(const v4u*)(gk + (size_t)((t) * 128 + 32 * j) * HW); RV[j] = *(const v4u*)(gv + (size_t)((t) * 128 + 32 * j) * HW); } } while (0)
#define SB_WRITE(RK, RV, bufi) do { _Pragma("unroll") for (int j = 0; j < 4; ++j) { *(LAS v4u*)(Kl + (bufi) * SBK_T + skoff + 32 * j * SBK_RS) = RK[j]; *(LAS v4u*)(Vl + (bufi) * SBV_T + svoff + 32 * j * SBV_RS) = RV[j]; } } while (0)
#define SB_TILE(T, bufi) do { \
        const LAS bf16* Kc = Kl + (bufi) * SBK_T; const LAS bf16* Vc = Vl + (bufi) * SBV_T; \
        const int top = sd - 4 * (T); \
        if (top >= 0) { \
            const int hs = top < 3 ? top : 3; \
            f32x16 pc, pn; bf16x8s pa[2]; \
            if (hs == 3) SB_QK(pc, 3); else if (hs == 2) SB_QK(pc, 2); else if (hs == 1) SB_QK(pc, 1); else SB_QK(pc, 0); \
            _Pragma("unroll") for (int sub = 3; sub >= 0; --sub) { \
                if (sub <= hs) { \
                    if (sub > 0) SB_QK(pn, sub - 1); \
                    const int key0 = 128 * (T) + 32 * sub + 16 * hi; \
                    if (sub == top) sb_weights<true>(pc, key0, qpos, hi, Cc, pa); else sb_weights<false>(pc, key0, qpos, hi, Cc, pa); \
                    SB_PV(sub); \
                    if (sub > 0) pc = pn; \
                } } } } while (0)
    SB_ISSUE(rk2, rv2, ntp - 2);
    grp4_barrier(gcnt, gtarget, lane);
    for (int k = 0; k < ntp; k += 2) {
        { const int ti = ntp - 3 - k; SB_ISSUE(rk, rv, (ti > 0 ? ti : 0)); }
        SB_TILE(ntp - 1 - k, 0);
        SB_WRITE(rk2, rv2, 1);
        grp4_barrier(gcnt, gtarget, lane);
        { const int ti = ntp - 4 - k; SB_ISSUE(rk2, rv2, (ti > 0 ? ti : 0)); }
        SB_TILE(ntp - 2 - k, 1);
        SB_WRITE(rk, rv, 0);
        grp4_barrier(gcnt, gtarget, lane);
    }
#undef SB_ISSUE
#undef SB_WRITE
#undef SB_TILE
#undef SB_QK
#undef SB_PV
    bf16* orow = OMIX + (size_t)(b * SEQ + qlo) * DM + HW + h * HD + r32;
#pragma unroll
    for (int r = 0; r < 16; ++r) { const int q = sb_crow(r, hi); orow[(size_t)q * DM] = f2bf(o0[r]); orow[(size_t)q * DM + 32] = f2bf(o1[r]); }
}
__device__ __forceinline__ void sb_prompt_role(const Ctx& C, volatile LAS unsigned* gcnt, unsigned rep) {
    const int G = gridDim.x, bid = blockIdx.x;
    const int vcu = (G % 8 == 0) ? (bid % 8) * (G / 8) + bid / 8 : bid;
    unsigned gtarget = rep * 4u * 2u * 68u;
    for (int p = vcu; p < NBATCH * NH * 32; p += G) {
        const int bh = p >> 5, s = p & 31;
        sb_unit4(C, bh >> 3, bh & 7, 63 - s, gcnt, gtarget);
        sb_unit4(C, bh >> 3, bh & 7, s, gcnt, gtarget);
    }
}
__device__ __forceinline__ void sbs_item4(const Ctx& C, int n, int half) {
    const bf16* SQ = (const bf16*)(C.ws + WS_SQ); const bf16* SK = (const bf16*)(C.ws + WS_SK); const bf16* SV = (const bf16*)(C.ws + WS_SV);
    const float* ck = (const float*)C.in[I_CK]; const float* cv = (const float*)C.in[I_CV]; const int* pt = (const int*)C.in[I_PT];
    float* PO = (float*)(C.ws + WS_SBP); float* PC = PO + (size_t)NDEC * 2 * NH * TDEC * HD;
    const int lane = C.lane, r32 = lane & 31, hi = lane >> 5, ws = C.wave - 4, h0 = 2 * ws;
    LAS bf16* Kt = (LAS bf16*)(C.lds + RING_OFF + 2 * (SBK_T + SBV_T) * 2) + ws * (2 * 32 * SB_RS); LAS bf16* Vt = Kt + 32 * SB_RS;
    const int qpos = PAST + r32;
    bf16x8s qf[2][4]; float bias2[2];
#pragma unroll
    for (int a = 0; a < 2; ++a) { bias2[a] = ((const float*)C.in[I_SBB])[h0 + a] * LOG2E;
#pragma unroll
        for (int ks = 0; ks < 4; ++ks) { qf[a][ks] = (bf16x8s){0, 0, 0, 0, 0, 0, 0, 0}; if (r32 < TDEC) qf[a][ks] = *(const bf16x8s*)(SQ + (size_t)(MP + n * TDEC + r32) * HW + (h0 + a) * HD + 16 * ks + 8 * hi); } }
    f32x16 o0[2], o1[2]; float Cc[2] = {1.f, 1.f};
#pragma unroll
    for (int a = 0; a < 2; ++a)
#pragma unroll
        for (int r = 0; r < 16; ++r) { o0[a][r] = 0.f; o1[a][r] = 0.f; }
    const int kap = 16 * ((r32 >> 2) & 1) + (r32 & 3) + 4 * (r32 >> 3);
    const LAS bf16* Kp = Kt + kap * SB_RS + 8 * hi;
    const int gi = lane >> 4, i16 = lane & 15;
    const LAS bf16* Vp = Vt + (16 * hi + (i16 >> 2)) * SB_RS + 16 * (gi & 1) + (i16 & 3) * 4;
    const int srow = lane >> 4, sch = lane & 15;
    if (half == 1) {
#pragma unroll
        for (int a = 0; a < 2; ++a) {
#pragma unroll
            for (int it = 0; it < 8; ++it) { const int row = it * 4 + srow; v2u kw = {0u, 0u}, vw = {0u, 0u};
                if (row < TDEC) { kw = *(const v2u*)(SK + (size_t)(MP + n * TDEC + row) * HW + (h0 + a) * HD + sch * 4); vw = *(const v2u*)(SV + (size_t)(MP + n * TDEC + row) * HW + (h0 + a) * HD + sch * 4); }
                *(LAS v2u*)(Kt + row * SB_RS + sch * 4) = kw; *(LAS v2u*)(Vt + row * SB_RS + sch * 4) = vw; }
            LDS_WAIT();
            sb_subtile(Kp, Vp, qf[a], bias2[a], true, PAST + 16 * hi, qpos, hi, Cc[a], o0[a], o1[a]);
            LDS_WAIT();
        }
    }
    const int pg_hi = half ? NPAGES - 1 : NPAGES / 2 - 1, nsteps = (NPAGES / 2) * 4 * 2;
    f32x4 rk[8], rv[8];
    { const size_t base = (((size_t)pt[n * NPAGES + pg_hi] * PAGE + 96 + srow) * NH + h0) * HD + sch * 4;
#pragma unroll
      for (int it = 0; it < 8; ++it) { rk[it] = *(const f32x4*)(ck + base + (size_t)it * 4 * NH * HD); rv[it] = *(const f32x4*)(cv + base + (size_t)it * 4 * NH * HD); } }
    for (int st = 0; st < nsteps; st += 2) {
#pragma unroll
        for (int a = 0; a < 2; ++a) {
#pragma unroll
            for (int it = 0; it < 8; ++it) { const int row = it * 4 + srow;
                const v2u kw = {pk_bf16(rk[it].x, rk[it].y), pk_bf16(rk[it].z, rk[it].w)}, vw = {pk_bf16(rv[it].x, rv[it].y), pk_bf16(rv[it].z, rv[it].w)};
                *(LAS v2u*)(Kt + row * SB_RS + sch * 4) = kw; *(LAS v2u*)(Vt + row * SB_RS + sch * 4) = vw; }
            const int s2 = st + a + 1;
            if (s2 < nsteps) { const int sg = s2 >> 1, pg = pg_hi - (sg >> 2), sub = 3 - (sg & 3);
                const size_t base = (((size_t)pt[n * NPAGES + pg] * PAGE + 32 * sub + srow) * NH + h0 + (s2 & 1)) * HD + sch * 4;
#pragma unroll
                for (int it = 0; it < 8; ++it) { rk[it] = *(const f32x4*)(ck + base + (size_t)it * 4 * NH * HD); rv[it] = *(const f32x4*)(cv + base + (size_t)it * 4 * NH * HD); } }
            LDS_WAIT();
            sb_subtile(Kp, Vp, qf[a], bias2[a], false, 0, qpos, hi, Cc[a], o0[a], o1[a]);
            LDS_WAIT();
        }
    }
#pragma unroll
    for (int a = 0; a < 2; ++a) {
        float* po = PO + ((size_t)(n * 2 + half) * NH + h0 + a) * TDEC * HD;
#pragma unroll
        for (int r = 0; r < 4; ++r) { po[(r + 4 * hi) * HD + r32] = o0[a][r]; po[(r + 4 * hi) * HD + 32 + r32] = o1[a][r]; }
        if (lane < TDEC) PC[((size_t)(n * 2 + half) * NH + h0 + a) * TDEC + lane] = Cc[a];
    }
}
__device__ __forceinline__ void sbs_role(const Ctx& C) {
    for (int it = blockIdx.x; it < NDEC * 2; it += gridDim.x) sbs_item4(C, it >> 1, it & 1);
}
__device__ __forceinline__ void sbs_combine(const Ctx& C) {
    const float* PO = (const float*)(C.ws + WS_SBP); const float* PC = PO + (size_t)NDEC * 2 * NH * TDEC * HD; bf16* OMIX = (bf16*)(C.ws + WS_OMIX);
    const int gt = C.gw * 64 + C.lane, ngt = C.ngw * 64;
    for (int e = gt; e < NDEC * NH * TDEC * HD; e += ngt) {
        const int d = e & 63, q = (e >> 6) & 7, h = (e >> 9) & 7, n = e >> 12;
        const size_t i1 = ((size_t)(n * 2 + 1) * NH + h) * TDEC + q, i0 = ((size_t)(n * 2) * NH + h) * TDEC + q;
        OMIX[(size_t)(MP + n * TDEC + q) * DM + HW + h * HD + d] = f2bf(PO[i1 * HD + d] + PC[i1] * PO[i0 * HD + d]);
    }
}
constexpr int CA_KRS = 264, CA_VRS = 288;
constexpr int CA_KT = 64 * CA_KRS, CA_VT = 64 * CA_VRS;
__device__ __forceinline__ void ca_unit(const Ctx& C, int b, int hh, int qblk) {
    const bf16* QCA = (const bf16*)(C.ws + WS_QCA); const bf16* MK = (const bf16*)(C.ws + WS_MK); const bf16* MV = (const bf16*)(C.ws + WS_MV); bf16* OCA = (bf16*)(C.ws + WS_OMIX);
    const int tid = C.tid, lane = C.lane, r32 = lane & 31, hi = lane >> 5, w = C.wave, gi = lane >> 4, i16 = lane & 15;
    LAS bf16* Kl = (LAS bf16*)(C.lds + RING_OFF); LAS bf16* Vl = Kl + 2 * CA_KT; LAS float* wsf = (LAS float*)(Vl + 2 * CA_VT) + w * 32;
    const size_t qrow = (size_t)b * SEQ + 256 * qblk + 32 * w;
    bf16x8s qf[16];
#pragma unroll
    for (int ks = 0; ks < 16; ++ks) qf[ks] = *(const bf16x8s*)(QCA + (qrow + r32) * DM + hh * CAD + 16 * ks + 8 * hi);
    const bf16* gk = MK + (size_t)(b * NMEM) * DM + hh * CAD; const bf16* gv = MV + (size_t)(b * NMEM) * DM + hh * CAD;
    v4u rg[4];
#define CA_LOAD(i) do { const bf16* src_ = ((i) < 4 ? gk : gv) + (size_t)(((i) & 3) * 64) * DM; _Pragma("unroll") for (int p_ = 0; p_ < 4; ++p_) { const int id_ = tid + 512 * p_; rg[p_] = *(const v4u*)(src_ + (size_t)(id_ >> 5) * DM + (id_ & 31) * 8); } } while (0)
#define CA_WRITE(i) do { _Pragma("unroll") for (int p_ = 0; p_ < 4; ++p_) { const int id_ = tid + 512 * p_; if ((i) < 4) *(LAS v4u*)(Kl + ((i) & 1) * CA_KT + (id_ >> 5) * CA_KRS + (id_ & 31) * 8) = rg[p_]; else *(LAS v4u*)(Vl + ((i) & 1) * CA_VT + (id_ >> 5) * CA_VRS + (id_ & 31) * 8) = rg[p_]; } } while (0)
    CA_LOAD(0); CA_WRITE(0); __syncthreads();
    f32x16 s[8];
#pragma unroll
    for (int j = 0; j < 8; ++j)
#pragma unroll
        for (int r = 0; r < 16; ++r) s[j][r] = 0.f;
#pragma unroll
    for (int kt = 0; kt < 4; ++kt) {
        if (kt < 3) CA_LOAD(kt + 1);
        const LAS bf16* Kc = Kl + (kt & 1) * CA_KT + r32 * CA_KRS + 8 * hi;
#pragma unroll
        for (int sub = 0; sub < 2; ++sub)
#pragma unroll
            for (int ks = 0; ks < 16; ++ks) { const bf16x8s kf = *(const LAS bf16x8s*)(Kc + sub * 32 * CA_KRS + 16 * ks); s[2 * kt + sub] = mfma32(kf, qf[ks], s[2 * kt + sub]); }
        if (kt < 3) { CA_WRITE(kt + 1); } __syncthreads();
    }
    float mx = s[0][0];
#pragma unroll
    for (int j = 0; j < 8; ++j)
#pragma unroll
        for (int r = 0; r < 16; ++r) mx = fmaxf(mx, s[j][r]);
    mx = fmaxf(mx, __shfl_xor(mx, 32));
    float l = 0.f;
#pragma unroll
    for (int j = 0; j < 8; ++j)
#pragma unroll
        for (int r = 0; r < 16; ++r) { s[j][r] = __builtin_amdgcn_exp2f(s[j][r] - mx); l += s[j][r]; }
    l += __shfl_xor(l, 32);
    if (hi == 0) wsf[r32] = l;
    bf16x8s pa[8][2];
#pragma unroll
    for (int j = 0; j < 8; ++j)
#pragma unroll
        for (int s2 = 0; s2 < 2; ++s2) { const v4u ww = {pk_bf16(s[j][8 * s2], s[j][8 * s2 + 1]), pk_bf16(s[j][8 * s2 + 2], s[j][8 * s2 + 3]), pk_bf16(s[j][8 * s2 + 4], s[j][8 * s2 + 5]), pk_bf16(s[j][8 * s2 + 6], s[j][8 * s2 + 7])}; pa[j][s2] = __builtin_bit_cast(bf16x8s, ww); }
    CA_LOAD(4); CA_WRITE(4); __syncthreads();
    f32x16 o[8];
#pragma unroll
    for (int j = 0; j < 8; ++j)
#pragma unroll
        for (int r = 0; r < 16; ++r) o[j][r] = 0.f;
#pragma unroll
    for (int kt = 0; kt < 4; ++kt) {
        if (kt >= 1 && kt < 3) CA_LOAD(kt + 5);
        const LAS bf16* Vc = Vl + (kt & 1) * CA_VT + (4 * hi + (i16 >> 2)) * CA_VRS + 16 * (gi & 1) + (i16 & 3) * 4;
#pragma unroll
        for (int sub = 0; sub < 2; ++sub)
#pragma unroll
            for (int s2 = 0; s2 < 2; ++s2)
#pragma unroll
                for (int dt = 0; dt < 8; ++dt) { const LAS bf16* vb = Vc + (32 * sub + 16 * s2) * CA_VRS + 32 * dt; const bf16x8s vf = cat8(tr4(vb), tr4(vb + 8 * CA_VRS)); o[dt] = mfma32(pa[2 * kt + sub][s2], vf, o[dt]); }
        if (kt == 0) CA_LOAD(5);
        if (kt < 3) { CA_WRITE(kt + 5); }
        __syncthreads();
    }
#undef CA_LOAD
#undef CA_WRITE
    float rl[16];
#pragma unroll
    for (int r = 0; r < 16; ++r) rl[r] = 1.f / wsf[sb_crow(r, hi)];
    bf16* orow = OCA + qrow * DM + hh * CAD + r32;
#pragma unroll
    for (int r = 0; r < 16; ++r) { const int q = sb_crow(r, hi);
#pragma unroll
        for (int dt = 0; dt < 8; ++dt) orow[(size_t)q * DM + 32 * dt] = f2bf(o[dt][r] * rl[r]); }
}
__device__ __forceinline__ void cas_item(const Ctx& C, int n, int hh) {
    const bf16* QCA = (const bf16*)(C.ws + WS_QCA); const float* cmk = (const float*)C.in[I_MK]; const float* cmv = (const float*)C.in[I_MV]; bf16* OCA = (bf16*)(C.ws + WS_OMIX);
    const int tid = C.tid, lane = C.lane, r32 = lane & 31, hi = lane >> 5, w = C.wave, gi = lane >> 4, i16 = lane & 15;
    LAS bf16* Vt = (LAS bf16*)(C.lds + RING_OFF) + w * (32 * CA_VRS);
    LAS float* part = (LAS float*)(C.lds + RING_OFF);
    LAS float* red = (LAS float*)(C.lds + RING_OFF + 8 * 32 * CA_VRS * 2);
    bf16x8s qf[16];
#pragma unroll
    for (int ks = 0; ks < 16; ++ks) { qf[ks] = (bf16x8s){0, 0, 0, 0, 0, 0, 0, 0}; if (r32 < TDEC) qf[ks] = *(const bf16x8s*)(QCA + (size_t)(MP + n * TDEC + r32) * DM + hh * CAD + 16 * ks + 8 * hi); }
    f32x16 s;
#pragma unroll
    for (int r = 0; r < 16; ++r) s[r] = 0.f;
    const float* kr = cmk + ((size_t)(n * NMEM + 32 * w + r32) * CAH + hh) * CAD + 8 * hi;
#pragma unroll
    for (int kb = 0; kb < 2; ++kb) {
        f32x4 ra[8], rb[8];
#pragma unroll
        for (int k8 = 0; k8 < 8; ++k8) { ra[k8] = *(const f32x4*)(kr + 16 * (8 * kb + k8)); rb[k8] = *(const f32x4*)(kr + 16 * (8 * kb + k8) + 4); }
#pragma unroll
        for (int k8 = 0; k8 < 8; ++k8) { const v4u ww = {pk_bf16(ra[k8].x, ra[k8].y), pk_bf16(ra[k8].z, ra[k8].w), pk_bf16(rb[k8].x, rb[k8].y), pk_bf16(rb[k8].z, rb[k8].w)};
            s = mfma32(__builtin_bit_cast(bf16x8s, ww), qf[8 * kb + k8], s); }
    }
    const float* vr = cmv + ((size_t)(n * NMEM + 32 * w) * CAH + hh) * CAD + lane * 4;
#pragma unroll
    for (int vb = 0; vb < 2; ++vb) {
        f32x4 rvv[16];
#pragma unroll
        for (int j = 0; j < 16; ++j) rvv[j] = *(const f32x4*)(vr + (size_t)(16 * vb + j) * CAH * CAD);
#pragma unroll
        for (int j = 0; j < 16; ++j) { const v2u ww = {pk_bf16(rvv[j].x, rvv[j].y), pk_bf16(rvv[j].z, rvv[j].w)}; *(LAS v2u*)(Vt + (16 * vb + j) * CA_VRS + lane * 4) = ww; }
    }
    float mx = s[0];
#pragma unroll
    for (int r = 1; r < 16; ++r) mx = fmaxf(mx, s[r]);
    mx = fmaxf(mx, __shfl_xor(mx, 32));
    if (lane < TDEC) red[w * TDEC + lane] = mx;
    LDS_WAIT(); __syncthreads();
    { float m2 = red[(r32 & 7)];
#pragma unroll
      for (int ww = 1; ww < 8; ++ww) m2 = fmaxf(m2, red[ww * TDEC + (r32 & 7)]);
      mx = m2; }
    float l = 0.f;
#pragma unroll
    for (int r = 0; r < 16; ++r) { s[r] = __builtin_amdgcn_exp2f(s[r] - mx); l += s[r]; }
    l += __shfl_xor(l, 32);
    if (lane < TDEC) red[64 + w * TDEC + lane] = l;
    bf16x8s pa[2];
#pragma unroll
    for (int s2 = 0; s2 < 2; ++s2) { const v4u ww = {pk_bf16(s[8 * s2], s[8 * s2 + 1]), pk_bf16(s[8 * s2 + 2], s[8 * s2 + 3]), pk_bf16(s[8 * s2 + 4], s[8 * s2 + 5]), pk_bf16(s[8 * s2 + 6], s[8 * s2 + 7])}; pa[s2] = __builtin_bit_cast(bf16x8s, ww); }
    LDS_WAIT();
    f32x16 o[8];
#pragma unroll
    for (int j = 0; j < 8; ++j)
#pragma unroll
        for (int r = 0; r < 16; ++r) o[j][r] = 0.f;
    const LAS bf16* Vc = Vt + (4 * hi + (i16 >> 2)) * CA_VRS + 16 * (gi & 1) + (i16 & 3) * 4;
#pragma unroll
    for (int s2 = 0; s2 < 2; ++s2)
#pragma unroll
        for (int dt = 0; dt < 8; ++dt) { const LAS bf16* vb = Vc + 16 * s2 * CA_VRS + 32 * dt; const bf16x8s vf = cat8(tr4(vb), tr4(vb + 8 * CA_VRS)); o[dt] = mfma32(pa[s2], vf, o[dt]); }
    LDS_WAIT(); __syncthreads();
#pragma unroll
    for (int r = 0; r < 4; ++r)
#pragma unroll
        for (int dt = 0; dt < 8; ++dt) part[(w * TDEC + r + 4 * hi) * CAD + 32 * dt + r32] = o[dt][r];
    LDS_WAIT(); __syncthreads();
    { const int q = tid >> 6, d0 = (tid & 63) * 4;
      float lt = 0.f;
#pragma unroll
      for (int ww = 0; ww < 8; ++ww) lt += red[64 + ww * TDEC + q];
      f32x4 a = {0.f, 0.f, 0.f, 0.f};
#pragma unroll
      for (int ww = 0; ww < 8; ++ww) a += *(const LAS f32x4*)(part + (ww * TDEC + q) * CAD + d0);
      const float il = 1.f / lt; const v2u ow = {pk_bf16(a.x * il, a.y * il), pk_bf16(a.z * il, a.w * il)};
      *(v2u*)(OCA + (size_t)(MP + n * TDEC + q) * DM + hh * CAD + d0) = ow; }
    LDS_WAIT(); __syncthreads();
}
__device__ __forceinline__ void ca_phase(const Ctx& C) {
    for (int it = blockIdx.x; it < NDEC * CAH; it += gridDim.x) cas_item(C, it >> 2, it & 3);
    const int G = gridDim.x, bid = blockIdx.x; const int vcu = (G % 8 == 0) ? (bid % 8) * (G / 8) + bid / 8 : bid;
    for (int u = vcu; u < NBATCH * CAH * 32; u += G) ca_unit(C, u >> 7, (u >> 5) & 3, u & 31);
}
__device__ __forceinline__ void hgrn_chain(const Ctx& C, int rowbase, int T, int h, const float* S0, float* Sout) {
    const float* LF = (const float*)(C.ws + WS_LF); const bf16* QH = (const bf16*)(C.ws + WS_QH); const bf16* VH = (const bf16*)(C.ws + WS_VH); const bf16* GH = (const bf16*)(C.ws + WS_GH);
    bf16* OMIX = (bf16*)(C.ws + WS_OMIX); const float* hgn = (const float*)C.in[I_HGN];
    const int lane = C.lane; const float gn = hgn[h * HD + lane];
    float S[64];
#pragma unroll
    for (int k = 0; k < 64; ++k) S[k] = S0 ? S0[k * 64 + lane] : 0.f;
    for (int t = 0; t < T; ++t) {
        const size_t off = (size_t)(rowbase + t) * HW + h * HD + lane;
        const float fk = __expf(LF[off]), kk = 1.f - fk, qk = bf2f(QH[off]), vd = bf2f(VH[off]), g = bf2f(GH[off]);
        float o = 0.f;
#pragma unroll
        for (int k = 0; k < 64; ++k) { const float f_ = rdlane(fk, k), k_ = rdlane(kk, k), q_ = rdlane(qk, k); S[k] = f_ * S[k] + k_ * vd; o += S[k] * q_; }
        const float r = rsqrtf(wave_sum(o * o) * (1.f / HD) + RMS_EPS);
        OMIX[(size_t)(rowbase + t) * DM + h * HD + lane] = f2bf(o * r * gn * (g / (1.f + __expf(-g))));
    }
#pragma unroll
    for (int k = 0; k < 64; ++k) Sout[k * 64 + lane] = S[k];
}
template <bool SAMPLE>
__device__ __forceinline__ void sb_query(const Ctx& C, int row, int h, int nkeys, int seq  ) {
    const bf16* SQ = (const bf16*)(C.ws + WS_SQ); const bf16* SK = (const bf16*)(C.ws + WS_SK); const bf16* SV = (const bf16*)(C.ws + WS_SV);
    const float* ck = (const float*)C.in[I_CK]; const float* cv = (const float*)C.in[I_CV]; const int* pt = (const int*)C.in[I_PT];
    bf16* OMIX = (bf16*)(C.ws + WS_OMIX);
    const int lane = C.lane; const float bias2 = ((const float*)C.in[I_SBB])[h] * LOG2E;
    float q[64];
    { const v4u* qp = (const v4u*)(SQ + (size_t)row * HW + h * HD);
#pragma unroll
      for (int c = 0; c < 8; ++c) { const v4u w = qp[c]; q[8 * c] = bflo(w.x); q[8 * c + 1] = bfhi(w.x); q[8 * c + 2] = bflo(w.y); q[8 * c + 3] = bfhi(w.y); q[8 * c + 4] = bflo(w.z); q[8 * c + 5] = bfhi(w.z); q[8 * c + 6] = bflo(w.w); q[8 * c + 7] = bfhi(w.w); } }
    float Cc = 1.f, o = 0.f;
    for (int base = nkeys > 0 ? ((nkeys - 1) & ~63) : -1; base >= 0; base -= 64) {
        const int j = base + lane; const bool valid = j < nkeys; const int jc = valid ? j : nkeys - 1;
        float z = 0.f;
        if (SAMPLE && jc < PAST) {
            const float* kr = ck + (((size_t)pt[seq * NPAGES + (jc >> 7)] * PAGE + (jc & 127)) * NH + h) * HD;
#pragma unroll
            for (int c = 0; c < 16; ++c) { const f32x4 w = ((const f32x4*)kr)[c]; z += q[4 * c] * w.x + q[4 * c + 1] * w.y + q[4 * c + 2] * w.z + q[4 * c + 3] * w.w; }
        } else {
            const size_t krow = SAMPLE ? (size_t)(MP + seq * TDEC + (jc - PAST)) : (size_t)seq * SEQ + jc;
            const v4u* kr = (const v4u*)(SK + krow * HW + h * HD);
#pragma unroll
            for (int c = 0; c < 8; ++c) { const v4u w = kr[c]; z += q[8 * c] * bflo(w.x) + q[8 * c + 1] * bfhi(w.x) + q[8 * c + 2] * bflo(w.y) + q[8 * c + 3] * bfhi(w.y) + q[8 * c + 4] * bflo(w.z) + q[8 * c + 5] * bfhi(w.z) + q[8 * c + 6] * bflo(w.w) + q[8 * c + 7] * bfhi(w.w); }
        }
        const float u = valid ? exp2f(z + bias2) : 0.f;
        float incl = 1.f / (1.f + u);
#pragma unroll
        for (int off = 1; off < 64; off <<= 1) { const float y = __shfl_down(incl, off); if (lane + off < 64) incl *= y; }
        const float a = u * incl * Cc;
        Cc *= __shfl(incl, 0);
        const int nk = nkeys - base < 64 ? nkeys - base : 64;
        for (int jj = 0; jj < nk; ++jj) {
            const float aj = __shfl(a, jj); const int jk = base + jj; float vv;
            if (SAMPLE && jk < PAST) vv = cv[(((size_t)pt[seq * NPAGES + (jk >> 7)] * PAGE + (jk & 127)) * NH + h) * HD + lane];
            else { const size_t vrow = SAMPLE ? (size_t)(MP + seq * TDEC + (jk - PAST)) : (size_t)seq * SEQ + jk; vv = bf2f(SV[vrow * HW + h * HD + lane]); }
            o += aj * vv;
        }
    }
    OMIX[(size_t)row * DM + HW + h * HD + lane] = f2bf(o);
}
__device__ __forceinline__ void p2_mix1(const Ctx& C) {
    for (int cid = C.gw; cid < NBATCH * NH * (SEQ / 64); cid += C.ngw) hgrn_h1(C, cid);
    const int w = C.gw, nw = C.ngw;
    for (int i = w; i < NDEC * NH; i += nw) { const int n = i / NH, h = i % NH; hgrn_chain(C, MP + n * TDEC, TDEC, h, (const float*)C.in[I_SH] + (size_t)i * 4096, C.out + O_HS + (size_t)i * 4096); }
    volatile LAS unsigned* gcnt = (volatile LAS unsigned*)(C.lds + MISC_OFF) + 16;
    if (C.tid == 0) *gcnt = 0u;
    LDS_WAIT(); __syncthreads();
    if (C.wave < 4) { sb_prompt_role(C, gcnt, 0u); if constexpr (PROBE_PH == 120) sb_prompt_role(C, gcnt, 1u); } else { sbs_role(C); if constexpr (PROBE_PH == 121) sbs_role(C); }
    __syncthreads();
}
__device__ __forceinline__ void p4_mix3(const Ctx& C) {
    for (int cid = C.gw; cid < NBATCH * NH * (SEQ / 64); cid += C.ngw) hgrn_h3(C, cid);
}

__device__ __forceinline__ void thin_row(const float* xin, const bf16* br, const float* gpost, float* xout, const float* gpre, bf16* hrow, int lane) {
    const f32x4* xr = (const f32x4*)xin + lane; const v2u* bp = (const v2u*)br + lane; const f32x4* gp = (const f32x4*)gpost + lane;
    f32x4 b[4]; float s = 0.f;
#pragma unroll
    for (int j = 0; j < 4; ++j) { const v2u w = bp[64 * j]; b[j] = (f32x4){bflo(w.x), bfhi(w.x), bflo(w.y), bfhi(w.y)}; s += (b[j].x * b[j].x + b[j].y * b[j].y) + (b[j].z * b[j].z + b[j].w * b[j].w); }
    const float r = rsqrtf(wave_sum(s) * (1.f / DM) + RMS_EPS);
    float s2 = 0.f;
#pragma unroll
    for (int j = 0; j < 4; ++j) { b[j] = xr[64 * j] + b[j] * r * gp[64 * j]; s2 += (b[j].x * b[j].x + b[j].y * b[j].y) + (b[j].z * b[j].z + b[j].w * b[j].w); }
    f32x4* xo = (f32x4*)xout + lane;
#pragma unroll
    for (int j = 0; j < 4; ++j) xo[64 * j] = b[j];
    if (hrow) {
        const float r2 = rsqrtf(wave_sum(s2) * (1.f / DM) + RMS_EPS); const f32x4* g2 = (const f32x4*)gpre + lane; v2u* o8 = (v2u*)hrow + lane;
#pragma unroll
        for (int j = 0; j < 4; ++j) { const f32x4 gg = g2[64 * j]; v2u w; w.x = pk_bf16(b[j].x * r2 * gg.x, b[j].y * r2 * gg.y); w.y = pk_bf16(b[j].z * r2 * gg.z, b[j].w * r2 * gg.w); o8[64 * j] = w; }
    }
}
template <int WHICH>
__device__ __forceinline__ void p_thin(const Ctx& C) {
    const bf16* BR = (const bf16*)(C.ws + WS_BR); bf16* H = (bf16*)(C.ws + WS_H);
    float* X1 = (float*)(C.ws + WS_X1); float* X2 = (float*)(C.ws + WS_X2);
    const float* gpost = (const float*)C.in[WHICH == 0 ? I_GMIXPOST : WHICH == 1 ? I_GCAPOST : I_GFFNPOST];
    const float* gpre = (const float*)C.in[WHICH == 0 ? I_GCAPRE : I_GFFNPRE];
    for (int m = C.gw; m < MT; m += C.ngw) {
        const float* xin; float* xout;
        if (WHICH == 0) { xin = m < MP ? (const float*)C.in[I_XP] + (size_t)m * DM : (const float*)C.in[I_XS] + (size_t)(m - MP) * DM; xout = X1 + (size_t)m * DM; }
        else if (WHICH == 1) { xin = X1 + (size_t)m * DM; xout = X2 + (size_t)m * DM; }
        else { xin = X2 + (size_t)m * DM; xout = m < MP ? C.out + O_YP + (size_t)m * DM : C.out + O_YS + (size_t)(m - MP) * DM; }
        thin_row(xin, BR + (size_t)m * DM, gpost, xout, gpre, WHICH == 2 ? nullptr : H + (size_t)m * DM, C.lane);
    }
}

__device__ __forceinline__ void p6_naive(const Ctx& C) {
    const bf16* QCA = (const bf16*)(C.ws + WS_QCA); const bf16* MK = (const bf16*)(C.ws + WS_MK); const bf16* MV = (const bf16*)(C.ws + WS_MV);
    const float* cmk = (const float*)C.in[I_MK]; const float* cmv = (const float*)C.in[I_MV]; bf16* OCA = (bf16*)(C.ws + WS_OMIX);
    const int lane = C.lane;
    for (int it = C.gw; it < MT * CAH; it += C.ngw) {
        const int row = it >> 2, h = it & 3;
        const v2u qw = *((const v2u*)(QCA + (size_t)row * DM + h * CAD) + lane);
        const float q0 = bflo(qw.x), q1 = bfhi(qw.x), q2 = bflo(qw.y), q3 = bfhi(qw.y);
        float mx = -1e30f, l = 0.f, o0 = 0.f, o1 = 0.f, o2 = 0.f, o3 = 0.f;
        for (int m = 0; m < NMEM; ++m) {
            float k0, k1, k2, k3, v0, v1, v2, v3;
            if (row < MP) { const size_t off = ((size_t)((row >> 13) * NMEM + m)) * DM + h * CAD; const v2u kw = *((const v2u*)(MK + off) + lane), vw = *((const v2u*)(MV + off) + lane);
                k0 = bflo(kw.x); k1 = bfhi(kw.x); k2 = bflo(kw.y); k3 = bfhi(kw.y); v0 = bflo(vw.x); v1 = bfhi(vw.x); v2 = bflo(vw.y); v3 = bfhi(vw.y); }
            else { const size_t off = ((size_t)(((row - MP) >> 3) * NMEM + m)) * DM + h * CAD; const f32x4 kw = *((const f32x4*)(cmk + off) + lane), vw = *((const f32x4*)(cmv + off) + lane);
                k0 = kw.x; k1 = kw.y; k2 = kw.z; k3 = kw.w; v0 = vw.x; v1 = vw.y; v2 = vw.z; v3 = vw.w; }
            const float s = wave_sum(q0 * k0 + q1 * k1 + q2 * k2 + q3 * k3);
            const float mn = fmaxf(mx, s), sc = exp2f(mx - mn), p = exp2f(s - mn);
            l = l * sc + p; o0 = o0 * sc + p * v0; o1 = o1 * sc + p * v1; o2 = o2 * sc + p * v2; o3 = o3 * sc + p * v3; mx = mn;
        }
        const float il = 1.f / l; v2u w; w.x = pk_bf16(o0 * il, o1 * il); w.y = pk_bf16(o2 * il, o3 * il);
        *((v2u*)(OCA + (size_t)row * DM + h * CAD) + lane) = w;
    }
}

__device__ __forceinline__ float gelu_tanh(float x) { return x / (1.f + __expf(-1.5957691216057308f * (x + 0.044715f * x * x * x))); }
__device__ __forceinline__ void ld8(const bf16* p, float (&v)[8]) { const v4u w = *(const v4u*)p; v[0] = bflo(w.x); v[1] = bfhi(w.x); v[2] = bflo(w.y); v[3] = bfhi(w.y); v[4] = bflo(w.z); v[5] = bfhi(w.z); v[6] = bflo(w.w); v[7] = bfhi(w.w); }
__device__ __forceinline__ void ld8f(const float* p, float (&v)[8]) { const f32x4 a = *(const f32x4*)p, b = *(const f32x4*)(p + 4); v[0] = a.x; v[1] = a.y; v[2] = a.z; v[3] = a.w; v[4] = b.x; v[5] = b.y; v[6] = b.z; v[7] = b.w; }
__device__ __forceinline__ void p10_convgate(const Ctx& C) {
    const bf16* U = (const bf16*)(C.ws + WS_U); bf16* G = (bf16*)(C.ws + WS_G); const float* FIX = (const float*)(C.ws + WS_FIX); const float* UL = (const float*)(C.ws + WS_ULAST);
    const float* cw = (const float*)C.in[I_CONVW]; const float* cb = (const float*)C.in[I_CONVB]; const float* sc = (const float*)C.in[I_SC];
    constexpr int NCH = DFF / 8, NSI = NDEC * NCH, NFX = (MP / 256) * 2 * NCH;
    const int gt = C.gw * 64 + C.lane, ngt = C.ngw * 64;
    for (int it = gt; it < NSI + NFX; it += ngt) {
        if (it < NSI) {
            const int n = it / NCH, c = (it % NCH) * 8, row0 = MP + n * TDEC, cp = 256 * (c >> 7) + (c & 127);
            float m1[2][8], m2[2][8], w0[2][8], w1[2][8], w2[2][8], bb[2][8];
#pragma unroll
            for (int hf = 0; hf < 2; ++hf) { ld8f(sc + ((size_t)n * 2 + 1) * DFF2 + c + hf * DFF, m1[hf]); ld8f(sc + ((size_t)n * 2) * DFF2 + c + hf * DFF, m2[hf]);
                ld8f(cw + c + hf * DFF, w0[hf]); ld8f(cw + DFF2 + c + hf * DFF, w1[hf]); ld8f(cw + 2 * DFF2 + c + hf * DFF, w2[hf]); ld8f(cb + c + hf * DFF, bb[hf]); }
#pragma unroll
            for (int r = 0; r < TDEC; ++r) {
                float u[2][8], res[2][8];
                ld8(U + (size_t)(row0 + r) * DFF2 + cp, u[0]); ld8(U + (size_t)(row0 + r) * DFF2 + cp + 128, u[1]);
#pragma unroll
                for (int hf = 0; hf < 2; ++hf)
#pragma unroll
                    for (int e = 0; e < 8; ++e) { res[hf][e] = bb[hf][e] + w0[hf][e] * m2[hf][e] + w1[hf][e] * m1[hf][e] + w2[hf][e] * u[hf][e]; m2[hf][e] = m1[hf][e]; m1[hf][e] = u[hf][e]; }
                v4u o;
                o.x = pk_bf16(gelu_tanh(res[0][0]) * res[1][0], gelu_tanh(res[0][1]) * res[1][1]); o.y = pk_bf16(gelu_tanh(res[0][2]) * res[1][2], gelu_tanh(res[0][3]) * res[1][3]);
                o.z = pk_bf16(gelu_tanh(res[0][4]) * res[1][4], gelu_tanh(res[0][5]) * res[1][5]); o.w = pk_bf16(gelu_tanh(res[0][6]) * res[1][6], gelu_tanh(res[0][7]) * res[1][7]);
                *(v4u*)(G + (size_t)(row0 + r) * DFF + c) = o;
            }
        } else {
            const int j = it - NSI, pr = j / NCH, c = (j % NCH) * 8, pm = pr >> 1, rr = pr & 1;
            float res[2][8];
#pragma unroll
            for (int hf = 0; hf < 2; ++hf) {
                ld8f(FIX + (size_t)pr * DFF2 + c + hf * DFF, res[hf]);
                if (pm & 31) {
                    float a1[8], w0[8]; ld8f(UL + (size_t)((pm - 1) * 2 + 1) * DFF2 + c + hf * DFF, a1); ld8f(cw + c + hf * DFF, w0);
                    if (rr == 0) { float a2[8], w1[8]; ld8f(UL + (size_t)((pm - 1) * 2) * DFF2 + c + hf * DFF, a2); ld8f(cw + DFF2 + c + hf * DFF, w1);
#pragma unroll
                        for (int e = 0; e < 8; ++e) res[hf][e] += w0[e] * a2[e] + w1[e] * a1[e];
                    } else {
#pragma unroll
                        for (int e = 0; e < 8; ++e) res[hf][e] += w0[e] * a1[e];
                    }
                }
            }
            v4u o;
            o.x = pk_bf16(gelu_tanh(res[0][0]) * res[1][0], gelu_tanh(res[0][1]) * res[1][1]); o.y = pk_bf16(gelu_tanh(res[0][2]) * res[1][2], gelu_tanh(res[0][3]) * res[1][3]);
            o.z = pk_bf16(gelu_tanh(res[0][4]) * res[1][4], gelu_tanh(res[0][5]) * res[1][5]); o.w = pk_bf16(gelu_tanh(res[0][6]) * res[1][6], gelu_tanh(res[0][7]) * res[1][7]);
            *(v4u*)(G + (size_t)(pm * 256 + rr) * DFF + c) = o;
        }
    }
}
enum { PH_PRO = 0, PH_INPROJ, PH_MIX1, PH_SCAN, PH_MIX3, PH_OPROJ, PH_THIN0, PH_CQ, PH_CA, PH_CO, PH_THIN1, PH_UP, PH_CONV, PH_DOWN, PH_THIN2, NPH };
#ifndef MK_ONE_LAUNCH
#define MK_ONE_LAUNCH 1
#endif
__global__ void __launch_bounds__(NTHREADS, 2) fwd(Args args) {
    extern __shared__ __attribute__((aligned(16))) unsigned char lds_raw[];
    Ctx C;
    C.in = args.in; C.out = args.out; C.ws = args.ws; C.lds = (LAS unsigned char*)lds_raw;
    C.tid = threadIdx.x; C.lane = C.tid & 63; C.wave = __builtin_amdgcn_readfirstlane(C.tid >> 6);
    C.gw = blockIdx.x * NWAVES + C.wave; C.ngw = gridDim.x * NWAVES;
    const int G = gridDim.x, bid = blockIdx.x;
    volatile LAS unsigned* MISC = (volatile LAS unsigned*)(C.lds + MISC_OFF);
    for (int u = C.tid; u < (LDS_BYTES - LDSCTL_OFF) / 4; u += NTHREADS) ((LAS unsigned*)(C.lds + LDSCTL_OFF))[u] = 0u;
    __syncthreads();
    const int lo = args.ph_lo, hi = args.ph_hi;
    XcdBarrier bar; bar.bar = (unsigned*)(C.ws + WS_CTL) + CW_BAR; bar.x = 0; bar.st = nullptr;
    bar = xcd_barrier_post((unsigned*)(C.ws + WS_CTL) + CW_BAR, MISC + 8);
#define IN(k) (lo <= (k) && (k) < hi)
#define SEAM(k) do { if (IN(k) && IN((k) + 1)) xcd_barrier(bar); } while (0)
#define PHASE(k, ...) do { if (IN(k)) { __VA_ARGS__ if constexpr (PROBE_PH == (k)) { __VA_ARGS__ } } } while (0)
    bf16* H = (bf16*)(C.ws + WS_H);
    PHASE(PH_PRO, p0_prologue(C);); SEAM(PH_PRO);
    PHASE(PH_INPROJ, { pg8::Gemm g{H, (const bf16*)(C.ws + WS_WIN), MT, DIN, DM}; pg8::StaticOrder S; S.init(MT, DIN, G, bid);
          pg8::EpiInProj E{(bf16*)(C.ws + WS_QH), (bf16*)(C.ws + WS_VH), (bf16*)(C.ws + WS_GH), (bf16*)(C.ws + WS_SQ), (bf16*)(C.ws + WS_SK), (bf16*)(C.ws + WS_SV), (float*)(C.ws + WS_LF),
                           (const float*)(C.ws + WS_LB), C.out + O_KP, C.out + O_VP, C.out + O_KS, C.out + O_VS, SQ_SCALE};
          pg8::gemm_phase<pg8::EpiInProj, pg8::StaticOrder, true, true>(C.lds + RING_OFF, g, S, E); }
        { pg8::Gemm g{(const bf16*)(C.ws + WS_MN), (const bf16*)(C.ws + WS_WCKV), NBATCH * NMEM, 2 * DM, DM}; pg8::StaticOrder S; S.init(NBATCH * NMEM, 2 * DM, G, (bid + G - 184 % G) % G);
          pg8::EpiMemKV E{(bf16*)(C.ws + WS_MK), (bf16*)(C.ws + WS_MV), C.out + O_MKP, C.out + O_MVP};
          pg8::gemm_phase<pg8::EpiMemKV, pg8::StaticOrder, true, true>(C.lds + RING_OFF, g, S, E); }); SEAM(PH_INPROJ);
    PHASE(PH_MIX1, p2_mix1(C);); SEAM(PH_MIX1);
    PHASE(PH_SCAN, hgrn_h2(C); sbs_combine(C);); SEAM(PH_SCAN);
    PHASE(PH_MIX3, p4_mix3(C);); SEAM(PH_MIX3);
    PHASE(PH_OPROJ, pg8::Gemm g{(const bf16*)(C.ws + WS_OMIX), (const bf16*)(C.ws + WS_WO), MT, DM, DM}; pg8::StaticOrder S; S.init(MT, DM, G, bid);
        pg8::EpiStore<false> E{(bf16*)(C.ws + WS_BR), DM, 1.f, nullptr};
        pg8::gemm_phase<pg8::EpiStore<false>, pg8::StaticOrder, true, true>(C.lds + RING_OFF, g, S, E);); SEAM(PH_OPROJ);
    PHASE(PH_THIN0, p_thin<0>(C);); SEAM(PH_THIN0);
    PHASE(PH_CQ, pg8::Gemm g{H, (const bf16*)(C.ws + WS_WCQ), MT, DM, DM}; pg8::StaticOrder S; S.init(MT, DM, G, bid);
        pg8::EpiStore<false> E{(bf16*)(C.ws + WS_QCA), DM, CQ_SCALE, nullptr};
        pg8::gemm_phase<pg8::EpiStore<false>, pg8::StaticOrder, true, true>(C.lds + RING_OFF, g, S, E);); SEAM(PH_CQ);
    PHASE(PH_CA, ca_phase(C);); SEAM(PH_CA);
    PHASE(PH_CO, pg8::Gemm g{(const bf16*)(C.ws + WS_OMIX), (const bf16*)(C.ws + WS_WCO), MT, DM, DM}; pg8::StaticOrder S; S.init(MT, DM, G, bid);
        pg8::EpiStore<false> E{(bf16*)(C.ws + WS_BR), DM, 1.f, nullptr};
        pg8::gemm_phase<pg8::EpiStore<false>, pg8::StaticOrder, true, true>(C.lds + RING_OFF, g, S, E);); SEAM(PH_CO);
    PHASE(PH_THIN1, p_thin<1>(C);); SEAM(PH_THIN1);
    PHASE(PH_UP, pg8::Gemm g{H, (const bf16*)(C.ws + WS_WUP), MT, DFF2, DM}; pg8::StaticOrder S; S.init(MT, DFF2, G, bid);
        pg8::EpiUpConv E{(bf16*)(C.ws + WS_G), (bf16*)(C.ws + WS_U), C.out, (float*)(C.ws + WS_FIX), (float*)(C.ws + WS_ULAST), (const float*)C.in[I_CONVW], (const float*)C.in[I_CONVB], (LAS float*)(C.lds + XB_OFF)};
        pg8::gemm_phase<pg8::EpiUpConv, pg8::StaticOrder, true, true>(C.lds + RING_OFF, g, S, E);); SEAM(PH_UP);
    PHASE(PH_CONV, p10_convgate(C);); SEAM(PH_CONV);
    PHASE(PH_DOWN, pg8::Gemm g{(const bf16*)(C.ws + WS_G), (const bf16*)(C.ws + WS_WDN), MT, DM, DFF}; pg8::StaticOrder S; S.init(MT, DM, G, bid);
        pg8::EpiStore<false> E{(bf16*)(C.ws + WS_BR), DM, 1.f, nullptr};
        pg8::gemm_phase<pg8::EpiStore<false>, pg8::StaticOrder, true, true>(C.lds + RING_OFF, g, S, E);); SEAM(PH_DOWN);
    PHASE(PH_THIN2, p_thin<2>(C););
#undef IN
#undef PHASE
#undef SEAM
}

extern "C" void kernel_launch(void* const* d_in, const int* in_sizes, int n_in, void* d_out, int out_size, void* d_ws, size_t ws_size, hipStream_t stream) {
    static int grid = 0;
    if (grid == 0) {
        if (n_in != N_IN || (size_t)out_size != O_END || ws_size < WS_END) { fprintf(stderr, "kernel_launch: unexpected problem: n_in %d out %d ws %zu\n", n_in, out_size, ws_size); grid = -1; return; }
        int dev = 0, cus = 0, per_cu = 0;
        if (hipGetDevice(&dev) != hipSuccess || hipDeviceGetAttribute(&cus, hipDeviceAttributeMultiprocessorCount, dev) != hipSuccess) { grid = -1; return; }
        if (hipFuncSetAttribute((const void*)fwd, hipFuncAttributeMaxDynamicSharedMemorySize, LDS_BYTES) != hipSuccess) { fprintf(stderr, "kernel_launch: hipFuncSetAttribute failed\n"); grid = -1; return; }
        if (hipOccupancyMaxActiveBlocksPerMultiprocessor(&per_cu, (const void*)fwd, NTHREADS, LDS_BYTES) != hipSuccess || per_cu < 1) fprintf(stderr, "kernel_launch: occupancy query says %d\n", per_cu);
        (void)hipGetLastError();
        grid = cus;
    }
    if (grid < 0) return;
    (void)hipMemsetAsync((char*)d_ws + WS_CTL, 0, CTL_ZERO_BYTES, stream);
    Args a{};
    for (int i = 0; i < N_IN; ++i) a.in[i] = d_in[i];
    a.out = (float*)d_out; a.ws = (unsigned char*)d_ws;
    a.ph_lo = 0; a.ph_hi = NPH;
    hipLaunchKernelGGL(fwd, dim3(grid), dim3(NTHREADS), LDS_BYTES, stream, a);
}
```

```cpp
#include <hip/hip_runtime.h>
#include <cstdio>
#include <cstdint>
namespace pg8 {
#define PG8_LAS __attribute__((address_space(3)))
typedef unsigned short bf16_t;
typedef short bf16x8 __attribute__((ext_vector_type(8)));
typedef float f32x4 __attribute__((ext_vector_type(4)));
typedef unsigned u32x4 __attribute__((ext_vector_type(4)));
constexpr int BM = 256, BK = 64, HALF = 128, HTB = HALF * BK * 2  , STAGE_BYTES = 8 * HTB, NXCD = 8, WGM = 8;

__host__ __device__ __forceinline__ int lds_byte(int r, int c) { const int st = (r >> 4) * 2 + (c >> 5), rr = r & 15, cc = c & 31, ob = rr * 64 + cc * 2; return st * 1024 + (ob ^ (((ob >> 9) & 1) << 5)); }
__host__ __device__ __forceinline__ void stage_rc(int b, int& R, int& C) { const int st = b / 1024, sb = b % 1024, swz = sb ^ (((sb >> 9) & 1) << 5); R = (st >> 1) * 16 + swz / 64; C = (st & 1) * 32 + (swz % 64) / 2; }
__host__ __device__ __forceinline__ int perm32(int rho) { const int n = rho >> 4, i = rho & 15; return 8 * (i >> 2) + 4 * n + (i & 3); }

struct Unit { int pm, pn; };
struct Gemm { const bf16_t* A; const bf16_t* Bt; int M, N, K; };

struct StaticOrder {
    int nM, nN, nwg, G, c;
    __host__ __device__ void init(int M, int N, int G_, int c_) { nM = M / BM; nN = N / BM; nwg = nM * nN; G = G_; c = c_; }
    __host__ __device__ bool next(int i, Unit& u) const {
        const long L = (long)i * G + c; if (L >= nwg) return false;
        int wgid = (int)L; { const int q = nwg / NXCD, r = nwg % NXCD, xcd = wgid % NXCD, off = wgid / NXCD; wgid = (xcd < r ? xcd * (q + 1) : r * (q + 1) + (xcd - r) * q) + off; }
        const int nig = WGM * nN, gid = wgid / nig, fm = gid * WGM, gsz = (nM - fm) < WGM ? (nM - fm) : WGM;
        u.pm = fm + ((wgid % nig) % gsz); u.pn = (wgid % nig) / gsz; return true;
    }
    __device__ __forceinline__ void a_ready(const Unit&) const {}
    __device__ __forceinline__ void done(const Unit&) const {}
};

__device__ __forceinline__ unsigned cvt_pk_bf16(float lo, float hi) { unsigned r; asm volatile("v_cvt_pk_bf16_f32 %0, %1, %2" : "=v"(r) : "v"(lo), "v"(hi)); return r; }
typedef float f32x2 __attribute__((ext_vector_type(2)));
typedef __bf16 bf16x2_t __attribute__((ext_vector_type(2)));
__device__ __forceinline__ unsigned pk_bf16(float lo, float hi) { f32x2 v = {lo, hi}; bf16x2_t b = __builtin_convertvector(v, bf16x2_t); return __builtin_bit_cast(unsigned, b); }
__device__ __forceinline__ u32x4 pk8(f32x4 a, f32x4 b) { u32x4 w; w.x = pk_bf16(a[0], a[1]); w.y = pk_bf16(a[2], a[3]); w.z = pk_bf16(b[0], b[1]); w.w = pk_bf16(b[2], b[3]); return w; }

template <bool CAP> struct EpiStore {
    static constexpr bool PERM = true, AFTER_DRAIN = false;
    bf16_t* O; int ldc; float scale; float* outb;
    __device__ __forceinline__ void operator()(const f32x4 (&acc)[2][2][4][2], const Unit& u, int wr, int wc, int fr, int fq) const {
        const int row0 = u.pm * BM + wr * 64 + fr, col0 = u.pn * BM + wc * 32 + 8 * fq;
#pragma unroll
        for (int ai = 0; ai < 2; ++ai)
#pragma unroll
            for (int m = 0; m < 4; ++m) {
                const int row = row0 + ai * HALF + m * 16;
                float* cap = nullptr;
                if constexpr (CAP) {
                    if (row < 16384) { const int t = row & 8191; if (t >= 8190) cap = outb + 34668544 + (size_t)((row >> 13) * 2 + (t - 8190)) * 5632; }
                    else { const int r2 = row - 16384, t = r2 & 7; if (t >= 6) cap = outb + 40982528 + (size_t)((r2 >> 3) * 2 + (t - 6)) * 5632; }
                }
#pragma unroll
                for (int bj = 0; bj < 2; ++bj) {
                    const int col = col0 + bj * HALF;
                    const f32x4 v0 = acc[ai][bj][m][0] * scale, v1 = acc[ai][bj][m][1] * scale;
                    *(u32x4*)(O + (size_t)row * ldc + col) = pk8(v0, v1);
                    if constexpr (CAP) { if (cap) { *(f32x4*)(cap + col) = v0; *(f32x4*)(cap + col + 4) = v1; } }
                }
            }
    }
};

struct EpiInProj {
    static constexpr bool PERM = true, AFTER_DRAIN = false;
    bf16_t *QH, *VH, *GH, *SQ, *SK, *SV; float* LF; const float* LB; float* kp; float* vp; float* ks; float* vs; float sqscale;
    __device__ __forceinline__ void operator()(const f32x4 (&acc)[2][2][4][2], const Unit& u, int wr, int wc, int fr, int fq) const {
        const int seg = u.pn >> 1;
        const int row0 = u.pm * BM + wr * 64 + fr, col0 = (u.pn & 1) * BM + wc * 32 + 8 * fq;
        if (seg == 1) {
#pragma unroll
            for (int bj = 0; bj < 2; ++bj) {
                const int col = col0 + bj * HALF;
                const f32x4 l0 = *(const f32x4*)(LB + col), l1 = *(const f32x4*)(LB + col + 4);
#pragma unroll
                for (int ai = 0; ai < 2; ++ai)
#pragma unroll
                    for (int m = 0; m < 4; ++m) {
                        const int row = row0 + ai * HALF + m * 16;
                        f32x4 o0, o1;
#pragma unroll
                        for (int e = 0; e < 4; ++e) {
                            const float s0 = 1.f / (1.f + __expf(-acc[ai][bj][m][0][e])), s1 = 1.f / (1.f + __expf(-acc[ai][bj][m][1][e]));
                            o0[e] = __logf(l0[e] + (1.f - l0[e]) * s0); o1[e] = __logf(l1[e] + (1.f - l1[e]) * s1);
                        }
                        *(f32x4*)(LF + (size_t)row * 512 + col) = o0; *(f32x4*)(LF + (size_t)row * 512 + col + 4) = o1;
                    }
            }
            return;
        }
        bf16_t* dst = seg == 0 ? QH : seg == 2 ? VH : seg == 3 ? GH : seg == 4 ? SQ : seg == 5 ? SK : SV;
        const float sc = seg == 4 ? sqscale : 1.f;
        float* fp = seg == 5 ? kp : seg == 6 ? vp : nullptr;
        float* fs = seg == 5 ? ks : vs;
#pragma unroll
        for (int ai = 0; ai < 2; ++ai)
#pragma unroll
            for (int m = 0; m < 4; ++m) {
                const int row = row0 + ai * HALF + m * 16;
#pragma unroll
                for (int bj = 0; bj < 2; ++bj) {
                    const int col = col0 + bj * HALF;
                    const f32x4 v0 = acc[ai][bj][m][0], v1 = acc[ai][bj][m][1];
                    *(u32x4*)(dst + (size_t)row * 512 + col) = pk8(v0 * sc, v1 * sc);
                    if (fp) { float* f = row < 16384 ? fp + (size_t)row * 512 + col : fs + (size_t)(row - 16384) * 512 + col; *(f32x4*)f = v0; *(f32x4*)(f + 4) = v1; }
                }
            }
    }
};

struct EpiMemKV {
    static constexpr bool PERM = true, AFTER_DRAIN = false;
    bf16_t *MK, *MV; float *ok, *ov;
    __device__ __forceinline__ void operator()(const f32x4 (&acc)[2][2][4][2], const Unit& u, int wr, int wc, int fr, int fq) const {
        const int seg = u.pn >> 2;
        const int row0 = u.pm * BM + wr * 64 + fr, col0 = (u.pn & 3) * BM + wc * 32 + 8 * fq;
        bf16_t* dst = seg == 0 ? MK : MV; float* fo = seg == 0 ? ok : ov;
#pragma unroll
        for (int ai = 0; ai < 2; ++ai)
#pragma unroll
            for (int m = 0; m < 4; ++m) {
                const int row = row0 + ai * HALF + m * 16;
#pragma unroll
                for (int bj = 0; bj < 2; ++bj) {
                    const int col = col0 + bj * HALF;
                    const f32x4 v0 = acc[ai][bj][m][0], v1 = acc[ai][bj][m][1];
                    *(u32x4*)(dst + (size_t)row * 1024 + col) = pk8(v0, v1);
                    *(f32x4*)(fo + (size_t)row * 1024 + col) = v0; *(f32x4*)(fo + (size_t)row * 1024 + col + 4) = v1;
                }
            }
    }
};


__device__ __forceinline__ float dpp_ror(float x, int n) { return n == 1 ? __uint_as_float((unsigned)__builtin_amdgcn_update_dpp(0, (int)__float_as_uint(x), 0x121, 0xf, 0xf, true)) : __uint_as_float((unsigned)__builtin_amdgcn_update_dpp(0, (int)__float_as_uint(x), 0x122, 0xf, 0xf, true)); }
__device__ __forceinline__ float dpp_shr1(float old, float x) { return __uint_as_float((unsigned)__builtin_amdgcn_update_dpp((int)__float_as_uint(old), (int)__float_as_uint(x), 0x111, 0xf, 0xf, false)); }
__device__ __forceinline__ float dpp_shr2(float old, float x) { return __uint_as_float((unsigned)__builtin_amdgcn_update_dpp((int)__float_as_uint(old), (int)__float_as_uint(x), 0x112, 0xf, 0xf, false)); }
__device__ __forceinline__ float gelu_t(float x) { return x / (1.f + __expf(-1.5957691216057308f * (x + 0.044715f * x * x * x))); }
struct EpiUpConv {
    static constexpr bool PERM = true, AFTER_DRAIN = false;
    bf16_t* G; bf16_t* U; float* outb; float* FIX; float* ULAST; const float* cw; const float* cb; PG8_LAS float* XB;
    __device__ __forceinline__ void operator()(const f32x4 (&acc)[2][2][4][2], const Unit& u, int wr, int wc, int fr, int fq) const {
        const int gc0 = u.pn * 128 + wc * 32 + 8 * fq;
        if (u.pm >= 64) {
            const int row0 = u.pm * BM + wr * 64 + fr, colp = u.pn * BM + wc * 32 + 8 * fq;
#pragma unroll
            for (int ai = 0; ai < 2; ++ai)
#pragma unroll
                for (int m = 0; m < 4; ++m) {
                    const int row = row0 + ai * HALF + m * 16, r2 = row - 16384, t = r2 & 7;
                    float* cap = t >= 6 ? outb + 40982528 + (size_t)((r2 >> 3) * 2 + (t - 6)) * 5632 + gc0 : nullptr;
#pragma unroll
                    for (int bj = 0; bj < 2; ++bj) {
                        const f32x4 v0 = acc[ai][bj][m][0], v1 = acc[ai][bj][m][1];
                        *(u32x4*)(U + (size_t)row * 5632 + colp + bj * HALF) = pk8(v0, v1);
                        if (cap) { *(f32x4*)(cap + bj * 2816) = v0; *(f32x4*)(cap + bj * 2816 + 4) = v1; }
                    }
                }
            return;
        }
        if (fr >= 14) {
#pragma unroll
            for (int ai = 0; ai < 2; ++ai)
#pragma unroll
                for (int bj = 0; bj < 2; ++bj)
#pragma unroll
                    for (int n = 0; n < 2; ++n) {
                        const f32x4 v = acc[ai][bj][3][n];
                        *(PG8_LAS f32x4*)(XB + ((2 * ai + wr) * 2 + (fr - 14)) * 256 + bj * HALF + wc * 32 + 8 * fq + 4 * n) = v;
                        if (ai == 1 && wr == 1) {
                            *(f32x4*)(ULAST + (size_t)(u.pm * 2 + fr - 14) * 5632 + bj * 2816 + gc0 + 4 * n) = v;
                            if ((u.pm & 31) == 31) *(f32x4*)(outb + 34668544 + (size_t)((u.pm >> 5) * 2 + fr - 14) * 5632 + bj * 2816 + gc0 + 4 * n) = v;
                        }
                    }
        }
        asm volatile("s_waitcnt lgkmcnt(0)" ::: "memory"); __builtin_amdgcn_s_barrier(); asm volatile("" ::: "memory");
#pragma unroll
        for (int ai = 0; ai < 2; ++ai) {
            const int chunk = 2 * ai + wr;
#pragma unroll
            for (int n = 0; n < 2; ++n) {
                const int gc = gc0 + 4 * n;
                f32x4 w0[2], w1[2], w2[2], bb[2], h1[2], h2[2];
#pragma unroll
                for (int bj = 0; bj < 2; ++bj) {
                    w0[bj] = *(const f32x4*)(cw + bj * 2816 + gc); w1[bj] = *(const f32x4*)(cw + 5632 + bj * 2816 + gc); w2[bj] = *(const f32x4*)(cw + 2 * 5632 + bj * 2816 + gc); bb[bj] = *(const f32x4*)(cb + bj * 2816 + gc);
                    if (chunk > 0) { h1[bj] = *(const PG8_LAS f32x4*)(XB + ((chunk - 1) * 2 + 1) * 256 + bj * HALF + wc * 32 + 8 * fq + 4 * n); h2[bj] = *(const PG8_LAS f32x4*)(XB + ((chunk - 1) * 2) * 256 + bj * HALF + wc * 32 + 8 * fq + 4 * n); }
                    else { h1[bj] = (f32x4){0.f, 0.f, 0.f, 0.f}; h2[bj] = (f32x4){0.f, 0.f, 0.f, 0.f}; }
                }
#pragma unroll
                for (int m = 0; m < 4; ++m) {
                    f32x4 c[2];
#pragma unroll
                    for (int bj = 0; bj < 2; ++bj)
#pragma unroll
                        for (int e = 0; e < 4; ++e) {
                            const float cur = acc[ai][bj][m][n][e];
                            const float o1 = m ? dpp_ror(acc[ai][bj][m ? m - 1 : 0][n][e], 1) : h1[bj][e];
                            const float o2 = m ? dpp_ror(acc[ai][bj][m ? m - 1 : 0][n][e], 2) : (fr == 0 ? h2[bj][e] : h1[bj][e]);
                            const float p1 = dpp_shr1(o1, cur), p2 = dpp_shr2(o2, cur);
                            c[bj][e] = bb[bj][e] + w0[bj][e] * p2 + w1[bj][e] * p1 + w2[bj][e] * cur;
                        }
                    const int row = u.pm * BM + ai * HALF + wr * 64 + m * 16 + fr;
                    if (chunk == 0 && m == 0 && fr < 2) {
                        *(f32x4*)(FIX + (size_t)(u.pm * 2 + fr) * 5632 + gc) = c[0]; *(f32x4*)(FIX + (size_t)(u.pm * 2 + fr) * 5632 + 2816 + gc) = c[1];
                    } else {
                        typedef unsigned u32x2 __attribute__((ext_vector_type(2)));
                        const u32x2 ow = {pk_bf16(gelu_t(c[0][0]) * c[1][0], gelu_t(c[0][1]) * c[1][1]), pk_bf16(gelu_t(c[0][2]) * c[1][2], gelu_t(c[0][3]) * c[1][3])};
                        *(u32x2*)(G + (size_t)row * 2816 + gc) = ow;
                    }
                }
            }
        }
        asm volatile("s_waitcnt lgkmcnt(0)" ::: "memory"); __builtin_amdgcn_s_barrier(); asm volatile("" ::: "memory");
    }
};
template <class Epi, class Sched, bool ALIGN_EPI = false, bool SP2 = false>
__device__ __forceinline__ void gemm_phase(PG8_LAS unsigned char* lds, const Gemm g, const Sched& S, const Epi& E) {
    const int tid = threadIdx.x, wid = __builtin_amdgcn_readfirstlane(tid >> 6), lane = tid & 63, wr = wid >> 2, wc = wid & 3, fr = lane & 15, fq = lane >> 4;
    const int K = g.K, nt = K / BK;
    unsigned voffA[2], voffB[2];
#pragma unroll
    for (int i = 0; i < 2; ++i) { int R, C; stage_rc(tid * 16 + i * 8192, R, C); const int Rb = Epi::PERM ? ((R & ~31) + perm32(R & 31)) : R;
        voffA[i] = (unsigned)(R * K + C) * 2u; voffB[i] = (unsigned)(Rb * K + C) * 2u; }
    const size_t kstep = (size_t)(BK * 2);
    const size_t hstep = (size_t)HALF * K * 2;
    const size_t tstep = 2 * hstep;
    const unsigned ldsw = (unsigned)wid * 1024u;
    const int aoff = lds_byte(wr * 64 + fr, fq * 8), boff = lds_byte(wc * 32 + fr, fq * 8);
#define PG8_SA(b, h) (((b) * 2 + (h)) * HTB)
#define PG8_SB(b, h) ((4 + (b) * 2 + (h)) * HTB)
#define PG8_STAGE(bufoff, gbase, voff) do { _Pragma("unroll") for (int _i = 0; _i < 2; ++_i) \
        __builtin_amdgcn_global_load_lds((const unsigned*)((const char*)(gbase) + (voff)[_i]), (PG8_LAS unsigned*)(lds + (bufoff) + ldsw + _i * 8192), 16, 0, 0); } while (0)
#define PG8_LDA(dst, b, h) do { _Pragma("unroll") for (int m = 0; m < 4; ++m) _Pragma("unroll") for (int k = 0; k < 2; ++k) dst[m][k] = *(const PG8_LAS bf16x8*)(lds + PG8_SA(b, h) + aoff + m * 2048 + k * 1024); } while (0)
#define PG8_LDB(dst, b, h) do { _Pragma("unroll") for (int n = 0; n < 2; ++n) _Pragma("unroll") for (int k = 0; k < 2; ++k) dst[n][k] = *(const PG8_LAS bf16x8*)(lds + PG8_SB(b, h) + boff + n * 2048 + k * 1024); } while (0)
#define PG8_MMA(ai, bj, At, Bt) do { __builtin_amdgcn_s_setprio(1); _Pragma("unroll") for (int m = 0; m < 4; ++m) _Pragma("unroll") for (int n = 0; n < 2; ++n) _Pragma("unroll") for (int k = 0; k < 2; ++k) \
        acc[ai][bj][m][n] = __builtin_amdgcn_mfma_f32_16x16x32_bf16(Bt[n][k], At[m][k], acc[ai][bj][m][n], 0, 0, 0); __builtin_amdgcn_s_setprio(0); } while (0)
#define PG8_WAIT_V(n) asm volatile("s_waitcnt vmcnt(" #n ")" ::: "memory")
#define PG8_WAIT_L(n) asm volatile("s_waitcnt lgkmcnt(" #n ")" ::: "memory")
#define PG8_BAR __builtin_amdgcn_s_barrier()
#define PG8_SCHED __builtin_amdgcn_sched_barrier(0)
    Unit cur, nxt; int ui = 0;
    if (!S.next(0, cur)) return;
    f32x4 acc[2][2][4][2];
#pragma unroll
    for (int a = 0; a < 2; ++a)
#pragma unroll
        for (int b = 0; b < 2; ++b)
#pragma unroll
            for (int m = 0; m < 4; ++m)
#pragma unroll
                for (int n = 0; n < 2; ++n) acc[a][b][m][n] = (f32x4){0.f, 0.f, 0.f, 0.f};
    bf16x8 At[4][2], B0[2][2], B1[2][2];
    const char* cA = (const char*)g.A + (size_t)cur.pm * tstep; const char* cB = (const char*)g.Bt + (size_t)cur.pn * tstep;
    S.a_ready(cur);
    if constexpr (SP2) {
        PG8_STAGE(PG8_SB(0, 0), cB, voffB); PG8_STAGE(PG8_SB(0, 1), cB + hstep, voffB); PG8_STAGE(PG8_SA(0, 0), cA, voffA); PG8_STAGE(PG8_SA(0, 1), cA + hstep, voffA);
        if (wr == 1) PG8_BAR;
        PG8_WAIT_V(2); PG8_BAR;
        PG8_STAGE(PG8_SB(1, 0), cB + kstep, voffB); PG8_STAGE(PG8_SA(1, 0), cA + kstep, voffA); PG8_STAGE(PG8_SB(1, 1), cB + hstep + kstep, voffB);
        PG8_WAIT_V(6); PG8_BAR;
    } else {
        PG8_STAGE(PG8_SB(0, 0), cB, voffB); PG8_STAGE(PG8_SA(0, 0), cA, voffA); PG8_STAGE(PG8_SB(0, 1), cB + hstep, voffB); PG8_STAGE(PG8_SA(0, 1), cA + hstep, voffA);
        if (wr == 1) PG8_BAR;
        PG8_WAIT_V(4); PG8_BAR;
        PG8_STAGE(PG8_SB(1, 0), cB + kstep, voffB); PG8_STAGE(PG8_SA(1, 0), cA + kstep, voffA); PG8_STAGE(PG8_SB(1, 1), cB + hstep + kstep, voffB);
        PG8_WAIT_V(6); PG8_BAR;
    }
    for (;;) {
        const bool has_next = S.next(ui + 1, nxt);
        const char* nA = has_next ? (const char*)g.A + (size_t)nxt.pm * tstep : cA; const char* nB = has_next ? (const char*)g.Bt + (size_t)nxt.pn * tstep : cB;
        for (int t = 0; t < nt; t += 2) {
            const bool last = (t == nt - 2);
            const char* a1 = cA + (size_t)(t + 1) * kstep;
            const char* a2 = last ? nA : cA + (size_t)(t + 2) * kstep; const char* b2 = last ? nB : cB + (size_t)(t + 2) * kstep;
            const char* a3 = a2 + kstep; const char* b3 = b2 + kstep;
            if (last && has_next) S.a_ready(nxt);
            if constexpr (SP2) {
            PG8_LDB(B0, 0, 0); PG8_LDB(B1, 0, 1); PG8_SCHED; PG8_LDA(At, 0, 0); PG8_STAGE(PG8_SA(1, 1), a1 + hstep, voffA);
            PG8_WAIT_V(8); PG8_WAIT_L(0); PG8_BAR; PG8_MMA(0, 0, At, B0); PG8_MMA(0, 1, At, B1); PG8_BAR; PG8_SCHED;
            PG8_LDA(At, 0, 1); PG8_STAGE(PG8_SB(0, 0), b2, voffB); PG8_STAGE(PG8_SB(0, 1), b2 + hstep, voffB); PG8_STAGE(PG8_SA(0, 0), a2, voffA);
            PG8_WAIT_V(8); PG8_WAIT_L(0); PG8_BAR; PG8_MMA(1, 0, At, B0); PG8_MMA(1, 1, At, B1); PG8_BAR; PG8_SCHED;
            PG8_LDB(B0, 1, 0); PG8_LDB(B1, 1, 1); PG8_SCHED; PG8_LDA(At, 1, 0); PG8_STAGE(PG8_SA(0, 1), a2 + hstep, voffA);
            PG8_WAIT_V(8); PG8_WAIT_L(0); PG8_BAR; PG8_MMA(0, 0, At, B0); PG8_MMA(0, 1, At, B1); PG8_BAR; PG8_SCHED;
            PG8_LDA(At, 1, 1); PG8_STAGE(PG8_SB(1, 0), b3, voffB); PG8_STAGE(PG8_SB(1, 1), b3 + hstep, voffB); PG8_STAGE(PG8_SA(1, 0), a3, voffA);
            PG8_WAIT_V(8); PG8_WAIT_L(0); PG8_BAR; PG8_MMA(1, 0, At, B0); PG8_MMA(1, 1, At, B1); PG8_BAR; PG8_SCHED;
            } else {
            PG8_LDB(B0, 0, 0); PG8_SCHED; PG8_LDA(At, 0, 0); PG8_STAGE(PG8_SA(1, 1), a1 + hstep, voffA);
            PG8_WAIT_L(8); PG8_BAR; PG8_WAIT_L(0); PG8_MMA(0, 0, At, B0); PG8_BAR; PG8_SCHED;
            PG8_LDB(B1, 0, 1); PG8_STAGE(PG8_SB(0, 0), b2, voffB);
            PG8_BAR; PG8_WAIT_L(0); PG8_MMA(0, 1, At, B1); PG8_BAR;
            PG8_LDA(At, 0, 1); PG8_STAGE(PG8_SA(0, 0), a2, voffA);
            PG8_BAR; PG8_WAIT_L(0); PG8_MMA(1, 0, At, B0); PG8_BAR; PG8_SCHED;
            PG8_STAGE(PG8_SB(0, 1), b2 + hstep, voffB);
            PG8_WAIT_V(6); PG8_BAR; PG8_MMA(1, 1, At, B1); PG8_BAR;
            PG8_LDB(B0, 1, 0); PG8_SCHED; PG8_LDA(At, 1, 0); PG8_STAGE(PG8_SA(0, 1), a2 + hstep, voffA);
            PG8_WAIT_L(8); PG8_BAR; PG8_WAIT_L(0); PG8_MMA(0, 0, At, B0); PG8_BAR; PG8_SCHED;
            PG8_LDB(B1, 1, 1); PG8_STAGE(PG8_SB(1, 0), b3, voffB);
            PG8_BAR; PG8_WAIT_L(0); PG8_MMA(0, 1, At, B1); PG8_BAR;
            PG8_LDA(At, 1, 1); PG8_STAGE(PG8_SA(1, 0), a3, voffA);
            PG8_BAR; PG8_WAIT_L(0); PG8_MMA(1, 0, At, B0); PG8_BAR; PG8_SCHED;
            PG8_STAGE(PG8_SB(1, 1), b3 + hstep, voffB);
            PG8_WAIT_V(6); PG8_BAR; PG8_MMA(1, 1, At, B1); PG8_BAR;
            }
        }
        if constexpr (ALIGN_EPI) { if (wr == 0) PG8_BAR; }
        if constexpr (!Epi::AFTER_DRAIN) { E(acc, cur, wr, wc, fr, fq); S.done(cur); }
        if (!has_next) break;
#pragma unroll
        for (int a = 0; a < 2; ++a)
#pragma unroll
            for (int b = 0; b < 2; ++b)
#pragma unroll
                for (int m = 0; m < 4; ++m)
#pragma unroll
                    for (int n = 0; n < 2; ++n) acc[a][b][m][n] = (f32x4){0.f, 0.f, 0.f, 0.f};
        cur = nxt; cA = nA; cB = nB; ++ui;
        if constexpr (ALIGN_EPI) { if (wr == 1) PG8_BAR; }
    }
    PG8_WAIT_V(0);
    if constexpr (!ALIGN_EPI) { if (wr == 0) PG8_BAR; }
    PG8_BAR;
    if constexpr (Epi::AFTER_DRAIN) { E.fused(acc, cur, wr, wc, fr, fq, lds, wid, lane); S.done(cur); }
#undef PG8_SA
#undef PG8_SB
#undef PG8_STAGE
#undef PG8_LDA
#undef PG8_LDB
#undef PG8_MMA
#undef PG8_WAIT_V
#undef PG8_WAIT_L
#undef PG8_BAR
#undef PG8_SCHED
}
}
#define GAS __attribute__((address_space(1)))
#define LAS __attribute__((address_space(3)))
#define LDS_WAIT() asm volatile("s_waitcnt lgkmcnt(0)" ::: "memory")
#define VM_WAIT() asm volatile("s_waitcnt vmcnt(0)" ::: "memory")
#define XB_TMO      128
#define XB_XCNT(j)  (256  + 64 * (j))
#define XB_XSUB(j)  (1280 + 64 * (j))
#define XB_XGEN(j)  (2304 + 64 * (j))
#define XB_TOP      3328
#define XB_TOPGEN   3392
#define XCD_BAR_WORDS 3456
#define XB_SPIN_CAP (1u << 23)

__device__ __forceinline__ unsigned xb_ld(unsigned* p)              { return __hip_atomic_load(p, __ATOMIC_RELAXED, __HIP_MEMORY_SCOPE_AGENT); }
__device__ __forceinline__ unsigned xb_add(unsigned* p, unsigned v) { return __hip_atomic_fetch_add(p, v, __ATOMIC_RELAXED, __HIP_MEMORY_SCOPE_AGENT); }
__device__ __forceinline__ unsigned xb_xcc_id() { return (unsigned)__builtin_amdgcn_s_getreg((3 << 11) | 20) & 0xFu; }
#define XB_SPIN(cond, bar) do { unsigned _sp = 0; while (cond) { __builtin_amdgcn_s_sleep(1); \
    if ((++_sp & 255u) == 0u) { if (xb_ld(&(bar)[XB_TMO])) break; if (_sp > XB_SPIN_CAP) { atomicAdd(&(bar)[XB_TMO], 1u); break; } } } } while (0)

struct XcdBarrier {
    unsigned* bar; unsigned x;
    volatile LAS unsigned* st;
};

__device__ __forceinline__ XcdBarrier xcd_barrier_post(unsigned* bar, volatile LAS unsigned* st) {
    XcdBarrier b; b.bar = bar; b.x = xb_xcc_id(); b.st = st;
    if (threadIdx.x == 0) (void)xb_add(&bar[XB_XCNT(b.x)], 1u);
    return b;
}
__device__ __forceinline__ void xcd_barrier_complete(unsigned* bar, unsigned x, unsigned& nloc, unsigned& nx) {
    const unsigned G = gridDim.x * gridDim.y * gridDim.z;
    unsigned sum, cnt, mine, sp = 0u;
    for (;;) {
        sum = 0u; cnt = 0u; mine = 0u;
#pragma unroll
        for (unsigned j = 0; j < 16; ++j) { const unsigned c = xb_ld(&bar[XB_XCNT(j)]); sum += c; cnt += (c > 0u) ? 1u : 0u; mine = (j == x) ? c : mine; }
        if (sum == G) break;
        __builtin_amdgcn_s_sleep(1);
        if ((++sp & 255u) == 0u) { if (xb_ld(&bar[XB_TMO])) break; if (sp > XB_SPIN_CAP) { atomicAdd(&bar[XB_TMO], 1u); break; } }
    }
    nloc = mine > 0u ? mine : 1u; nx = cnt > 0u ? cnt : 1u;
}

__device__ __forceinline__ void xcd_barrier(const XcdBarrier& b) {
    asm volatile("s_waitcnt vmcnt(0)" ::: "memory");
    __syncthreads();
    if (threadIdx.x == 0) {
        unsigned* bar = b.bar;
        __builtin_amdgcn_s_waitcnt(0);
        unsigned nloc = b.st[0], nx = b.st[1];
        if (nloc == 0u) { xcd_barrier_complete(bar, b.x, nloc, nx); b.st[0] = nloc; b.st[1] = nx; }
        const unsigned old = xb_add(&bar[XB_XSUB(b.x)], 1u);
        const unsigned gen = old / nloc;
        if (old + 1u == (gen + 1u) * nloc) {
            __builtin_amdgcn_fence(__ATOMIC_RELEASE, "agent");
            asm volatile("s_waitcnt vmcnt(0)" ::: "memory");
            const unsigned og = xb_add(&bar[XB_TOP], 1u);
            const unsigned tg = og / nx;
            if (og + 1u == (tg + 1u) * nx) xb_add(&bar[XB_TOPGEN], 1u);
            else XB_SPIN(xb_ld(&bar[XB_TOPGEN]) == tg, bar);
            __builtin_amdgcn_fence(__ATOMIC_ACQUIRE, "agent");
            xb_add(&bar[XB_XGEN(b.x)], 1u);
            asm volatile("s_waitcnt vmcnt(0)" ::: "memory");
        } else {
            XB_SPIN(xb_ld(&bar[XB_XGEN(b.x)]) == gen, bar);
            __builtin_amdgcn_fence(__ATOMIC_ACQUIRE, "agent");
            asm volatile("s_waitcnt vmcnt(0)" ::: "memory");
        }
    }
    __syncthreads();
}
#define PROBE_PH -1
constexpr int NWAVES = 8, NTHREADS = 512;
constexpr int DM = 1024, SEQ = 8192, NBATCH = 2, MP = NBATCH * SEQ, NDEC = 128, TDEC = 8, MS = NDEC * TDEC, MT = MP + MS;
constexpr int DIN = 3584, HW = 512, NH = 8, HD = 64;
constexpr int NMEM = 256, CAH = 4, CAD = 256, DFF = 2816, DFF2 = 5632;
constexpr int PAST = 2048, PAGE = 128, NPAGES = 16;
constexpr float RMS_EPS = 1e-6f, LOG2E = 1.4426950408889634f;
constexpr float SQ_SCALE = 0.125f * LOG2E;
constexpr float CQ_SCALE = 0.0625f * LOG2E;
enum { I_XP = 0, I_XS, I_CK, I_CV, I_SH, I_SC, I_MK, I_MV, I_PT, I_MEM, I_WIN, I_HGN, I_HLB, I_SBB, I_WO, I_GMIXPRE, I_GMIXPOST, I_GCAPRE, I_GCAPOST, I_GMEM,
       I_WCQ, I_WCK, I_WCV, I_WCO, I_GFFNPRE, I_GFFNPOST, I_WUP, I_CONVW, I_CONVB, I_WDN, N_IN };
constexpr size_t O_YP = 0, O_YS = 16777216, O_KP = 17825792, O_VP = 26214400, O_HP = 34603008, O_CP = 34668544, O_MKP = 34691072, O_MVP = 35215360,
                 O_KS = 35739648, O_VS = 36263936, O_HS = 36788224, O_CS = 40982528, O_END = 42424320;
constexpr size_t MiB = 1u << 20;
constexpr size_t WS_CTL = 0, CTL_ZERO_BYTES = 1 * MiB;
constexpr size_t WS_WIN = 2 * MiB, WS_WO = 9 * MiB, WS_WCQ = 11 * MiB, WS_WCO = 13 * MiB, WS_WCKV = 15 * MiB, WS_WUP = 19 * MiB, WS_WDN = 30 * MiB;
constexpr size_t WS_LB = 36 * MiB, WS_MN = 37 * MiB, WS_MK = 38 * MiB, WS_MV = 39 * MiB;
constexpr size_t WS_H = 40 * MiB, WS_QH = 74 * MiB, WS_LF = 91 * MiB, WS_VH = 125 * MiB, WS_GH = 142 * MiB, WS_SQ = 159 * MiB, WS_SK = 176 * MiB, WS_SV = 193 * MiB;
constexpr size_t WS_OMIX = 210 * MiB, WS_BR = 244 * MiB, WS_X1 = 278 * MiB, WS_X2 = 346 * MiB, WS_QCA = 414 * MiB, WS_U = 448 * MiB, WS_G = 635 * MiB, WS_UCT = 730 * MiB, WS_DC = 762 * MiB, WS_SCT = 763 * MiB, WS_SBP = 780 * MiB, WS_FIX = 786 * MiB, WS_ULAST = 790 * MiB, WS_END = 794 * MiB;
constexpr int CW_BAR = 4096;
constexpr int XB_OFF = 131072;
constexpr int RING_OFF = 0, RING_BYTES = 162816, LDSCTL_OFF = RING_BYTES, MISC_OFF = LDSCTL_OFF + 320, LDS_BYTES = 163840;

typedef unsigned short bf16;
typedef unsigned v4u __attribute__((ext_vector_type(4)));
typedef unsigned v2u __attribute__((ext_vector_type(2)));
typedef float f32x4 __attribute__((ext_vector_type(4)));
using pg8::pk_bf16;
__device__ __forceinline__ float bf2f(unsigned short b) { return __uint_as_float((unsigned)b << 16); }
__device__ __forceinline__ float bflo(unsigned w) { return __uint_as_float(w << 16); }
__device__ __forceinline__ float bfhi(unsigned w) { return __uint_as_float(w & 0xffff0000u); }
__device__ __forceinline__ unsigned short f2bf(float f) { return (unsigned short)(pk_bf16(f, 0.f) & 0xffffu); }
__device__ __forceinline__ float wave_sum(float v) {
#pragma unroll
    for (int o = 1; o < 64; o <<= 1) v += __shfl_xor(v, o);
    return v;
}
__device__ __forceinline__ float rdlane(float v, int l) { return __uint_as_float((unsigned)__builtin_amdgcn_readlane((int)__float_as_uint(v), l)); }

struct Args { const void* in[N_IN]; float* out; unsigned char* ws; int ph_lo, ph_hi; };
struct Ctx { const void* const* in; float* out; unsigned char* ws; LAS unsigned char* lds; int tid, lane, wave, gw, ngw; };

template <bool UPPERM = false>
__device__ __forceinline__ void p0_transpose_item(const float* W, int K, int N, bf16* WT, int row_off, LAS float* scr, int item, int lane) {
    const int nblk = N / 32, kb = item / nblk, nb = item % nblk, k0 = 64 * kb, n0 = 32 * nb;
    const int r0 = UPPERM ? (n0 < DFF ? 256 * (n0 >> 7) + (n0 & 127) : 256 * ((n0 - DFF) >> 7) + 128 + ((n0 - DFF) & 127)) : n0;
#pragma unroll 8
    for (int i = 0; i < 32; ++i) { const int kk = 2 * i + (lane >> 5); scr[kk * 33 + (lane & 31)] = W[(size_t)(k0 + kk) * N + n0 + (lane & 31)]; }
    LDS_WAIT(); asm volatile("" ::: "memory");
    const int c = lane & 7;
#pragma unroll
    for (int j = 0; j < 4; ++j) { const int n = (lane >> 3) + 8 * j; const LAS float* s = scr + (8 * c) * 33 + n;
        v4u o; o.x = pk_bf16(s[0 * 33], s[1 * 33]); o.y = pk_bf16(s[2 * 33], s[3 * 33]); o.z = pk_bf16(s[4 * 33], s[5 * 33]); o.w = pk_bf16(s[6 * 33], s[7 * 33]);
        *(v4u*)(WT + (size_t)(row_off + r0 + n) * K + k0 + 8 * c) = o; }
    LDS_WAIT(); asm volatile("" ::: "memory");
}
__device__ __forceinline__ void rms_row_to_bf16(const float* xrow, const float* g, bf16* orow, int lane) {
    const f32x4* xr = (const f32x4*)xrow + lane; const f32x4* gr = (const f32x4*)g + lane;
    f32x4 v[4]; float s = 0.f;
#pragma unroll
    for (int j = 0; j < 4; ++j) { v[j] = xr[64 * j]; s += (v[j].x * v[j].x + v[j].y * v[j].y) + (v[j].z * v[j].z + v[j].w * v[j].w); }
    const float r = rsqrtf(wave_sum(s) * (1.f / DM) + RMS_EPS);
    v2u* o8 = (v2u*)orow + lane;
#pragma unroll
    for (int j = 0; j < 4; ++j) { const f32x4 gg = gr[64 * j]; v2u w; w.x = pk_bf16(v[j].x * r * gg.x, v[j].y * r * gg.y); w.y = pk_bf16(v[j].z * r * gg.z, v[j].w * r * gg.w); o8[64 * j] = w; }
}
__device__ __forceinline__ void p0_prologue(const Ctx& C) {
    LAS float* scr = (LAS float*)(C.lds + RING_OFF + C.wave * 16384);
    const float* w_in = (const float*)C.in[I_WIN]; const float* w_o = (const float*)C.in[I_WO]; const float* w_cq = (const float*)C.in[I_WCQ]; const float* w_ck = (const float*)C.in[I_WCK];
    const float* w_cv = (const float*)C.in[I_WCV]; const float* w_co = (const float*)C.in[I_WCO]; const float* w_up = (const float*)C.in[I_WUP]; const float* w_dn = (const float*)C.in[I_WDN];
    bf16* Win = (bf16*)(C.ws + WS_WIN); bf16* Wo = (bf16*)(C.ws + WS_WO); bf16* Wcq = (bf16*)(C.ws + WS_WCQ); bf16* Wco = (bf16*)(C.ws + WS_WCO); bf16* Wckv = (bf16*)(C.ws + WS_WCKV);
    bf16* Wup = (bf16*)(C.ws + WS_WUP); bf16* Wdn = (bf16*)(C.ws + WS_WDN);
    constexpr int I_IN = (DM / 64) * (DIN / 32), I_SQ = (DM / 64) * (DM / 32), I_UP = (DM / 64) * (DFF2 / 32), I_DN = (DFF / 64) * (DM / 32);
    constexpr int NITEMS = I_IN + 5 * I_SQ + I_UP + I_DN;
    for (int it = C.gw; it < NITEMS; it += C.ngw) {
        int r = it;
        if (r < I_IN) { p0_transpose_item(w_in, DM, DIN, Win, 0, scr, r, C.lane); continue; } r -= I_IN;
        if (r < I_SQ) { p0_transpose_item(w_o, DM, DM, Wo, 0, scr, r, C.lane); continue; } r -= I_SQ;
        if (r < I_SQ) { p0_transpose_item(w_cq, DM, DM, Wcq, 0, scr, r, C.lane); continue; } r -= I_SQ;
        if (r < I_SQ) { p0_transpose_item(w_co, DM, DM, Wco, 0, scr, r, C.lane); continue; } r -= I_SQ;
        if (r < I_SQ) { p0_transpose_item(w_ck, DM, DM, Wckv, 0, scr, r, C.lane); continue; } r -= I_SQ;
        if (r < I_SQ) { p0_transpose_item(w_cv, DM, DM, Wckv, DM, scr, r, C.lane); continue; } r -= I_SQ;
        if (r < I_UP) { p0_transpose_item<true>(w_up, DM, DFF2, Wup, 0, scr, r, C.lane); continue; } r -= I_UP;
        p0_transpose_item(w_dn, DFF, DM, Wdn, 0, scr, r, C.lane);
    }
    const float* xp = (const float*)C.in[I_XP]; const float* xs = (const float*)C.in[I_XS]; const float* mem = (const float*)C.in[I_MEM];
    bf16* H = (bf16*)(C.ws + WS_H); bf16* MN = (bf16*)(C.ws + WS_MN);
    const float* g_pre = (const float*)C.in[I_GMIXPRE]; const float* g_mem = (const float*)C.in[I_GMEM];
    for (int m = C.gw; m < MT + NBATCH * NMEM; m += C.ngw) {
        if (m < MP) rms_row_to_bf16(xp + (size_t)m * DM, g_pre, H + (size_t)m * DM, C.lane);
        else if (m < MT) rms_row_to_bf16(xs + (size_t)(m - MP) * DM, g_pre, H + (size_t)m * DM, C.lane);
        else rms_row_to_bf16(mem + (size_t)(m - MT) * DM, g_mem, MN + (size_t)(m - MT) * DM, C.lane);
    }
    if (C.gw == 0) {
        const float* lbp = (const float*)C.in[I_HLB]; float* LB = (float*)(C.ws + WS_LB);
        for (int k = C.lane; k < HW; k += 64) { const float a = lbp[k], b = lbp[HW + k]; LB[k] = 1.f / (1.f + __expf(b - a)); }
    }
}
typedef short bf16x8s __attribute__((ext_vector_type(8)));
typedef short s16x4 __attribute__((ext_vector_type(4)));
typedef short v4i16_t __attribute__((ext_vector_type(4)));
constexpr int HRS = 72;
__device__ __forceinline__ s16x4 tr4(const LAS bf16* p) { return __builtin_bit_cast(s16x4, __builtin_amdgcn_ds_read_tr16_b64_v4i16((LAS v4i16_t*)p)); }
__device__ __forceinline__ bf16x8s cat8(s16x4 lo, s16x4 hi) { return (bf16x8s){lo[0], lo[1], lo[2], lo[3], hi[0], hi[1], hi[2], hi[3]}; }
__device__ __forceinline__ f32x4 mfma16(bf16x8s a, bf16x8s b, f32x4 c) { return __builtin_amdgcn_mfma_f32_16x16x32_bf16(a, b, c, 0, 0, 0); }
__device__ __forceinline__ void hg_stage_v(const bf16* VH, int r0, int h, LAS bf16* Vt, int lane) {
#pragma unroll
    for (int it = 0; it < 8; ++it) { const int row = it * 8 + (lane >> 3), ch = lane & 7; const v4u w = *(const v4u*)(VH + (size_t)(r0 + row) * HW + h * HD + ch * 8); *(LAS v4u*)(Vt + row * HRS + ch * 8) = w; }
}
__device__ __forceinline__ void hgrn_h1(const Ctx& C, int cid) {
    const float* LF = (const float*)(C.ws + WS_LF); const bf16* VH = (const bf16*)(C.ws + WS_VH);
    float* UCT = (float*)(C.ws + WS_UCT); float* DC = (float*)(C.ws + WS_DC);
    const int lane = C.lane, i = lane & 15, g = lane >> 4;
    const int chain = cid >> 7, ci = cid & 127, b = chain >> 3, h = chain & 7, r0 = b * SEQ + ci * 64;
    LAS bf16* Vt = (LAS bf16*)(C.lds + RING_OFF + C.wave * 18432); LAS bf16* Kt = Vt + 64 * HRS;
    hg_stage_v(VH, r0, h, Vt, lane);
    const float* lfp = LF + (size_t)r0 * HW + h * HD + lane;
    float bl = 0.f;
#pragma unroll 16
    for (int t = 0; t < 64; ++t) bl += lfp[(size_t)t * HW];
    { float run = 0.f;
#pragma unroll 16
      for (int s = 0; s < 64; ++s) { const float lf = lfp[(size_t)s * HW]; run += lf; Kt[s * HRS + lane] = f2bf((1.f - __expf(lf)) * __expf(bl - run)); } }
    DC[(size_t)cid * 64 + lane] = __expf(bl);
    LDS_WAIT();
#pragma unroll
    for (int kb = 0; kb < 4; ++kb) {
        bf16x8s af[2];
#pragma unroll
        for (int ks = 0; ks < 2; ++ks) af[ks] = cat8(tr4(Kt + (32 * ks + 8 * g + (i >> 2)) * HRS + 16 * kb + (i & 3) * 4), tr4(Kt + (32 * ks + 8 * g + 4 + (i >> 2)) * HRS + 16 * kb + (i & 3) * 4));
#pragma unroll
        for (int db = 0; db < 4; ++db) {
            f32x4 acc = {0.f, 0.f, 0.f, 0.f};
#pragma unroll
            for (int ks = 0; ks < 2; ++ks) { const bf16x8s bfr = cat8(tr4(Vt + (32 * ks + 8 * g + (i >> 2)) * HRS + 16 * db + (i & 3) * 4), tr4(Vt + (32 * ks + 8 * g + 4 + (i >> 2)) * HRS + 16 * db + (i & 3) * 4));
                acc = mfma16(af[ks], bfr, acc); }
            *(f32x4*)(UCT + ((size_t)cid * 64 + 16 * db + i) * 64 + 16 * kb + 4 * g) = acc;
        }
    }
    LDS_WAIT();
}
__device__ __forceinline__ void hgrn_h2(const Ctx& C) {
    const float* UCT = (const float*)(C.ws + WS_UCT); const float* DC = (const float*)(C.ws + WS_DC); bf16* SCT = (bf16*)(C.ws + WS_SCT);
    const int lane = C.lane;
    for (int w = C.gw; w < NBATCH * NH * 64; w += C.ngw) {
        const int chain = w >> 6, d = w & 63; float S = 0.f;
        for (int c0 = 0; c0 < 128; c0 += 16) {
            float u[16], dc[16];
#pragma unroll
            for (int j = 0; j < 16; ++j) { const size_t cid = (size_t)chain * 128 + c0 + j; u[j] = UCT[(cid * 64 + d) * 64 + lane]; dc[j] = DC[cid * 64 + lane]; }
#pragma unroll
            for (int j = 0; j < 16; ++j) { const size_t cid = (size_t)chain * 128 + c0 + j; SCT[(cid * 64 + d) * 64 + lane] = f2bf(S); S = dc[j] * S + u[j]; }
        }
        C.out[O_HP + (size_t)chain * 4096 + lane * 64 + d] = S;
    }
}
__device__ __forceinline__ void hgrn_h3(const Ctx& C, int cid) {
    const float* LF = (const float*)(C.ws + WS_LF); const bf16* QH = (const bf16*)(C.ws + WS_QH); const bf16* VH = (const bf16*)(C.ws + WS_VH); const bf16* GH = (const bf16*)(C.ws + WS_GH);
    const bf16* SCT = (const bf16*)(C.ws + WS_SCT); bf16* OMIX = (bf16*)(C.ws + WS_OMIX); const float* hgn = (const float*)C.in[I_HGN];
    const int lane = C.lane, i = lane & 15, g = lane >> 4;
    const int chain = cid >> 7, ci = cid & 127, b = chain >> 3, h = chain & 7, r0 = b * SEQ + ci * 64;
    LAS bf16* Vt = (LAS bf16*)(C.lds + RING_OFF + C.wave * 18432); LAS bf16* Kb = Vt + 64 * HRS; LAS bf16* Qh = Kb + 16 * HRS; LAS bf16* Qt = Qh + 16 * HRS;
    hg_stage_v(VH, r0, h, Vt, lane);
    const float* lfp = LF + (size_t)r0 * HW + h * HD + lane; const bf16* qp = QH + (size_t)r0 * HW + h * HD + lane;
    float eb[4];
    bf16x8s sfr[4][2];
#pragma unroll
    for (int db = 0; db < 4; ++db)
#pragma unroll
        for (int ks = 0; ks < 2; ++ks) sfr[db][ks] = *(const bf16x8s*)(SCT + ((size_t)cid * 64 + 16 * db + i) * 64 + 32 * ks + 8 * g);
#pragma unroll
    for (int is = 0; is < 4; ++is) {
        const float ri = is ? eb[is - 1] : 0.f, er = __expf(ri);
        { float run = 0.f;
#pragma unroll
          for (int tt = 0; tt < 16; ++tt) { const int t = 16 * is + tt; run += lfp[(size_t)t * HW]; const float qt = bf2f(qp[(size_t)t * HW]) * __expf(run);
              Qt[tt * HRS + lane] = f2bf(qt); Qh[tt * HRS + lane] = f2bf(qt * er); }
          eb[is] = ri + run; }
        LDS_WAIT();
        bf16x8s qhf[2], qtf[2];
#pragma unroll
        for (int ks = 0; ks < 2; ++ks) { qhf[ks] = *(const LAS bf16x8s*)(Qh + i * HRS + 32 * ks + 8 * g); qtf[ks] = *(const LAS bf16x8s*)(Qt + i * HRS + 32 * ks + 8 * g); }
        f32x4 o[4];
#pragma unroll
        for (int db = 0; db < 4; ++db) { o[db] = (f32x4){0.f, 0.f, 0.f, 0.f};
#pragma unroll
            for (int ks = 0; ks < 2; ++ks) o[db] = mfma16(sfr[db][ks], qhf[ks], o[db]); }
#pragma unroll
        for (int jp = 0; jp <= is / 2; ++jp) {
            f32x4 x[2];
#pragma unroll
            for (int jj = 0; jj < 2; ++jj) {
                const int j = 2 * jp + jj; x[jj] = (f32x4){0.f, 0.f, 0.f, 0.f};
                if (j <= is) {
                    { float run = (j ? eb[j - 1] : 0.f) - ri;
#pragma unroll
                      for (int ss = 0; ss < 16; ++ss) { const int s = 16 * j + ss; const float lf = lfp[(size_t)s * HW]; run += lf; Kb[ss * HRS + lane] = f2bf((1.f - __expf(lf)) * __expf(-run)); } }
                    LDS_WAIT();
#pragma unroll
                    for (int ks = 0; ks < 2; ++ks) { const bf16x8s kf = *(const LAS bf16x8s*)(Kb + i * HRS + 32 * ks + 8 * g); x[jj] = mfma16(kf, qtf[ks], x[jj]); }
                    if (j == is) {
#pragma unroll
                        for (int e = 0; e < 4; ++e) if (4 * g + e > i) x[jj][e] = 0.f;
                    }
                    LDS_WAIT();
                }
            }
            bf16x8s pb; { const unsigned w0 = pk_bf16(x[0][0], x[0][1]), w1 = pk_bf16(x[0][2], x[0][3]), w2 = pk_bf16(x[1][0], x[1][1]), w3 = pk_bf16(x[1][2], x[1][3]); const v4u ww = {w0, w1, w2, w3}; pb = __builtin_bit_cast(bf16x8s, ww); }
            const int j0 = 2 * jp, j1 = (2 * jp + 1 <= is) ? 2 * jp + 1 : 2 * jp;
#pragma unroll
            for (int db = 0; db < 4; ++db) { const bf16x8s vf = cat8(tr4(Vt + (16 * j0 + 4 * g + (i >> 2)) * HRS + 16 * db + (i & 3) * 4), tr4(Vt + (16 * j1 + 4 * g + (i >> 2)) * HRS + 16 * db + (i & 3) * 4));
                o[db] = mfma16(vf, pb, o[db]); }
        }
        float ss = 0.f;
#pragma unroll
        for (int db = 0; db < 4; ++db) ss += (o[db][0] * o[db][0] + o[db][1] * o[db][1]) + (o[db][2] * o[db][2] + o[db][3] * o[db][3]);
        ss += __shfl_xor(ss, 16); ss += __shfl_xor(ss, 32);
        const float r = rsqrtf(ss * (1.f / HD) + RMS_EPS); const size_t row = (size_t)(r0 + 16 * is + i);
#pragma unroll
        for (int db = 0; db < 4; ++db) { const int d0 = h * HD + 16 * db + 4 * g; const v2u gw = *(const v2u*)(GH + row * HW + d0); const f32x4 gn = *(const f32x4*)(hgn + d0);
            const float g0 = bflo(gw.x), g1 = bfhi(gw.x), g2 = bflo(gw.y), g3 = bfhi(gw.y);
            v2u w; w.x = pk_bf16(o[db][0] * r * gn.x * (g0 / (1.f + __expf(-g0))), o[db][1] * r * gn.y * (g1 / (1.f + __expf(-g1))));
            w.y = pk_bf16(o[db][2] * r * gn.z * (g2 / (1.f + __expf(-g2))), o[db][3] * r * gn.w * (g3 / (1.f + __expf(-g3))));
            *(v2u*)(OMIX + row * DM + d0) = w; }
    }
    LDS_WAIT();
}
typedef float f32x16 __attribute__((ext_vector_type(16)));
constexpr int SB_RS = 72;
constexpr int SB_TILE = 64 * SB_RS;
__device__ __forceinline__ f32x16 mfma32(bf16x8s a, bf16x8s b, f32x16 c) { return __builtin_amdgcn_mfma_f32_32x32x16_bf16(a, b, c, 0, 0, 0); }
__device__ __forceinline__ int sb_crow(int r, int hi) { return (r & 3) + 8 * (r >> 2) + 4 * hi; }
__device__ __forceinline__ void sb_subtile(const LAS bf16* Kp, const LAS bf16* Vp, const bf16x8s (&qf)[4], float bias2, bool diag, int key0, int qpos, int hi, float& Cc, f32x16& o0, f32x16& o1) {
    f32x16 p;
#pragma unroll
    for (int r = 0; r < 16; ++r) p[r] = bias2;
#pragma unroll
    for (int ks = 0; ks < 4; ++ks) { const bf16x8s kf = *(const LAS bf16x8s*)(Kp + 16 * ks); p = mfma32(kf, qf[ks], p); }
    float E = 1.f;
#pragma unroll
    for (int r = 0; r < 16; ++r) { float u = __builtin_amdgcn_exp2f(p[r]); if (diag) u = (key0 + r < qpos) ? u : 0.f; const float tt = E * u; E += tt; p[r] = tt; }
    const float Ti = __builtin_amdgcn_rcpf(E), Tp = __shfl_xor(Ti, 32);
    const float G = Ti * (hi ? Cc : Cc * Tp);
    Cc = Cc * Ti * Tp;
#pragma unroll
    for (int r = 0; r < 16; ++r) p[r] *= G;
    bf16x8s pa[2];
#pragma unroll
    for (int s = 0; s < 2; ++s) { const v4u ww = {pk_bf16(p[8 * s], p[8 * s + 1]), pk_bf16(p[8 * s + 2], p[8 * s + 3]), pk_bf16(p[8 * s + 4], p[8 * s + 5]), pk_bf16(p[8 * s + 6], p[8 * s + 7])}; pa[s] = __builtin_bit_cast(bf16x8s, ww); }
#pragma unroll
    for (int s = 0; s < 2; ++s) {
        const LAS bf16* vb = Vp + 8 * s * SB_RS;
        const bf16x8s v0 = cat8(tr4(vb), tr4(vb + 4 * SB_RS)), v1 = cat8(tr4(vb + 32), tr4(vb + 4 * SB_RS + 32));
        o0 = mfma32(pa[s], v0, o0); o1 = mfma32(pa[s], v1, o1);
    }
}
constexpr int SBK_RS = 72, SBV_RS = 160;
constexpr int SBK_T = 128 * SBK_RS, SBV_T = 128 * SBV_RS;
template <bool MASK>
__device__ __forceinline__ void sb_weights(f32x16& p, int key0, int qpos, int hi, float& Cc, bf16x8s (&pa)[2]) {
    float E = 1.f;
#pragma unroll
    for (int r = 0; r < 16; ++r) { float u = __builtin_amdgcn_exp2f(p[r]); if (MASK) u = (key0 + r < qpos) ? u : 0.f; const float tt = E * u; E += tt; p[r] = tt; }
    const float Ti = __builtin_amdgcn_rcpf(E);
    const auto rr = __builtin_amdgcn_permlane32_swap(__float_as_uint(Ti), __float_as_uint(Ti), false, false);
    const float Tp = __uint_as_float(rr[0] == __float_as_uint(Ti) ? rr[1] : rr[0]);
    const float G = Ti * (hi ? Cc : Cc * Tp);
    Cc = Cc * Ti * Tp;
#pragma unroll
    for (int s = 0; s < 2; ++s) { const v4u ww = {pk_bf16(p[8 * s] * G, p[8 * s + 1] * G), pk_bf16(p[8 * s + 2] * G, p[8 * s + 3] * G), pk_bf16(p[8 * s + 4] * G, p[8 * s + 5] * G), pk_bf16(p[8 * s + 6] * G, p[8 * s + 7] * G)}; pa[s] = __builtin_bit_cast(bf16x8s, ww); }
}
__device__ __forceinline__ void grp4_barrier(volatile LAS unsigned* cnt, unsigned& target, int lane) {
    target += 4u;
    if (lane == 0) __hip_atomic_fetch_add((LAS unsigned*)cnt, 1u, __ATOMIC_RELAXED, __HIP_MEMORY_SCOPE_WORKGROUP);
    while (*cnt < target) __builtin_amdgcn_s_sleep(1);
    asm volatile("" ::: "memory");
}
__device__ __forceinline__ void sb_unit4(const Ctx& C, int b, int h, int qb, volatile LAS unsigned* gcnt, unsigned& gtarget) {
    const bf16* SQ = (const bf16*)(C.ws + WS_SQ); const bf16* SK = (const bf16*)(C.ws + WS_SK); const bf16* SV = (const bf16*)(C.ws + WS_SV); bf16* OMIX = (bf16*)(C.ws + WS_OMIX);
    const int tid = C.tid, lane = C.lane, r32 = lane & 31, hi = lane >> 5, w = C.wave;
    const int q0 = qb * 128, qlo = q0 + 32 * w, qpos = qlo + r32;
    LAS bf16* Kl = (LAS bf16*)(C.lds + RING_OFF); LAS bf16* Vl = Kl + 2 * SBK_T;
    const float bias2 = ((const float*)C.in[I_SBB])[h] * LOG2E;
    bf16x8s qf[4];
#pragma unroll
    for (int ks = 0; ks < 4; ++ks) qf[ks] = *(const bf16x8s*)(SQ + (size_t)(b * SEQ + qpos) * HW + h * HD + 16 * ks + 8 * hi);
    const int srow = tid >> 3, sch = tid & 7;
    const bf16* gk = SK + (size_t)(b * SEQ + srow) * HW + h * HD + sch * 8; const bf16* gv = SV + (size_t)(b * SEQ + srow) * HW + h * HD + sch * 8;
    const int skoff = srow * SBK_RS + sch * 8, svoff = srow * SBV_RS + sch * 8;
    const int nt = qb + 1, ntp = nt + (nt & 1), sd = q0 / 32 + w;
    v4u rk[4], rv[4];
#pragma unroll
    for (int j = 0; j < 4; ++j) { rk[j] = *(const v4u*)(gk + (size_t)((ntp - 1) * 128 + 32 * j) * HW); rv[j] = *(const v4u*)(gv + (size_t)((ntp - 1) * 128 + 32 * j) * HW); }
#pragma unroll
    for (int j = 0; j < 4; ++j) { *(LAS v4u*)(Kl + skoff + 32 * j * SBK_RS) = rk[j]; *(LAS v4u*)(Vl + svoff + 32 * j * SBV_RS) = rv[j]; }
    asm volatile("" :: "v"(qf[0]), "v"(qf[1]), "v"(qf[2]), "v"(qf[3]));
    f32x16 o0, o1;
#pragma unroll
    for (int r = 0; r < 16; ++r) { o0[r] = 0.f; o1[r] = 0.f; }
    float Cc = 1.f;
    const int kap = 16 * ((r32 >> 2) & 1) + (r32 & 3) + 4 * (r32 >> 3);
    const int koff = kap * SBK_RS + 8 * hi;
    const int gi = lane >> 4, i16 = lane & 15;
    const int voff = (16 * hi + (i16 >> 2)) * SBV_RS + 16 * (gi & 1) + (i16 & 3) * 4;
    f32x16 pinit;
#pragma unroll
    for (int r = 0; r < 16; ++r) pinit[r] = bias2;
#define SB_QK(dst, sub) do { const LAS bf16* kp_ = Kc + (sub) * 32 * SBK_RS + koff; bf16x8s kf_[4]; _Pragma("unroll") for (int ks = 0; ks < 4; ++ks) kf_[ks] = *(const LAS bf16x8s*)(kp_ + 16 * ks); \
        dst = mfma32(kf_[0], qf[0], pinit); dst = mfma32(kf_[1], qf[1], dst); dst = mfma32(kf_[2], qf[2], dst); dst = mfma32(kf_[3], qf[3], dst); } while (0)
#define SB_PV(sub) do { const LAS bf16* vb_ = Vc + (sub) * 32 * SBV_RS + voff; \
        const bf16x8s v00 = cat8(tr4(vb_), tr4(vb_ + 4 * SBV_RS)), v01 = cat8(tr4(vb_ + 32), tr4(vb_ + 4 * SBV_RS + 32)); \
        const bf16x8s v10 = cat8(tr4(vb_ + 8 * SBV_RS), tr4(vb_ + 12 * SBV_RS)), v11 = cat8(tr4(vb_ + 8 * SBV_RS + 32), tr4(vb_ + 12 * SBV_RS + 32)); \
        o0 = mfma32(pa[0], v00, o0); o1 = mfma32(pa[0], v01, o1); o0 = mfma32(pa[1], v10, o0); o1 = mfma32(pa[1], v11, o1); } while (0)
    v4u rk2[4], rv2[4];
#define SB_ISSUE(RK, RV, t) do { _Pragma("unroll") for (int j = 0; j < 4; ++j) { RK[j] = *(const v4u*)(gk + (size_t)((t) * 128 + 32 * j) * HW); RV[j] = *(const v4u*)(gv + (size_t)((t) * 128 + 32 * j) * HW); } } while (0)
#define SB_WRITE(RK, RV, bufi) do { _Pragma("unroll") for (int j = 0; j < 4; ++j) { *(LAS v4u*)(Kl + (bufi) * SBK_T + skoff + 32 * j * SBK_RS) = RK[j]; *(LAS v4u*)(Vl + (bufi) * SBV_T + svoff + 32 * j * SBV_RS) = RV[j]; } } while (0)
#define SB_TILE(T, bufi) do { \
        const LAS bf16* Kc = Kl + (bufi) * SBK_T; const LAS bf16* Vc = Vl + (bufi) * SBV_T; \
        const int top = sd - 4 * (T); \
        if (top >= 0) { \
            const int hs = top < 3 ? top : 3; \
            f32x16 pc, pn; bf16x8s pa[2]; \
            if (hs == 3) SB_QK(pc, 3); else if (hs == 2) SB_QK(pc, 2); else if (hs == 1) SB_QK(pc, 1); else SB_QK(pc, 0); \
            _Pragma("unroll") for (int sub = 3; sub >= 0; --sub) { \
                if (sub <= hs) { \
                    if (sub > 0) SB_QK(pn, sub - 1); \
                    const int key0 = 128 * (T) + 32 * sub + 16 * hi; \
                    if (sub == top) sb_weights<true>(pc, key0, qpos, hi, Cc, pa); else sb_weights<false>(pc, key0, qpos, hi, Cc, pa); \
                    SB_PV(sub); \
                    if (sub > 0) pc = pn; \
                } } } } while (0)
    SB_ISSUE(rk2, rv2, ntp - 2);
    grp4_barrier(gcnt, gtarget, lane);
    for (int k = 0; k < ntp; k += 2) {
        { const int ti = ntp - 3 - k; SB_ISSUE(rk, rv, (ti > 0 ? ti : 0)); }
        SB_TILE(ntp - 1 - k, 0);
        SB_WRITE(rk2, rv2, 1);
        grp4_barrier(gcnt, gtarget, lane);
        { const int ti = ntp - 4 - k; SB_ISSUE(rk2, rv2, (ti > 0 ? ti : 0)); }
        SB_TILE(ntp - 2 - k, 1);
        SB_WRITE(rk, rv, 0);
        grp4_barrier(gcnt, gtarget, lane);
    }
#undef SB_ISSUE
#undef SB_WRITE
#undef SB_TILE
#undef SB_QK
#undef SB_PV
    bf16* orow = OMIX + (size_t)(b * SEQ + qlo) * DM + HW + h * HD + r32;
#pragma unroll
    for (int r = 0; r < 16; ++r) { const int q = sb_crow(r, hi); orow[(size_t)q * DM] = f2bf(o0[r]); orow[(size_t)q * DM + 32] = f2bf(o1[r]); }
}
__device__ __forceinline__ void sb_prompt_role(const Ctx& C, volatile LAS unsigned* gcnt, unsigned rep) {
    const int G = gridDim.x, bid = blockIdx.x;
    const int vcu = (G % 8 == 0) ? (bid % 8) * (G / 8) + bid / 8 : bid;
    unsigned gtarget = rep * 4u * 2u * 68u;
    for (int p = vcu; p < NBATCH * NH * 32; p += G) {
        const int bh = p >> 5, s = p & 31;
        sb_unit4(C, bh >> 3, bh & 7, 63 - s, gcnt, gtarget);
        sb_unit4(C, bh >> 3, bh & 7, s, gcnt, gtarget);
    }
}
__device__ __forceinline__ void sbs_item4(const Ctx& C, int n, int half) {
    const bf16* SQ = (const bf16*)(C.ws + WS_SQ); const bf16* SK = (const bf16*)(C.ws + WS_SK); const bf16* SV = (const bf16*)(C.ws + WS_SV);
    const float* ck = (const float*)C.in[I_CK]; const float* cv = (const float*)C.in[I_CV]; const int* pt = (const int*)C.in[I_PT];
    float* PO = (float*)(C.ws + WS_SBP); float* PC = PO + (size_t)NDEC * 2 * NH * TDEC * HD;
    const int lane = C.lane, r32 = lane & 31, hi = lane >> 5, ws = C.wave - 4, h0 = 2 * ws;
    LAS bf16* Kt = (LAS bf16*)(C.lds + RING_OFF + 2 * (SBK_T + SBV_T) * 2) + ws * (2 * 32 * SB_RS); LAS bf16* Vt = Kt + 32 * SB_RS;
    const int qpos = PAST + r32;
    bf16x8s qf[2][4]; float bias2[2];
#pragma unroll
    for (int a = 0; a < 2; ++a) { bias2[a] = ((const float*)C.in[I_SBB])[h0 + a] * LOG2E;
#pragma unroll
        for (int ks = 0; ks < 4; ++ks) { qf[a][ks] = (bf16x8s){0, 0, 0, 0, 0, 0, 0, 0}; if (r32 < TDEC) qf[a][ks] = *(const bf16x8s*)(SQ + (size_t)(MP + n * TDEC + r32) * HW + (h0 + a) * HD + 16 * ks + 8 * hi); } }
    f32x16 o0[2], o1[2]; float Cc[2] = {1.f, 1.f};
#pragma unroll
    for (int a = 0; a < 2; ++a)
#pragma unroll
        for (int r = 0; r < 16; ++r) { o0[a][r] = 0.f; o1[a][r] = 0.f; }
    const int kap = 16 * ((r32 >> 2) & 1) + (r32 & 3) + 4 * (r32 >> 3);
    const LAS bf16* Kp = Kt + kap * SB_RS + 8 * hi;
    const int gi = lane >> 4, i16 = lane & 15;
    const LAS bf16* Vp = Vt + (16 * hi + (i16 >> 2)) * SB_RS + 16 * (gi & 1) + (i16 & 3) * 4;
    const int srow = lane >> 4, sch = lane & 15;
    if (half == 1) {
#pragma unroll
        for (int a = 0; a < 2; ++a) {
#pragma unroll
            for (int it = 0; it < 8; ++it) { const int row = it * 4 + srow; v2u kw = {0u, 0u}, vw = {0u, 0u};
                if (row < TDEC) { kw = *(const v2u*)(SK + (size_t)(MP + n * TDEC + row) * HW + (h0 + a) * HD + sch * 4); vw = *(const v2u*)(SV + (size_t)(MP + n * TDEC + row) * HW + (h0 + a) * HD + sch * 4); }
                *(LAS v2u*)(Kt + row * SB_RS + sch * 4) = kw; *(LAS v2u*)(Vt + row * SB_RS + sch * 4) = vw; }
            LDS_WAIT();
            sb_subtile(Kp, Vp, qf[a], bias2[a], true, PAST + 16 * hi, qpos, hi, Cc[a], o0[a], o1[a]);
            LDS_WAIT();
        }
    }
    const int pg_hi = half ? NPAGES - 1 : NPAGES / 2 - 1, nsteps = (NPAGES / 2) * 4 * 2;
    f32x4 rk[8], rv[8];
    { const size_t base = (((size_t)pt[n * NPAGES + pg_hi] * PAGE + 96 + srow) * NH + h0) * HD + sch * 4;
#pragma unroll
      for (int it = 0; it < 8; ++it) { rk[it] = *(const f32x4*)(ck + base + (size_t)it * 4 * NH * HD); rv[it] = *(const f32x4*)(cv + base + (size_t)it * 4 * NH * HD); } }
    for (int st = 0; st < nsteps; st += 2) {
#pragma unroll
        for (int a = 0; a < 2; ++a) {
#pragma unroll
            for (int it = 0; it < 8; ++it) { const int row = it * 4 + srow;
                const v2u kw = {pk_bf16(rk[it].x, rk[it].y), pk_bf16(rk[it].z, rk[it].w)}, vw = {pk_bf16(rv[it].x, rv[it].y), pk_bf16(rv[it].z, rv[it].w)};
                *(LAS v2u*)(Kt + row * SB_RS + sch * 4) = kw; *(LAS v2u*)(Vt + row * SB_RS + sch * 4) = vw; }
            const int s2 = st + a + 1;
            if (s2 < nsteps) { const int sg = s2 >> 1, pg = pg_hi - (sg >> 2), sub = 3 - (sg & 3);
                const size_t base = (((size_t)pt[n * NPAGES + pg] * PAGE + 32 * sub + srow) * NH + h0 + (s2 & 1)) * HD + sch * 4;
#pragma unroll
                for (int it = 0; it < 8; ++it) { rk[it] = *(const f32x4*)(ck + base + (size_t)it * 4 * NH * HD); rv[it] = *(const f32x4*)(cv + base + (size_t)it * 4 * NH * HD); } }
            LDS_WAIT();
            sb_subtile(Kp, Vp, qf[a], bias2[a], false, 0, qpos, hi, Cc[a], o0[a], o1[a]);
            LDS_WAIT();
        }
    }
#pragma unroll
    for (int a = 0; a < 2; ++a) {
        float* po = PO + ((size_t)(n * 2 + half) * NH + h0 + a) * TDEC * HD;
#pragma unroll
        for (int r = 0; r < 4; ++r) { po[(r + 4 * hi) * HD + r32] = o0[a][r]; po[(r + 4 * hi) * HD + 32 + r32] = o1[a][r]; }
        if (lane < TDEC) PC[((size_t)(n * 2 + half) * NH + h0 + a) * TDEC + lane] = Cc[a];
    }
}
__device__ __forceinline__ void sbs_role(const Ctx& C) {
    for (int it = blockIdx.x; it < NDEC * 2; it += gridDim.x) sbs_item4(C, it >> 1, it & 1);
}
__device__ __forceinline__ void sbs_combine(const Ctx& C) {
    const float* PO = (const float*)(C.ws + WS_SBP); const float* PC = PO + (size_t)NDEC * 2 * NH * TDEC * HD; bf16* OMIX = (bf16*)(C.ws + WS_OMIX);
    const int gt = C.gw * 64 + C.lane, ngt = C.ngw * 64;
    for (int e = gt; e < NDEC * NH * TDEC * HD; e += ngt) {
        const int d = e & 63, q = (e >> 6) & 7, h = (e >> 9) & 7, n = e >> 12;
        const size_t i1 = ((size_t)(n * 2 + 1) * NH + h) * TDEC + q, i0 = ((size_t)(n * 2) * NH + h) * TDEC + q;
        OMIX[(size_t)(MP + n * TDEC + q) * DM + HW + h * HD + d] = f2bf(PO[i1 * HD + d] + PC[i1] * PO[i0 * HD + d]);
    }
}
constexpr int CA_KRS = 264, CA_VRS = 288;
constexpr int CA_KT = 64 * CA_KRS, CA_VT = 64 * CA_VRS;
__device__ __forceinline__ void ca_unit(const Ctx& C, int b, int hh, int qblk) {
    const bf16* QCA = (const bf16*)(C.ws + WS_QCA); const bf16* MK = (const bf16*)(C.ws + WS_MK); const bf16* MV = (const bf16*)(C.ws + WS_MV); bf16* OCA = (bf16*)(C.ws + WS_OMIX);
    const int tid = C.tid, lane = C.lane, r32 = lane & 31, hi = lane >> 5, w = C.wave, gi = lane >> 4, i16 = lane & 15;
    LAS bf16* Kl = (LAS bf16*)(C.lds + RING_OFF); LAS bf16* Vl = Kl + 2 * CA_KT; LAS float* wsf = (LAS float*)(Vl + 2 * CA_VT) + w * 32;
    const size_t qrow = (size_t)b * SEQ + 256 * qblk + 32 * w;
    bf16x8s qf[16];
#pragma unroll
    for (int ks = 0; ks < 16; ++ks) qf[ks] = *(const bf16x8s*)(QCA + (qrow + r32) * DM + hh * CAD + 16 * ks + 8 * hi);
    const bf16* gk = MK + (size_t)(b * NMEM) * DM + hh * CAD; const bf16* gv = MV + (size_t)(b * NMEM) * DM + hh * CAD;
    v4u rg[4];
#define CA_LOAD(i) do { const bf16* src_ = ((i) < 4 ? gk : gv) + (size_t)(((i) & 3) * 64) * DM; _Pragma("unroll") for (int p_ = 0; p_ < 4; ++p_) { const int id_ = tid + 512 * p_; rg[p_] = *(const v4u*)(src_ + (size_t)(id_ >> 5) * DM + (id_ & 31) * 8); } } while (0)
#define CA_WRITE(i) do { _Pragma("unroll") for (int p_ = 0; p_ < 4; ++p_) { const int id_ = tid + 512 * p_; if ((i) < 4) *(LAS v4u*)(Kl + ((i) & 1) * CA_KT + (id_ >> 5) * CA_KRS + (id_ & 31) * 8) = rg[p_]; else *(LAS v4u*)(Vl + ((i) & 1) * CA_VT + (id_ >> 5) * CA_VRS + (id_ & 31) * 8) = rg[p_]; } } while (0)
    CA_LOAD(0); CA_WRITE(0); __syncthreads();
    f32x16 s[8];
#pragma unroll
    for (int j = 0; j < 8; ++j)
#pragma unroll
        for (int r = 0; r < 16; ++r) s[j][r] = 0.f;
#pragma unroll
    for (int kt = 0; kt < 4; ++kt) {
        if (kt < 3) CA_LOAD(kt + 1);
        const LAS bf16* Kc = Kl + (kt & 1) * CA_KT + r32 * CA_KRS + 8 * hi;
#pragma unroll
        for (int sub = 0; sub < 2; ++sub)
#pragma unroll
            for (int ks = 0; ks < 16; ++ks) { const bf16x8s kf = *(const LAS bf16x8s*)(Kc + sub * 32 * CA_KRS + 16 * ks); s[2 * kt + sub] = mfma32(kf, qf[ks], s[2 * kt + sub]); }
        if (kt < 3) { CA_WRITE(kt + 1); } __syncthreads();
    }
    float mx = s[0][0];
#pragma unroll
    for (int j = 0; j < 8; ++j)
#pragma unroll
        for (int r = 0; r < 16; ++r) mx = fmaxf(mx, s[j][r]);
    mx = fmaxf(mx, __shfl_xor(mx, 32));
    float l = 0.f;
#pragma unroll
    for (int j = 0; j < 8; ++j)
#pragma unroll
        for (int r = 0; r < 16; ++r) { s[j][r] = __builtin_amdgcn_exp2f(s[j][r] - mx); l += s[j][r]; }
    l += __shfl_xor(l, 32);
    if (hi == 0) wsf[r32] = l;
    bf16x8s pa[8][2];
#pragma unroll
    for (int j = 0; j < 8; ++j)
#pragma unroll
        for (int s2 = 0; s2 < 2; ++s2) { const v4u ww = {pk_bf16(s[j][8 * s2], s[j][8 * s2 + 1]), pk_bf16(s[j][8 * s2 + 2], s[j][8 * s2 + 3]), pk_bf16(s[j][8 * s2 + 4], s[j][8 * s2 + 5]), pk_bf16(s[j][8 * s2 + 6], s[j][8 * s2 + 7])}; pa[j][s2] = __builtin_bit_cast(bf16x8s, ww); }
    CA_LOAD(4); CA_WRITE(4); __syncthreads();
    f32x16 o[8];
#pragma unroll
    for (int j = 0; j < 8; ++j)
#pragma unroll
        for (int r = 0; r < 16; ++r) o[j][r] = 0.f;
#pragma unroll
    for (int kt = 0; kt < 4; ++kt) {
        if (kt >= 1 && kt < 3) CA_LOAD(kt + 5);
        const LAS bf16* Vc = Vl + (kt & 1) * CA_VT + (4 * hi + (i16 >> 2)) * CA_VRS + 16 * (gi & 1) + (i16 & 3) * 4;
#pragma unroll
        for (int sub = 0; sub < 2; ++sub)
#pragma unroll
            for (int s2 = 0; s2 < 2; ++s2)
#pragma unroll
                for (int dt = 0; dt < 8; ++dt) { const LAS bf16* vb = Vc + (32 * sub + 16 * s2) * CA_VRS + 32 * dt; const bf16x8s vf = cat8(tr4(vb), tr4(vb + 8 * CA_VRS)); o[dt] = mfma32(pa[2 * kt + sub][s2], vf, o[dt]); }
        if (kt == 0) CA_LOAD(5);
        if (kt < 3) { CA_WRITE(kt + 5); }
        __syncthreads();
    }
#undef CA_LOAD
#undef CA_WRITE
    float rl[16];
#pragma unroll
    for (int r = 0; r < 16; ++r) rl[r] = 1.f / wsf[sb_crow(r, hi)];
    bf16* orow = OCA + qrow * DM + hh * CAD + r32;
#pragma unroll
    for (int r = 0; r < 16; ++r) { const int q = sb_crow(r, hi);
#pragma unroll
        for (int dt = 0; dt < 8; ++dt) orow[(size_t)q * DM + 32 * dt] = f2bf(o[dt][r] * rl[r]); }
}
__device__ __forceinline__ void cas_item(const Ctx& C, int n, int hh) {
    const bf16* QCA = (const bf16*)(C.ws + WS_QCA); const float* cmk = (const float*)C.in[I_MK]; const float* cmv = (const float*)C.in[I_MV]; bf16* OCA = (bf16*)(C.ws + WS_OMIX);
    const int tid = C.tid, lane = C.lane, r32 = lane & 31, hi = lane >> 5, w = C.wave, gi = lane >> 4, i16 = lane & 15;
    LAS bf16* Vt = (LAS bf16*)(C.lds + RING_OFF) + w * (32 * CA_VRS);
    LAS float* part = (LAS float*)(C.lds + RING_OFF);
    LAS float* red = (LAS float*)(C.lds + RING_OFF + 8 * 32 * CA_VRS * 2);
    bf16x8s qf[16];
#pragma unroll
    for (int ks = 0; ks < 16; ++ks) { qf[ks] = (bf16x8s){0, 0, 0, 0, 0, 0, 0, 0}; if (r32 < TDEC) qf[ks] = *(const bf16x8s*)(QCA + (size_t)(MP + n * TDEC + r32) * DM + hh * CAD + 16 * ks + 8 * hi); }
    f32x16 s;
#pragma unroll
    for (int r = 0; r < 16; ++r) s[r] = 0.f;
    const float* kr = cmk + ((size_t)(n * NMEM + 32 * w + r32) * CAH + hh) * CAD + 8 * hi;
#pragma unroll
    for (int kb = 0; kb < 2; ++kb) {
        f32x4 ra[8], rb[8];
#pragma unroll
        for (int k8 = 0; k8 < 8; ++k8) { ra[k8] = *(const f32x4*)(kr + 16 * (8 * kb + k8)); rb[k8] = *(const f32x4*)(kr + 16 * (8 * kb + k8) + 4); }
#pragma unroll
        for (int k8 = 0; k8 < 8; ++k8) { const v4u ww = {pk_bf16(ra[k8].x, ra[k8].y), pk_bf16(ra[k8].z, ra[k8].w), pk_bf16(rb[k8].x, rb[k8].y), pk_bf16(rb[k8].z, rb[k8].w)};
            s = mfma32(__builtin_bit_cast(bf16x8s, ww), qf[8 * kb + k8], s); }
    }
    const float* vr = cmv + ((size_t)(n * NMEM + 32 * w) * CAH + hh) * CAD + lane * 4;
#pragma unroll
    for (int vb = 0; vb < 2; ++vb) {
        f32x4 rvv[16];
#pragma unroll
        for (int j = 0; j < 16; ++j) rvv[j] = *(const f32x4*)(vr + (size_t)(16 * vb + j) * CAH * CAD);
#pragma unroll
        for (int j = 0; j < 16; ++j) { const v2u ww = {pk_bf16(rvv[j].x, rvv[j].y), pk_bf16(rvv[j].z, rvv[j].w)}; *(LAS v2u*)(Vt + (16 * vb + j) * CA_VRS + lane * 4) = ww; }
    }
    float mx = s[0];
#pragma unroll
    for (int r = 1; r < 16; ++r) mx = fmaxf(mx, s[r]);
    mx = fmaxf(mx, __shfl_xor(mx, 32));
    if (lane < TDEC) red[w * TDEC + lane] = mx;
    LDS_WAIT(); __syncthreads();
    { float m2 = red[(r32 & 7)];
#pragma unroll
      for (int ww = 1; ww < 8; ++ww) m2 = fmaxf(m2, red[ww * TDEC + (r32 & 7)]);
      mx = m2; }
    float l = 0.f;
#pragma unroll
    for (int r = 0; r < 16; ++r) { s[r] = __builtin_amdgcn_exp2f(s[r] - mx); l += s[r]; }
    l += __shfl_xor(l, 32);
    if (lane < TDEC) red[64 + w * TDEC + lane] = l;
    bf16x8s pa[2];
#pragma unroll
    for (int s2 = 0; s2 < 2; ++s2) { const v4u ww = {pk_bf16(s[8 * s2], s[8 * s2 + 1]), pk_bf16(s[8 * s2 + 2], s[8 * s2 + 3]), pk_bf16(s[8 * s2 + 4], s[8 * s2 + 5]), pk_bf16(s[8 * s2 + 6], s[8 * s2 + 7])}; pa[s2] = __builtin_bit_cast(bf16x8s, ww); }
    LDS_WAIT();
    f32x16 o[8];
#pragma unroll
    for (int j = 0; j < 8; ++j)
#pragma unroll
        for (int r = 0; r < 16; ++r) o[j][r] = 0.f;
    const LAS bf16* Vc = Vt + (4 * hi + (i16 >> 2)) * CA_VRS + 16 * (gi & 1) + (i16 & 3) * 4;
#pragma unroll
    for (int s2 = 0; s2 < 2; ++s2)
#pragma unroll
        for (int dt = 0; dt < 8; ++dt) { const LAS bf16* vb = Vc + 16 * s2 * CA_VRS + 32 * dt; const bf16x8s vf = cat8(tr4(vb), tr4(vb + 8 * CA_VRS)); o[dt] = mfma32(pa[s2], vf, o[dt]); }
    LDS_WAIT(); __syncthreads();
#pragma unroll
    for (int r = 0; r < 4; ++r)
#pragma unroll
        for (int dt = 0; dt < 8; ++dt) part[(w * TDEC + r + 4 * hi) * CAD + 32 * dt + r32] = o[dt][r];
    LDS_WAIT(); __syncthreads();
    { const int q = tid >> 6, d0 = (tid & 63) * 4;
      float lt = 0.f;
#pragma unroll
      for (int ww = 0; ww < 8; ++ww) lt += red[64 + ww * TDEC + q];
      f32x4 a = {0.f, 0.f, 0.f, 0.f};
#pragma unroll
      for (int ww = 0; ww < 8; ++ww) a += *(const LAS f32x4*)(part + (ww * TDEC + q) * CAD + d0);
      const float il = 1.f / lt; const v2u ow = {pk_bf16(a.x * il, a.y * il), pk_bf16(a.z * il, a.w * il)};
      *(v2u*)(OCA + (size_t)(MP + n * TDEC + q) * DM + hh * CAD + d0) = ow; }
    LDS_WAIT(); __syncthreads();
}
__device__ __forceinline__ void ca_phase(const Ctx& C) {
    for (int it = blockIdx.x; it < NDEC * CAH; it += gridDim.x) cas_item(C, it >> 2, it & 3);
    const int G = gridDim.x, bid = blockIdx.x; const int vcu = (G % 8 == 0) ? (bid % 8) * (G / 8) + bid / 8 : bid;
    for (int u = vcu; u < NBATCH * CAH * 32; u += G) ca_unit(C, u >> 7, (u >> 5) & 3, u & 31);
}
__device__ __forceinline__ void hgrn_chain(const Ctx& C, int rowbase, int T, int h, const float* S0, float* Sout) {
    const float* LF = (const float*)(C.ws + WS_LF); const bf16* QH = (const bf16*)(C.ws + WS_QH); const bf16* VH = (const bf16*)(C.ws + WS_VH); const bf16* GH = (const bf16*)(C.ws + WS_GH);
    bf16* OMIX = (bf16*)(C.ws + WS_OMIX); const float* hgn = (const float*)C.in[I_HGN];
    const int lane = C.lane; const float gn = hgn[h * HD + lane];
    float S[64];
#pragma unroll
    for (int k = 0; k < 64; ++k) S[k] = S0 ? S0[k * 64 + lane] : 0.f;
    for (int t = 0; t < T; ++t) {
        const size_t off = (size_t)(rowbase + t) * HW + h * HD + lane;
        const float fk = __expf(LF[off]), kk = 1.f - fk, qk = bf2f(QH[off]), vd = bf2f(VH[off]), g = bf2f(GH[off]);
        float o = 0.f;
#pragma unroll
        for (int k = 0; k < 64; ++k) { const float f_ = rdlane(fk, k), k_ = rdlane(kk, k), q_ = rdlane(qk, k); S[k] = f_ * S[k] + k_ * vd; o += S[k] * q_; }
        const float r = rsqrtf(wave_sum(o * o) * (1.f / HD) + RMS_EPS);
        OMIX[(size_t)(rowbase + t) * DM + h * HD + lane] = f2bf(o * r * gn * (g / (1.f + __expf(-g))));
    }
#pragma unroll
    for (int k = 0; k < 64; ++k) Sout[k * 64 + lane] = S[k];
}
template <bool SAMPLE>
__device__ __forceinline__ void sb_query(const Ctx& C, int row, int h, int nkeys, int seq  ) {
    const bf16* SQ = (const bf16*)(C.ws + WS_SQ); const bf16* SK = (const bf16*)(C.ws + WS_SK); const bf16* SV = (const bf16*)(C.ws + WS_SV);
    const float* ck = (const float*)C.in[I_CK]; const float* cv = (const float*)C.in[I_CV]; const int* pt = (const int*)C.in[I_PT];
    bf16* OMIX = (bf16*)(C.ws + WS_OMIX);
    const int lane = C.lane; const float bias2 = ((const float*)C.in[I_SBB])[h] * LOG2E;
    float q[64];
    { const v4u* qp = (const v4u*)(SQ + (size_t)row * HW + h * HD);
#pragma unroll
      for (int c = 0; c < 8; ++c) { const v4u w = qp[c]; q[8 * c] = bflo(w.x); q[8 * c + 1] = bfhi(w.x); q[8 * c + 2] = bflo(w.y); q[8 * c + 3] = bfhi(w.y); q[8 * c + 4] = bflo(w.z); q[8 * c + 5] = bfhi(w.z); q[8 * c + 6] = bflo(w.w); q[8 * c + 7] = bfhi(w.w); } }
    float Cc = 1.f, o = 0.f;
    for (int base = nkeys > 0 ? ((nkeys - 1) & ~63) : -1; base >= 0; base -= 64) {
        const int j = base + lane; const bool valid = j < nkeys; const int jc = valid ? j : nkeys - 1;
        float z = 0.f;
        if (SAMPLE && jc < PAST) {
            const float* kr = ck + (((size_t)pt[seq * NPAGES + (jc >> 7)] * PAGE + (jc & 127)) * NH + h) * HD;
#pragma unroll
            for (int c = 0; c < 16; ++c) { const f32x4 w = ((const f32x4*)kr)[c]; z += q[4 * c] * w.x + q[4 * c + 1] * w.y + q[4 * c + 2] * w.z + q[4 * c + 3] * w.w; }
        } else {
            const size_t krow = SAMPLE ? (size_t)(MP + seq * TDEC + (jc - PAST)) : (size_t)seq * SEQ + jc;
            const v4u* kr = (const v4u*)(SK + krow * HW + h * HD);
#pragma unroll
            for (int c = 0; c < 8; ++c) { const v4u w = kr[c]; z += q[8 * c] * bflo(w.x) + q[8 * c + 1] * bfhi(w.x) + q[8 * c + 2] * bflo(w.y) + q[8 * c + 3] * bfhi(w.y) + q[8 * c + 4] * bflo(w.z) + q[8 * c + 5] * bfhi(w.z) + q[8 * c + 6] * bflo(w.w) + q[8 * c + 7] * bfhi(w.w); }
        }
        const float u = valid ? exp2f(z + bias2) : 0.f;
        float incl = 1.f / (1.f + u);
#pragma unroll
        for (int off = 1; off < 64; off <<= 1) { const float y = __shfl_down(incl, off); if (lane + off < 64) incl *= y; }
        const float a = u * incl * Cc;
        Cc *= __shfl(incl, 0);
        const int nk = nkeys - base < 64 ? nkeys - base : 64;
        for (int jj = 0; jj < nk; ++jj) {
            const float aj = __shfl(a, jj); const int jk = base + jj; float vv;
            if (SAMPLE && jk < PAST) vv = cv[(((size_t)pt[seq * NPAGES + (jk >> 7)] * PAGE + (jk & 127)) * NH + h) * HD + lane];
            else { const size_t vrow = SAMPLE ? (size_t)(MP + seq * TDEC + (jk - PAST)) : (size_t)seq * SEQ + jk; vv = bf2f(SV[vrow * HW + h * HD + lane]); }
            o += aj * vv;
        }
    }
    OMIX[(size_t)row * DM + HW + h * HD + lane] = f2bf(o);
}
__device__ __forceinline__ void p2_mix1(const Ctx& C) {
    for (int cid = C.gw; cid < NBATCH * NH * (SEQ / 64); cid += C.ngw) hgrn_h1(C, cid);
    const int w = C.gw, nw = C.ngw;
    for (int i = w; i < NDEC * NH; i += nw) { const int n = i / NH, h = i % NH; hgrn_chain(C, MP + n * TDEC, TDEC, h, (const float*)C.in[I_SH] + (size_t)i * 4096, C.out + O_HS + (size_t)i * 4096); }
    volatile LAS unsigned* gcnt = (volatile LAS unsigned*)(C.lds + MISC_OFF) + 16;
    if (C.tid == 0) *gcnt = 0u;
    LDS_WAIT(); __syncthreads();
    if (C.wave < 4) { sb_prompt_role(C, gcnt, 0u); if constexpr (PROBE_PH == 120) sb_prompt_role(C, gcnt, 1u); } else { sbs_role(C); if constexpr (PROBE_PH == 121) sbs_role(C); }
    __syncthreads();
}
__device__ __forceinline__ void p4_mix3(const Ctx& C) {
    for (int cid = C.gw; cid < NBATCH * NH * (SEQ / 64); cid += C.ngw) hgrn_h3(C, cid);
}


__device__ __forceinline__ void mini_gemm(const Ctx& C, const bf16* A, const bf16* Bt, int K, bf16* O, int ldo, float scale) {
    const int tile = blockIdx.x; if (tile >= 256) return;
    const int lane = C.lane, i = lane & 15, g = lane >> 4, w = C.wave, tid = C.tid;
    const int r0 = (tile >> 4) * 64, c0 = (tile & 15) * 64, kw = K >> 3, kb = w * kw;
    const bf16* ap = A + (size_t)(r0 + i) * K + kb + 8 * g; const bf16* bp = Bt + (size_t)(c0 + i) * K + kb + 8 * g;
    f32x4 acc[4][4];
#pragma unroll
    for (int mt = 0; mt < 4; ++mt)
#pragma unroll
        for (int nt = 0; nt < 4; ++nt) acc[mt][nt] = (f32x4){0.f, 0.f, 0.f, 0.f};
    for (int k0 = 0; k0 < kw; k0 += 32) {
        bf16x8s af[4], bfr[4];
#pragma unroll
        for (int t = 0; t < 4; ++t) { af[t] = *(const bf16x8s*)(ap + (size_t)(16 * t) * K + k0); bfr[t] = *(const bf16x8s*)(bp + (size_t)(16 * t) * K + k0); }
#pragma unroll
        for (int mt = 0; mt < 4; ++mt)
#pragma unroll
            for (int nt = 0; nt < 4; ++nt) acc[mt][nt] = mfma16(bfr[nt], af[mt], acc[mt][nt]);
    }
    LAS float* part = (LAS float*)(C.lds + RING_OFF) + w * 4096;
#pragma unroll
    for (int mt = 0; mt < 4; ++mt)
#pragma unroll
        for (int nt = 0; nt < 4; ++nt) *(LAS f32x4*)(part + (16 * mt + i) * 64 + 16 * nt + 4 * g) = acc[mt][nt];
    LDS_WAIT(); __syncthreads();
    { const int row = tid >> 3, cc = (tid & 7) * 8; const LAS float* p = (const LAS float*)(C.lds + RING_OFF) + row * 64 + cc;
      f32x4 s0 = {0.f, 0.f, 0.f, 0.f}, s1 = {0.f, 0.f, 0.f, 0.f};
#pragma unroll
      for (int ww = 0; ww < 8; ++ww) { s0 += *(const LAS f32x4*)(p + ww * 4096); s1 += *(const LAS f32x4*)(p + ww * 4096 + 4); }
      const v4u o = {pk_bf16(s0.x * scale, s0.y * scale), pk_bf16(s0.z * scale, s0.w * scale), pk_bf16(s1.x * scale, s1.y * scale), pk_bf16(s1.z * scale, s1.w * scale)};
      *(v4u*)(O + (size_t)(r0 + row) * ldo + c0 + cc) = o; }
    LDS_WAIT(); __syncthreads();
}
__device__ __forceinline__ void thin_row(const float* xin, const bf16* br, const float* gpost, float* xout, const float* gpre, bf16* hrow, int lane) {
    const f32x4* xr = (const f32x4*)xin + lane; const v2u* bp = (const v2u*)br + lane; const f32x4* gp = (const f32x4*)gpost + lane;
    f32x4 b[4]; float s = 0.f;
#pragma unroll
    for (int j = 0; j < 4; ++j) { const v2u w = bp[64 * j]; b[j] = (f32x4){bflo(w.x), bfhi(w.x), bflo(w.y), bfhi(w.y)}; s += (b[j].x * b[j].x + b[j].y * b[j].y) + (b[j].z * b[j].z + b[j].w * b[j].w); }
    const float r = rsqrtf(wave_sum(s) * (1.f / DM) + RMS_EPS);
    float s2 = 0.f;
#pragma unroll
    for (int j = 0; j < 4; ++j) { b[j] = xr[64 * j] + b[j] * r * gp[64 * j]; s2 += (b[j].x * b[j].x + b[j].y * b[j].y) + (b[j].z * b[j].z + b[j].w * b[j].w); }
    f32x4* xo = (f32x4*)xout + lane;
#pragma unroll
    for (int j = 0; j < 4; ++j) xo[64 * j] = b[j];
    if (hrow) {
        const float r2 = rsqrtf(wave_sum(s2) * (1.f / DM) + RMS_EPS); const f32x4* g2 = (const f32x4*)gpre + lane; v2u* o8 = (v2u*)hrow + lane;
#pragma unroll
        for (int j = 0; j < 4; ++j) { const f32x4 gg = g2[64 * j]; v2u w; w.x = pk_bf16(b[j].x * r2 * gg.x, b[j].y * r2 * gg.y); w.y = pk_bf16(b[j].z * r2 * gg.z, b[j].w * r2 * gg.w); o8[64 * j] = w; }
    }
}
template <int WHICH>
__device__ __forceinline__ void p_thin(const Ctx& C) {
    const bf16* BR = (const bf16*)(C.ws + WS_BR); bf16* H = (bf16*)(C.ws + WS_H);
    float* X1 = (float*)(C.ws + WS_X1); float* X2 = (float*)(C.ws + WS_X2);
    const float* gpost = (const float*)C.in[WHICH == 0 ? I_GMIXPOST : WHICH == 1 ? I_GCAPOST : I_GFFNPOST];
    const float* gpre = (const float*)C.in[WHICH == 0 ? I_GCAPRE : I_GFFNPRE];
    for (int m = C.gw; m < MT; m += C.ngw) {
        const float* xin; float* xout;
        if (WHICH == 0) { xin = m < MP ? (const float*)C.in[I_XP] + (size_t)m * DM : (const float*)C.in[I_XS] + (size_t)(m - MP) * DM; xout = X1 + (size_t)m * DM; }
        else if (WHICH == 1) { xin = X1 + (size_t)m * DM; xout = X2 + (size_t)m * DM; }
        else { xin = X2 + (size_t)m * DM; xout = m < MP ? C.out + O_YP + (size_t)m * DM : C.out + O_YS + (size_t)(m - MP) * DM; }
        thin_row(xin, BR + (size_t)m * DM, gpost, xout, gpre, WHICH == 2 ? nullptr : H + (size_t)m * DM, C.lane);
    }
}

__device__ __forceinline__ void p6_naive(const Ctx& C) {
    const bf16* QCA = (const bf16*)(C.ws + WS_QCA); const bf16* MK = (const bf16*)(C.ws + WS_MK); const bf16* MV = (const bf16*)(C.ws + WS_MV);
    const float* cmk = (const float*)C.in[I_MK]; const float* cmv = (const float*)C.in[I_MV]; bf16* OCA = (bf16*)(C.ws + WS_OMIX);
    const int lane = C.lane;
    for (int it = C.gw; it < MT * CAH; it += C.ngw) {
        const int row = it >> 2, h = it & 3;
        const v2u qw = *((const v2u*)(QCA + (size_t)row * DM + h * CAD) + lane);
        const float q0 = bflo(qw.x), q1 = bfhi(qw.x), q2 = bflo(qw.y), q3 = bfhi(qw.y);
        float mx = -1e30f, l = 0.f, o0 = 0.f, o1 = 0.f, o2 = 0.f, o3 = 0.f;
        for (int m = 0; m < NMEM; ++m) {
            float k0, k1, k2, k3, v0, v1, v2, v3;
            if (row < MP) { const size_t off = ((size_t)((row >> 13) * NMEM + m)) * DM + h * CAD; const v2u kw = *((const v2u*)(MK + off) + lane), vw = *((const v2u*)(MV + off) + lane);
                k0 = bflo(kw.x); k1 = bfhi(kw.x); k2 = bflo(kw.y); k3 = bfhi(kw.y); v0 = bflo(vw.x); v1 = bfhi(vw.x); v2 = bflo(vw.y); v3 = bfhi(vw.y); }
            else { const size_t off = ((size_t)(((row - MP) >> 3) * NMEM + m)) * DM + h * CAD; const f32x4 kw = *((const f32x4*)(cmk + off) + lane), vw = *((const f32x4*)(cmv + off) + lane);
                k0 = kw.x; k1 = kw.y; k2 = kw.z; k3 = kw.w; v0 = vw.x; v1 = vw.y; v2 = vw.z; v3 = vw.w; }
            const float s = wave_sum(q0 * k0 + q1 * k1 + q2 * k2 + q3 * k3);
            const float mn = fmaxf(mx, s), sc = exp2f(mx - mn), p = exp2f(s - mn);
            l = l * sc + p; o0 = o0 * sc + p * v0; o1 = o1 * sc + p * v1; o2 = o2 * sc + p * v2; o3 = o3 * sc + p * v3; mx = mn;
        }
        const float il = 1.f / l; v2u w; w.x = pk_bf16(o0 * il, o1 * il); w.y = pk_bf16(o2 * il, o3 * il);
        *((v2u*)(OCA + (size_t)row * DM + h * CAD) + lane) = w;
    }
}

__device__ __forceinline__ float gelu_tanh(float x) { return x / (1.f + __expf(-1.5957691216057308f * (x + 0.044715f * x * x * x))); }
__device__ __forceinline__ void ld8(const bf16* p, float (&v)[8]) { const v4u w = *(const v4u*)p; v[0] = bflo(w.x); v[1] = bfhi(w.x); v[2] = bflo(w.y); v[3] = bfhi(w.y); v[4] = bflo(w.z); v[5] = bfhi(w.z); v[6] = bflo(w.w); v[7] = bfhi(w.w); }
__device__ __forceinline__ void ld8f(const float* p, float (&v)[8]) { const f32x4 a = *(const f32x4*)p, b = *(const f32x4*)(p + 4); v[0] = a.x; v[1] = a.y; v[2] = a.z; v[3] = a.w; v[4] = b.x; v[5] = b.y; v[6] = b.z; v[7] = b.w; }
__device__ __forceinline__ void p10_convgate(const Ctx& C) {
    const bf16* U = (const bf16*)(C.ws + WS_U); bf16* G = (bf16*)(C.ws + WS_G); const float* FIX = (const float*)(C.ws + WS_FIX); const float* UL = (const float*)(C.ws + WS_ULAST);
    const float* cw = (const float*)C.in[I_CONVW]; const float* cb = (const float*)C.in[I_CONVB]; const float* sc = (const float*)C.in[I_SC];
    constexpr int NCH = DFF / 8, NSI = NDEC * NCH, NFX = (MP / 256) * 2 * NCH;
    const int gt = C.gw * 64 + C.lane, ngt = C.ngw * 64;
    for (int it = gt; it < NSI + NFX; it += ngt) {
        if (it < NSI) {
            const int n = it / NCH, c = (it % NCH) * 8, row0 = MP + n * TDEC, cp = 256 * (c >> 7) + (c & 127);
            float m1[2][8], m2[2][8], w0[2][8], w1[2][8], w2[2][8], bb[2][8];
#pragma unroll
            for (int hf = 0; hf < 2; ++hf) { ld8f(sc + ((size_t)n * 2 + 1) * DFF2 + c + hf * DFF, m1[hf]); ld8f(sc + ((size_t)n * 2) * DFF2 + c + hf * DFF, m2[hf]);
                ld8f(cw + c + hf * DFF, w0[hf]); ld8f(cw + DFF2 + c + hf * DFF, w1[hf]); ld8f(cw + 2 * DFF2 + c + hf * DFF, w2[hf]); ld8f(cb + c + hf * DFF, bb[hf]); }
#pragma unroll
            for (int r = 0; r < TDEC; ++r) {
                float u[2][8], res[2][8];
                ld8(U + (size_t)(row0 + r) * DFF2 + cp, u[0]); ld8(U + (size_t)(row0 + r) * DFF2 + cp + 128, u[1]);
#pragma unroll
                for (int hf = 0; hf < 2; ++hf)
#pragma unroll
                    for (int e = 0; e < 8; ++e) { res[hf][e] = bb[hf][e] + w0[hf][e] * m2[hf][e] + w1[hf][e] * m1[hf][e] + w2[hf][e] * u[hf][e]; m2[hf][e] = m1[hf][e]; m1[hf][e] = u[hf][e]; }
                v4u o;
                o.x = pk_bf16(gelu_tanh(res[0][0]) * res[1][0], gelu_tanh(res[0][1]) * res[1][1]); o.y = pk_bf16(gelu_tanh(res[0][2]) * res[1][2], gelu_tanh(res[0][3]) * res[1][3]);
                o.z = pk_bf16(gelu_tanh(res[0][4]) * res[1][4], gelu_tanh(res[0][5]) * res[1][5]); o.w = pk_bf16(gelu_tanh(res[0][6]) * res[1][6], gelu_tanh(res[0][7]) * res[1][7]);
                *(v4u*)(G + (size_t)(row0 + r) * DFF + c) = o;
            }
        } else {
            const int j = it - NSI, pr = j / NCH, c = (j % NCH) * 8, pm = pr >> 1, rr = pr & 1;
            float res[2][8];
#pragma unroll
            for (int hf = 0; hf < 2; ++hf) {
                ld8f(FIX + (size_t)pr * DFF2 + c + hf * DFF, res[hf]);
                if (pm & 31) {
                    float a1[8], w0[8]; ld8f(UL + (size_t)((pm - 1) * 2 + 1) * DFF2 + c + hf * DFF, a1); ld8f(cw + c + hf * DFF, w0);
                    if (rr == 0) { float a2[8], w1[8]; ld8f(UL + (size_t)((pm - 1) * 2) * DFF2 + c + hf * DFF, a2); ld8f(cw + DFF2 + c + hf * DFF, w1);
#pragma unroll
                        for (int e = 0; e < 8; ++e) res[hf][e] += w0[e] * a2[e] + w1[e] * a1[e];
                    } else {
#pragma unroll
                        for (int e = 0; e < 8; ++e) res[hf][e] += w0[e] * a1[e];
                    }
                }
            }
            v4u o;
            o.x = pk_bf16(gelu_tanh(res[0][0]) * res[1][0], gelu_tanh(res[0][1]) * res[1][1]); o.y = pk_bf16(gelu_tanh(res[0][2]) * res[1][2], gelu_tanh(res[0][3]) * res[1][3]);
            o.z = pk_bf16(gelu_tanh(res[0][4]) * res[1][4], gelu_tanh(res[0][5]) * res[1][5]); o.w = pk_bf16(gelu_tanh(res[0][6]) * res[1][6], gelu_tanh(res[0][7]) * res[1][7]);
            *(v4u*)(G + (size_t)(pm * 256 + rr) * DFF + c) = o;
        }
    }
}
enum { PH_PRO = 0, PH_INPROJ, PH_MIX1, PH_SCAN, PH_MIX3, PH_OPROJ, PH_THIN0, PH_CQ, PH_CA, PH_CO, PH_THIN1, PH_UP, PH_CONV, PH_DOWN, PH_THIN2, NPH };
#ifndef MK_ONE_LAUNCH
#define MK_ONE_LAUNCH 1
#endif
__global__ void __launch_bounds__(NTHREADS, 2) fwd(Args args) {
    extern __shared__ __attribute__((aligned(16))) unsigned char lds_raw[];
    Ctx C;
    C.in = args.in; C.out = args.out; C.ws = args.ws; C.lds = (LAS unsigned char*)lds_raw;
    C.tid = threadIdx.x; C.lane = C.tid & 63; C.wave = __builtin_amdgcn_readfirstlane(C.tid >> 6);
    C.gw = blockIdx.x * NWAVES + C.wave; C.ngw = gridDim.x * NWAVES;
    const int G = gridDim.x, bid = blockIdx.x;
    volatile LAS unsigned* MISC = (volatile LAS unsigned*)(C.lds + MISC_OFF);
    for (int u = C.tid; u < (LDS_BYTES - LDSCTL_OFF) / 4; u += NTHREADS) ((LAS unsigned*)(C.lds + LDSCTL_OFF))[u] = 0u;
    __syncthreads();
    const int lo = args.ph_lo, hi = args.ph_hi;
    XcdBarrier bar; bar.bar = (unsigned*)(C.ws + WS_CTL) + CW_BAR; bar.x = 0; bar.st = nullptr;
    bar = xcd_barrier_post((unsigned*)(C.ws + WS_CTL) + CW_BAR, MISC + 8);
#define IN(k) (lo <= (k) && (k) < hi)
#define SEAM(k) do { if (IN(k) && IN((k) + 1)) xcd_barrier(bar); } while (0)
#define PHASE(k, ...) do { if (IN(k)) { __VA_ARGS__ if constexpr (PROBE_PH == (k)) { __VA_ARGS__ } } } while (0)
    bf16* H = (bf16*)(C.ws + WS_H);
    PHASE(PH_PRO, p0_prologue(C);); SEAM(PH_PRO);
    PHASE(PH_INPROJ, { pg8::Gemm g{H, (const bf16*)(C.ws + WS_WIN), MT, DIN, DM}; pg8::StaticOrder S; S.init(MT, DIN, G, bid);
          pg8::EpiInProj E{(bf16*)(C.ws + WS_QH), (bf16*)(C.ws + WS_VH), (bf16*)(C.ws + WS_GH), (bf16*)(C.ws + WS_SQ), (bf16*)(C.ws + WS_SK), (bf16*)(C.ws + WS_SV), (float*)(C.ws + WS_LF),
                           (const float*)(C.ws + WS_LB), C.out + O_KP, C.out + O_VP, C.out + O_KS, C.out + O_VS, SQ_SCALE};
          pg8::gemm_phase<pg8::EpiInProj, pg8::StaticOrder, true, true>(C.lds + RING_OFF, g, S, E); }
        { pg8::Gemm g{(const bf16*)(C.ws + WS_MN), (const bf16*)(C.ws + WS_WCKV), NBATCH * NMEM, 2 * DM, DM}; pg8::StaticOrder S; S.init(NBATCH * NMEM, 2 * DM, G, (bid + G - 184 % G) % G);
          pg8::EpiMemKV E{(bf16*)(C.ws + WS_MK), (bf16*)(C.ws + WS_MV), C.out + O_MKP, C.out + O_MVP};
          pg8::gemm_phase<pg8::EpiMemKV, pg8::StaticOrder, true, true>(C.lds + RING_OFF, g, S, E); }); SEAM(PH_INPROJ);
    PHASE(PH_MIX1, p2_mix1(C);); SEAM(PH_MIX1);
    PHASE(PH_SCAN, hgrn_h2(C); sbs_combine(C);); SEAM(PH_SCAN);
    PHASE(PH_MIX3, p4_mix3(C);); SEAM(PH_MIX3);
    PHASE(PH_OPROJ, pg8::Gemm g{(const bf16*)(C.ws + WS_OMIX), (const bf16*)(C.ws + WS_WO), MP, DM, DM}; pg8::StaticOrder S; S.init(MP, DM, G, bid);
        pg8::EpiStore<false> E{(bf16*)(C.ws + WS_BR), DM, 1.f, nullptr};
        pg8::gemm_phase<pg8::EpiStore<false>, pg8::StaticOrder, true, true>(C.lds + RING_OFF, g, S, E);
        mini_gemm(C, (const bf16*)(C.ws + WS_OMIX) + (size_t)MP * DM, (const bf16*)(C.ws + WS_WO), DM, (bf16*)(C.ws + WS_BR) + (size_t)MP * DM, DM, 1.f);); SEAM(PH_OPROJ);
    PHASE(PH_THIN0, p_thin<0>(C);); SEAM(PH_THIN0);
    PHASE(PH_CQ, pg8::Gemm g{H, (const bf16*)(C.ws + WS_WCQ), MP, DM, DM}; pg8::StaticOrder S; S.init(MP, DM, G, bid);
        pg8::EpiStore<false> E{(bf16*)(C.ws + WS_QCA), DM, CQ_SCALE, nullptr};
        pg8::gemm_phase<pg8::EpiStore<false>, pg8::StaticOrder, true, true>(C.lds + RING_OFF, g, S, E);
        mini_gemm(C, H + (size_t)MP * DM, (const bf16*)(C.ws + WS_WCQ), DM, (bf16*)(C.ws + WS_QCA) + (size_t)MP * DM, DM, CQ_SCALE);); SEAM(PH_CQ);
    PHASE(PH_CA, ca_phase(C);); SEAM(PH_CA);
    PHASE(PH_CO, pg8::Gemm g{(const bf16*)(C.ws + WS_OMIX), (const bf16*)(C.ws + WS_WCO), MP, DM, DM}; pg8::StaticOrder S; S.init(MP, DM, G, bid);
        pg8::EpiStore<false> E{(bf16*)(C.ws + WS_BR), DM, 1.f, nullptr};
        pg8::gemm_phase<pg8::EpiStore<false>, pg8::StaticOrder, true, true>(C.lds + RING_OFF, g, S, E);
        mini_gemm(C, (const bf16*)(C.ws + WS_OMIX) + (size_t)MP * DM, (const bf16*)(C.ws + WS_WCO), DM, (bf16*)(C.ws + WS_BR) + (size_t)MP * DM, DM, 1.f);); SEAM(PH_CO);
    PHASE(PH_THIN1, p_thin<1>(C);); SEAM(PH_THIN1);
    PHASE(PH_UP, pg8::Gemm g{H, (const bf16*)(C.ws + WS_WUP), MT, DFF2, DM}; pg8::StaticOrder S; S.init(MT, DFF2, G, bid);
        pg8::EpiUpConv E{(bf16*)(C.ws + WS_G), (bf16*)(C.ws + WS_U), C.out, (float*)(C.ws + WS_FIX), (float*)(C.ws + WS_ULAST), (const float*)C.in[I_CONVW], (const float*)C.in[I_CONVB], (LAS float*)(C.lds + XB_OFF)};
        pg8::gemm_phase<pg8::EpiUpConv, pg8::StaticOrder, true, true>(C.lds + RING_OFF, g, S, E);); SEAM(PH_UP);
    PHASE(PH_CONV, p10_convgate(C);); SEAM(PH_CONV);
    PHASE(PH_DOWN, pg8::Gemm g{(const bf16*)(C.ws + WS_G), (const bf16*)(C.ws + WS_WDN), MP, DM, DFF}; pg8::StaticOrder S; S.init(MP, DM, G, bid);
        pg8::EpiStore<false> E{(bf16*)(C.ws + WS_BR), DM, 1.f, nullptr};
        pg8::gemm_phase<pg8::EpiStore<false>, pg8::StaticOrder, true, true>(C.lds + RING_OFF, g, S, E);
        mini_gemm(C, (const bf16*)(C.ws + WS_G) + (size_t)MP * DFF, (const bf16*)(C.ws + WS_WDN), DFF, (bf16*)(C.ws + WS_BR) + (size_t)MP * DM, DM, 1.f);); SEAM(PH_DOWN);
    PHASE(PH_THIN2, p_thin<2>(C););
#undef IN
#undef PHASE
#undef SEAM
}

extern "C" void kernel_launch(void* const* d_in, const int* in_sizes, int n_in, void* d_out, int out_size, void* d_ws, size_t ws_size, hipStream_t stream) {
    static int grid = 0;
    if (grid == 0) {
        if (n_in != N_IN || (size_t)out_size != O_END || ws_size < WS_END) { fprintf(stderr, "kernel_launch: unexpected problem: n_in %d out %d ws %zu\n", n_in, out_size, ws_size); grid = -1; return; }
        int dev = 0, cus = 0, per_cu = 0;
        if (hipGetDevice(&dev) != hipSuccess || hipDeviceGetAttribute(&cus, hipDeviceAttributeMultiprocessorCount, dev) != hipSuccess) { grid = -1; return; }
        if (hipFuncSetAttribute((const void*)fwd, hipFuncAttributeMaxDynamicSharedMemorySize, LDS_BYTES) != hipSuccess) { fprintf(stderr, "kernel_launch: hipFuncSetAttribute failed\n"); grid = -1; return; }
        if (hipOccupancyMaxActiveBlocksPerMultiprocessor(&per_cu, (const void*)fwd, NTHREADS, LDS_BYTES) != hipSuccess || per_cu < 1) fprintf(stderr, "kernel_launch: occupancy query says %d\n", per_cu);
        (void)hipGetLastError();
        grid = cus;
    }
    if (grid < 0) return;
    (void)hipMemsetAsync((char*)d_ws + WS_CTL, 0, CTL_ZERO_BYTES, stream);
    Args a{};
    for (int i = 0; i < N_IN; ++i) a.in[i] = d_in[i];
    a.out = (float*)d_out; a.ws = (unsigned char*)d_ws;
    a.ph_lo = 0; a.ph_hi = NPH;
    hipLaunchKernelGGL(fwd, dim3(grid), dim3(NTHREADS), LDS_BYTES, stream, a);
}
```
